# Optimizing an MI355X kernel written in HIP

```python
import math
import jax, jax.numpy as jnp
from jax import lax
import numpy as np

D_MODEL = 1024
BATCH = 16
SEQ = 256
DEPTH = 2
DEC_BATCH = 2
DEC_SEQ = 2048
PAST_LEN = 256

GRID_W = 64
BR_W = 512
N_BRANCH = 4
N_HEADS = 8
N_KV = 2
HEAD_DIM = 64
Q_PER_KV = N_HEADS // N_KV
WINDOW = 128
BLOCK = 128
ROPE_THETA = 10000.0
NEG_INF = -1e30
CONV_K = 31
POOL_WINDOWS = (2, 4, 8, 16)
POOL_GROUPS = 4
POOL_GW = BR_W // POOL_GROUPS
SSM_CH = 16
SSM_GROUPS = BR_W // SSM_CH
SSM_P = 64
EPS = 1e-6

IN_SIZES = (N_HEADS * HEAD_DIM, N_KV * HEAD_DIM, N_KV * HEAD_DIM, BR_W,
            2 * BR_W, BR_W,
            BR_W, BR_W,
            BR_W, BR_W,
            N_BRANCH * D_MODEL)
IN_COLS = sum(IN_SIZES)

kernel_name = "hybrid_diffusion_prefix_step"

f32 = jnp.float32


def _rmsnorm(x, g):
    xf = x.astype(f32)
    xf = xf * lax.rsqrt(jnp.mean(xf * xf, axis=-1, keepdims=True) + EPS)
    return xf.astype(x.dtype) * g


def _layernorm(x, g, b):
    xf = x.astype(f32)
    mu = jnp.mean(xf, axis=-1, keepdims=True)
    xc = xf - mu
    xn = xc * lax.rsqrt(jnp.mean(xc * xc, axis=-1, keepdims=True) + EPS)
    return xn.astype(x.dtype) * g + b


def _split_cols(u):
    idx, s = [], 0
    for n in IN_SIZES[:-1]:
        s += n
        idx.append(s)
    return jnp.split(u, idx, axis=-1)


def _axial_rope(x):
    L = x.shape[1]
    rows = L // GRID_W
    row = jnp.repeat(jnp.arange(rows, dtype=f32), GRID_W)
    col = jnp.tile(jnp.arange(GRID_W, dtype=f32), rows)
    n_freq = HEAD_DIM // 4
    inv = ROPE_THETA ** (-jnp.arange(n_freq, dtype=f32) / n_freq)
    ang = jnp.concatenate([row[:, None] * inv, col[:, None] * inv], axis=-1)
    shape = (1, L) + (1,) * (x.ndim - 3) + (HEAD_DIM // 2,)
    cos = jnp.cos(ang).reshape(shape)
    sin = jnp.sin(ang).reshape(shape)
    xf = x.astype(f32)
    x1, x2 = xf[..., :HEAD_DIM // 2], xf[..., HEAD_DIM // 2:]
    return jnp.concatenate([x1 * cos - x2 * sin, x1 * sin + x2 * cos], axis=-1).astype(x.dtype)


def _attend(q, kv_groups, sink):
    scale = HEAD_DIM ** -0.5
    scores = []
    for k, v, mask in kv_groups:
        s = jnp.einsum('bqkgd,bskd->bkgqs', q, k).astype(f32) * scale
        if mask is not None:
            s = jnp.where(mask, s, NEG_INF)
        scores.append(s)
    sink_col = jnp.broadcast_to(sink.astype(f32).reshape(N_KV, Q_PER_KV, 1, 1), scores[0].shape[:-1] + (1,))
    p = jax.nn.softmax(jnp.concatenate(scores + [sink_col], axis=-1), axis=-1)
    out, start = None, 0
    for (k, v, _), s in zip(kv_groups, scores):
        n = s.shape[-1]
        o = jnp.einsum('bkgqs,bskd->bqkgd', p[..., start:start + n].astype(v.dtype), v)
        out = o if out is None else out + o
        start += n
    return out


def _context_attention(q, k, v, sink):
    B, S = q.shape[:2]
    nb = S // BLOCK
    qb = q.reshape(B, nb, BLOCK, N_KV, Q_PER_KV, HEAD_DIM).transpose(1, 0, 2, 3, 4, 5)
    out = lax.map(lambda qi: _attend(qi, [(k, v, None)], sink), qb)
    return out.transpose(1, 0, 2, 3, 4, 5).reshape(B, S, N_HEADS * HEAD_DIM)


def _latent_attention(q, k, v, ck, cv, sink):
    B, L = q.shape[:2]
    nb = L // BLOCK
    pad = ((0, 0), (BLOCK, BLOCK), (0, 0), (0, 0))
    kp, vp = jnp.pad(k, pad), jnp.pad(v, pad)

    def block(i):
        q_i = lax.dynamic_slice_in_dim(q, i * BLOCK, BLOCK, axis=1)
        k_i = lax.dynamic_slice_in_dim(kp, i * BLOCK, 3 * BLOCK, axis=1)
        v_i = lax.dynamic_slice_in_dim(vp, i * BLOCK, 3 * BLOCK, axis=1)
        qpos = i * BLOCK + jnp.arange(BLOCK)
        kpos = (i - 1) * BLOCK + jnp.arange(3 * BLOCK)
        mask = (jnp.abs(qpos[:, None] - kpos[None, :]) <= WINDOW) & (kpos >= 0)[None, :] & (kpos < L)[None, :]
        return _attend(q_i, [(ck, cv, None), (k_i, v_i, mask)], sink)

    out = lax.map(block, jnp.arange(nb))
    return out.transpose(1, 0, 2, 3, 4, 5).reshape(B, L, N_HEADS * HEAD_DIM)


def _conformer_conv(a, w_dw, b_dw, ln_g, ln_b):
    x = a[..., :BR_W] * jax.nn.sigmoid(a[..., BR_W:])
    y = lax.conv_general_dilated(x.astype(w_dw.dtype), w_dw[:, None, :], window_strides=(1,),
                                 padding=[(CONV_K // 2, CONV_K // 2)],
                                 dimension_numbers=('NWC', 'WIO', 'NWC'),
                                 feature_group_count=BR_W) + b_dw
    return jax.nn.silu(_layernorm(y, ln_g, ln_b))


def _multiscale_pool(x, w_pool, scale):
    B, L, _ = x.shape
    xg = x.reshape(B, L, POOL_GROUPS, POOL_GW).astype(f32)
    cs = jnp.pad(jnp.cumsum(xg, axis=1), ((0, 0), (1, 0), (0, 0), (0, 0)))
    t = jnp.arange(L)
    pooled = []
    for g, w in enumerate(POOL_WINDOWS):
        lo = jnp.clip(t - w // 2, 0, L)
        hi = jnp.clip(t + w - w // 2, 0, L)
        cnt = (hi - lo).astype(f32)[None, :, None]
        pooled.append((cs[:, hi, g] - cs[:, lo, g]) / cnt)
    d = (jnp.stack(pooled, axis=2) - xg).astype(x.dtype)
    y = jnp.einsum('blgc,gcd->blgd', d, w_pool)
    return y.reshape(B, L, BR_W) * scale


def _lin_combine(e1, e2):
    a1, b1 = e1
    a2, b2 = e2
    return a1 * a2, a2 * b1 + b2


def _diag_scan(xg, lam_bar, b_bar, c_re, c_im, h0):
    bu = lax.complex(jnp.einsum('blgc,gpc->blgp', xg, jnp.real(b_bar)),
                     jnp.einsum('blgc,gpc->blgp', xg, jnp.imag(b_bar)))
    if h0 is not None:
        bu = bu.at[:, 0].add(lam_bar * h0)
    a = jnp.broadcast_to(lam_bar, bu.shape)
    _, h = lax.associative_scan(_lin_combine, (a, bu), axis=1)
    y = jnp.einsum('blgp,gcp->blgc', jnp.real(h), c_re) - jnp.einsum('blgp,gcp->blgc', jnp.imag(h), c_im)
    return y, h[:, -1]


def _ssm_branch(x, p, state):
    B, L, _ = x.shape
    xg = x.astype(f32).reshape(B, L, SSM_GROUPS, SSM_CH)
    y_sum, finals = None, []
    for d in range(2):
        lam = lax.complex(p['lam_re'][d].astype(f32), p['lam_im'][d].astype(f32))
        dt = jnp.exp(p['log_dt'][d].astype(f32))[:, None]
        lam_bar = jnp.exp(lam * dt)
        bmat = lax.complex(p['b_re'][d].astype(f32), p['b_im'][d].astype(f32))
        b_bar = ((lam_bar - 1.0) / lam)[..., None] * bmat
        h0 = None if state is None else lax.complex(state[:, d, 0].astype(f32), state[:, d, 1].astype(f32))
        xd = xg if d == 0 else jnp.flip(xg, axis=1)
        y, h_last = _diag_scan(xd, lam_bar, b_bar, p['c_re'][d].astype(f32), p['c_im'][d].astype(f32), h0)
        if d == 1:
            y = jnp.flip(y, axis=1)
        y_sum = y if y_sum is None else y_sum + y
        finals.append(h_last)
    y = y_sum + p['ssm_d'].astype(f32).reshape(SSM_GROUPS, SSM_CH) * xg
    y = jax.nn.gelu(y.reshape(B, L, BR_W)).astype(x.dtype)
    z = y @ p['glu_w']
    out = z[..., :BR_W] * jax.nn.sigmoid(z[..., BR_W:])
    if state is None:
        packed = jnp.stack([jnp.stack([jnp.real(h), jnp.imag(h)], axis=1) for h in finals], axis=1)
        return out, packed
    return out, None


def _layer(x, mod, p, cache):
    B, L, _ = x.shape
    shift, scale, gate = jnp.split(mod, 3, axis=-1)
    h = _rmsnorm(x, p['norm_g']) * (1.0 + scale) + shift
    u = h @ p['w_in']
    q, k, v, g_att, a_conv, g_conv, x_pool, g_pool, x_ssm, g_ssm, g_mrg = _split_cols(u)
    q = q.reshape(B, L, N_KV, Q_PER_KV, HEAD_DIM)
    k = k.reshape(B, L, N_KV, HEAD_DIM)
    v = v.reshape(B, L, N_KV, HEAD_DIM)
    if cache is None:
        o_att = _context_attention(q, k, v, p['sink'])
        o_ssm, st = _ssm_branch(x_ssm, p, None)
        new = (k, v, st)
    else:
        ck, cv, st0 = cache
        o_att = _latent_attention(_axial_rope(q), _axial_rope(k), v, ck, cv, p['sink'])
        o_ssm, _ = _ssm_branch(x_ssm, p, st0)
        new = None
    o_conv = _conformer_conv(a_conv, p['conv_dw'], p['conv_db'], p['conv_ln_g'], p['conv_ln_b'])
    o_pool = _multiscale_pool(x_pool, p['pool_w'], p['pool_scale'])
    br = jnp.stack([o_att * jax.nn.silu(g_att), o_conv * jax.nn.silu(g_conv),
                    o_pool * jax.nn.silu(g_pool), o_ssm * jax.nn.silu(g_ssm)], axis=2)
    proj = jnp.einsum('blnw,nwd->blnd', br, p['w_br'])
    gates = jax.nn.sigmoid(g_mrg.reshape(B, L, N_BRANCH, D_MODEL))
    merged = jnp.sum(gates * proj, axis=2)
    return x + gate * (merged @ p['w_out']), new


def setup_inputs(seed: int = 0) -> dict:
    key = jax.random.key(seed)
    ks = jax.random.split(key, 32)
    W, G, P, C, D = BR_W, SSM_GROUPS, SSM_P, SSM_CH, D_MODEL

    def nrm(k, shape, s):
        return jax.random.normal(k, shape, f32) * s

    return {
        "x_prompt": nrm(ks[0], (BATCH, SEQ, D), 1.0),
        "x_sample": nrm(ks[1], (DEC_BATCH, DEC_SEQ, D), 1.0),
        "cache_k": nrm(ks[2], (DEC_BATCH, DEPTH, PAST_LEN, N_KV, HEAD_DIM), 1.0),
        "cache_v": nrm(ks[3], (DEC_BATCH, DEPTH, PAST_LEN, N_KV, HEAD_DIM), 1.0),
        "state_ssm": nrm(ks[4], (DEC_BATCH, DEPTH, 2, 2, G, P), 0.3),
        "c": nrm(ks[5], (DEC_BATCH, D), 1.0),
        "c_ctx": nrm(ks[6], (D,), 1.0),
        "norm_g": 1.0 + nrm(ks[7], (DEPTH, D), 0.02),
        "w_ada": nrm(ks[8], (DEPTH, D, 3 * D), 0.5 * D ** -0.5),
        "b_ada": nrm(ks[9], (DEPTH, 3 * D), 0.02),
        "w_in": nrm(ks[10], (DEPTH, D, IN_COLS), D ** -0.5),
        "attn_sink": nrm(ks[11], (DEPTH, N_HEADS), 0.5),
        "conv_dw": nrm(ks[12], (DEPTH, CONV_K, W), CONV_K ** -0.5),
        "conv_db": nrm(ks[13], (DEPTH, W), 0.02),
        "conv_ln_g": 1.0 + nrm(ks[14], (DEPTH, W), 0.02),
        "conv_ln_b": nrm(ks[15], (DEPTH, W), 0.02),
        "pool_w": nrm(ks[16], (DEPTH, POOL_GROUPS, POOL_GW, POOL_GW), POOL_GW ** -0.5),
        "pool_scale": 1.0 + nrm(ks[17], (DEPTH, W), 0.1),
        "ssm_lam_re": -0.5 + nrm(ks[18], (DEPTH, 2, G, P), 0.01),
        "ssm_lam_im": math.pi * jnp.arange(P, dtype=f32) + nrm(ks[19], (DEPTH, 2, G, P), 0.01),
        "ssm_log_dt": jax.random.uniform(ks[20], (DEPTH, 2, G), f32, math.log(1e-3), math.log(1e-1)),
        "ssm_b_re": nrm(ks[21], (DEPTH, 2, G, P, C), (2 * C) ** -0.5),
        "ssm_b_im": nrm(ks[22], (DEPTH, 2, G, P, C), (2 * C) ** -0.5),
        "ssm_c_re": nrm(ks[23], (DEPTH, 2, G, C, P), (2 * P) ** -0.5),
        "ssm_c_im": nrm(ks[24], (DEPTH, 2, G, C, P), (2 * P) ** -0.5),
        "ssm_d": nrm(ks[25], (DEPTH, W), 1.0),
        "ssm_glu_w": nrm(ks[26], (DEPTH, W, 2 * W), W ** -0.5),
        "w_br": nrm(ks[27], (DEPTH, N_BRANCH, W, D), W ** -0.5),
        "w_out": nrm(ks[28], (DEPTH, D, D), D ** -0.5),
        "final_g": 1.0 + nrm(ks[29], (D,), 0.02),
    }


def reference(x_prompt, x_sample, cache_k, cache_v, state_ssm, c, c_ctx, norm_g, w_ada, b_ada, w_in,
              attn_sink, conv_dw, conv_db, conv_ln_g, conv_ln_b, pool_w, pool_scale, ssm_lam_re, ssm_lam_im,
              ssm_log_dt, ssm_b_re, ssm_b_im, ssm_c_re, ssm_c_im, ssm_d, ssm_glu_w, w_br, w_out, final_g):
    xp, xs = x_prompt, x_sample
    new_k, new_v, new_st = [], [], []
    for l in range(DEPTH):
        p = {
            'norm_g': norm_g[l], 'w_in': w_in[l], 'sink': attn_sink[l],
            'conv_dw': conv_dw[l], 'conv_db': conv_db[l], 'conv_ln_g': conv_ln_g[l], 'conv_ln_b': conv_ln_b[l],
            'pool_w': pool_w[l], 'pool_scale': pool_scale[l],
            'lam_re': ssm_lam_re[l], 'lam_im': ssm_lam_im[l], 'log_dt': ssm_log_dt[l],
            'b_re': ssm_b_re[l], 'b_im': ssm_b_im[l], 'c_re': ssm_c_re[l], 'c_im': ssm_c_im[l],
            'ssm_d': ssm_d[l], 'glu_w': ssm_glu_w[l], 'w_br': w_br[l], 'w_out': w_out[l],
        }
        mod_p = (jax.nn.silu(c_ctx) @ w_ada[l] + b_ada[l])[None, None, :]
        mod_s = (jax.nn.silu(c) @ w_ada[l] + b_ada[l])[:, None, :]
        xp, (k_l, v_l, st_l) = _layer(xp, mod_p, p, None)
        new_k.append(k_l)
        new_v.append(v_l)
        new_st.append(st_l)
        xs, _ = _layer(xs, mod_s, p, (cache_k[:, l], cache_v[:, l], state_ssm[:, l]))
    y_prompt = _rmsnorm(xp, final_g)
    y_sample = _rmsnorm(xs, final_g)
    new_cache_k = jnp.stack(new_k, axis=1)
    new_cache_v = jnp.stack(new_v, axis=1)
    new_state_ssm = jnp.stack(new_st, axis=1)
    return (y_prompt, y_sample, new_cache_k, new_cache_v, new_state_ssm)
```

```cpp
#include <hip/hip_runtime.h>
#include <cstring>
#ifdef CPU_EMU
#include <cmath>
#include <cstddef>
#define HD_FN inline
#else
#define HD_FN __host__ __device__ __forceinline__
#endif

namespace nv {
#ifndef CFG_BATCH
#define CFG_BATCH 16
#endif
#ifndef CFG_DEC_BATCH
#define CFG_DEC_BATCH 2
#endif
constexpr int D = 1024, BATCH = CFG_BATCH, SEQ = 256, DEPTH = 2, DEC_BATCH = CFG_DEC_BATCH, DEC_SEQ = 2048, PAST = 256;
constexpr int GRID_W = 64, BRW = 512, NH = 8, NKV = 2, HDIM = 64, WINDOW = 128, CONVK = 31;
constexpr int SG = 32, SC = 16, SP = 64, INC = 8960;
constexpr int C_Q = 0, C_K = 512, C_V = 640, C_GATT = 768, C_ACONV = 1280, C_GCONV = 2304, C_XPOOL = 2816, C_GPOOL = 3328, C_XSSM = 3840, C_GSSM = 4352, C_GMRG = 4864;
constexpr float EPS = 1e-6f;

HD_FN float sigmoidf_(float x) { return 1.0f / (1.0f + expf(-x)); }
HD_FN float siluf_(float x) { return x * sigmoidf_(x); }
HD_FN float geluf_(float x) { return 0.5f * x * (1.0f + tanhf(0.7978845608028654f * (x + 0.044715f * x * x * x))); }

struct In {
    const float *x_prompt, *x_sample, *cache_k, *cache_v, *state_ssm, *c, *c_ctx, *norm_g, *w_ada, *b_ada, *w_in, *attn_sink, *conv_dw, *conv_db,
        *conv_ln_g, *conv_ln_b, *pool_w, *pool_scale, *lam_re, *lam_im, *log_dt, *b_re, *b_im, *c_re, *c_im, *ssm_d, *glu_w, *w_br, *w_out, *final_g;
};
struct Chunk {
    int path;
    int seq0;
    int nseq, L;
    int layer, pad0;
    const float* x_in;
    float* x_out;
};
struct Buf {
    float *mod;
    float *ropec, *ropes;
    float *lamb;
    float *bbar;
    float *h;
    float *u;
    float *qr, *kr;
    float *oatt, *yconv, *dpool, *yssm;
    float *S;
    float *br;
    float *merged;
};

struct StMod { In in; Buf b;
    HD_FN void operator()(long i) const { int n = i % 3072; int j = (i / 3072) % 3; int l = i / (3 * 3072);
        if (j >= 1 + DEC_BATCH) { b.mod[i] = 0.f; return; }
        const float* cv = j == 0 ? in.c_ctx : in.c + (size_t)(j - 1) * D; const float* w = in.w_ada + (size_t)l * D * 3072;
        float acc = 0.f; for (int k = 0; k < D; ++k) acc += siluf_(cv[k]) * w[(size_t)k * 3072 + n];
        b.mod[i] = acc + in.b_ada[l * 3072 + n]; } };
struct StRope { Buf b;
    HD_FN void operator()(long i) const { int j = i % 32, t = i / 32; float row = (float)(t / GRID_W), col = (float)(t % GRID_W);
        float inv = powf(10000.0f, -(float)(j % 16) / 16.0f); float ang = (j < 16 ? row : col) * inv; b.ropec[i] = cosf(ang); b.ropes[i] = sinf(ang); } };
struct StSsmParam { In in; Buf b;
    HD_FN void operator()(long i) const { int g = (i / SP) % SG; long ld = i / (SP * SG);
        float lr = in.lam_re[i], li = in.lam_im[i]; float dt = expf(in.log_dt[ld * SG + g]);
        float e = expf(lr * dt), br_ = e * cosf(li * dt), bi_ = e * sinf(li * dt); b.lamb[2 * i] = br_; b.lamb[2 * i + 1] = bi_;
        float nr = br_ - 1.0f, ni = bi_; float den = lr * lr + li * li; float fr = (nr * lr + ni * li) / den, fi = (ni * lr - nr * li) / den;
        for (int c = 0; c < SC; ++c) { float xr = in.b_re[i * SC + c], xi = in.b_im[i * SC + c];
            b.bbar[(i * SC + c) * 2] = fr * xr - fi * xi; b.bbar[(i * SC + c) * 2 + 1] = fr * xi + fi * xr; } } };

HD_FN int modj(const Chunk& c, int tl) { return c.path == 0 ? 0 : 1 + c.seq0 + tl / c.L; }
struct StH { In in; Buf b; Chunk c;
    HD_FN void operator()(long tl) const { const float* x = c.x_in + (size_t)tl * D; float ss = 0.f; for (int k = 0; k < D; ++k) ss += x[k] * x[k];
        float r = 1.0f / sqrtf(ss / D + EPS); const float* m = b.mod + ((size_t)c.layer * 3 + modj(c, tl)) * 3072; const float* g = in.norm_g + c.layer * D;
        for (int k = 0; k < D; ++k) b.h[(size_t)tl * D + k] = (x[k] * r) * g[k] * (1.0f + m[1024 + k]) + m[k]; } };
struct StGemm { const float* A; const float* B; float* C; int lda, ldb, ldc, N, K, pad;
    HD_FN void operator()(long i) const { int n = i % N; long m = i / N; const float* a = A + (size_t)m * lda; float acc = 0.f;
        for (int k = 0; k < K; ++k) acc += a[k] * B[(size_t)k * ldb + n]; C[(size_t)m * ldc + n] = acc; } };
struct StQK { In in; Buf b; Chunk c; float* out_k; float* out_v;
    HD_FN void operator()(long i) const { int col = i % 768; int tl = i / 768; int t = tl % c.L; const float* u = b.u + (size_t)tl * INC;
        if (col < 640) { int d = col % 64; float v;
            if (c.path == 1) { int j = d % 32; float cs = b.ropec[t * 32 + j], sn = b.ropes[t * 32 + j]; float x1 = u[col - d + j], x2 = u[col - d + 32 + j];
                v = d < 32 ? x1 * cs - x2 * sn : x1 * sn + x2 * cs; } else v = u[col];
            if (col < 512) b.qr[(size_t)tl * 512 + col] = v; else b.kr[(size_t)tl * 128 + col - 512] = v; }
        if (c.path == 0 && col >= 512) { int bb = c.seq0 + tl / c.L; size_t o = (((size_t)bb * DEPTH + c.layer) * SEQ + t) * 128;
            if (col < 640) out_k[o + col - 512] = u[col]; else out_v[o + col - 640] = u[col]; } } };
struct StAttn { In in; Buf b; Chunk c;
    HD_FN void operator()(long i) const { int dp = i % 4, hh = (i / 4) % 8; int tl = i / 32; int s = tl / c.L, t = tl % c.L; int kv = hh / 4;
        const float* q = b.qr + (size_t)tl * 512 + hh * 64; const float sink = in.attn_sink[c.layer * NH + hh];
        const int bb = c.seq0 + s;
        const float* ck = in.cache_k + (((size_t)bb * DEPTH + c.layer) * PAST) * 128 + kv * 64; const float* cvp = in.cache_v + (((size_t)bb * DEPTH + c.layer) * PAST) * 128 + kv * 64;
        int lo, hi; if (c.path == 0) { lo = 0; hi = c.L - 1; } else { lo = t - WINDOW < 0 ? 0 : t - WINDOW; hi = t + WINDOW > c.L - 1 ? c.L - 1 : t + WINDOW; }
        const int nctx = c.path == 1 ? PAST : 0;
        float mx = sink;
        for (int pass = 0; pass < 2; ++pass) {
            float den = 0.f, acc[16]; for (int d = 0; d < 16; ++d) acc[d] = 0.f;
            for (int kk = 0; kk < nctx + (hi - lo + 1); ++kk) {
                const float *kp, *vp;
                if (kk < nctx) { kp = ck + (size_t)kk * 128; vp = cvp + (size_t)kk * 128; }
                else { int tk = s * c.L + lo + (kk - nctx); kp = b.kr + (size_t)tk * 128 + kv * 64; vp = b.u + (size_t)tk * INC + C_V + kv * 64; }
                float sc = 0.f; for (int d = 0; d < 64; ++d) sc += q[d] * kp[d]; sc *= 0.125f;
                if (pass == 0) { mx = sc > mx ? sc : mx; }
                else { float p = expf(sc - mx); den += p; for (int d = 0; d < 16; ++d) acc[d] += p * vp[dp * 16 + d]; }
            }
            if (pass == 1) { den += expf(sink - mx); for (int d = 0; d < 16; ++d) b.oatt[(size_t)tl * 512 + hh * 64 + dp * 16 + d] = acc[d] / den; }
        } } };
struct StConv { In in; Buf b; Chunk c;
    HD_FN void operator()(long i) const { int ch = i % 512; int tl = i / 512; int s = tl / c.L, t = tl % c.L; float acc = in.conv_db[c.layer * 512 + ch];
        for (int j = 0; j < CONVK; ++j) { int tt = t + j - CONVK / 2; if (tt < 0 || tt >= c.L) continue; const float* u = b.u + (size_t)(s * c.L + tt) * INC + C_ACONV;
            acc += u[ch] * sigmoidf_(u[512 + ch]) * in.conv_dw[((size_t)c.layer * CONVK + j) * 512 + ch]; }
        b.yconv[i] = acc; } };
struct StConvLn { In in; Buf b; Chunk c;
    HD_FN void operator()(long tl) const { const float* y = b.yconv + (size_t)tl * 512; float mu = 0.f; for (int k = 0; k < 512; ++k) mu += y[k]; mu /= 512.f;
        float var = 0.f; for (int k = 0; k < 512; ++k) { float d = y[k] - mu; var += d * d; } float r = 1.0f / sqrtf(var / 512.f + EPS);
        for (int k = 0; k < 512; ++k) { float o = siluf_((y[k] - mu) * r * in.conv_ln_g[c.layer * 512 + k] + in.conv_ln_b[c.layer * 512 + k]);
            b.br[((size_t)tl * 4 + 1) * 512 + k] = o * siluf_(b.u[(size_t)tl * INC + C_GCONV + k]); } } };
struct StPoolD { Buf b; Chunk c;
    HD_FN void operator()(long i) const { int ch = i % 512; int tl = i / 512; int s = tl / c.L, t = tl % c.L; int w = 2 << (ch / 128);
        int lo = t - w / 2 < 0 ? 0 : t - w / 2, hi = t + w / 2 > c.L ? c.L : t + w / 2; float sum = 0.f;
        for (int tt = lo; tt < hi; ++tt) sum += b.u[(size_t)(s * c.L + tt) * INC + C_XPOOL + ch];
        b.dpool[i] = sum / (float)(hi - lo) - b.u[(size_t)tl * INC + C_XPOOL + ch]; } };
struct StPoolMM { In in; Buf b; Chunk c;
    HD_FN void operator()(long i) const { int co = i % 512; int tl = i / 512; int g = co / 128; const float* w = in.pool_w + ((size_t)c.layer * 4 + g) * 128 * 128 + (co % 128);
        const float* d = b.dpool + (size_t)tl * 512 + g * 128; float acc = 0.f; for (int ci = 0; ci < 128; ++ci) acc += d[ci] * w[(size_t)ci * 128];
        b.br[((size_t)tl * 4 + 2) * 512 + co] = acc * in.pool_scale[c.layer * 512 + co] * siluf_(b.u[(size_t)tl * INC + C_GPOOL + co]); } };
struct StSsmBu { Buf b; Chunk c; int dir, pad;
    HD_FN void operator()(long i) const { int p = i % SP, g = (i / SP) % SG; int tl = i / (SP * SG); const float* x = b.u + (size_t)tl * INC + C_XSSM + g * SC;
        const float* bb = b.bbar + ((((size_t)c.layer * 2 + dir) * SG + g) * SP + p) * SC * 2; float ar = 0.f, ai = 0.f;
        for (int k = 0; k < SC; ++k) { ar += x[k] * bb[2 * k]; ai += x[k] * bb[2 * k + 1]; } b.S[2 * i] = ar; b.S[2 * i + 1] = ai; } };
struct StSsmScan { In in; Buf b; Chunk c; float* out_state; int dir, pad;
    HD_FN void operator()(long i) const { int p = i % SP, g = (i / SP) % SG; int s = i / (SP * SG); int bb = c.seq0 + s;
        const float* lb = b.lamb + ((((size_t)c.layer * 2 + dir) * SG + g) * SP + p) * 2; float lr = lb[0], li = lb[1]; float hr = 0.f, hi = 0.f;
        if (c.path == 1) { const float* st = in.state_ssm + ((((size_t)bb * DEPTH + c.layer) * 2 + dir) * 2) * SG * SP + g * SP + p; hr = st[0]; hi = st[SG * SP]; }
        for (int k = 0; k < c.L; ++k) { int t = dir == 0 ? k : c.L - 1 - k; float* S = b.S + (((size_t)(s * c.L + t) * SG + g) * SP + p) * 2;
            float nr = lr * hr - li * hi + S[0], ni = lr * hi + li * hr + S[1]; hr = nr; hi = ni; S[0] = hr; S[1] = hi; }
        if (c.path == 0) { float* o = out_state + ((((size_t)bb * DEPTH + c.layer) * 2 + dir) * 2) * SG * SP + g * SP + p; o[0] = hr; o[SG * SP] = hi; } } };
struct StSsmY { In in; Buf b; Chunk c; int dir, pad;
    HD_FN void operator()(long i) const { int gc = i % 512; int tl = i / 512; int g = gc / SC, ch = gc % SC; const float* S = b.S + ((size_t)tl * SG + g) * SP * 2;
        const float* cr = in.c_re + ((((size_t)c.layer * 2 + dir) * SG + g) * SC + ch) * SP; const float* ci = in.c_im + ((((size_t)c.layer * 2 + dir) * SG + g) * SC + ch) * SP;
        float acc = 0.f; for (int p = 0; p < SP; ++p) acc += S[2 * p] * cr[p] - S[2 * p + 1] * ci[p];
        if (dir == 0) b.yssm[i] = acc + in.ssm_d[c.layer * 512 + gc] * b.u[(size_t)tl * INC + C_XSSM + gc]; else b.yssm[i] = geluf_(b.yssm[i] + acc); } };
struct StSsmGlu { Buf b; Chunk c;
    HD_FN void operator()(long i) const { int ch = i % 512; int tl = i / 512; const float* z = b.h + (size_t)tl * 1024;
        b.br[((size_t)tl * 4 + 3) * 512 + ch] = z[ch] * sigmoidf_(z[512 + ch]) * siluf_(b.u[(size_t)tl * INC + C_GSSM + ch]); } };
struct StAttBr { Buf b; Chunk c;
    HD_FN void operator()(long i) const { int ch = i % 512; int tl = i / 512; b.br[((size_t)tl * 4 + 0) * 512 + ch] = b.oatt[i] * siluf_(b.u[(size_t)tl * INC + C_GATT + ch]); } };
struct StMerge { In in; Buf b; Chunk c;
    HD_FN void operator()(long i) const { int dc = i % 1024; int tl = i / 1024; float m = 0.f;
        for (int n = 0; n < 4; ++n) { const float* a = b.br + ((size_t)tl * 4 + n) * 512; const float* w = in.w_br + (((size_t)c.layer * 4 + n) * 512) * 1024 + dc; float acc = 0.f;
            for (int k = 0; k < 512; ++k) acc += a[k] * w[(size_t)k * 1024]; m += sigmoidf_(b.u[(size_t)tl * INC + C_GMRG + n * 1024 + dc]) * acc; }
        b.merged[i] = m; } };
struct StOut { In in; Buf b; Chunk c;
    HD_FN void operator()(long i) const { int dc = i % 1024; int tl = i / 1024; const float* a = b.merged + (size_t)tl * 1024; const float* w = in.w_out + (size_t)c.layer * 1024 * 1024 + dc; float acc = 0.f;
        for (int k = 0; k < 1024; ++k) acc += a[k] * w[(size_t)k * 1024];
        float gate = b.mod[((size_t)c.layer * 3 + modj(c, tl)) * 3072 + 2048 + dc]; c.x_out[i] = c.x_in[i] + gate * acc; } };
struct StFinal { In in; const float* x; float* y;
    HD_FN void operator()(long tl) const { const float* xr = x + (size_t)tl * D; float ss = 0.f; for (int k = 0; k < D; ++k) ss += xr[k] * xr[k]; float r = 1.0f / sqrtf(ss / D + EPS);
        for (int k = 0; k < D; ++k) y[(size_t)tl * D + k] = xr[k] * r * in.final_g[k]; } };

constexpr size_t OUT_YP = 0, OUT_YS = OUT_YP + (size_t)BATCH * SEQ * D, OUT_K = OUT_YS + (size_t)DEC_BATCH * DEC_SEQ * D,
                 OUT_V = OUT_K + (size_t)BATCH * DEPTH * SEQ * 128, OUT_ST = OUT_V + (size_t)BATCH * DEPTH * SEQ * 128, OUT_TOTAL = OUT_ST + (size_t)BATCH * DEPTH * 2 * 2 * SG * SP;

template <class Runner> inline void forward(const In& in, float* out, float* ws, Runner& R) {
    Buf b{}; float* p = ws; auto take = [&](size_t n) { float* r = p; p += (n + 63) / 64 * 64; return r; };
    b.mod = take((size_t)DEPTH * 3 * 3072); b.ropec = take(2048 * 32); b.ropes = take(2048 * 32); b.lamb = take((size_t)DEPTH * 2 * SG * SP * 2); b.bbar = take((size_t)DEPTH * 2 * SG * SP * SC * 2);
    b.h = take((size_t)2048 * 1024); b.u = take((size_t)2048 * INC); b.qr = take((size_t)2048 * 512); b.kr = take((size_t)2048 * 128);
    b.oatt = take((size_t)2048 * 512); b.yconv = take((size_t)2048 * 512); b.dpool = take((size_t)2048 * 512); b.yssm = take((size_t)2048 * 512);
    b.S = take((size_t)2048 * SG * SP * 2); b.br = take((size_t)2048 * 4 * 512); b.merged = take((size_t)2048 * 1024);
    float* x1p = take((size_t)BATCH * SEQ * D); float* x1s = take((size_t)DEC_BATCH * DEC_SEQ * D);
    R(StMod{in, b}, (long)DEPTH * 3 * 3072); R(StRope{b}, 2048 * 32); R(StSsmParam{in, b}, (long)DEPTH * 2 * SG * SP);
    for (int l = 0; l < DEPTH; ++l) {
        for (int path = 0; path < 2; ++path) {
            const int nseq_tot = path == 0 ? BATCH : DEC_BATCH, L = path == 0 ? SEQ : DEC_SEQ, per = 2048 / L;
            const float* xin = l == 0 ? (path == 0 ? in.x_prompt : in.x_sample) : (path == 0 ? x1p : x1s);
            float* xout = l == 0 ? (path == 0 ? x1p : x1s) : out + (path == 0 ? OUT_YP : OUT_YS);
            for (int s0 = 0; s0 < nseq_tot; s0 += per) {
                Chunk c{}; c.path = path; c.seq0 = s0; c.nseq = (nseq_tot - s0) < per ? (nseq_tot - s0) : per; c.L = L; c.layer = l;
                c.x_in = xin + (size_t)s0 * L * D; c.x_out = xout + (size_t)s0 * L * D; const long T = (long)c.nseq * L;
                R(StH{in, b, c}, T);
                R(StGemm{b.h, in.w_in + (size_t)l * D * INC, b.u, 1024, INC, INC, INC, 1024, 0}, T * INC);
                R(StQK{in, b, c, out + OUT_K, out + OUT_V}, T * 768);
                R(StAttn{in, b, c}, T * 32);
                R(StAttBr{b, c}, T * 512);
                R(StConv{in, b, c}, T * 512); R(StConvLn{in, b, c}, T);
                R(StPoolD{b, c}, T * 512); R(StPoolMM{in, b, c}, T * 512);
                for (int dir = 0; dir < 2; ++dir) { R(StSsmBu{b, c, dir, 0}, T * SG * SP); R(StSsmScan{in, b, c, out + OUT_ST, dir, 0}, (long)c.nseq * SG * SP); R(StSsmY{in, b, c, dir, 0}, T * 512); }
                R(StGemm{b.yssm, in.glu_w + (size_t)l * 512 * 1024, b.h, 512, 1024, 1024, 1024, 512, 0}, T * 1024);
                R(StSsmGlu{b, c}, T * 512);
                R(StMerge{in, b, c}, T * 1024);
                R(StOut{in, b, c}, T * 1024);
            }
        }
    }
    R(StFinal{in, out + OUT_YP, out + OUT_YP}, (long)BATCH * SEQ); R(StFinal{in, out + OUT_YS, out + OUT_YS}, (long)DEC_BATCH * DEC_SEQ);
}
}
template <class F> __global__ void __launch_bounds__(256) nv_run_k(F f, long n) {
    for (long i = (long)blockIdx.x * blockDim.x + threadIdx.x; i < n; i += (long)gridDim.x * blockDim.x) f(i);
}
struct GpuRunner { hipStream_t s; template <class F> void operator()(const F& f, long n) {
    long blocks = (n + 255) / 256; if (blocks > 8192) blocks = 8192; if (blocks < 1) blocks = 1;
    nv_run_k<F><<<dim3((unsigned)blocks), dim3(256), 0, s>>>(f, n); } };
extern "C" void kernel_launch(void* const* d_in, const int* in_sizes, int n_in, void* d_out, int out_size, void* d_ws, size_t ws_size, hipStream_t stream) {
    nv::In in; const float* ptr[30]; for (int i = 0; i < 30; ++i) ptr[i] = (const float*)d_in[i]; memcpy(&in, ptr, sizeof(in));
    GpuRunner R{stream}; nv::forward(in, (float*)d_out, (float*)d_ws, R);
}
```

```cpp
#include <hip/hip_runtime.h>
#include <cstdio>
#include <cstring>
#include <cstdint>
#ifdef CPU_EMU
#include <cmath>
#include <cstddef>
#include <cstring>
#define HD_FN inline
#else
#define HD_FN __host__ __device__ __forceinline__
#endif

namespace g2 {
typedef unsigned short bf16_t;
#ifndef CFG_BATCH
#define CFG_BATCH 16
#endif
#ifndef CFG_DEC_BATCH
#define CFG_DEC_BATCH 2
#endif
constexpr int D = 1024, DEPTH = 2, NB_P = CFG_BATCH, L_P = 256, NB_S = CFG_DEC_BATCH, L_S = 2048, PAST = 256;
constexpr int MP = NB_P * L_P, MS = NB_S * L_S, M = MP + MS;
constexpr int GRID_W = 64, NH = 8, WINDOW = 128, CONVK = 31, SG = 32, SC = 16, SP = 64, INC = 8960, NT1 = INC / 256;
constexpr int C_XPOOL = 2816;
constexpr float EPS = 1e-6f;

HD_FN bf16_t f2bf(float f) { unsigned u; memcpy(&u, &f, 4); u = (u + 0x7fffu + ((u >> 16) & 1u)) >> 16; return (bf16_t)u; }
HD_FN float bf2f(bf16_t h) { unsigned u = (unsigned)h << 16; float f; memcpy(&f, &u, 4); return f; }
HD_FN float sigmoidf_(float x) { return 1.0f / (1.0f + expf(-x)); }
HD_FN float siluf_(float x) { return x * sigmoidf_(x); }
HD_FN float geluf_(float x) { return 0.5f * x * (1.0f + tanhf(0.7978845608028654f * (x + 0.044715f * x * x * x))); }

HD_FN int row_path(int m) { return m >= MP; }
HD_FN int row_len(int m) { return m >= MP ? L_S : L_P; }
HD_FN int row_seq0(int m) { return m >= MP ? MP + ((m - MP) / L_S) * L_S : (m / L_P) * L_P; }
HD_FN int row_batch(int m) { return m >= MP ? (m - MP) / L_S : m / L_P; }
HD_FN int row_modj(int m) { return m >= MP ? 1 + (m - MP) / L_S : 0; }

struct In {
    const float *x_prompt, *x_sample, *cache_k, *cache_v, *state_ssm, *c, *c_ctx, *norm_g, *w_ada, *b_ada, *w_in, *attn_sink, *conv_dw, *conv_db,
        *conv_ln_g, *conv_ln_b, *pool_w, *pool_scale, *lam_re, *lam_im, *log_dt, *b_re, *b_im, *c_re, *c_im, *ssm_d, *glu_w, *w_br, *w_out, *final_g;
};
#ifdef CPU_EMU
typedef const In* InP;
#else
typedef const __attribute__((address_space(4))) In* InP;
#endif
constexpr size_t OUT_YP = 0, OUT_YS = (size_t)MP * D, OUT_K = (size_t)M * D, OUT_V = OUT_K + (size_t)NB_P * DEPTH * L_P * 128, OUT_ST = OUT_V + (size_t)NB_P * DEPTH * L_P * 128,
                 OUT_TOTAL = OUT_ST + (size_t)NB_P * DEPTH * 2 * 2 * SG * SP;

constexpr size_t MiB = 1u << 20;
constexpr size_t WS_CTL = 0;
constexpr size_t WS_MOD = 1 * MiB;
constexpr size_t WS_ROPE = WS_MOD + 128 * 1024;
constexpr size_t WS_LAMB = WS_ROPE + 512 * 1024;
constexpr size_t WS_BBAR = WS_LAMB + 64 * 1024;
constexpr size_t WS_WIN = 4 * MiB;
constexpr size_t WS_WGLU = WS_WIN + (size_t)2 * INC * 1024 * 2;
constexpr size_t WS_WBR = WS_WGLU + 2 * MiB;
constexpr size_t WS_WOUT = WS_WBR + 8 * MiB;
constexpr size_t WS_H = WS_WOUT + 4 * MiB;
constexpr size_t WS_Q = WS_H + 16 * MiB;
constexpr size_t WS_XC = WS_Q + 8 * MiB;
constexpr size_t WS_MRGP = WS_H;
constexpr size_t WS_XP = WS_XC + 8 * MiB;
constexpr size_t WS_XS = WS_XP + 8 * MiB;
constexpr size_t WS_K = WS_XS + 8 * MiB;
constexpr size_t WS_V = WS_K + 2 * MiB;
constexpr size_t WS_GATE = WS_V + 2 * MiB;
constexpr size_t WS_GM = WS_GATE + 32 * MiB;
constexpr size_t WS_YS = WS_GM + 64 * MiB;
constexpr size_t WS_MRG = WS_YS + 8 * MiB;
constexpr size_t WS_TMP = WS_MRG + 16 * MiB;
constexpr size_t WS_S = WS_TMP + 16 * MiB;
constexpr size_t WS_END = WS_S + 32 * MiB;
static_assert(WS_END <= 293601280ull, "workspace map exceeds the guaranteed d_ws size");

struct W {
    unsigned char* ws; float* out;
    HD_FN unsigned* ctl() const { return (unsigned*)(ws + WS_CTL); }
    HD_FN float* mod() const { return (float*)(ws + WS_MOD); }
    HD_FN float* ropec() const { return (float*)(ws + WS_ROPE); }
    HD_FN float* ropes() const { return (float*)(ws + WS_ROPE) + 2048 * 32; }
    HD_FN float* lamb() const { return (float*)(ws + WS_LAMB); }
    HD_FN float* bbar() const { return (float*)(ws + WS_BBAR); }
    HD_FN bf16_t* win() const { return (bf16_t*)(ws + WS_WIN); }
    HD_FN bf16_t* wglu() const { return (bf16_t*)(ws + WS_WGLU); }
    HD_FN bf16_t* wbr() const { return (bf16_t*)(ws + WS_WBR); }
    HD_FN bf16_t* wout() const { return (bf16_t*)(ws + WS_WOUT); }
    HD_FN bf16_t* H() const { return (bf16_t*)(ws + WS_H); }
    HD_FN bf16_t* Q() const { return (bf16_t*)(ws + WS_Q); }
    HD_FN bf16_t* XC() const { return (bf16_t*)(ws + WS_XC); }
    HD_FN bf16_t* XP() const { return (bf16_t*)(ws + WS_XP); }
    HD_FN bf16_t* XS() const { return (bf16_t*)(ws + WS_XS); }
    HD_FN bf16_t* K() const { return (bf16_t*)(ws + WS_K); }
    HD_FN bf16_t* V() const { return (bf16_t*)(ws + WS_V); }
    HD_FN bf16_t* GATE() const { return (bf16_t*)(ws + WS_GATE); }
    HD_FN bf16_t* GM() const { return (bf16_t*)(ws + WS_GM); }
    HD_FN bf16_t* YS() const { return (bf16_t*)(ws + WS_YS); }
    HD_FN bf16_t* MRG() const { return (bf16_t*)(ws + WS_MRG); }
    HD_FN float* MRGP() const { return (float*)(ws + WS_MRGP); }
    HD_FN float* TMP() const { return (float*)(ws + WS_TMP); }
    HD_FN float* S() const { return (float*)(ws + WS_S); }
};
HD_FN W make_w(unsigned char* ws, float* out) { W w{}; w.ws = ws; w.out = out; return w; }

HD_FN const float* xrow(InP in, const W& w, int l, int m) { return l == 0 ? (m < MP ? in->x_prompt + (size_t)m * D : in->x_sample + (size_t)(m - MP) * D) : w.out + (size_t)m * D; }

HD_FN int in_orig_col(int row) { const int pn = row >> 8, c = row & 255, bj = c >> 7, cc = c & 127;
    if (pn < 2) return (pn * 4 + (cc >> 5)) * 64 + bj * 32 + (cc & 31);
    if (pn == 2) return cc < 64 ? 512 + (cc >> 5) * 64 + bj * 32 + (cc & 31) : 640 + bj * 64 + (cc - 64);
    if (pn < 5) return 768 + (pn - 3) * 256 + c;
    if (pn < 9) return 1280 + bj * 512 + (pn - 5) * 128 + cc;
    if (pn < 11) return 2304 + (pn - 9) * 256 + c;
    if (pn < 13) return 2816 + (pn - 11) * 256 + c;
    if (pn < 15) return 3328 + (pn - 13) * 256 + c;
    if (pn < 17) return 3840 + (pn - 15) * 256 + c;
    if (pn < 19) return 4352 + (pn - 17) * 256 + c;
    return 4864 + (pn - 19) * 256 + c; }
HD_FN int glu_orig_col(int row) { const int pn = row >> 8, c = row & 255, bj = c >> 7, cc = c & 127; return bj * 512 + pn * 128 + cc; }

struct FMod { InP in; W w;
    HD_FN void operator()(long i) const { int n = i % 3072; int j = (i / 3072) % 3; int l = i / (3 * 3072);
        const float* cv = j == 0 ? in->c_ctx : in->c + (size_t)(j - 1) * D; const float* wa = in->w_ada + (size_t)l * D * 3072;
        float acc = 0.f; for (int k = 0; k < D; ++k) acc += siluf_(cv[k]) * wa[(size_t)k * 3072 + n];
        w.mod()[i] = acc + in->b_ada[l * 3072 + n]; } };
struct FRope { W w;
    HD_FN void operator()(long i) const { int j = i % 32, t = i / 32; float row = (float)(t / GRID_W), col = (float)(t % GRID_W);
        float inv = powf(10000.0f, -(float)(j % 16) / 16.0f); float ang = (j < 16 ? row : col) * inv; w.ropec()[i] = cosf(ang); w.ropes()[i] = sinf(ang); } };
struct FSsmParam { InP in; W w;
    HD_FN void operator()(long i) const { int g = (i / SP) % SG; long ld = i / (SP * SG);
        float lr = in->lam_re[i], li = in->lam_im[i]; float dt = expf(in->log_dt[ld * SG + g]);
        float e = expf(lr * dt), br_ = e * cosf(li * dt), bi_ = e * sinf(li * dt); w.lamb()[2 * i] = br_; w.lamb()[2 * i + 1] = bi_;
        float nr = br_ - 1.0f, ni = bi_; float den = lr * lr + li * li; float fr = (nr * lr + ni * li) / den, fi = (ni * lr - nr * li) / den;
        for (int c = 0; c < SC; ++c) { float xr = in->b_re[i * SC + c], xi = in->b_im[i * SC + c];
            w.bbar()[(i * SC + c) * 2] = fr * xr - fi * xi; w.bbar()[(i * SC + c) * 2 + 1] = fr * xi + fi * xr; } } };
struct FCvtIn { InP in; W w;
    HD_FN void operator()(long i) const { int k = i % 1024; int row = (i / 1024) % INC; int l = i / ((long)INC * 1024); const int oc = in_orig_col(row);
        const float* src = in->w_in + ((size_t)l * D + k) * INC; float v;
        if (oc >= C_XPOOL && oc < C_XPOOL + 512) { const int g = (oc - C_XPOOL) >> 7, co = (oc - C_XPOOL) & 127; const float* pw = in->pool_w + ((size_t)l * 4 + g) * 128 * 128 + co; const float* s = src + C_XPOOL + g * 128;
            float acc = 0.f; for (int ci = 0; ci < 128; ++ci) acc += s[ci] * pw[(size_t)ci * 128]; v = acc * in->pool_scale[l * 512 + g * 128 + co]; }
        else v = src[oc];
        w.win()[i] = f2bf(v); } };
struct FCvtGlu { InP in; W w;
    HD_FN void operator()(long i) const { int k = i % 512; int row = (i / 512) % 1024; int l = i / (512 * 1024); w.wglu()[i] = f2bf(in->glu_w[((size_t)l * 512 + k) * 1024 + glu_orig_col(row)]); } };
struct FCvtBr { InP in; W w;
    HD_FN void operator()(long i) const { int k = i % 512; int d = (i / 512) % 1024; int ln = i / (512 * 1024); w.wbr()[i] = f2bf(in->w_br[((size_t)ln * 512 + k) * 1024 + d]); } };
struct FCvtOut { InP in; W w;
    HD_FN void operator()(long i) const { int k = i % 1024; int d = (i / 1024) % 1024; int l = i / (1024 * 1024); w.wout()[i] = f2bf(in->w_out[((size_t)l * 1024 + k) * 1024 + d]); } };

struct FH { InP in; W w; int l, pad;
    HD_FN void operator()(long m) const { const float* x = xrow(in, w, l, (int)m); float ss = 0.f; for (int k = 0; k < D; ++k) ss += x[k] * x[k];
        float r = 1.0f / sqrtf(ss / D + EPS); const float* mo = w.mod() + ((size_t)l * 3 + row_modj((int)m)) * 3072; const float* g = in->norm_g + l * D;
        for (int k = 0; k < D; ++k) w.H()[(size_t)m * D + k] = f2bf((x[k] * r) * g[k] * (1.0f + mo[1024 + k]) + mo[k]); } };

HD_FN void epi1(const W& w, int l, int m, int pn, int cc, float a0, float a1) {
    if (pn <= 2) { const bool smp = m >= MP; const int t = m - row_seq0(m);
        if (pn < 2 || cc < 64) { const int j = cc & 31; float o1 = a0, o2 = a1;
            if (smp) { const float cs = w.ropec()[t * 32 + j], sn = w.ropes()[t * 32 + j]; o1 = a0 * cs - a1 * sn; o2 = a0 * sn + a1 * cs; }
            if (pn < 2) { const int h = pn * 4 + (cc >> 5); w.Q()[(size_t)m * 512 + h * 64 + j] = f2bf(o1); w.Q()[(size_t)m * 512 + h * 64 + 32 + j] = f2bf(o2); }
            else { const int kv = cc >> 5; w.K()[(size_t)m * 128 + kv * 64 + j] = f2bf(o1); w.K()[(size_t)m * 128 + kv * 64 + 32 + j] = f2bf(o2);
                if (!smp) { float* o = w.out + OUT_K + (((size_t)row_batch(m) * DEPTH + l) * L_P + t) * 128 + kv * 64 + j; o[0] = a0; o[32] = a1; } } }
        else { const int c2 = cc - 64; w.V()[(size_t)m * 128 + c2] = f2bf(a0); w.V()[(size_t)m * 128 + 64 + c2] = f2bf(a1);
            if (!smp) { float* o = w.out + OUT_V + (((size_t)row_batch(m) * DEPTH + l) * L_P + t) * 128 + c2; o[0] = a0; o[64] = a1; } }
        return; }
    if (pn >= 5 && pn < 9) { w.XC()[(size_t)m * 512 + (pn - 5) * 128 + cc] = f2bf(a0 * sigmoidf_(a1)); return; }
    if (pn >= 19) { bf16_t* o = w.GM() + (size_t)m * 4096 + (pn - 19) * 256 + cc; o[0] = f2bf(sigmoidf_(a0)); o[128] = f2bf(sigmoidf_(a1)); return; }
    if (pn == 11 || pn == 12) { bf16_t* o = w.XP() + (size_t)m * 512 + (pn - 11) * 256 + cc; o[0] = f2bf(a0); o[128] = f2bf(a1); return; }
    if (pn == 15 || pn == 16) { bf16_t* o = w.XS() + (size_t)m * 512 + (pn - 15) * 256 + cc; o[0] = f2bf(a0); o[128] = f2bf(a1); return; }
    { const int br = pn < 5 ? 0 : pn < 11 ? 1 : pn < 15 ? 2 : 3; const int t0 = br == 0 ? 3 : br == 1 ? 9 : br == 2 ? 13 : 17;
      bf16_t* o = w.GATE() + ((size_t)br * M + m) * 512 + (pn - t0) * 256 + cc; o[0] = f2bf(siluf_(a0)); o[128] = f2bf(siluf_(a1)); } }
struct FG1 { InP in; W w; int l, pad;
    HD_FN void operator()(long i) const { int cc = i % 128; int pn = (i / 128) % NT1; int m = i / (128 * NT1); const bf16_t* a = w.H() + (size_t)m * D;
        const bf16_t* b0 = w.win() + ((size_t)l * INC + pn * 256 + cc) * D; const bf16_t* b1 = b0 + (size_t)128 * D; float a0 = 0.f, a1 = 0.f;
        for (int k = 0; k < D; ++k) { const float av = bf2f(a[k]); a0 += av * bf2f(b0[k]); a1 += av * bf2f(b1[k]); }
        epi1(w, l, m, pn, cc, a0, a1); } };

struct FAttn { InP in; W w; int l, pad;
    HD_FN void operator()(long i) const { int dp = i % 4, hh = (i / 4) % 8; int m = i / 32; const bool smp = m >= MP; const int L = row_len(m), s0 = row_seq0(m), t = m - s0, kv = hh / 4, bb = row_batch(m);
        const bf16_t* q = w.Q() + (size_t)m * 512 + hh * 64; const float sink = in->attn_sink[l * NH + hh];
        const float* ck = in->cache_k + (((size_t)bb * DEPTH + l) * PAST) * 128 + kv * 64; const float* cvp = in->cache_v + (((size_t)bb * DEPTH + l) * PAST) * 128 + kv * 64;
        int lo, hi; if (!smp) { lo = 0; hi = L - 1; } else { lo = t - WINDOW < 0 ? 0 : t - WINDOW; hi = t + WINDOW > L - 1 ? L - 1 : t + WINDOW; }
        const int nctx = smp ? PAST : 0; float mx = sink;
        for (int pass = 0; pass < 2; ++pass) { float den = 0.f, acc[16];
#pragma unroll
            for (int d = 0; d < 16; ++d) acc[d] = 0.f;
            for (int kk = 0; kk < nctx + (hi - lo + 1); ++kk) { float sc = 0.f;
                if (kk < nctx) { const float* kp = ck + (size_t)kk * 128; for (int d = 0; d < 64; ++d) sc += bf2f(q[d]) * kp[d]; }
                else { const bf16_t* kp = w.K() + (size_t)(s0 + lo + kk - nctx) * 128 + kv * 64; for (int d = 0; d < 64; ++d) sc += bf2f(q[d]) * bf2f(kp[d]); }
                sc *= 0.125f;
                if (pass == 0) { mx = sc > mx ? sc : mx; }
                else { const float p = expf(sc - mx); den += p;
                    if (kk < nctx) { const float* vp = cvp + (size_t)kk * 128 + dp * 16;
#pragma unroll
                        for (int d = 0; d < 16; ++d) acc[d] += p * vp[d]; }
                    else { const bf16_t* vp = w.V() + (size_t)(s0 + lo + kk - nctx) * 128 + kv * 64 + dp * 16;
#pragma unroll
                        for (int d = 0; d < 16; ++d) acc[d] += p * bf2f(vp[d]); } } }
            if (pass == 1) { den += expf(sink - mx); bf16_t* o = w.GATE() + (size_t)m * 512 + hh * 64 + dp * 16;
#pragma unroll
                for (int d = 0; d < 16; ++d) o[d] = f2bf(acc[d] / den * bf2f(o[d])); } } } };
struct FConv { InP in; W w; int l, pad;
    HD_FN void operator()(long i) const { int ch = i % 512; int m = i / 512; const int L = row_len(m), s0 = row_seq0(m), t = m - s0; float acc = in->conv_db[l * 512 + ch];
        for (int j = 0; j < CONVK; ++j) { int tt = t + j - CONVK / 2; if (tt < 0 || tt >= L) continue; acc += bf2f(w.XC()[(size_t)(s0 + tt) * 512 + ch]) * in->conv_dw[((size_t)l * CONVK + j) * 512 + ch]; }
        w.TMP()[i] = acc; } };
struct FConvLn { InP in; W w; int l, pad;
    HD_FN void operator()(long m) const { const float* y = w.TMP() + (size_t)m * 512; float mu = 0.f; for (int k = 0; k < 512; ++k) mu += y[k]; mu /= 512.f;
        float var = 0.f; for (int k = 0; k < 512; ++k) { float d = y[k] - mu; var += d * d; } float r = 1.0f / sqrtf(var / 512.f + EPS); bf16_t* o = w.GATE() + ((size_t)1 * M + m) * 512;
        for (int k = 0; k < 512; ++k) o[k] = f2bf(siluf_((y[k] - mu) * r * in->conv_ln_g[l * 512 + k] + in->conv_ln_b[l * 512 + k]) * bf2f(o[k])); } };
struct FPool { W w;
    HD_FN void operator()(long i) const { int ch = i % 512; int m = i / 512; const int L = row_len(m), s0 = row_seq0(m), t = m - s0; const int wd = 2 << (ch / 128);
        int lo = t - wd / 2 < 0 ? 0 : t - wd / 2, hi = t + wd / 2 > L ? L : t + wd / 2; float sum = 0.f;
        for (int tt = lo; tt < hi; ++tt) sum += bf2f(w.XP()[(size_t)(s0 + tt) * 512 + ch]);
        bf16_t* o = w.GATE() + ((size_t)2 * M + m) * 512 + ch; *o = f2bf((sum / (float)(hi - lo) - bf2f(w.XP()[(size_t)m * 512 + ch])) * bf2f(*o)); } };
struct FSsmBu { W w; int l, dir, m0, pad;
    HD_FN void operator()(long i) const { int p = i % SP, g = (i / SP) % SG; int tl = i / (SP * SG); const bf16_t* x = w.XS() + (size_t)(m0 + tl) * 512 + g * SC;
        const float* bb = w.bbar() + ((((size_t)l * 2 + dir) * SG + g) * SP + p) * SC * 2; float ar = 0.f, ai = 0.f;
        for (int k = 0; k < SC; ++k) { const float xv = bf2f(x[k]); ar += xv * bb[2 * k]; ai += xv * bb[2 * k + 1]; } w.S()[2 * i] = ar; w.S()[2 * i + 1] = ai; } };
struct FSsmScan { InP in; W w; int l, dir, m0, pad;
    HD_FN void operator()(long i) const { int p = i % SP, g = (i / SP) % SG; int s = i / (SP * SG); const int L = row_len(m0); const int bb = row_batch(m0) + s;
        const float* lb = w.lamb() + ((((size_t)l * 2 + dir) * SG + g) * SP + p) * 2; float lr = lb[0], li = lb[1]; float hr = 0.f, hi = 0.f;
        if (m0 >= MP) { const float* st = in->state_ssm + ((((size_t)bb * DEPTH + l) * 2 + dir) * 2) * SG * SP + g * SP + p; hr = st[0]; hi = st[SG * SP]; }
        for (int k = 0; k < L; ++k) { int t = dir == 0 ? k : L - 1 - k; float* S = w.S() + (((size_t)(s * L + t) * SG + g) * SP + p) * 2;
            float nr = lr * hr - li * hi + S[0], ni = lr * hi + li * hr + S[1]; hr = nr; hi = ni; S[0] = hr; S[1] = hi; }
        if (m0 < MP) { float* o = w.out + OUT_ST + ((((size_t)bb * DEPTH + l) * 2 + dir) * 2) * SG * SP + g * SP + p; o[0] = hr; o[SG * SP] = hi; } } };
struct FSsmY { InP in; W w; int l, dir, m0, pad;
    HD_FN void operator()(long i) const { int gc = i % 512; int tl = i / 512; int g = gc / SC, ch = gc % SC; const int m = m0 + tl; const float* S = w.S() + ((size_t)tl * SG + g) * SP * 2;
        const float* cr = in->c_re + ((((size_t)l * 2 + dir) * SG + g) * SC + ch) * SP; const float* cim = in->c_im + ((((size_t)l * 2 + dir) * SG + g) * SC + ch) * SP;
        float acc = 0.f; for (int p = 0; p < SP; ++p) acc += S[2 * p] * cr[p] - S[2 * p + 1] * cim[p];
        float* y = w.TMP() + (size_t)m * 512 + gc;
        if (dir == 0) *y = acc + in->ssm_d[l * 512 + gc] * bf2f(w.XS()[(size_t)m * 512 + gc]); else w.YS()[(size_t)m * 512 + gc] = f2bf(geluf_(*y + acc)); } };
HD_FN void epi3(const W& w, int m, int pn, int cc, float a0, float a1) { bf16_t* o = w.GATE() + ((size_t)3 * M + m) * 512 + pn * 128 + cc; *o = f2bf(a0 * sigmoidf_(a1) * bf2f(*o)); }
struct FG3 { W w; int l, pad;
    HD_FN void operator()(long i) const { int cc = i % 128; int pn = (i / 128) % 4; int m = i / 512; const bf16_t* a = w.YS() + (size_t)m * 512;
        const bf16_t* b0 = w.wglu() + ((size_t)l * 1024 + pn * 256 + cc) * 512; const bf16_t* b1 = b0 + (size_t)128 * 512; float a0 = 0.f, a1 = 0.f;
        for (int k = 0; k < 512; ++k) { const float av = bf2f(a[k]); a0 += av * bf2f(b0[k]); a1 += av * bf2f(b1[k]); }
        epi3(w, m, pn, cc, a0, a1); } };
struct FG4a { W w; int l, pad;
    HD_FN void operator()(long i) const { int d = i % 1024; int m = i / 1024; float mg = 0.f;
        for (int n = 0; n < 4; ++n) { const bf16_t* a = w.GATE() + ((size_t)n * M + m) * 512; const bf16_t* b = w.wbr() + (((size_t)l * 4 + n) * 1024 + d) * 512; float acc = 0.f;
            for (int k = 0; k < 512; ++k) acc += bf2f(a[k]) * bf2f(b[k]); mg += bf2f(w.GM()[(size_t)m * 4096 + n * 1024 + d]) * acc; }
        w.MRG()[i] = f2bf(mg); } };
struct FG4b { InP in; W w; int l, pad;
    HD_FN void operator()(long i) const { int d = i % 1024; int m = i / 1024; const bf16_t* a = w.MRG() + (size_t)m * 1024; const bf16_t* b = w.wout() + ((size_t)l * 1024 + d) * 1024; float acc = 0.f;
        for (int k = 0; k < 1024; ++k) acc += bf2f(a[k]) * bf2f(b[k]);
        const float gate = w.mod()[((size_t)l * 3 + row_modj(m)) * 3072 + 2048 + d]; w.out[i] = xrow(in, w, l, m)[d] + gate * acc; } };
struct FFinal { InP in; W w;
    HD_FN void operator()(long m) const { float* xr = w.out + (size_t)m * D; float ss = 0.f; for (int k = 0; k < D; ++k) ss += xr[k] * xr[k]; float r = 1.0f / sqrtf(ss / D + EPS);
        for (int k = 0; k < D; ++k) xr[k] = xr[k] * r * in->final_g[k]; } };

template <class Runner> inline void forward(InP in, const W& w, Runner& R) {
    R(FMod{in, w}, 2L * 3 * 3072); R(FRope{w}, 2048L * 32); R(FSsmParam{in, w}, 2L * 2 * SG * SP);
    R(FCvtIn{in, w}, 2L * INC * 1024); R(FCvtGlu{in, w}, 2L * 1024 * 512); R(FCvtBr{in, w}, 2L * 4 * 1024 * 512); R(FCvtOut{in, w}, 2L * 1024 * 1024);
    for (int l = 0; l < DEPTH; ++l) {
        R(FH{in, w, l, 0}, (long)M);
        R(FG1{in, w, l, 0}, (long)M * NT1 * 128);
        R(FAttn{in, w, l, 0}, (long)M * 32);
        R(FConv{in, w, l, 0}, (long)M * 512); R(FConvLn{in, w, l, 0}, (long)M);
        R(FPool{w}, (long)M * 512);
        for (int m0 = 0; m0 < M;) { const int L = row_len(m0); int nrows = 2048; if (m0 < MP && m0 + nrows > MP) nrows = MP - m0; const int nseq = nrows / L;
            for (int dir = 0; dir < 2; ++dir) { R(FSsmBu{w, l, dir, m0, 0}, (long)nrows * SG * SP); R(FSsmScan{in, w, l, dir, m0, 0}, (long)nseq * SG * SP); R(FSsmY{in, w, l, dir, m0, 0}, (long)nrows * 512); }
            m0 += nrows; }
        R(FG3{w, l, 0}, (long)M * 512);
        R(FG4a{w, l, 0}, (long)M * 1024);
        R(FG4b{in, w, l, 0}, (long)M * 1024);
    }
    R(FFinal{in, w}, (long)M);
}
}
namespace pg8 {
#define PG8_LAS __attribute__((address_space(3)))
typedef unsigned short bf16_t;
typedef short bf16x8 __attribute__((ext_vector_type(8)));
typedef float f32x4 __attribute__((ext_vector_type(4)));
typedef unsigned u32x4 __attribute__((ext_vector_type(4)));
constexpr int BM = 256, BK = 64, HALF = 128, HTB = HALF * BK * 2  , STAGE_BYTES = 8 * HTB, NXCD = 8, WGM = 8;

__host__ __device__ __forceinline__ int lds_byte(int r, int c) { const int st = (r >> 4) * 2 + (c >> 5), rr = r & 15, cc = c & 31, ob = rr * 64 + cc * 2; return st * 1024 + (ob ^ (((ob >> 9) & 1) << 5)); }
__host__ __device__ __forceinline__ void stage_rc(int b, int& R, int& C) { const int st = b / 1024, sb = b % 1024, swz = sb ^ (((sb >> 9) & 1) << 5); R = (st >> 1) * 16 + swz / 64; C = (st & 1) * 32 + (swz % 64) / 2; }
__host__ __device__ __forceinline__ int perm32(int rho) { const int n = rho >> 4, i = rho & 15; return 8 * (i >> 2) + 4 * n + (i & 3); }

struct Unit { int pm, pn; };
struct Gemm { const bf16_t* A; const bf16_t* Bt; int M, N, K; };

struct StaticOrder {
    int nM, nN, nwg, G, c;
    __host__ __device__ void init(int M, int N, int G_, int c_) { nM = M / BM; nN = N / BM; nwg = nM * nN; G = G_; c = c_; }
    __host__ __device__ bool next(int i, Unit& u) const {
        const long L = (long)i * G + c; if (L >= nwg) return false;
        int wgid = (int)L; { const int q = nwg / NXCD, r = nwg % NXCD, xcd = wgid % NXCD, off = wgid / NXCD; wgid = (xcd < r ? xcd * (q + 1) : r * (q + 1) + (xcd - r) * q) + off; }
        const int nig = WGM * nN, gid = wgid / nig, fm = gid * WGM, gsz = (nM - fm) < WGM ? (nM - fm) : WGM;
        u.pm = fm + ((wgid % nig) % gsz); u.pn = (wgid % nig) / gsz; return true;
    }
    __device__ __forceinline__ void a_ready(const Unit&) const {}
    __device__ __forceinline__ void done(const Unit&) const {}
};

__device__ __forceinline__ unsigned cvt_pk_bf16(float lo, float hi) { unsigned r; asm volatile("v_cvt_pk_bf16_f32 %0, %1, %2" : "=v"(r) : "v"(lo), "v"(hi)); return r; }
typedef float f32x2 __attribute__((ext_vector_type(2)));
template <class Epi, class Sched, bool ALIGN_EPI = false, bool SP2 = false>
__device__ __forceinline__ void gemm_phase(PG8_LAS unsigned char* lds, const Gemm g, const Sched& S, const Epi& E) {
    int tid_ = threadIdx.x; asm volatile("" : "+v"(tid_));
    const int tid = tid_, wid = __builtin_amdgcn_readfirstlane(tid >> 6), lane = tid & 63, wr = wid >> 2, wc = wid & 3, fr = lane & 15, fq = lane >> 4;
    const int K = g.K, nt = K / BK;
    unsigned voffA[2], voffB[2];
#pragma unroll
    for (int i = 0; i < 2; ++i) { int R, C; stage_rc(tid * 16 + i * 8192, R, C); const int Rb = Epi::PERM ? ((R & ~31) + perm32(R & 31)) : R;
        voffA[i] = (unsigned)(R * K + C) * 2u; voffB[i] = (unsigned)(Rb * K + C) * 2u; }
    const size_t kstep = (size_t)(BK * 2);
    const size_t hstep = (size_t)HALF * K * 2;
    const size_t tstep = 2 * hstep;
    const unsigned ldsw = (unsigned)wid * 1024u;
    const int aoff = lds_byte(wr * 64 + fr, fq * 8), boff = lds_byte(wc * 32 + fr, fq * 8);
#define PG8_SA(b, h) (((b) * 2 + (h)) * HTB)
#define PG8_SB(b, h) ((4 + (b) * 2 + (h)) * HTB)
#define PG8_STAGE(bufoff, gbase, voff) do { _Pragma("unroll") for (int _i = 0; _i < 2; ++_i) \
        __builtin_amdgcn_global_load_lds((const unsigned*)((const char*)(gbase) + (voff)[_i]), (PG8_LAS unsigned*)(lds + (bufoff) + ldsw + _i * 8192), 16, 0, 0); } while (0)
#define PG8_LDA(dst, b, h) do { _Pragma("unroll") for (int m = 0; m < 4; ++m) _Pragma("unroll") for (int k = 0; k < 2; ++k) dst[m][k] = *(const PG8_LAS bf16x8*)(lds + PG8_SA(b, h) + aoff + m * 2048 + k * 1024); } while (0)
#define PG8_LDB(dst, b, h) do { _Pragma("unroll") for (int n = 0; n < 2; ++n) _Pragma("unroll") for (int k = 0; k < 2; ++k) dst[n][k] = *(const PG8_LAS bf16x8*)(lds + PG8_SB(b, h) + boff + n * 2048 + k * 1024); } while (0)
#define PG8_MMA(ai, bj, At, Bt) do { __builtin_amdgcn_s_setprio(1); _Pragma("unroll") for (int m = 0; m < 4; ++m) _Pragma("unroll") for (int n = 0; n < 2; ++n) _Pragma("unroll") for (int k = 0; k < 2; ++k) \
        acc[ai][bj][m][n] = __builtin_amdgcn_mfma_f32_16x16x32_bf16(Bt[n][k], At[m][k], acc[ai][bj][m][n], 0, 0, 0); __builtin_amdgcn_s_setprio(0); } while (0)
#define PG8_WAIT_V(n) asm volatile("s_waitcnt vmcnt(" #n ")" ::: "memory")
#define PG8_WAIT_L(n) asm volatile("s_waitcnt lgkmcnt(" #n ")" ::: "memory")
#define PG8_BAR __builtin_amdgcn_s_barrier()
#define PG8_SCHED __builtin_amdgcn_sched_barrier(0)
    Unit cur, nxt; int ui = 0;
    if (!S.next(0, cur)) return;
    f32x4 acc[2][2][4][2];
#pragma unroll
    for (int a = 0; a < 2; ++a)
#pragma unroll
        for (int b = 0; b < 2; ++b)
#pragma unroll
            for (int m = 0; m < 4; ++m)
#pragma unroll
                for (int n = 0; n < 2; ++n) acc[a][b][m][n] = (f32x4){0.f, 0.f, 0.f, 0.f};
    bf16x8 At[4][2], B0[2][2], B1[2][2];
    const char* cA = (const char*)g.A + (size_t)cur.pm * tstep; const char* cB = (const char*)g.Bt + (size_t)cur.pn * tstep;
    S.a_ready(cur);
    if constexpr (SP2) {
        PG8_STAGE(PG8_SB(0, 0), cB, voffB); PG8_STAGE(PG8_SB(0, 1), cB + hstep, voffB); PG8_STAGE(PG8_SA(0, 0), cA, voffA); PG8_STAGE(PG8_SA(0, 1), cA + hstep, voffA);
        if (wr == 1) PG8_BAR;
        PG8_WAIT_V(2); PG8_BAR;
        PG8_STAGE(PG8_SB(1, 0), cB + kstep, voffB); PG8_STAGE(PG8_SA(1, 0), cA + kstep, voffA); PG8_STAGE(PG8_SB(1, 1), cB + hstep + kstep, voffB);
        PG8_WAIT_V(6); PG8_BAR;
    } else {
        PG8_STAGE(PG8_SB(0, 0), cB, voffB); PG8_STAGE(PG8_SA(0, 0), cA, voffA); PG8_STAGE(PG8_SB(0, 1), cB + hstep, voffB); PG8_STAGE(PG8_SA(0, 1), cA + hstep, voffA);
        if (wr == 1) PG8_BAR;
        PG8_WAIT_V(4); PG8_BAR;
        PG8_STAGE(PG8_SB(1, 0), cB + kstep, voffB); PG8_STAGE(PG8_SA(1, 0), cA + kstep, voffA); PG8_STAGE(PG8_SB(1, 1), cB + hstep + kstep, voffB);
        PG8_WAIT_V(6); PG8_BAR;
    }
    for (;;) {
        const bool has_next = S.next(ui + 1, nxt);
        const char* nA = has_next ? (const char*)g.A + (size_t)nxt.pm * tstep : cA; const char* nB = has_next ? (const char*)g.Bt + (size_t)nxt.pn * tstep : cB;
        for (int t = 0; t < nt; t += 2) {
            const bool last = (t == nt - 2);
            const char* a1 = cA + (size_t)(t + 1) * kstep;
            const char* a2 = last ? nA : cA + (size_t)(t + 2) * kstep; const char* b2 = last ? nB : cB + (size_t)(t + 2) * kstep;
            const char* a3 = a2 + kstep; const char* b3 = b2 + kstep;
            if (last && has_next) S.a_ready(nxt);
            if constexpr (SP2) {
            PG8_LDB(B0, 0, 0); PG8_LDB(B1, 0, 1); PG8_SCHED; PG8_LDA(At, 0, 0); PG8_STAGE(PG8_SA(1, 1), a1 + hstep, voffA);
            PG8_WAIT_V(8); PG8_WAIT_L(0); PG8_BAR; PG8_MMA(0, 0, At, B0); PG8_MMA(0, 1, At, B1); PG8_BAR; PG8_SCHED;
            PG8_LDA(At, 0, 1); PG8_STAGE(PG8_SB(0, 0), b2, voffB); PG8_STAGE(PG8_SB(0, 1), b2 + hstep, voffB); PG8_STAGE(PG8_SA(0, 0), a2, voffA);
            PG8_WAIT_V(8); PG8_WAIT_L(0); PG8_BAR; PG8_MMA(1, 0, At, B0); PG8_MMA(1, 1, At, B1); PG8_BAR; PG8_SCHED;
            PG8_LDB(B0, 1, 0); PG8_LDB(B1, 1, 1); PG8_SCHED; PG8_LDA(At, 1, 0); PG8_STAGE(PG8_SA(0, 1), a2 + hstep, voffA);
            PG8_WAIT_V(8); PG8_WAIT_L(0); PG8_BAR; PG8_MMA(0, 0, At, B0); PG8_MMA(0, 1, At, B1); PG8_BAR; PG8_SCHED;
            PG8_LDA(At, 1, 1); PG8_STAGE(PG8_SB(1, 0), b3, voffB); PG8_STAGE(PG8_SB(1, 1), b3 + hstep, voffB); PG8_STAGE(PG8_SA(1, 0), a3, voffA);
            PG8_WAIT_V(8); PG8_WAIT_L(0); PG8_BAR; PG8_MMA(1, 0, At, B0); PG8_MMA(1, 1, At, B1); PG8_BAR; PG8_SCHED;
            } else {
            PG8_LDB(B0, 0, 0); PG8_SCHED; PG8_LDA(At, 0, 0); PG8_STAGE(PG8_SA(1, 1), a1 + hstep, voffA);
            PG8_WAIT_L(8); PG8_BAR; PG8_WAIT_L(0); PG8_MMA(0, 0, At, B0); PG8_BAR; PG8_SCHED;
            PG8_LDB(B1, 0, 1); PG8_STAGE(PG8_SB(0, 0), b2, voffB);
            PG8_BAR; PG8_WAIT_L(0); PG8_MMA(0, 1, At, B1); PG8_BAR;
            PG8_LDA(At, 0, 1); PG8_STAGE(PG8_SA(0, 0), a2, voffA);
            PG8_BAR; PG8_WAIT_L(0); PG8_MMA(1, 0, At, B0); PG8_BAR; PG8_SCHED;
            PG8_STAGE(PG8_SB(0, 1), b2 + hstep, voffB);
            PG8_WAIT_V(6); PG8_BAR; PG8_MMA(1, 1, At, B1); PG8_BAR;
            PG8_LDB(B0, 1, 0); PG8_SCHED; PG8_LDA(At, 1, 0); PG8_STAGE(PG8_SA(0, 1), a2 + hstep, voffA);
            PG8_WAIT_L(8); PG8_BAR; PG8_WAIT_L(0); PG8_MMA(0, 0, At, B0); PG8_BAR; PG8_SCHED;
            PG8_LDB(B1, 1, 1); PG8_STAGE(PG8_SB(1, 0), b3, voffB);
            PG8_BAR; PG8_WAIT_L(0); PG8_MMA(0, 1, At, B1); PG8_BAR;
            PG8_LDA(At, 1, 1); PG8_STAGE(PG8_SA(1, 0), a3, voffA);
            PG8_BAR; PG8_WAIT_L(0); PG8_MMA(1, 0, At, B0); PG8_BAR; PG8_SCHED;
            PG8_STAGE(PG8_SB(1, 1), b3 + hstep, voffB);
            PG8_WAIT_V(6); PG8_BAR; PG8_MMA(1, 1, At, B1); PG8_BAR;
            }
        }
        if constexpr (ALIGN_EPI) { if (wr == 0) PG8_BAR; }
        if constexpr (!Epi::AFTER_DRAIN) { E(acc, cur, wr, wc, fr, fq); S.done(cur); }
        if (!has_next) break;
#pragma unroll
        for (int a = 0; a < 2; ++a)
#pragma unroll
            for (int b = 0; b < 2; ++b)
#pragma unroll
                for (int m = 0; m < 4; ++m)
#pragma unroll
                    for (int n = 0; n < 2; ++n) acc[a][b][m][n] = (f32x4){0.f, 0.f, 0.f, 0.f};
        cur = nxt; cA = nA; cB = nB; ++ui;
        if constexpr (ALIGN_EPI) { if (wr == 1) PG8_BAR; }
    }
    PG8_WAIT_V(0);
    if constexpr (!ALIGN_EPI) { if (wr == 0) PG8_BAR; }
    PG8_BAR;
    if constexpr (Epi::AFTER_DRAIN) { E.fused(acc, cur, wr, wc, fr, fq, lds, wid, lane); S.done(cur); }
#undef PG8_SA
#undef PG8_SB
#undef PG8_STAGE
#undef PG8_LDA
#undef PG8_LDB
#undef PG8_MMA
#undef PG8_WAIT_V
#undef PG8_WAIT_L
#undef PG8_BAR
#undef PG8_SCHED
}
}
#define GAS __attribute__((address_space(1)))
#define LAS __attribute__((address_space(3)))
typedef unsigned short bf16;
typedef unsigned v4u __attribute__((ext_vector_type(4)));
typedef float f32x4 __attribute__((ext_vector_type(4)));
typedef short bf16x8 __attribute__((ext_vector_type(8)));
typedef GAS unsigned gu32;
typedef GAS unsigned long long gu64;
#define RLX_AGENT __ATOMIC_RELAXED, __HIP_MEMORY_SCOPE_AGENT
#define LDS_WAIT() asm volatile("s_waitcnt lgkmcnt(0)" ::: "memory")
#define VM_WAIT() asm volatile("s_waitcnt vmcnt(0)" ::: "memory")
__device__ __forceinline__ unsigned long long rt() { return __builtin_amdgcn_s_memrealtime(); }
__device__ __forceinline__ unsigned f2bf(float f) { unsigned u = __builtin_bit_cast(unsigned, f); return (u + 0x7fffu + ((u >> 16) & 1u)) >> 16; }
__device__ __forceinline__ unsigned pk2(float lo, float hi) { return f2bf(lo) | (f2bf(hi) << 16); }
#define XB_TMO      128
#define XB_XCNT(j)  (256  + 64 * (j))
#define XB_XSUB(j)  (1280 + 64 * (j))
#define XB_XGEN(j)  (2304 + 64 * (j))
#define XB_TOP      3328
#define XB_TOPGEN   3392
#define XCD_BAR_WORDS 3456
#define XB_SPIN_CAP (1u << 18)

__device__ __forceinline__ unsigned xb_ld(unsigned* p)              { return __hip_atomic_load(p, __ATOMIC_RELAXED, __HIP_MEMORY_SCOPE_AGENT); }
__device__ __forceinline__ unsigned xb_add(unsigned* p, unsigned v) { return __hip_atomic_fetch_add(p, v, __ATOMIC_RELAXED, __HIP_MEMORY_SCOPE_AGENT); }
__device__ __forceinline__ unsigned xb_xcc_id() { return (unsigned)__builtin_amdgcn_s_getreg((3 << 11) | 20) & 0xFu; }
#define XB_SPIN(cond, bar) do { unsigned _sp = 0; while (cond) { __builtin_amdgcn_s_sleep(1); \
    if ((++_sp & 255u) == 0u) { if (xb_ld(&(bar)[XB_TMO])) break; if (_sp > XB_SPIN_CAP) { atomicAdd(&(bar)[XB_TMO], 1u); break; } } } } while (0)

struct XcdBarrier {
    unsigned* bar; unsigned x;
    volatile LAS unsigned* st;
};

__device__ __forceinline__ XcdBarrier xcd_barrier_post(unsigned* bar, volatile LAS unsigned* st) {
    XcdBarrier b; b.bar = bar; b.x = xb_xcc_id(); b.st = st;
    if (threadIdx.x == 0) (void)xb_add(&bar[XB_XCNT(b.x)], 1u);
    return b;
}
__device__ __forceinline__ void xcd_barrier_complete(unsigned* bar, unsigned x, unsigned& nloc, unsigned& nx) {
    const unsigned G = gridDim.x * gridDim.y * gridDim.z;
    unsigned sum, cnt, mine, sp = 0u;
    for (;;) {
        sum = 0u; cnt = 0u; mine = 0u;
#pragma unroll
        for (unsigned j = 0; j < 16; ++j) { const unsigned c = xb_ld(&bar[XB_XCNT(j)]); sum += c; cnt += (c > 0u) ? 1u : 0u; mine = (j == x) ? c : mine; }
        if (sum == G) break;
        __builtin_amdgcn_s_sleep(1);
        if ((++sp & 255u) == 0u) { if (xb_ld(&bar[XB_TMO])) break; if (sp > XB_SPIN_CAP) { atomicAdd(&bar[XB_TMO], 1u); break; } }
    }
    nloc = mine > 0u ? mine : 1u; nx = cnt > 0u ? cnt : 1u;
}

__device__ __forceinline__ void xcd_barrier(const XcdBarrier& b) {
    asm volatile("s_waitcnt vmcnt(0)" ::: "memory");
    __syncthreads();
    if (threadIdx.x == 0) {
        unsigned* bar = b.bar;
        __builtin_amdgcn_s_waitcnt(0);
        unsigned nloc = b.st[0], nx = b.st[1];
        if (nloc == 0u) { xcd_barrier_complete(bar, b.x, nloc, nx); b.st[0] = nloc; b.st[1] = nx; }
        const unsigned old = xb_add(&bar[XB_XSUB(b.x)], 1u);
        const unsigned gen = old / nloc;
        if (old + 1u == (gen + 1u) * nloc) {
            __builtin_amdgcn_fence(__ATOMIC_RELEASE, "agent");
            asm volatile("s_waitcnt vmcnt(0)" ::: "memory");
            const unsigned og = xb_add(&bar[XB_TOP], 1u);
            const unsigned tg = og / nx;
            if (og + 1u == (tg + 1u) * nx) xb_add(&bar[XB_TOPGEN], 1u);
            else XB_SPIN(xb_ld(&bar[XB_TOPGEN]) == tg, bar);
            __builtin_amdgcn_fence(__ATOMIC_ACQUIRE, "agent");
            xb_add(&bar[XB_XGEN(b.x)], 1u);
            asm volatile("s_waitcnt vmcnt(0)" ::: "memory");
        } else {
            XB_SPIN(xb_ld(&bar[XB_XGEN(b.x)]) == gen, bar);
            __builtin_amdgcn_fence(__ATOMIC_ACQUIRE, "agent");
            asm volatile("s_waitcnt vmcnt(0)" ::: "memory");
        }
    }
    __syncthreads();
}
namespace mk {
using pg8::f32x4; using pg8::Unit;
using g2::In; using g2::InP; using g2::W; using g2::M; using g2::MP; using g2::INC;
typedef unsigned u32x4 __attribute__((ext_vector_type(4)));
constexpr int NWAVES = 8, NTHREADS = 512;
constexpr int RING_BYTES = 131072, LDSCTL_OFF = RING_BYTES, MISC_OFF = LDSCTL_OFF + 320, LDS_BYTES = 147456;
constexpr int CW_BAR = 4096; constexpr size_t CTL_ZERO_BYTES = 65536;

__device__ __forceinline__ float fsig(float x) { return __builtin_amdgcn_rcpf(1.0f + __builtin_amdgcn_exp2f(-1.4426950408889634f * x)); }
__device__ __forceinline__ float fsilu(float x) { return x * fsig(x); }
__device__ __forceinline__ u32x4 pack8(const float* v) { u32x4 r; r.x = pg8::cvt_pk_bf16(v[0], v[1]); r.y = pg8::cvt_pk_bf16(v[2], v[3]); r.z = pg8::cvt_pk_bf16(v[4], v[5]); r.w = pg8::cvt_pk_bf16(v[6], v[7]); return r; }
__device__ __forceinline__ void unpack8(u32x4 r, float* v) { v[0] = __uint_as_float(r.x << 16); v[1] = __uint_as_float(r.x & 0xffff0000u); v[2] = __uint_as_float(r.y << 16); v[3] = __uint_as_float(r.y & 0xffff0000u);
    v[4] = __uint_as_float(r.z << 16); v[5] = __uint_as_float(r.z & 0xffff0000u); v[6] = __uint_as_float(r.w << 16); v[7] = __uint_as_float(r.w & 0xffff0000u); }
__device__ __forceinline__ void st16(g2::bf16_t* p, u32x4 v) { *(u32x4*)p = v; }
__device__ __forceinline__ void stf8(float* p, const float* v) { *(f32x4*)p = (f32x4){v[0], v[1], v[2], v[3]}; *(f32x4*)(p + 4) = (f32x4){v[4], v[5], v[6], v[7]}; }
__device__ __forceinline__ void ldf8(const float* p, float* v) { const f32x4 a = *(const f32x4*)p, b = *(const f32x4*)(p + 4); v[0] = a.x; v[1] = a.y; v[2] = a.z; v[3] = a.w; v[4] = b.x; v[5] = b.y; v[6] = b.z; v[7] = b.w; }

#define MK_ROWS_BEGIN _Pragma("unroll") for (int ai = 0; ai < 2; ++ai) _Pragma("unroll") for (int m = 0; m < 4; ++m) { \
        float v0[8], v1[8]; _Pragma("unroll") for (int n = 0; n < 2; ++n) _Pragma("unroll") for (int i = 0; i < 4; ++i) { v0[4 * n + i] = acc[ai][0][m][n][i]; v1[4 * n + i] = acc[ai][1][m][n][i]; }
#define MK_ROWS_END }

struct Epi1 {
    static constexpr bool PERM = true, AFTER_DRAIN = false;
    W w; int l;
    __device__ __forceinline__ void operator()(const f32x4 (&acc)[2][2][4][2], const Unit& u, int wr, int wc, int fr, int fq) const {
        const int pn = u.pn, cc0 = wc * 32 + fq * 8;
        MK_ROWS_BEGIN
            const int row = u.pm * 256 + ai * 128 + wr * 64 + m * 16 + fr;
            if (pn <= 2) {
                const bool smp = row >= MP; const int t = smp ? ((row - MP) & 2047) : (row & 255);
                if (pn < 2 || wc < 2) {
                    float o1[8], o2[8];
                    if (smp) { float cs[8], sn[8]; ldf8(w.ropec() + t * 32 + fq * 8, cs); ldf8(w.ropes() + t * 32 + fq * 8, sn);
#pragma unroll
                        for (int e = 0; e < 8; ++e) { o1[e] = v0[e] * cs[e] - v1[e] * sn[e]; o2[e] = v0[e] * sn[e] + v1[e] * cs[e]; } }
                    else {
#pragma unroll
                        for (int e = 0; e < 8; ++e) { o1[e] = v0[e]; o2[e] = v1[e]; } }
                    if (pn < 2) { g2::bf16_t* q = w.Q() + (size_t)row * 512 + (pn * 4 + wc) * 64 + fq * 8; st16(q, pack8(o1)); st16(q + 32, pack8(o2)); }
                    else { g2::bf16_t* k = w.K() + (size_t)row * 128 + wc * 64 + fq * 8; st16(k, pack8(o1)); st16(k + 32, pack8(o2));
                        if (!smp) { float* o = w.out + g2::OUT_K + (((size_t)(row >> 8) * 2 + l) * 256 + t) * 128 + wc * 64 + fq * 8; stf8(o, v0); stf8(o + 32, v1); } }
                } else { const int c2 = (wc - 2) * 32 + fq * 8; g2::bf16_t* vp = w.V() + (size_t)row * 128 + c2; st16(vp, pack8(v0)); st16(vp + 64, pack8(v1));
                    if (!smp) { float* o = w.out + g2::OUT_V + (((size_t)(row >> 8) * 2 + l) * 256 + t) * 128 + c2; stf8(o, v0); stf8(o + 64, v1); } }
            } else if (pn >= 5 && pn < 9) { float o[8];
#pragma unroll
                for (int e = 0; e < 8; ++e) o[e] = v0[e] * fsig(v1[e]);
                st16(w.XC() + (size_t)row * 512 + (pn - 5) * 128 + cc0, pack8(o));
            } else if (pn >= 19) { float o0[8], o1[8];
#pragma unroll
                for (int e = 0; e < 8; ++e) { o0[e] = fsig(v0[e]); o1[e] = fsig(v1[e]); }
                g2::bf16_t* p = w.GM() + (size_t)row * 4096 + (pn - 19) * 256 + cc0; st16(p, pack8(o0)); st16(p + 128, pack8(o1));
            } else if (pn == 11 || pn == 12) { g2::bf16_t* p = w.XP() + (size_t)row * 512 + (pn - 11) * 256 + cc0; st16(p, pack8(v0)); st16(p + 128, pack8(v1));
            } else if (pn == 15 || pn == 16) { g2::bf16_t* p = w.XS() + (size_t)row * 512 + (pn - 15) * 256 + cc0; st16(p, pack8(v0)); st16(p + 128, pack8(v1));
            } else { const int br = pn < 5 ? 0 : pn < 11 ? 1 : pn < 15 ? 2 : 3; const int t0 = br == 0 ? 3 : br == 1 ? 9 : br == 2 ? 13 : 17; float o0[8], o1[8];
#pragma unroll
                for (int e = 0; e < 8; ++e) { o0[e] = fsilu(v0[e]); o1[e] = fsilu(v1[e]); }
                g2::bf16_t* p = w.GATE() + ((size_t)br * M + row) * 512 + (pn - t0) * 256 + cc0; st16(p, pack8(o0)); st16(p + 128, pack8(o1)); }
        MK_ROWS_END
    }
};
struct Epi3 {
    static constexpr bool PERM = true, AFTER_DRAIN = false;
    W w;
    __device__ __forceinline__ void operator()(const f32x4 (&acc)[2][2][4][2], const Unit& u, int wr, int wc, int fr, int fq) const {
        const int cc0 = wc * 32 + fq * 8;
        MK_ROWS_BEGIN
            const int row = u.pm * 256 + ai * 128 + wr * 64 + m * 16 + fr; g2::bf16_t* p = w.GATE() + ((size_t)3 * M + row) * 512 + u.pn * 128 + cc0;
            float g[8], o[8]; unpack8(*(const u32x4*)p, g);
#pragma unroll
            for (int e = 0; e < 8; ++e) o[e] = v0[e] * fsig(v1[e]) * g[e];
            st16(p, pack8(o));
        MK_ROWS_END
    }
};
struct Epi4a {
    static constexpr bool PERM = true, AFTER_DRAIN = false;
    W w;
    __device__ __forceinline__ void operator()(const f32x4 (&acc)[2][2][4][2], const Unit& u, int wr, int wc, int fr, int fq) const {
        const int n_ = u.pn >> 2, pn = u.pn & 3, pm = u.pm & 31, cc0 = wc * 32 + fq * 8;
        MK_ROWS_BEGIN
            const int row = pm * 256 + ai * 128 + wr * 64 + m * 16 + fr;
#pragma unroll
            for (int bj = 0; bj < 2; ++bj) { const int col = pn * 256 + bj * 128 + cc0; float g[8], o[8]; unpack8(*(const u32x4*)(w.GM() + (size_t)row * 4096 + n_ * 1024 + col), g);
                float* P = w.MRGP() + (size_t)row * 1024 + col;
#pragma unroll
                for (int e = 0; e < 8; ++e) o[e] = g[e] * (bj ? v1[e] : v0[e]);
                if (n_ > 0) { float pv[8]; ldf8(P, pv);
#pragma unroll
                    for (int e = 0; e < 8; ++e) o[e] += pv[e]; }
                if (n_ < 3) stf8(P, o); else st16(w.MRG() + (size_t)row * 1024 + col, pack8(o)); }
        MK_ROWS_END
    }
};
struct Sched4a { int c;
    __device__ __forceinline__ bool next(int i, Unit& u) const { if (c >= 128 || i >= 4) return false; u.pm = (c >> 2) + 32 * i; u.pn = (c & 3) + 4 * i; return true; }
    __device__ __forceinline__ void a_ready(const Unit&) const {}
    __device__ __forceinline__ void done(const Unit&) const {}
};
struct Epi4b {
    static constexpr bool PERM = true, AFTER_DRAIN = false;
    InP in; W w; int l;
    __device__ __forceinline__ void operator()(const f32x4 (&acc)[2][2][4][2], const Unit& u, int wr, int wc, int fr, int fq) const {
        const int cc0 = wc * 32 + fq * 8;
        MK_ROWS_BEGIN
            const int row = u.pm * 256 + ai * 128 + wr * 64 + m * 16 + fr; const float* xr = g2::xrow(in, w, l, row); const float* gt = w.mod() + ((size_t)l * 3 + g2::row_modj(row)) * 3072 + 2048;
#pragma unroll
            for (int bj = 0; bj < 2; ++bj) { const int col = u.pn * 256 + bj * 128 + cc0; float x[8], g[8], o[8]; ldf8(xr + col, x); ldf8(gt + col, g);
#pragma unroll
                for (int e = 0; e < 8; ++e) o[e] = x[e] + g[e] * (bj ? v1[e] : v0[e]);
                stf8(w.out + (size_t)row * 1024 + col, o); }
        MK_ROWS_END
    }
};

struct Args { In in; float* out; unsigned char* ws; };
__device__ __forceinline__ InP fresh_in() { InP p = (InP)__builtin_amdgcn_kernarg_segment_ptr(); asm volatile("" : "+s"(p)); return p; }

template <class F> __device__ __forceinline__ void run_stage(const F& f, long n) {
    int tid_ = threadIdx.x; asm volatile("" : "+v"(tid_));
    for (long i = (long)blockIdx.x * NTHREADS + tid_; i < n; i += (long)gridDim.x * NTHREADS) f(i);
}

__global__ void __launch_bounds__(NTHREADS, 2) mk_fwd(Args a) {
    extern __shared__ __attribute__((aligned(16))) unsigned char lds[];
    LAS unsigned char* L = (LAS unsigned char*)lds;
    volatile LAS unsigned* MISC = (volatile LAS unsigned*)(L + MISC_OFF);
    for (int u = threadIdx.x; u < (LDS_BYTES - LDSCTL_OFF) / 4; u += NTHREADS) ((LAS unsigned*)(L + LDSCTL_OFF))[u] = 0u;
    __syncthreads();
    const W w = g2::make_w(a.ws, a.out);
#define in fresh_in()
    XcdBarrier bar = xcd_barrier_post((unsigned*)w.ctl() + CW_BAR, MISC + 8);
#define BAR() xcd_barrier(bar)
    run_stage(g2::FMod{in, w}, 2L * 3 * 3072); run_stage(g2::FRope{w}, 2048L * 32); run_stage(g2::FSsmParam{in, w}, 2L * 2 * g2::SG * g2::SP);
    run_stage(g2::FCvtIn{in, w}, 2L * INC * 1024); run_stage(g2::FCvtGlu{in, w}, 2L * 1024 * 512); run_stage(g2::FCvtBr{in, w}, 2L * 4 * 1024 * 512); run_stage(g2::FCvtOut{in, w}, 2L * 1024 * 1024);
    BAR();
#pragma unroll 1
    for (int l = 0; l < 2; ++l) {
        run_stage(g2::FH{in, w, l, 0}, (long)M); BAR();
        { pg8::Gemm g{w.H(), w.win() + (size_t)l * INC * 1024, M, INC, 1024}; pg8::StaticOrder S; S.init(M, INC, (int)gridDim.x, (int)blockIdx.x); Epi1 E{w, l};
          pg8::gemm_phase<Epi1, pg8::StaticOrder, true, true>(L, g, S, E); }
        BAR();
        run_stage(g2::FAttn{in, w, l, 0}, (long)M * 32); run_stage(g2::FConv{in, w, l, 0}, (long)M * 512); run_stage(g2::FPool{w}, (long)M * 512); BAR();
        run_stage(g2::FConvLn{in, w, l, 0}, (long)M); BAR();
#pragma unroll 1
        for (int m0 = 0; m0 < M; m0 += 2048) { const int nseq = m0 < MP ? 8 : 1;
#pragma unroll 1
            for (int dir = 0; dir < 2; ++dir) { run_stage(g2::FSsmBu{w, l, dir, m0, 0}, 2048L * g2::SG * g2::SP); BAR(); run_stage(g2::FSsmScan{in, w, l, dir, m0, 0}, (long)nseq * g2::SG * g2::SP); BAR();
                run_stage(g2::FSsmY{in, w, l, dir, m0, 0}, 2048L * 512); BAR(); } }
        { pg8::Gemm g{w.YS(), w.wglu() + (size_t)l * 1024 * 512, M, 1024, 512}; pg8::StaticOrder S; S.init(M, 1024, (int)gridDim.x, (int)blockIdx.x); Epi3 E{w};
          pg8::gemm_phase<Epi3, pg8::StaticOrder, true, true>(L, g, S, E); }
        BAR();
        { pg8::Gemm g{w.GATE(), w.wbr() + (size_t)l * 4 * 1024 * 512, 4 * M, 4 * 1024, 512}; Sched4a S{(int)blockIdx.x}; Epi4a E{w};
          pg8::gemm_phase<Epi4a, Sched4a, true, true>(L, g, S, E); }
        BAR();
        { pg8::Gemm g{w.MRG(), w.wout() + (size_t)l * 1024 * 1024, M, 1024, 1024}; pg8::StaticOrder S; S.init(M, 1024, (int)gridDim.x, (int)blockIdx.x); Epi4b E{in, w, l};
          pg8::gemm_phase<Epi4b, pg8::StaticOrder, true, true>(L, g, S, E); }
        BAR();
    }
    run_stage(g2::FFinal{in, w}, (long)M);
#undef BAR
#undef in
}
}

extern "C" void kernel_launch(void* const* d_in, const int* in_sizes, int n_in, void* d_out, int out_size, void* d_ws, size_t ws_size, hipStream_t stream) {
    static int grid = 0;
    if (grid == 0) {
        if (n_in != 30 || (size_t)out_size != g2::OUT_TOTAL || ws_size < g2::WS_END) { fprintf(stderr, "kernel_launch: unexpected problem shape (n_in %d out %d ws %zu)\n", n_in, out_size, ws_size); grid = -1; return; }
        int dev = 0, cus = 0, per_cu = 0;
        if (hipGetDevice(&dev) != hipSuccess || hipDeviceGetAttribute(&cus, hipDeviceAttributeMultiprocessorCount, dev) != hipSuccess) { grid = -1; return; }
        if (hipFuncSetAttribute((const void*)mk::mk_fwd, hipFuncAttributeMaxDynamicSharedMemorySize, mk::LDS_BYTES) != hipSuccess) { fprintf(stderr, "kernel_launch: hipFuncSetAttribute failed\n"); grid = -1; return; }
        if (hipOccupancyMaxActiveBlocksPerMultiprocessor(&per_cu, (const void*)mk::mk_fwd, mk::NTHREADS, mk::LDS_BYTES) != hipSuccess || per_cu < 1) { fprintf(stderr, "kernel_launch: occupancy query says %d blocks/CU\n", per_cu); (void)hipGetLastError(); grid = -1; return; }
        grid = cus;
    }
    if (grid < 0) return;
    if (hipMemsetAsync((char*)d_ws + g2::WS_CTL, 0, mk::CTL_ZERO_BYTES, stream) != hipSuccess) return;
    mk::Args a{}; const float* ptr[30]; for (int i = 0; i < 30; ++i) ptr[i] = (const float*)d_in[i]; memcpy(&a.in, ptr, sizeof(a.in));
    a.out = (float*)d_out; a.ws = (unsigned char*)d_ws;
    hipLaunchKernelGGL(mk::mk_fwd, dim3(grid), dim3(mk::NTHREADS), mk::LDS_BYTES, stream, a);
}
```

```cpp
#include <hip/hip_runtime.h>
#include <cstdio>
#include <cstring>
#include <cstdint>
#ifdef CPU_EMU
#include <cmath>
#include <cstddef>
#include <cstring>
#define HD_FN inline
#else
#define HD_FN __host__ __device__ __forceinline__
#endif

namespace g2 {
typedef unsigned short bf16_t;
#ifndef CFG_BATCH
#define CFG_BATCH 16
#endif
#ifndef CFG_DEC_BATCH
#define CFG_DEC_BATCH 2
#endif
constexpr int D = 1024, DEPTH = 2, NB_P = CFG_BATCH, L_P = 256, NB_S = CFG_DEC_BATCH, L_S = 2048, PAST = 256;
constexpr int MP = NB_P * L_P, MS = NB_S * L_S, M = MP + MS;
constexpr int GRID_W = 64, NH = 8, WINDOW = 128, CONVK = 31, SG = 32, SC = 16, SP = 64, INC = 8960, NT1 = INC / 256;
constexpr int C_XPOOL = 2816;
constexpr float EPS = 1e-6f;

HD_FN bf16_t f2bf(float f) { unsigned u; memcpy(&u, &f, 4); u = (u + 0x7fffu + ((u >> 16) & 1u)) >> 16; return (bf16_t)u; }
HD_FN float bf2f(bf16_t h) { unsigned u = (unsigned)h << 16; float f; memcpy(&f, &u, 4); return f; }
HD_FN float sigmoidf_(float x) { return 1.0f / (1.0f + expf(-x)); }
HD_FN float siluf_(float x) { return x * sigmoidf_(x); }
HD_FN float geluf_(float x) { return 0.5f * x * (1.0f + tanhf(0.7978845608028654f * (x + 0.044715f * x * x * x))); }

HD_FN int row_path(int m) { return m >= MP; }
HD_FN int row_len(int m) { return m >= MP ? L_S : L_P; }
HD_FN int row_seq0(int m) { return m >= MP ? MP + ((m - MP) / L_S) * L_S : (m / L_P) * L_P; }
HD_FN int row_batch(int m) { return m >= MP ? (m - MP) / L_S : m / L_P; }
HD_FN int row_modj(int m) { return m >= MP ? 1 + (m - MP) / L_S : 0; }

struct In {
    const float *x_prompt, *x_sample, *cache_k, *cache_v, *state_ssm, *c, *c_ctx, *norm_g, *w_ada, *b_ada, *w_in, *attn_sink, *conv_dw, *conv_db,
        *conv_ln_g, *conv_ln_b, *pool_w, *pool_scale, *lam_re, *lam_im, *log_dt, *b_re, *b_im, *c_re, *c_im, *ssm_d, *glu_w, *w_br, *w_out, *final_g;
};
#ifdef CPU_EMU
typedef const In* InP;
#else
typedef const __attribute__((address_space(4))) In* InP;
#endif
constexpr size_t OUT_YP = 0, OUT_YS = (size_t)MP * D, OUT_K = (size_t)M * D, OUT_V = OUT_K + (size_t)NB_P * DEPTH * L_P * 128, OUT_ST = OUT_V + (size_t)NB_P * DEPTH * L_P * 128,
                 OUT_TOTAL = OUT_ST + (size_t)NB_P * DEPTH * 2 * 2 * SG * SP;

constexpr size_t MiB = 1u << 20;
constexpr size_t WS_CTL = 0;
constexpr size_t WS_MOD = 1 * MiB;
constexpr size_t WS_ROPE = WS_MOD + 128 * 1024;
constexpr size_t WS_LAMB = WS_ROPE + 512 * 1024;
constexpr size_t WS_BBAR = WS_LAMB + 64 * 1024;
constexpr size_t WS_WIN = 4 * MiB;
constexpr size_t WS_WGLU = WS_WIN + (size_t)2 * INC * 1024 * 2;
constexpr size_t WS_WBR = WS_WGLU + 2 * MiB;
constexpr size_t WS_WOUT = WS_WBR + 8 * MiB;
constexpr size_t WS_H = WS_WOUT + 4 * MiB;
constexpr size_t WS_Q = WS_H + 16 * MiB;
constexpr size_t WS_XC = WS_Q + 8 * MiB;
constexpr size_t WS_MRGP = WS_H;
constexpr size_t WS_XP = WS_XC + 8 * MiB;
constexpr size_t WS_XS = WS_XP + 8 * MiB;
constexpr size_t WS_K = WS_XS + 8 * MiB;
constexpr size_t WS_V = WS_K + 2 * MiB;
constexpr size_t WS_GATE = WS_V + 2 * MiB;
constexpr size_t WS_GM = WS_GATE + 32 * MiB;
constexpr size_t WS_YS = WS_GM + 64 * MiB;
constexpr size_t WS_MRG = WS_YS + 8 * MiB;
constexpr size_t WS_TMP = WS_MRG + 16 * MiB;
constexpr size_t WS_S = WS_TMP + 16 * MiB;
constexpr size_t WS_END = WS_S + 32 * MiB;
static_assert(WS_END <= 293601280ull, "workspace map exceeds the guaranteed d_ws size");

struct W {
    unsigned char* ws; float* out;
    HD_FN unsigned* ctl() const { return (unsigned*)(ws + WS_CTL); }
    HD_FN float* mod() const { return (float*)(ws + WS_MOD); }
    HD_FN float* ropec() const { return (float*)(ws + WS_ROPE); }
    HD_FN float* ropes() const { return (float*)(ws + WS_ROPE) + 2048 * 32; }
    HD_FN float* lamb() const { return (float*)(ws + WS_LAMB); }
    HD_FN float* bbar() const { return (float*)(ws + WS_BBAR); }
    HD_FN bf16_t* win() const { return (bf16_t*)(ws + WS_WIN); }
    HD_FN bf16_t* wglu() const { return (bf16_t*)(ws + WS_WGLU); }
    HD_FN bf16_t* wbr() const { return (bf16_t*)(ws + WS_WBR); }
    HD_FN bf16_t* wout() const { return (bf16_t*)(ws + WS_WOUT); }
    HD_FN bf16_t* H() const { return (bf16_t*)(ws + WS_H); }
    HD_FN bf16_t* Q() const { return (bf16_t*)(ws + WS_Q); }
    HD_FN bf16_t* XC() const { return (bf16_t*)(ws + WS_XC); }
    HD_FN bf16_t* XP() const { return (bf16_t*)(ws + WS_XP); }
    HD_FN bf16_t* XS() const { return (bf16_t*)(ws + WS_XS); }
    HD_FN bf16_t* K() const { return (bf16_t*)(ws + WS_K); }
    HD_FN bf16_t* V() const { return (bf16_t*)(ws + WS_V); }
    HD_FN bf16_t* GATE() const { return (bf16_t*)(ws + WS_GATE); }
    HD_FN bf16_t* GM() const { return (bf16_t*)(ws + WS_GM); }
    HD_FN bf16_t* YS() const { return (bf16_t*)(ws + WS_YS); }
    HD_FN bf16_t* MRG() const { return (bf16_t*)(ws + WS_MRG); }
    HD_FN float* MRGP() const { return (float*)(ws + WS_MRGP); }
    HD_FN float* TMP() const { return (float*)(ws + WS_TMP); }
    HD_FN float* S() const { return (float*)(ws + WS_S); }
};
HD_FN W make_w(unsigned char* ws, float* out) { W w{}; w.ws = ws; w.out = out; return w; }

HD_FN const float* xrow(InP in, const W& w, int l, int m) { return l == 0 ? (m < MP ? in->x_prompt + (size_t)m * D : in->x_sample + (size_t)(m - MP) * D) : w.out + (size_t)m * D; }

HD_FN int in_orig_col(int row) { const int pn = row >> 8, c = row & 255, bj = c >> 7, cc = c & 127;
    if (pn < 2) return (pn * 4 + (cc >> 5)) * 64 + bj * 32 + (cc & 31);
    if (pn == 2) return cc < 64 ? 512 + (cc >> 5) * 64 + bj * 32 + (cc & 31) : 640 + bj * 64 + (cc - 64);
    if (pn < 5) return 768 + (pn - 3) * 256 + c;
    if (pn < 9) return 1280 + bj * 512 + (pn - 5) * 128 + cc;
    if (pn < 11) return 2304 + (pn - 9) * 256 + c;
    if (pn < 13) return 2816 + (pn - 11) * 256 + c;
    if (pn < 15) return 3328 + (pn - 13) * 256 + c;
    if (pn < 17) return 3840 + (pn - 15) * 256 + c;
    if (pn < 19) return 4352 + (pn - 17) * 256 + c;
    return 4864 + (pn - 19) * 256 + c; }
HD_FN int glu_orig_col(int row) { const int pn = row >> 8, c = row & 255, bj = c >> 7, cc = c & 127; return bj * 512 + pn * 128 + cc; }

struct FMod { InP in; W w;
    HD_FN void operator()(long i) const { int n = i % 3072; int j = (i / 3072) % 3; int l = i / (3 * 3072);
        const float* cv = j == 0 ? in->c_ctx : in->c + (size_t)(j - 1) * D; const float* wa = in->w_ada + (size_t)l * D * 3072;
        float acc = 0.f; for (int k = 0; k < D; ++k) acc += siluf_(cv[k]) * wa[(size_t)k * 3072 + n];
        w.mod()[i] = acc + in->b_ada[l * 3072 + n]; } };
struct FRope { W w;
    HD_FN void operator()(long i) const { int j = i % 32, t = i / 32; float row = (float)(t / GRID_W), col = (float)(t % GRID_W);
        float inv = powf(10000.0f, -(float)(j % 16) / 16.0f); float ang = (j < 16 ? row : col) * inv; w.ropec()[i] = cosf(ang); w.ropes()[i] = sinf(ang); } };
struct FSsmParam { InP in; W w;
    HD_FN void operator()(long i) const { int g = (i / SP) % SG; long ld = i / (SP * SG);
        float lr = in->lam_re[i], li = in->lam_im[i]; float dt = expf(in->log_dt[ld * SG + g]);
        float e = expf(lr * dt), br_ = e * cosf(li * dt), bi_ = e * sinf(li * dt); w.lamb()[2 * i] = br_; w.lamb()[2 * i + 1] = bi_;
        float nr = br_ - 1.0f, ni = bi_; float den = lr * lr + li * li; float fr = (nr * lr + ni * li) / den, fi = (ni * lr - nr * li) / den;
        for (int c = 0; c < SC; ++c) { float xr = in->b_re[i * SC + c], xi = in->b_im[i * SC + c];
            w.bbar()[(i * SC + c) * 2] = fr * xr - fi * xi; w.bbar()[(i * SC + c) * 2 + 1] = fr * xi + fi * xr; } } };
struct FCvtIn { InP in; W w;
    HD_FN void operator()(long i) const { int k = i % 1024; int row = (i / 1024) % INC; int l = i / ((long)INC * 1024); const int oc = in_orig_col(row);
        const float* src = in->w_in + ((size_t)l * D + k) * INC; float v;
        if (oc >= C_XPOOL && oc < C_XPOOL + 512) { const int g = (oc - C_XPOOL) >> 7, co = (oc - C_XPOOL) & 127; const float* pw = in->pool_w + ((size_t)l * 4 + g) * 128 * 128 + co; const float* s = src + C_XPOOL + g * 128;
            float acc = 0.f; for (int ci = 0; ci < 128; ++ci) acc += s[ci] * pw[(size_t)ci * 128]; v = acc * in->pool_scale[l * 512 + g * 128 + co]; }
        else v = src[oc];
        w.win()[i] = f2bf(v); } };
struct FCvtGlu { InP in; W w;
    HD_FN void operator()(long i) const { int k = i % 512; int row = (i / 512) % 1024; int l = i / (512 * 1024); w.wglu()[i] = f2bf(in->glu_w[((size_t)l * 512 + k) * 1024 + glu_orig_col(row)]); } };
struct FCvtBr { InP in; W w;
    HD_FN void operator()(long i) const { int k = i % 512; int d = (i / 512) % 1024; int ln = i / (512 * 1024); w.wbr()[i] = f2bf(in->w_br[((size_t)ln * 512 + k) * 1024 + d]); } };
struct FCvtOut { InP in; W w;
    HD_FN void operator()(long i) const { int k = i % 1024; int d = (i / 1024) % 1024; int l = i / (1024 * 1024); w.wout()[i] = f2bf(in->w_out[((size_t)l * 1024 + k) * 1024 + d]); } };

struct FH { InP in; W w; int l, pad;
    HD_FN void operator()(long m) const { const float* x = xrow(in, w, l, (int)m); float ss = 0.f; for (int k = 0; k < D; ++k) ss += x[k] * x[k];
        float r = 1.0f / sqrtf(ss / D + EPS); const float* mo = w.mod() + ((size_t)l * 3 + row_modj((int)m)) * 3072; const float* g = in->norm_g + l * D;
        for (int k = 0; k < D; ++k) w.H()[(size_t)m * D + k] = f2bf((x[k] * r) * g[k] * (1.0f + mo[1024 + k]) + mo[k]); } };

HD_FN void epi1(const W& w, int l, int m, int pn, int cc, float a0, float a1) {
    if (pn <= 2) { const bool smp = m >= MP; const int t = m - row_seq0(m);
        if (pn < 2 || cc < 64) { const int j = cc & 31; float o1 = a0, o2 = a1;
            if (smp) { const float cs = w.ropec()[t * 32 + j], sn = w.ropes()[t * 32 + j]; o1 = a0 * cs - a1 * sn; o2 = a0 * sn + a1 * cs; }
            if (pn < 2) { const int h = pn * 4 + (cc >> 5); w.Q()[(size_t)m * 512 + h * 64 + j] = f2bf(o1); w.Q()[(size_t)m * 512 + h * 64 + 32 + j] = f2bf(o2); }
            else { const int kv = cc >> 5; w.K()[(size_t)m * 128 + kv * 64 + j] = f2bf(o1); w.K()[(size_t)m * 128 + kv * 64 + 32 + j] = f2bf(o2);
                if (!smp) { float* o = w.out + OUT_K + (((size_t)row_batch(m) * DEPTH + l) * L_P + t) * 128 + kv * 64 + j; o[0] = a0; o[32] = a1; } } }
        else { const int c2 = cc - 64; w.V()[(size_t)m * 128 + c2] = f2bf(a0); w.V()[(size_t)m * 128 + 64 + c2] = f2bf(a1);
            if (!smp) { float* o = w.out + OUT_V + (((size_t)row_batch(m) * DEPTH + l) * L_P + t) * 128 + c2; o[0] = a0; o[64] = a1; } }
        return; }
    if (pn >= 5 && pn < 9) { w.XC()[(size_t)m * 512 + (pn - 5) * 128 + cc] = f2bf(a0 * sigmoidf_(a1)); return; }
    if (pn >= 19) { bf16_t* o = w.GM() + (size_t)m * 4096 + (pn - 19) * 256 + cc; o[0] = f2bf(sigmoidf_(a0)); o[128] = f2bf(sigmoidf_(a1)); return; }
    if (pn == 11 || pn == 12) { bf16_t* o = w.XP() + (size_t)m * 512 + (pn - 11) * 256 + cc; o[0] = f2bf(a0); o[128] = f2bf(a1); return; }
    if (pn == 15 || pn == 16) { bf16_t* o = w.XS() + (size_t)m * 512 + (pn - 15) * 256 + cc; o[0] = f2bf(a0); o[128] = f2bf(a1); return; }
    { const int br = pn < 5 ? 0 : pn < 11 ? 1 : pn < 15 ? 2 : 3; const int t0 = br == 0 ? 3 : br == 1 ? 9 : br == 2 ? 13 : 17;
      bf16_t* o = w.GATE() + ((size_t)br * M + m) * 512 + (pn - t0) * 256 + cc; o[0] = f2bf(siluf_(a0)); o[128] = f2bf(siluf_(a1)); } }
struct FG1 { InP in; W w; int l, pad;
    HD_FN void operator()(long i) const { int cc = i % 128; int pn = (i / 128) % NT1; int m = i / (128 * NT1); const bf16_t* a = w.H() + (size_t)m * D;
        const bf16_t* b0 = w.win() + ((size_t)l * INC + pn * 256 + cc) * D; const bf16_t* b1 = b0 + (size_t)128 * D; float a0 = 0.f, a1 = 0.f;
        for (int k = 0; k < D; ++k) { const float av = bf2f(a[k]); a0 += av * bf2f(b0[k]); a1 += av * bf2f(b1[k]); }
        epi1(w, l, m, pn, cc, a0, a1); } };

struct FAttn { InP in; W w; int l, pad;
    HD_FN void operator()(long i) const { int dp = i % 4, hh = (i / 4) % 8; int m = i / 32; const bool smp = m >= MP; const int L = row_len(m), s0 = row_seq0(m), t = m - s0, kv = hh / 4, bb = row_batch(m);
        const bf16_t* q = w.Q() + (size_t)m * 512 + hh * 64; const float sink = in->attn_sink[l * NH + hh];
        const float* ck = in->cache_k + (((size_t)bb * DEPTH + l) * PAST) * 128 + kv * 64; const float* cvp = in->cache_v + (((size_t)bb * DEPTH + l) * PAST) * 128 + kv * 64;
        int lo, hi; if (!smp) { lo = 0; hi = L - 1; } else { lo = t - WINDOW < 0 ? 0 : t - WINDOW; hi = t + WINDOW > L - 1 ? L - 1 : t + WINDOW; }
        const int nctx = smp ? PAST : 0; float mx = sink;
        for (int pass = 0; pass < 2; ++pass) { float den = 0.f, acc[16];
#pragma unroll
            for (int d = 0; d < 16; ++d) acc[d] = 0.f;
            for (int kk = 0; kk < nctx + (hi - lo + 1); ++kk) { float sc = 0.f;
                if (kk < nctx) { const float* kp = ck + (size_t)kk * 128; for (int d = 0; d < 64; ++d) sc += bf2f(q[d]) * kp[d]; }
                else { const bf16_t* kp = w.K() + (size_t)(s0 + lo + kk - nctx) * 128 + kv * 64; for (int d = 0; d < 64; ++d) sc += bf2f(q[d]) * bf2f(kp[d]); }
                sc *= 0.125f;
                if (pass == 0) { mx = sc > mx ? sc : mx; }
                else { const float p = expf(sc - mx); den += p;
                    if (kk < nctx) { const float* vp = cvp + (size_t)kk * 128 + dp * 16;
#pragma unroll
                        for (int d = 0; d < 16; ++d) acc[d] += p * vp[d]; }
                    else { const bf16_t* vp = w.V() + (size_t)(s0 + lo + kk - nctx) * 128 + kv * 64 + dp * 16;
#pragma unroll
                        for (int d = 0; d < 16; ++d) acc[d] += p * bf2f(vp[d]); } } }
            if (pass == 1) { den += expf(sink - mx); bf16_t* o = w.GATE() + (size_t)m * 512 + hh * 64 + dp * 16;
#pragma unroll
                for (int d = 0; d < 16; ++d) o[d] = f2bf(acc[d] / den * bf2f(o[d])); } } } };
struct FConv { InP in; W w; int l, pad;
    HD_FN void operator()(long i) const { int ch = i % 512; int m = i / 512; const int L = row_len(m), s0 = row_seq0(m), t = m - s0; float acc = in->conv_db[l * 512 + ch];
        for (int j = 0; j < CONVK; ++j) { int tt = t + j - CONVK / 2; if (tt < 0 || tt >= L) continue; acc += bf2f(w.XC()[(size_t)(s0 + tt) * 512 + ch]) * in->conv_dw[((size_t)l * CONVK + j) * 512 + ch]; }
        w.TMP()[i] = acc; } };
struct FConvLn { InP in; W w; int l, pad;
    HD_FN void operator()(long m) const { const float* y = w.TMP() + (size_t)m * 512; float mu = 0.f; for (int k = 0; k < 512; ++k) mu += y[k]; mu /= 512.f;
        float var = 0.f; for (int k = 0; k < 512; ++k) { float d = y[k] - mu; var += d * d; } float r = 1.0f / sqrtf(var / 512.f + EPS); bf16_t* o = w.GATE() + ((size_t)1 * M + m) * 512;
        for (int k = 0; k < 512; ++k) o[k] = f2bf(siluf_((y[k] - mu) * r * in->conv_ln_g[l * 512 + k] + in->conv_ln_b[l * 512 + k]) * bf2f(o[k])); } };
struct FPool { W w;
    HD_FN void operator()(long i) const { int ch = i % 512; int m = i / 512; const int L = row_len(m), s0 = row_seq0(m), t = m - s0; const int wd = 2 << (ch / 128);
        int lo = t - wd / 2 < 0 ? 0 : t - wd / 2, hi = t + wd / 2 > L ? L : t + wd / 2; float sum = 0.f;
        for (int tt = lo; tt < hi; ++tt) sum += bf2f(w.XP()[(size_t)(s0 + tt) * 512 + ch]);
        bf16_t* o = w.GATE() + ((size_t)2 * M + m) * 512 + ch; *o = f2bf((sum / (float)(hi - lo) - bf2f(w.XP()[(size_t)m * 512 + ch])) * bf2f(*o)); } };
struct FSsmBu { W w; int l, dir, m0, pad;
    HD_FN void operator()(long i) const { int p = i % SP, g = (i / SP) % SG; int tl = i / (SP * SG); const bf16_t* x = w.XS() + (size_t)(m0 + tl) * 512 + g * SC;
        const float* bb = w.bbar() + ((((size_t)l * 2 + dir) * SG + g) * SP + p) * SC * 2; float ar = 0.f, ai = 0.f;
        for (int k = 0; k < SC; ++k) { const float xv = bf2f(x[k]); ar += xv * bb[2 * k]; ai += xv * bb[2 * k + 1]; } w.S()[2 * i] = ar; w.S()[2 * i + 1] = ai; } };
struct FSsmScan { InP in; W w; int l, dir, m0, pad;
    HD_FN void operator()(long i) const { int p = i % SP, g = (i / SP) % SG; int s = i / (SP * SG); const int L = row_len(m0); const int bb = row_batch(m0) + s;
        const float* lb = w.lamb() + ((((size_t)l * 2 + dir) * SG + g) * SP + p) * 2; float lr = lb[0], li = lb[1]; float hr = 0.f, hi = 0.f;
        if (m0 >= MP) { const float* st = in->state_ssm + ((((size_t)bb * DEPTH + l) * 2 + dir) * 2) * SG * SP + g * SP + p; hr = st[0]; hi = st[SG * SP]; }
        for (int k = 0; k < L; ++k) { int t = dir == 0 ? k : L - 1 - k; float* S = w.S() + (((size_t)(s * L + t) * SG + g) * SP + p) * 2;
            float nr = lr * hr - li * hi + S[0], ni = lr * hi + li * hr + S[1]; hr = nr; hi = ni; S[0] = hr; S[1] = hi; }
        if (m0 < MP) { float* o = w.out + OUT_ST + ((((size_t)bb * DEPTH + l) * 2 + dir) * 2) * SG * SP + g * SP + p; o[0] = hr; o[SG * SP] = hi; } } };
struct FSsmY { InP in; W w; int l, dir, m0, pad;
    HD_FN void operator()(long i) const { int gc = i % 512; int tl = i / 512; int g = gc / SC, ch = gc % SC; const int m = m0 + tl; const float* S = w.S() + ((size_t)tl * SG + g) * SP * 2;
        const float* cr = in->c_re + ((((size_t)l * 2 + dir) * SG + g) * SC + ch) * SP; const float* cim = in->c_im + ((((size_t)l * 2 + dir) * SG + g) * SC + ch) * SP;
        float acc = 0.f; for (int p = 0; p < SP; ++p) acc += S[2 * p] * cr[p] - S[2 * p + 1] * cim[p];
        float* y = w.TMP() + (size_t)m * 512 + gc;
        if (dir == 0) *y = acc + in->ssm_d[l * 512 + gc] * bf2f(w.XS()[(size_t)m * 512 + gc]); else w.YS()[(size_t)m * 512 + gc] = f2bf(geluf_(*y + acc)); } };
HD_FN void epi3(const W& w, int m, int pn, int cc, float a0, float a1) { bf16_t* o = w.GATE() + ((size_t)3 * M + m) * 512 + pn * 128 + cc; *o = f2bf(a0 * sigmoidf_(a1) * bf2f(*o)); }
struct FG3 { W w; int l, pad;
    HD_FN void operator()(long i) const { int cc = i % 128; int pn = (i / 128) % 4; int m = i / 512; const bf16_t* a = w.YS() + (size_t)m * 512;
        const bf16_t* b0 = w.wglu() + ((size_t)l * 1024 + pn * 256 + cc) * 512; const bf16_t* b1 = b0 + (size_t)128 * 512; float a0 = 0.f, a1 = 0.f;
        for (int k = 0; k < 512; ++k) { const float av = bf2f(a[k]); a0 += av * bf2f(b0[k]); a1 += av * bf2f(b1[k]); }
        epi3(w, m, pn, cc, a0, a1); } };
struct FG4a { W w; int l, pad;
    HD_FN void operator()(long i) const { int d = i % 1024; int m = i / 1024; float mg = 0.f;
        for (int n = 0; n < 4; ++n) { const bf16_t* a = w.GATE() + ((size_t)n * M + m) * 512; const bf16_t* b = w.wbr() + (((size_t)l * 4 + n) * 1024 + d) * 512; float acc = 0.f;
            for (int k = 0; k < 512; ++k) acc += bf2f(a[k]) * bf2f(b[k]); mg += bf2f(w.GM()[(size_t)m * 4096 + n * 1024 + d]) * acc; }
        w.MRG()[i] = f2bf(mg); } };
struct FG4b { InP in; W w; int l, pad;
    HD_FN void operator()(long i) const { int d = i % 1024; int m = i / 1024; const bf16_t* a = w.MRG() + (size_t)m * 1024; const bf16_t* b = w.wout() + ((size_t)l * 1024 + d) * 1024; float acc = 0.f;
        for (int k = 0; k < 1024; ++k) acc += bf2f(a[k]) * bf2f(b[k]);
        const float gate = w.mod()[((size_t)l * 3 + row_modj(m)) * 3072 + 2048 + d]; w.out[i] = xrow(in, w, l, m)[d] + gate * acc; } };
struct FFinal { InP in; W w;
    HD_FN void operator()(long m) const { float* xr = w.out + (size_t)m * D; float ss = 0.f; for (int k = 0; k < D; ++k) ss += xr[k] * xr[k]; float r = 1.0f / sqrtf(ss / D + EPS);
        for (int k = 0; k < D; ++k) xr[k] = xr[k] * r * in->final_g[k]; } };

template <class Runner> inline void forward(InP in, const W& w, Runner& R) {
    R(FMod{in, w}, 2L * 3 * 3072); R(FRope{w}, 2048L * 32); R(FSsmParam{in, w}, 2L * 2 * SG * SP);
    R(FCvtIn{in, w}, 2L * INC * 1024); R(FCvtGlu{in, w}, 2L * 1024 * 512); R(FCvtBr{in, w}, 2L * 4 * 1024 * 512); R(FCvtOut{in, w}, 2L * 1024 * 1024);
    for (int l = 0; l < DEPTH; ++l) {
        R(FH{in, w, l, 0}, (long)M);
        R(FG1{in, w, l, 0}, (long)M * NT1 * 128);
        R(FAttn{in, w, l, 0}, (long)M * 32);
        R(FConv{in, w, l, 0}, (long)M * 512); R(FConvLn{in, w, l, 0}, (long)M);
        R(FPool{w}, (long)M * 512);
        for (int m0 = 0; m0 < M;) { const int L = row_len(m0); int nrows = 2048; if (m0 < MP && m0 + nrows > MP) nrows = MP - m0; const int nseq = nrows / L;
            for (int dir = 0; dir < 2; ++dir) { R(FSsmBu{w, l, dir, m0, 0}, (long)nrows * SG * SP); R(FSsmScan{in, w, l, dir, m0, 0}, (long)nseq * SG * SP); R(FSsmY{in, w, l, dir, m0, 0}, (long)nrows * 512); }
            m0 += nrows; }
        R(FG3{w, l, 0}, (long)M * 512);
        R(FG4a{w, l, 0}, (long)M * 1024);
        R(FG4b{in, w, l, 0}, (long)M * 1024);
    }
    R(FFinal{in, w}, (long)M);
}
}
namespace pg8 {
#define PG8_LAS __attribute__((address_space(3)))
typedef unsigned short bf16_t;
typedef short bf16x8 __attribute__((ext_vector_type(8)));
typedef float f32x4 __attribute__((ext_vector_type(4)));
typedef unsigned u32x4 __attribute__((ext_vector_type(4)));
constexpr int BM = 256, BK = 64, HALF = 128, HTB = HALF * BK * 2  , STAGE_BYTES = 8 * HTB, NXCD = 8, WGM = 8;

__host__ __device__ __forceinline__ int lds_byte(int r, int c) { const int st = (r >> 4) * 2 + (c >> 5), rr = r & 15, cc = c & 31, ob = rr * 64 + cc * 2; return st * 1024 + (ob ^ (((ob >> 9) & 1) << 5)); }
__host__ __device__ __forceinline__ void stage_rc(int b, int& R, int& C) { const int st = b / 1024, sb = b % 1024, swz = sb ^ (((sb >> 9) & 1) << 5); R = (st >> 1) * 16 + swz / 64; C = (st & 1) * 32 + (swz % 64) / 2; }
__host__ __device__ __forceinline__ int perm32(int rho) { const int n = rho >> 4, i = rho & 15; return 8 * (i >> 2) + 4 * n + (i & 3); }

struct Unit { int pm, pn; };
struct Gemm { const bf16_t* A; const bf16_t* Bt; int M, N, K; };

struct StaticOrder {
    int nM, nN, nwg, G, c;
    __host__ __device__ void init(int M, int N, int G_, int c_) { nM = M / BM; nN = N / BM; nwg = nM * nN; G = G_; c = c_; }
    __host__ __device__ bool next(int i, Unit& u) const {
        const long L = (long)i * G + c; if (L >= nwg) return false;
        int wgid = (int)L; { const int q = nwg / NXCD, r = nwg % NXCD, xcd = wgid % NXCD, off = wgid / NXCD; wgid = (xcd < r ? xcd * (q + 1) : r * (q + 1) + (xcd - r) * q) + off; }
        const int nig = WGM * nN, gid = wgid / nig, fm = gid * WGM, gsz = (nM - fm) < WGM ? (nM - fm) : WGM;
        u.pm = fm + ((wgid % nig) % gsz); u.pn = (wgid % nig) / gsz; return true;
    }
    __device__ __forceinline__ void a_ready(const Unit&) const {}
    __device__ __forceinline__ void done(const Unit&) const {}
};

__device__ __forceinline__ unsigned cvt_pk_bf16(float lo, float hi) { unsigned r; asm volatile("v_cvt_pk_bf16_f32 %0, %1, %2" : "=v"(r) : "v"(lo), "v"(hi)); return r; }
typedef float f32x2 __attribute__((ext_vector_type(2)));
template <class Epi, class Sched, bool ALIGN_EPI = false, bool SP2 = false>
__device__ __forceinline__ void gemm_phase(PG8_LAS unsigned char* lds, const Gemm g, const Sched& S, const Epi& E) {
    int tid_ = threadIdx.x; asm volatile("" : "+v"(tid_));
    const int tid = tid_, wid = __builtin_amdgcn_readfirstlane(tid >> 6), lane = tid & 63, wr = wid >> 2, wc = wid & 3, fr = lane & 15, fq = lane >> 4;
    const int K = g.K, nt = K / BK;
    unsigned voffA[2], voffB[2];
#pragma unroll
    for (int i = 0; i < 2; ++i) { int R, C; stage_rc(tid * 16 + i * 8192, R, C); const int Rb = Epi::PERM ? ((R & ~31) + perm32(R & 31)) : R;
        voffA[i] = (unsigned)(R * K + C) * 2u; voffB[i] = (unsigned)(Rb * K + C) * 2u; }
    const size_t kstep = (size_t)(BK * 2);
    const size_t hstep = (size_t)HALF * K * 2;
    const size_t tstep = 2 * hstep;
    const unsigned ldsw = (unsigned)wid * 1024u;
    const int aoff = lds_byte(wr * 64 + fr, fq * 8), boff = lds_byte(wc * 32 + fr, fq * 8);
#define PG8_SA(b, h) (((b) * 2 + (h)) * HTB)
#define PG8_SB(b, h) ((4 + (b) * 2 + (h)) * HTB)
#define PG8_STAGE(bufoff, gbase, voff) do { _Pragma("unroll") for (int _i = 0; _i < 2; ++_i) \
        __builtin_amdgcn_global_load_lds((const unsigned*)((const char*)(gbase) + (voff)[_i]), (PG8_LAS unsigned*)(lds + (bufoff) + ldsw + _i * 8192), 16, 0, 0); } while (0)
#define PG8_LDA(dst, b, h) do { _Pragma("unroll") for (int m = 0; m < 4; ++m) _Pragma("unroll") for (int k = 0; k < 2; ++k) dst[m][k] = *(const PG8_LAS bf16x8*)(lds + PG8_SA(b, h) + aoff + m * 2048 + k * 1024); } while (0)
#define PG8_LDB(dst, b, h) do { _Pragma("unroll") for (int n = 0; n < 2; ++n) _Pragma("unroll") for (int k = 0; k < 2; ++k) dst[n][k] = *(const PG8_LAS bf16x8*)(lds + PG8_SB(b, h) + boff + n * 2048 + k * 1024); } while (0)
#define PG8_MMA(ai, bj, At, Bt) do { __builtin_amdgcn_s_setprio(1); _Pragma("unroll") for (int m = 0; m < 4; ++m) _Pragma("unroll") for (int n = 0; n < 2; ++n) _Pragma("unroll") for (int k = 0; k < 2; ++k) \
        acc[ai][bj][m][n] = __builtin_amdgcn_mfma_f32_16x16x32_bf16(Bt[n][k], At[m][k], acc[ai][bj][m][n], 0, 0, 0); __builtin_amdgcn_s_setprio(0); } while (0)
#define PG8_WAIT_V(n) asm volatile("s_waitcnt vmcnt(" #n ")" ::: "memory")
#define PG8_WAIT_L(n) asm volatile("s_waitcnt lgkmcnt(" #n ")" ::: "memory")
#define PG8_BAR __builtin_amdgcn_s_barrier()
#define PG8_SCHED __builtin_amdgcn_sched_barrier(0)
    Unit cur, nxt; int ui = 0;
    if (!S.next(0, cur)) return;
    f32x4 acc[2][2][4][2];
#pragma unroll
    for (int a = 0; a < 2; ++a)
#pragma unroll
        for (int b = 0; b < 2; ++b)
#pragma unroll
            for (int m = 0; m < 4; ++m)
#pragma unroll
                for (int n = 0; n < 2; ++n) acc[a][b][m][n] = (f32x4){0.f, 0.f, 0.f, 0.f};
    bf16x8 At[4][2], B0[2][2], B1[2][2];
    const char* cA = (const char*)g.A + (size_t)cur.pm * tstep; const char* cB = (const char*)g.Bt + (size_t)cur.pn * tstep;
    S.a_ready(cur);
    if constexpr (SP2) {
        PG8_STAGE(PG8_SB(0, 0), cB, voffB); PG8_STAGE(PG8_SB(0, 1), cB + hstep, voffB); PG8_STAGE(PG8_SA(0, 0), cA, voffA); PG8_STAGE(PG8_SA(0, 1), cA + hstep, voffA);
        if (wr == 1) PG8_BAR;
        PG8_WAIT_V(2); PG8_BAR;
        PG8_STAGE(PG8_SB(1, 0), cB + kstep, voffB); PG8_STAGE(PG8_SA(1, 0), cA + kstep, voffA); PG8_STAGE(PG8_SB(1, 1), cB + hstep + kstep, voffB);
        PG8_WAIT_V(6); PG8_BAR;
    } else {
        PG8_STAGE(PG8_SB(0, 0), cB, voffB); PG8_STAGE(PG8_SA(0, 0), cA, voffA); PG8_STAGE(PG8_SB(0, 1), cB + hstep, voffB); PG8_STAGE(PG8_SA(0, 1), cA + hstep, voffA);
        if (wr == 1) PG8_BAR;
        PG8_WAIT_V(4); PG8_BAR;
        PG8_STAGE(PG8_SB(1, 0), cB + kstep, voffB); PG8_STAGE(PG8_SA(1, 0), cA + kstep, voffA); PG8_STAGE(PG8_SB(1, 1), cB + hstep + kstep, voffB);
        PG8_WAIT_V(6); PG8_BAR;
    }
    for (;;) {
        const bool has_next = S.next(ui + 1, nxt);
        const char* nA = has_next ? (const char*)g.A + (size_t)nxt.pm * tstep : cA; const char* nB = has_next ? (const char*)g.Bt + (size_t)nxt.pn * tstep : cB;
        for (int t = 0; t < nt; t += 2) {
            const bool last = (t == nt - 2);
            const char* a1 = cA + (size_t)(t + 1) * kstep;
            const char* a2 = last ? nA : cA + (size_t)(t + 2) * kstep; const char* b2 = last ? nB : cB + (size_t)(t + 2) * kstep;
            const char* a3 = a2 + kstep; const char* b3 = b2 + kstep;
            if (last && has_next) S.a_ready(nxt);
            if constexpr (SP2) {
            PG8_LDB(B0, 0, 0); PG8_LDB(B1, 0, 1); PG8_SCHED; PG8_LDA(At, 0, 0); PG8_STAGE(PG8_SA(1, 1), a1 + hstep, voffA);
            PG8_WAIT_V(8); PG8_WAIT_L(0); PG8_BAR; PG8_MMA(0, 0, At, B0); PG8_MMA(0, 1, At, B1); PG8_BAR; PG8_SCHED;
            PG8_LDA(At, 0, 1); PG8_STAGE(PG8_SB(0, 0), b2, voffB); PG8_STAGE(PG8_SB(0, 1), b2 + hstep, voffB); PG8_STAGE(PG8_SA(0, 0), a2, voffA);
            PG8_WAIT_V(8); PG8_WAIT_L(0); PG8_BAR; PG8_MMA(1, 0, At, B0); PG8_MMA(1, 1, At, B1); PG8_BAR; PG8_SCHED;
            PG8_LDB(B0, 1, 0); PG8_LDB(B1, 1, 1); PG8_SCHED; PG8_LDA(At, 1, 0); PG8_STAGE(PG8_SA(0, 1), a2 + hstep, voffA);
            PG8_WAIT_V(8); PG8_WAIT_L(0); PG8_BAR; PG8_MMA(0, 0, At, B0); PG8_MMA(0, 1, At, B1); PG8_BAR; PG8_SCHED;
            PG8_LDA(At, 1, 1); PG8_STAGE(PG8_SB(1, 0), b3, voffB); PG8_STAGE(PG8_SB(1, 1), b3 + hstep, voffB); PG8_STAGE(PG8_SA(1, 0), a3, voffA);
            PG8_WAIT_V(8); PG8_WAIT_L(0); PG8_BAR; PG8_MMA(1, 0, At, B0); PG8_MMA(1, 1, At, B1); PG8_BAR; PG8_SCHED;
            } else {
            PG8_LDB(B0, 0, 0); PG8_SCHED; PG8_LDA(At, 0, 0); PG8_STAGE(PG8_SA(1, 1), a1 + hstep, voffA);
            PG8_WAIT_L(8); PG8_BAR; PG8_WAIT_L(0); PG8_MMA(0, 0, At, B0); PG8_BAR; PG8_SCHED;
            PG8_LDB(B1, 0, 1); PG8_STAGE(PG8_SB(0, 0), b2, voffB);
            PG8_BAR; PG8_WAIT_L(0); PG8_MMA(0, 1, At, B1); PG8_BAR;
            PG8_LDA(At, 0, 1); PG8_STAGE(PG8_SA(0, 0), a2, voffA);
            PG8_BAR; PG8_WAIT_L(0); PG8_MMA(1, 0, At, B0); PG8_BAR; PG8_SCHED;
            PG8_STAGE(PG8_SB(0, 1), b2 + hstep, voffB);
            PG8_WAIT_V(6); PG8_BAR; PG8_MMA(1, 1, At, B1); PG8_BAR;
            PG8_LDB(B0, 1, 0); PG8_SCHED; PG8_LDA(At, 1, 0); PG8_STAGE(PG8_SA(0, 1), a2 + hstep, voffA);
            PG8_WAIT_L(8); PG8_BAR; PG8_WAIT_L(0); PG8_MMA(0, 0, At, B0); PG8_BAR; PG8_SCHED;
            PG8_LDB(B1, 1, 1); PG8_STAGE(PG8_SB(1, 0), b3, voffB);
            PG8_BAR; PG8_WAIT_L(0); PG8_MMA(0, 1, At, B1); PG8_BAR;
            PG8_LDA(At, 1, 1); PG8_STAGE(PG8_SA(1, 0), a3, voffA);
            PG8_BAR; PG8_WAIT_L(0); PG8_MMA(1, 0, At, B0); PG8_BAR; PG8_SCHED;
            PG8_STAGE(PG8_SB(1, 1), b3 + hstep, voffB);
            PG8_WAIT_V(6); PG8_BAR; PG8_MMA(1, 1, At, B1); PG8_BAR;
            }
        }
        if constexpr (ALIGN_EPI) { if (wr == 0) PG8_BAR; }
        if constexpr (!Epi::AFTER_DRAIN) { E(acc, cur, wr, wc, fr, fq); S.done(cur); }
        if (!has_next) break;
#pragma unroll
        for (int a = 0; a < 2; ++a)
#pragma unroll
            for (int b = 0; b < 2; ++b)
#pragma unroll
                for (int m = 0; m < 4; ++m)
#pragma unroll
                    for (int n = 0; n < 2; ++n) acc[a][b][m][n] = (f32x4){0.f, 0.f, 0.f, 0.f};
        cur = nxt; cA = nA; cB = nB; ++ui;
        if constexpr (ALIGN_EPI) { if (wr == 1) PG8_BAR; }
    }
    PG8_WAIT_V(0);
    if constexpr (!ALIGN_EPI) { if (wr == 0) PG8_BAR; }
    PG8_BAR;
    if constexpr (Epi::AFTER_DRAIN) { E.fused(acc, cur, wr, wc, fr, fq, lds, wid, lane); S.done(cur); }
#undef PG8_SA
#undef PG8_SB
#undef PG8_STAGE
#undef PG8_LDA
#undef PG8_LDB
#undef PG8_MMA
#undef PG8_WAIT_V
#undef PG8_WAIT_L
#undef PG8_BAR
#undef PG8_SCHED
}
}
#define GAS __attribute__((address_space(1)))
#define LAS __attribute__((address_space(3)))
typedef unsigned short bf16;
typedef unsigned v4u __attribute__((ext_vector_type(4)));
typedef float f32x4 __attribute__((ext_vector_type(4)));
typedef short bf16x8 __attribute__((ext_vector_type(8)));
typedef GAS unsigned gu32;
typedef GAS unsigned long long gu64;
#define RLX_AGENT __ATOMIC_RELAXED, __HIP_MEMORY_SCOPE_AGENT
#define LDS_WAIT() asm volatile("s_waitcnt lgkmcnt(0)" ::: "memory")
#define VM_WAIT() asm volatile("s_waitcnt vmcnt(0)" ::: "memory")
__device__ __forceinline__ unsigned long long rt() { return __builtin_amdgcn_s_memrealtime(); }
__device__ __forceinline__ unsigned f2bf(float f) { unsigned u = __builtin_bit_cast(unsigned, f); return (u + 0x7fffu + ((u >> 16) & 1u)) >> 16; }
__device__ __forceinline__ unsigned pk2(float lo, float hi) { return f2bf(lo) | (f2bf(hi) << 16); }
#define XB_TMO      128
#define XB_XCNT(j)  (256  + 64 * (j))
#define XB_XSUB(j)  (1280 + 64 * (j))
#define XB_XGEN(j)  (2304 + 64 * (j))
#define XB_TOP      3328
#define XB_TOPGEN   3392
#define XCD_BAR_WORDS 3456
#define XB_SPIN_CAP (1u << 18)

__device__ __forceinline__ unsigned xb_ld(unsigned* p)              { return __hip_atomic_load(p, __ATOMIC_RELAXED, __HIP_MEMORY_SCOPE_AGENT); }
__device__ __forceinline__ unsigned xb_add(unsigned* p, unsigned v) { return __hip_atomic_fetch_add(p, v, __ATOMIC_RELAXED, __HIP_MEMORY_SCOPE_AGENT); }
__device__ __forceinline__ unsigned xb_xcc_id() { return (unsigned)__builtin_amdgcn_s_getreg((3 << 11) | 20) & 0xFu; }
#define XB_SPIN(cond, bar) do { unsigned _sp = 0; while (cond) { __builtin_amdgcn_s_sleep(1); \
    if ((++_sp & 255u) == 0u) { if (xb_ld(&(bar)[XB_TMO])) break; if (_sp > XB_SPIN_CAP) { atomicAdd(&(bar)[XB_TMO], 1u); break; } } } } while (0)

struct XcdBarrier {
    unsigned* bar; unsigned x;
    volatile LAS unsigned* st;
};

__device__ __forceinline__ XcdBarrier xcd_barrier_post(unsigned* bar, volatile LAS unsigned* st) {
    XcdBarrier b; b.bar = bar; b.x = xb_xcc_id(); b.st = st;
    if (threadIdx.x == 0) (void)xb_add(&bar[XB_XCNT(b.x)], 1u);
    return b;
}
__device__ __forceinline__ void xcd_barrier_complete(unsigned* bar, unsigned x, unsigned& nloc, unsigned& nx) {
    const unsigned G = gridDim.x * gridDim.y * gridDim.z;
    unsigned sum, cnt, mine, sp = 0u;
    for (;;) {
        sum = 0u; cnt = 0u; mine = 0u;
#pragma unroll
        for (unsigned j = 0; j < 16; ++j) { const unsigned c = xb_ld(&bar[XB_XCNT(j)]); sum += c; cnt += (c > 0u) ? 1u : 0u; mine = (j == x) ? c : mine; }
        if (sum == G) break;
        __builtin_amdgcn_s_sleep(1);
        if ((++sp & 255u) == 0u) { if (xb_ld(&bar[XB_TMO])) break; if (sp > XB_SPIN_CAP) { atomicAdd(&bar[XB_TMO], 1u); break; } }
    }
    nloc = mine > 0u ? mine : 1u; nx = cnt > 0u ? cnt : 1u;
}

__device__ __forceinline__ void xcd_barrier(const XcdBarrier& b) {
    asm volatile("s_waitcnt vmcnt(0)" ::: "memory");
    __syncthreads();
    if (threadIdx.x == 0) {
        unsigned* bar = b.bar; asm volatile("" : "+s"(bar));
        __builtin_amdgcn_s_waitcnt(0);
        unsigned nloc = b.st[0], nx = b.st[1];
        if (nloc == 0u) { xcd_barrier_complete(bar, b.x, nloc, nx); b.st[0] = nloc; b.st[1] = nx; }
        const unsigned old = xb_add(&bar[XB_XSUB(b.x)], 1u);
        const unsigned gen = old / nloc;
        if (old + 1u == (gen + 1u) * nloc) {
            __builtin_amdgcn_fence(__ATOMIC_RELEASE, "agent");
            asm volatile("s_waitcnt vmcnt(0)" ::: "memory");
            const unsigned og = xb_add(&bar[XB_TOP], 1u);
            const unsigned tg = og / nx;
            if (og + 1u == (tg + 1u) * nx) xb_add(&bar[XB_TOPGEN], 1u);
            else XB_SPIN(xb_ld(&bar[XB_TOPGEN]) == tg, bar);
            __builtin_amdgcn_fence(__ATOMIC_ACQUIRE, "agent");
            xb_add(&bar[XB_XGEN(b.x)], 1u);
            asm volatile("s_waitcnt vmcnt(0)" ::: "memory");
        } else {
            XB_SPIN(xb_ld(&bar[XB_XGEN(b.x)]) == gen, bar);
            __builtin_amdgcn_fence(__ATOMIC_ACQUIRE, "agent");
            asm volatile("s_waitcnt vmcnt(0)" ::: "memory");
        }
    }
    __syncthreads();
}
namespace mk {
using pg8::f32x4; using pg8::Unit;
using g2::In; using g2::InP; using g2::W; using g2::M; using g2::MP; using g2::INC;
typedef unsigned u32x4 __attribute__((ext_vector_type(4)));
constexpr int NWAVES = 8, NTHREADS = 512;
constexpr int RING_BYTES = 131072, LDSCTL_OFF = RING_BYTES, MISC_OFF = LDSCTL_OFF + 320, LDS_BYTES = 147456;
constexpr int CW_BAR = 4096; constexpr size_t CTL_ZERO_BYTES = 65536;

__device__ __forceinline__ float fsig(float x) { return __builtin_amdgcn_rcpf(1.0f + __builtin_amdgcn_exp2f(-1.4426950408889634f * x)); }
__device__ __forceinline__ float fsilu(float x) { return x * fsig(x); }
__device__ __forceinline__ u32x4 pack8(const float* v) { u32x4 r; r.x = pg8::cvt_pk_bf16(v[0], v[1]); r.y = pg8::cvt_pk_bf16(v[2], v[3]); r.z = pg8::cvt_pk_bf16(v[4], v[5]); r.w = pg8::cvt_pk_bf16(v[6], v[7]); return r; }
__device__ __forceinline__ void unpack8(u32x4 r, float* v) { v[0] = __uint_as_float(r.x << 16); v[1] = __uint_as_float(r.x & 0xffff0000u); v[2] = __uint_as_float(r.y << 16); v[3] = __uint_as_float(r.y & 0xffff0000u);
    v[4] = __uint_as_float(r.z << 16); v[5] = __uint_as_float(r.z & 0xffff0000u); v[6] = __uint_as_float(r.w << 16); v[7] = __uint_as_float(r.w & 0xffff0000u); }
__device__ __forceinline__ void st16(g2::bf16_t* p, u32x4 v) { *(u32x4*)p = v; }
__device__ __forceinline__ void stf8(float* p, const float* v) { *(f32x4*)p = (f32x4){v[0], v[1], v[2], v[3]}; *(f32x4*)(p + 4) = (f32x4){v[4], v[5], v[6], v[7]}; }
__device__ __forceinline__ void ldf8(const float* p, float* v) { const f32x4 a = *(const f32x4*)p, b = *(const f32x4*)(p + 4); v[0] = a.x; v[1] = a.y; v[2] = a.z; v[3] = a.w; v[4] = b.x; v[5] = b.y; v[6] = b.z; v[7] = b.w; }

#define MK_ROWS_BEGIN _Pragma("unroll") for (int ai = 0; ai < 2; ++ai) _Pragma("unroll") for (int m = 0; m < 4; ++m) { \
        float v0[8], v1[8]; _Pragma("unroll") for (int n = 0; n < 2; ++n) _Pragma("unroll") for (int i = 0; i < 4; ++i) { v0[4 * n + i] = acc[ai][0][m][n][i]; v1[4 * n + i] = acc[ai][1][m][n][i]; }
#define MK_ROWS_END }

struct Epi1 {
    static constexpr bool PERM = true, AFTER_DRAIN = false;
    W w; int l;
    __device__ __forceinline__ void operator()(const f32x4 (&acc)[2][2][4][2], const Unit& u, int wr, int wc, int fr, int fq) const {
        int pn_ = __builtin_amdgcn_readfirstlane(u.pn), pm_ = __builtin_amdgcn_readfirstlane(u.pm); asm volatile("" : "+s"(pn_), "+s"(pm_), "+v"(fr), "+v"(fq));
        const int pn = pn_, cc0 = wc * 32 + fq * 8, rowb = pm_ * 256 + wr * 64 + fr;
#define MK_ROW (rowb + ai * 128 + m * 16)
        if (pn <= 2) {
            if (pn < 2 || wc < 2) {
                MK_ROWS_BEGIN
                    const int row = MK_ROW; const bool smp = row >= MP; const int t = smp ? ((row - MP) & 2047) : (row & 255);
                    float o1[8], o2[8];
                    if (smp) { float cs[8], sn[8]; ldf8(w.ropec() + t * 32 + fq * 8, cs); ldf8(w.ropes() + t * 32 + fq * 8, sn);
#pragma unroll
                        for (int e = 0; e < 8; ++e) { o1[e] = v0[e] * cs[e] - v1[e] * sn[e]; o2[e] = v0[e] * sn[e] + v1[e] * cs[e]; } }
                    else {
#pragma unroll
                        for (int e = 0; e < 8; ++e) { o1[e] = v0[e]; o2[e] = v1[e]; } }
                    if (pn < 2) { g2::bf16_t* q = w.Q() + (size_t)row * 512 + (pn * 4 + wc) * 64 + fq * 8; st16(q, pack8(o1)); st16(q + 32, pack8(o2)); }
                    else { g2::bf16_t* k = w.K() + (size_t)row * 128 + wc * 64 + fq * 8; st16(k, pack8(o1)); st16(k + 32, pack8(o2));
                        if (!smp) { float* o = w.out + g2::OUT_K + (((size_t)(row >> 8) * 2 + l) * 256 + t) * 128 + wc * 64 + fq * 8; stf8(o, v0); stf8(o + 32, v1); } }
                MK_ROWS_END
            } else {
                const int c2 = (wc - 2) * 32 + fq * 8;
                MK_ROWS_BEGIN
                    const int row = MK_ROW; g2::bf16_t* vp = w.V() + (size_t)row * 128 + c2; st16(vp, pack8(v0)); st16(vp + 64, pack8(v1));
                    if (row < MP) { float* o = w.out + g2::OUT_V + (((size_t)(row >> 8) * 2 + l) * 256 + (row & 255)) * 128 + c2; stf8(o, v0); stf8(o + 64, v1); }
                MK_ROWS_END
            }
        } else if (pn >= 19) {
            g2::bf16_t* base = w.GM() + (size_t)(pn - 19) * 256 + cc0;
            MK_ROWS_BEGIN
                float o0[8], o1[8];
#pragma unroll
                for (int e = 0; e < 8; ++e) { o0[e] = fsig(v0[e]); o1[e] = fsig(v1[e]); }
                g2::bf16_t* p = base + (size_t)MK_ROW * 4096; st16(p, pack8(o0)); st16(p + 128, pack8(o1));
            MK_ROWS_END
        } else if (pn >= 5 && pn < 9) {
            g2::bf16_t* base = w.XC() + (pn - 5) * 128 + cc0;
            MK_ROWS_BEGIN
                float o[8];
#pragma unroll
                for (int e = 0; e < 8; ++e) o[e] = v0[e] * fsig(v1[e]);
                st16(base + (size_t)MK_ROW * 512, pack8(o));
            MK_ROWS_END
        } else if (pn == 11 || pn == 12 || pn == 15 || pn == 16) {
            g2::bf16_t* base = (pn < 13 ? w.XP() + (pn - 11) * 256 : w.XS() + (pn - 15) * 256) + cc0;
            MK_ROWS_BEGIN
                g2::bf16_t* p = base + (size_t)MK_ROW * 512; st16(p, pack8(v0)); st16(p + 128, pack8(v1));
            MK_ROWS_END
        } else {
            const int br = pn < 5 ? 0 : pn < 11 ? 1 : pn < 15 ? 2 : 3; const int t0 = br == 0 ? 3 : br == 1 ? 9 : br == 2 ? 13 : 17;
            g2::bf16_t* base = w.GATE() + (size_t)br * M * 512 + (pn - t0) * 256 + cc0;
            MK_ROWS_BEGIN
                float o0[8], o1[8];
#pragma unroll
                for (int e = 0; e < 8; ++e) { o0[e] = fsilu(v0[e]); o1[e] = fsilu(v1[e]); }
                g2::bf16_t* p = base + (size_t)MK_ROW * 512; st16(p, pack8(o0)); st16(p + 128, pack8(o1));
            MK_ROWS_END
        }
#undef MK_ROW
    }
};
struct Epi3 {
    static constexpr bool PERM = true, AFTER_DRAIN = false;
    W w;
    __device__ __forceinline__ void operator()(const f32x4 (&acc)[2][2][4][2], const Unit& u, int wr, int wc, int fr, int fq) const {
        int pn_ = __builtin_amdgcn_readfirstlane(u.pn), pm_ = __builtin_amdgcn_readfirstlane(u.pm); asm volatile("" : "+s"(pn_), "+s"(pm_), "+v"(fr), "+v"(fq));
        const int cc0 = wc * 32 + fq * 8;
        MK_ROWS_BEGIN
            const int row = pm_ * 256 + ai * 128 + wr * 64 + m * 16 + fr; g2::bf16_t* p = w.GATE() + ((size_t)3 * M + row) * 512 + pn_ * 128 + cc0;
            float g[8], o[8]; unpack8(*(const u32x4*)p, g);
#pragma unroll
            for (int e = 0; e < 8; ++e) o[e] = v0[e] * fsig(v1[e]) * g[e];
            st16(p, pack8(o));
        MK_ROWS_END
    }
};
struct Epi4a {
    static constexpr bool PERM = true, AFTER_DRAIN = false;
    W w;
    __device__ __forceinline__ void operator()(const f32x4 (&acc)[2][2][4][2], const Unit& u, int wr, int wc, int fr, int fq) const {
        int pn_ = __builtin_amdgcn_readfirstlane(u.pn), pm_ = __builtin_amdgcn_readfirstlane(u.pm); asm volatile("" : "+s"(pn_), "+s"(pm_), "+v"(fr), "+v"(fq));
        const int n_ = pn_ >> 2, pn = pn_ & 3, pm = pm_ & 31, cc0 = wc * 32 + fq * 8;
        MK_ROWS_BEGIN
            const int row = pm * 256 + ai * 128 + wr * 64 + m * 16 + fr;
#pragma unroll
            for (int bj = 0; bj < 2; ++bj) { const int col = pn * 256 + bj * 128 + cc0; float g[8], o[8]; unpack8(*(const u32x4*)(w.GM() + (size_t)row * 4096 + n_ * 1024 + col), g);
                float* P = w.MRGP() + (size_t)row * 1024 + col;
#pragma unroll
                for (int e = 0; e < 8; ++e) o[e] = g[e] * (bj ? v1[e] : v0[e]);
                if (n_ > 0) { float pv[8]; ldf8(P, pv);
#pragma unroll
                    for (int e = 0; e < 8; ++e) o[e] += pv[e]; }
                if (n_ < 3) stf8(P, o); else st16(w.MRG() + (size_t)row * 1024 + col, pack8(o)); }
        MK_ROWS_END
    }
};
struct Sched4a { int c;
    __device__ __forceinline__ bool next(int i, Unit& u) const { if (c >= 128 || i >= 4) return false; u.pm = (c >> 2) + 32 * i; u.pn = (c & 3) + 4 * i; return true; }
    __device__ __forceinline__ void a_ready(const Unit&) const {}
    __device__ __forceinline__ void done(const Unit&) const {}
};
struct Epi4b {
    static constexpr bool PERM = true, AFTER_DRAIN = false;
    InP in; W w; int l;
    __device__ __forceinline__ void operator()(const f32x4 (&acc)[2][2][4][2], const Unit& u, int wr, int wc, int fr, int fq) const {
        int pn_ = __builtin_amdgcn_readfirstlane(u.pn), pm_ = __builtin_amdgcn_readfirstlane(u.pm); asm volatile("" : "+s"(pn_), "+s"(pm_), "+v"(fr), "+v"(fq));
        const int cc0 = wc * 32 + fq * 8;
        MK_ROWS_BEGIN
            const int row = pm_ * 256 + ai * 128 + wr * 64 + m * 16 + fr; const float* xr = g2::xrow(in, w, l, row); const float* gt = w.mod() + ((size_t)l * 3 + g2::row_modj(row)) * 3072 + 2048;
#pragma unroll
            for (int bj = 0; bj < 2; ++bj) { const int col = pn_ * 256 + bj * 128 + cc0; float x[8], g[8], o[8]; ldf8(xr + col, x); ldf8(gt + col, g);
#pragma unroll
                for (int e = 0; e < 8; ++e) o[e] = x[e] + g[e] * (bj ? v1[e] : v0[e]);
                stf8(w.out + (size_t)row * 1024 + col, o); }
        MK_ROWS_END
    }
};


__device__ __forceinline__ int fresh_grid() { int g = (int)gridDim.x; asm volatile("" : "+s"(g)); return g; }
__device__ __forceinline__ float wave_sum(float v) {
    v += __int_as_float(__builtin_amdgcn_ds_swizzle(__float_as_int(v), 0x041f)); v += __int_as_float(__builtin_amdgcn_ds_swizzle(__float_as_int(v), 0x081f));
    v += __int_as_float(__builtin_amdgcn_ds_swizzle(__float_as_int(v), 0x101f)); v += __int_as_float(__builtin_amdgcn_ds_swizzle(__float_as_int(v), 0x201f));
    v += __int_as_float(__builtin_amdgcn_ds_swizzle(__float_as_int(v), 0x401f));
    const auto rr = __builtin_amdgcn_permlane32_swap(__float_as_uint(v), __float_as_uint(v), false, false);
    return __uint_as_float(rr[0]) + __uint_as_float(rr[1]);
}
template <bool FINAL> __device__ __forceinline__ void ph_rows(InP in, const W& w, int l) {
    int tid_ = threadIdx.x; asm volatile("" : "+v"(tid_)); const int lane = tid_ & 63, wave = tid_ >> 6;
    const int gw = blockIdx.x * NWAVES + wave, NGW = fresh_grid() * NWAVES;
    for (int m = gw; m < M; m += NGW) {
        const float* xr = FINAL ? w.out + (size_t)m * 1024 : g2::xrow(in, w, l, m);
        f32x4 v[4]; float s = 0.f;
#pragma unroll
        for (int j = 0; j < 4; ++j) { v[j] = *(const f32x4*)(xr + 256 * j + 4 * lane); s += (v[j].x * v[j].x + v[j].y * v[j].y) + (v[j].z * v[j].z + v[j].w * v[j].w); }
        const float r = 1.0f / sqrtf(wave_sum(s) * (1.0f / 1024.f) + g2::EPS);
        if (FINAL) { const float* g = in->final_g;
#pragma unroll
            for (int j = 0; j < 4; ++j) { const f32x4 gv = *(const f32x4*)(g + 256 * j + 4 * lane); *(f32x4*)(w.out + (size_t)m * 1024 + 256 * j + 4 * lane) = v[j] * r * gv; } }
        else { const float* mo = w.mod() + ((size_t)l * 3 + g2::row_modj(m)) * 3072; const float* g = in->norm_g + l * 1024;
#pragma unroll
            for (int j = 0; j < 4; ++j) { const int k = 256 * j + 4 * lane; const f32x4 gv = *(const f32x4*)(g + k), sc = *(const f32x4*)(mo + 1024 + k), sh = *(const f32x4*)(mo + k);
                const f32x4 o = (v[j] * r) * gv * (sc + 1.0f) + sh; unsigned long long pk = (unsigned long long)pg8::cvt_pk_bf16(o.x, o.y) | ((unsigned long long)pg8::cvt_pk_bf16(o.z, o.w) << 32);
                *(unsigned long long*)(w.H() + (size_t)m * 1024 + k) = pk; } }
    }
}
__device__ __forceinline__ void cvt_item(const float* Wsrc, int ldw, int oc0, g2::bf16_t* WT, int K, int k0, LAS float* scr, int lane) {
#pragma unroll 8
    for (int i = 0; i < 32; ++i) { const int kk = 2 * i + (lane >> 5); scr[kk * 33 + (lane & 31)] = Wsrc[(size_t)(k0 + kk) * ldw + oc0 + (lane & 31)]; }
    asm volatile("s_waitcnt lgkmcnt(0)" ::: "memory");
    const int c = lane & 7;
#pragma unroll
    for (int j = 0; j < 4; ++j) { const int n = (lane >> 3) + 8 * j; const LAS float* s = scr + (8 * c) * 33 + n;
        u32x4 o; o.x = pg8::cvt_pk_bf16(s[0 * 33], s[1 * 33]); o.y = pg8::cvt_pk_bf16(s[2 * 33], s[3 * 33]); o.z = pg8::cvt_pk_bf16(s[4 * 33], s[5 * 33]); o.w = pg8::cvt_pk_bf16(s[6 * 33], s[7 * 33]);
        *(u32x4*)(WT + (size_t)n * K + k0 + 8 * c) = o; }
    asm volatile("s_waitcnt lgkmcnt(0)" ::: "memory");
}
__device__ __forceinline__ void ph_convert(InP in, const W& w, LAS unsigned char* L) {
    int tid_ = threadIdx.x; asm volatile("" : "+v"(tid_)); const int lane = tid_ & 63, wave = tid_ >> 6;
    LAS float* scr = (LAS float*)(L + wave * 16384);
    const int gw = blockIdx.x * NWAVES + wave, NGW = fresh_grid() * NWAVES;
    constexpr int I_IN = 16 * (INC / 32), I_GLU = 8 * 32, I_BR = 8 * 32, I_OUT = 16 * 32;
    constexpr int NITEMS = 2 * I_IN + 2 * I_GLU + 8 * I_BR + 2 * I_OUT;
    for (int it = gw; it < NITEMS; it += NGW) {
        int r = it;
        if (r < 2 * I_IN) { const int l = r / I_IN; r -= l * I_IN; const int kb = r / (INC / 32), nb = r % (INC / 32), n0 = nb * 32; const int oc0 = g2::in_orig_col(n0);
            if (oc0 >= g2::C_XPOOL && oc0 < g2::C_XPOOL + 512) continue;
            cvt_item(in->w_in + (size_t)l * 1024 * INC, INC, oc0, w.win() + ((size_t)l * INC + n0) * 1024, 1024, kb * 64, scr, lane); continue; }
        r -= 2 * I_IN;
        if (r < 2 * I_GLU) { const int l = r / I_GLU; r -= l * I_GLU; const int kb = r / 32, n0 = (r % 32) * 32;
            cvt_item(in->glu_w + (size_t)l * 512 * 1024, 1024, g2::glu_orig_col(n0), w.wglu() + ((size_t)l * 1024 + n0) * 512, 512, kb * 64, scr, lane); continue; }
        r -= 2 * I_GLU;
        if (r < 8 * I_BR) { const int ln = r / I_BR; r -= ln * I_BR; const int kb = r / 32, n0 = (r % 32) * 32;
            cvt_item(in->w_br + (size_t)ln * 512 * 1024, 1024, n0, w.wbr() + ((size_t)ln * 1024 + n0) * 512, 512, kb * 64, scr, lane); continue; }
        r -= 8 * I_BR;
        { const int l = r / I_OUT; r -= l * I_OUT; const int kb = r / 32, n0 = (r % 32) * 32;
          cvt_item(in->w_out + (size_t)l * 1024 * 1024, 1024, n0, w.wout() + ((size_t)l * 1024 + n0) * 1024, 1024, kb * 64, scr, lane); }
    }
}
struct FCvtPool { InP in; W w;
    __device__ __forceinline__ void operator()(long i) const { const int co = i % 128; const int g = (i / 128) % 4; const int k = (i / 512) % 1024; const int l = i / (512 * 1024);
        const float* s = in->w_in + ((size_t)l * 1024 + k) * INC + g2::C_XPOOL + g * 128; const float* pw = in->pool_w + ((size_t)l * 4 + g) * 128 * 128 + co; float acc = 0.f;
#pragma unroll 8
        for (int ci = 0; ci < 128; ++ci) acc += s[ci] * pw[(size_t)ci * 128];
        const int row = 11 * 256 + g * 128 + co;
        w.win()[((size_t)l * INC + row) * 1024 + k] = g2::f2bf(acc * in->pool_scale[l * 512 + g * 128 + co]); } };

template <int WD> __device__ __forceinline__ void pool_strip(const float (&xp)[32], int t0, int Lseq, g2::bf16_t* gp) {
#pragma unroll
    for (int tt = 0; tt < 16; ++tt) { float sum = 0.f;
#pragma unroll
        for (int i = 0; i < WD; ++i) sum += xp[tt + 8 - WD / 2 + i];
        const int t = t0 + tt; const int lo = t - WD / 2 < 0 ? 0 : t - WD / 2, hi = t + WD / 2 > Lseq ? Lseq : t + WD / 2;
        g2::bf16_t* o = gp + (size_t)tt * 512; *o = g2::f2bf((sum / (float)(hi - lo) - xp[tt + 8]) * g2::bf2f(*o)); }
}
__device__ __forceinline__ void ph_convpool(InP in, const W& w, int l, LAS unsigned char* L) {
    int tid_ = threadIdx.x; asm volatile("" : "+v"(tid_)); const int c = tid_, lane = tid_ & 63, wave = tid_ >> 6;
    LAS float* Y = (LAS float*)L;
    const int G_ = fresh_grid();
    for (int u = blockIdx.x; u < M / 16; u += G_) {
        const int m0 = u * 16, s0 = g2::row_seq0(m0), Lseq = g2::row_len(m0), t0 = m0 - s0;
        { float xp[32];
#pragma unroll
          for (int i = 0; i < 32; ++i) { const int t = t0 - 8 + i; xp[i] = (t >= 0 && t < Lseq) ? g2::bf2f(w.XP()[(size_t)(s0 + t) * 512 + c]) : 0.f; }
          g2::bf16_t* gp = w.GATE() + ((size_t)2 * M + m0) * 512 + c; const int grp = c >> 7;
          if (grp == 0) pool_strip<2>(xp, t0, Lseq, gp); else if (grp == 1) pool_strip<4>(xp, t0, Lseq, gp); else if (grp == 2) pool_strip<8>(xp, t0, Lseq, gp); else pool_strip<16>(xp, t0, Lseq, gp); }
        { float acc[16]; const float bias = in->conv_db[l * 512 + c];
#pragma unroll
          for (int tt = 0; tt < 16; ++tt) acc[tt] = bias;
          float wj[31];
#pragma unroll
          for (int j = 0; j < 31; ++j) wj[j] = in->conv_dw[((size_t)l * 31 + j) * 512 + c];
#pragma unroll
          for (int i = 0; i < 46; ++i) { const int t = t0 - 15 + i; const float x = (t >= 0 && t < Lseq) ? g2::bf2f(w.XC()[(size_t)(s0 + t) * 512 + c]) : 0.f;
#pragma unroll
              for (int tt = 0; tt < 16; ++tt) { const int j = i - tt; if (j >= 0 && j < 31) acc[tt] += x * wj[j]; } }
#pragma unroll
          for (int tt = 0; tt < 16; ++tt) Y[tt * 512 + c] = acc[tt]; }
        __syncthreads();
#pragma unroll
        for (int q = 0; q < 2; ++q) { const int tt = wave * 2 + q; float y[8]; const f32x4 a = *(const LAS f32x4*)(Y + tt * 512 + 8 * lane), b = *(const LAS f32x4*)(Y + tt * 512 + 8 * lane + 4);
            y[0] = a.x; y[1] = a.y; y[2] = a.z; y[3] = a.w; y[4] = b.x; y[5] = b.y; y[6] = b.z; y[7] = b.w; float s = 0.f;
#pragma unroll
            for (int e = 0; e < 8; ++e) s += y[e];
            const float mu = wave_sum(s) * (1.0f / 512.f); float q2 = 0.f;
#pragma unroll
            for (int e = 0; e < 8; ++e) { y[e] -= mu; q2 += y[e] * y[e]; }
            const float rs = 1.0f / sqrtf(wave_sum(q2) * (1.0f / 512.f) + g2::EPS);
            float lg[8], lb[8], gt[8], o[8]; ldf8(in->conv_ln_g + l * 512 + 8 * lane, lg); ldf8(in->conv_ln_b + l * 512 + 8 * lane, lb);
            g2::bf16_t* gp = w.GATE() + ((size_t)1 * M + m0 + tt) * 512 + 8 * lane; unpack8(*(const u32x4*)gp, gt);
#pragma unroll
            for (int e = 0; e < 8; ++e) o[e] = fsilu(y[e] * rs * lg[e] + lb[e]) * gt[e];
            st16(gp, pack8(o)); }
        __syncthreads();
    }
}


constexpr size_t WS_BB = 3 * g2::MiB, WS_CC = 3 * g2::MiB + 512 * 1024;
struct FSsmTab { InP in; W w;
    __device__ __forceinline__ void operator()(long i) const { const int p = i % 64, g = (i / 64) % 32; const long ld = i / (64 * 32);
        const float lr = in->lam_re[i], li = in->lam_im[i]; const float dt = expf(in->log_dt[ld * 32 + g]);
        const float e = expf(lr * dt), br_ = e * cosf(li * dt), bi_ = e * sinf(li * dt); w.lamb()[2 * i] = br_; w.lamb()[2 * i + 1] = bi_;
        const float nr = br_ - 1.0f, ni = bi_, den = lr * lr + li * li, fr = (nr * lr + ni * li) / den, fi = (ni * lr - nr * li) / den;
        g2::bf16_t* bb = (g2::bf16_t*)(w.ws + WS_BB) + ((size_t)(ld * 32 + g) * 2 * 64 + p) * 16; g2::bf16_t* cc = (g2::bf16_t*)(w.ws + WS_CC) + (size_t)(ld * 32 + g) * 16 * 128 + 2 * p;
        for (int c = 0; c < 16; ++c) { const float xr = in->b_re[i * 16 + c], xi = in->b_im[i * 16 + c]; bb[c] = g2::f2bf(fr * xr - fi * xi); bb[64 * 16 + c] = g2::f2bf(fr * xi + fi * xr);
            cc[c * 128] = g2::f2bf(in->c_re[((ld * 32 + g) * 16 + c) * 64 + p]); cc[c * 128 + 1] = g2::f2bf(-in->c_im[((ld * 32 + g) * 16 + c) * 64 + p]); } } };

typedef short bf16x8_t __attribute__((ext_vector_type(8)));
typedef float f32x2_t __attribute__((ext_vector_type(2)));
constexpr int SSM_WAVE_LDS = 12800, SSM_HROW = 272, SSM_XCH = 8 * SSM_WAVE_LDS;
__device__ __forceinline__ float fgelu(float x) { const float u = 0.7978845608028654f * (x + 0.044715f * x * x * x); return x * fsig(2.0f * u); }

template <int MODE> __device__ __forceinline__ void ssm_pass(const W& w, int l, int dir, int g, int m_lo, int ntok, float& hr, float& hi, LAS unsigned char* wl, int lane, float dval) {
    LAS f32x2_t* BU = (LAS f32x2_t*)wl; LAS unsigned char* Hb = wl + 8192;
    const int ld = l * 2 + dir, fr = lane & 15, fq = lane >> 4;
    const f32x2_t lam = *(const f32x2_t*)(w.lamb() + ((size_t)(ld * 32 + g) * 64 + lane) * 2);
    bf16x8_t bfr[4][2], cfr[4];
    { const g2::bf16_t* bb = (const g2::bf16_t*)(w.ws + WS_BB) + (size_t)(ld * 32 + g) * 2 * 64 * 16;
#pragma unroll
      for (int q = 0; q < 4; ++q)
#pragma unroll
          for (int ri = 0; ri < 2; ++ri) bfr[q][ri] = fq < 2 ? *(const bf16x8_t*)(bb + ((size_t)ri * 64 + 16 * q + fr) * 16 + 8 * fq) : (bf16x8_t){0, 0, 0, 0, 0, 0, 0, 0};
      if (MODE != 0) { const g2::bf16_t* cc = (const g2::bf16_t*)(w.ws + WS_CC) + ((size_t)(ld * 32 + g) * 16 + fr) * 128;
#pragma unroll
          for (int ks = 0; ks < 4; ++ks) cfr[ks] = *(const bf16x8_t*)(cc + 32 * ks + 8 * fq); } }
    const int nch = ntok >> 4; const g2::bf16_t* xs = w.XS() + (size_t)g * 16;
    auto chunk_row = [&](int ci) { return dir == 0 ? m_lo + 16 * ci : m_lo + ntok - 16 - 16 * ci; };
    bf16x8_t a_n = fq < 2 ? *(const bf16x8_t*)(xs + (size_t)(chunk_row(0) + fr) * 512 + 8 * fq) : (bf16x8_t){0, 0, 0, 0, 0, 0, 0, 0};
    float x_n[4], yf_n[4];
#pragma unroll
    for (int r = 0; r < 4; ++r) { x_n[r] = 0.f; yf_n[r] = 0.f; }
    if (MODE == 2) {
#pragma unroll
        for (int r = 0; r < 4; ++r) { const size_t o = (size_t)(chunk_row(0) + 4 * fq + r) * 512 + g * 16 + fr; x_n[r] = g2::bf2f(w.XS()[o]); yf_n[r] = w.TMP()[o]; } }
    if (MODE == 1) {
#pragma unroll
        for (int r = 0; r < 4; ++r) x_n[r] = g2::bf2f(w.XS()[(size_t)(chunk_row(0) + 4 * fq + r) * 512 + g * 16 + fr]); }
#pragma unroll 1
    for (int ci = 0; ci < nch; ++ci) {
        const int mt = chunk_row(ci); const bf16x8_t a = a_n; float xc[4], yfc[4];
#pragma unroll
        for (int r = 0; r < 4; ++r) { xc[r] = x_n[r]; yfc[r] = yf_n[r]; }
        if (ci + 1 < nch) { const int mn = chunk_row(ci + 1);
            a_n = fq < 2 ? *(const bf16x8_t*)(xs + (size_t)(mn + fr) * 512 + 8 * fq) : (bf16x8_t){0, 0, 0, 0, 0, 0, 0, 0};
            if (MODE != 0) {
#pragma unroll
                for (int r = 0; r < 4; ++r) { const size_t o = (size_t)(mn + 4 * fq + r) * 512 + g * 16 + fr; x_n[r] = g2::bf2f(w.XS()[o]); if (MODE == 2) yf_n[r] = w.TMP()[o]; } } }
#pragma unroll
        for (int q = 0; q < 4; ++q) { const f32x4 z = {0.f, 0.f, 0.f, 0.f};
            const f32x4 dre = __builtin_amdgcn_mfma_f32_16x16x32_bf16(a, bfr[q][0], z, 0, 0, 0), dim = __builtin_amdgcn_mfma_f32_16x16x32_bf16(a, bfr[q][1], z, 0, 0, 0);
#pragma unroll
            for (int r = 0; r < 4; ++r) BU[(4 * fq + r) * 64 + 16 * q + fr] = (f32x2_t){dre[r], dim[r]}; }
#pragma unroll
        for (int s_ = 0; s_ < 16; ++s_) { const int tt = dir == 0 ? s_ : 15 - s_; const f32x2_t b = BU[tt * 64 + lane];
            const float nr = lam.x * hr - lam.y * hi + b.x, ni = lam.x * hi + lam.y * hr + b.y; hr = nr; hi = ni;
            if (MODE != 0) *(LAS unsigned*)(Hb + tt * SSM_HROW + lane * 4) = pg8::cvt_pk_bf16(hr, hi); }
        if (MODE != 0) {
            f32x4 y = {0.f, 0.f, 0.f, 0.f};
#pragma unroll
            for (int ks = 0; ks < 4; ++ks) { const bf16x8_t ha = *(const LAS bf16x8_t*)(Hb + fr * SSM_HROW + 64 * ks + 16 * fq); y = __builtin_amdgcn_mfma_f32_16x16x32_bf16(ha, cfr[ks], y, 0, 0, 0); }
#pragma unroll
            for (int r = 0; r < 4; ++r) { const size_t o = (size_t)(mt + 4 * fq + r) * 512 + g * 16 + fr;
                if (MODE == 1) w.TMP()[o] = y[r] + dval * xc[r]; else w.YS()[o] = g2::f2bf(fgelu(y[r] + yfc[r])); } }
    }
}
__device__ __forceinline__ void ph_ssm(InP in, const W& w, int l, LAS unsigned char* L) {
    int tid_ = threadIdx.x; asm volatile("" : "+v"(tid_)); const int lane = tid_ & 63, wave = __builtin_amdgcn_readfirstlane(tid_ >> 6);
    LAS unsigned char* wl = L + wave * SSM_WAVE_LDS; LAS f32x2_t* XCH = (LAS f32x2_t*)(L + SSM_XCH);
    const int G_ = fresh_grid();
    for (int bu = blockIdx.x; bu < 128; bu += G_) {
        if (bu < 64) {
            const int b = bu >> 5, g = bu & 31, m_lo = MP + b * 2048 + wave * 256; const float dval = in->ssm_d[l * 512 + g * 16 + (lane & 15)];
            float ef_r = 0.f, ef_i = 0.f, eb_r = 0.f, eb_i = 0.f;
            ssm_pass<0>(w, l, 0, g, m_lo, 256, ef_r, ef_i, wl, lane, dval); ssm_pass<0>(w, l, 1, g, m_lo, 256, eb_r, eb_i, wl, lane, dval);
            XCH[(wave * 2 + 0) * 64 + lane] = (f32x2_t){ef_r, ef_i}; XCH[(wave * 2 + 1) * 64 + lane] = (f32x2_t){eb_r, eb_i};
            __syncthreads();
            float cr[2], ci[2];
#pragma unroll
            for (int dir = 0; dir < 2; ++dir) { const f32x2_t lam = *(const f32x2_t*)(w.lamb() + ((size_t)((l * 2 + dir) * 32 + g) * 64 + lane) * 2); float pr = lam.x, pi = lam.y;
#pragma unroll
                for (int sq = 0; sq < 8; ++sq) { const float t = pr * pr - pi * pi; pi = 2.f * pr * pi; pr = t; }
                const float* st = in->state_ssm + ((((size_t)b * 2 + l) * 2 + dir) * 2) * 2048 + g * 64 + lane; float hr = st[0], hi = st[2048];
                if (dir == 0) { for (int j = 0; j < wave; ++j) { const f32x2_t e = XCH[(j * 2 + 0) * 64 + lane]; const float t = pr * hr - pi * hi + e.x; hi = pr * hi + pi * hr + e.y; hr = t; } }
                else { for (int j = 7; j > wave; --j) { const f32x2_t e = XCH[(j * 2 + 1) * 64 + lane]; const float t = pr * hr - pi * hi + e.x; hi = pr * hi + pi * hr + e.y; hr = t; } }
                cr[dir] = hr; ci[dir] = hi; }
            ssm_pass<1>(w, l, 0, g, m_lo, 256, cr[0], ci[0], wl, lane, dval); ssm_pass<2>(w, l, 1, g, m_lo, 256, cr[1], ci[1], wl, lane, dval);
            __syncthreads();
        } else {
            const int pair = (bu - 64) * 8 + wave, b = pair >> 5, g = pair & 31, m_lo = b * 256; const float dval = in->ssm_d[l * 512 + g * 16 + (lane & 15)];
            float hr = 0.f, hi = 0.f;
            ssm_pass<1>(w, l, 0, g, m_lo, 256, hr, hi, wl, lane, dval);
            { float* o = w.out + g2::OUT_ST + ((((size_t)b * 2 + l) * 2 + 0) * 2) * 2048 + g * 64 + lane; o[0] = hr; o[2048] = hi; }
            hr = 0.f; hi = 0.f;
            ssm_pass<2>(w, l, 1, g, m_lo, 256, hr, hi, wl, lane, dval);
            { float* o = w.out + g2::OUT_ST + ((((size_t)b * 2 + l) * 2 + 1) * 2) * 2048 + g * 64 + lane; o[0] = hr; o[2048] = hi; }
        }
    }
}


constexpr size_t WS_CK = g2::WS_BBAR, WS_CV = g2::WS_BBAR + 256 * 1024;
struct FCvtCache { InP in; W w;
    __device__ __forceinline__ void operator()(long i) const { const long n = 2L * 2 * 256 * 128; if (i < n) ((g2::bf16_t*)(w.ws + WS_CK))[i] = g2::f2bf(in->cache_k[i]); else ((g2::bf16_t*)(w.ws + WS_CV))[i - n] = g2::f2bf(in->cache_v[i - n]); } };
typedef float f32x16 __attribute__((ext_vector_type(16)));
typedef short s16x4 __attribute__((ext_vector_type(4)));
constexpr int AT_SLOT = 16384, AT_KOFF = 0, AT_VOFF = 8192;
constexpr float AT_C2 = 0.125f * 1.4426950408889634f, AT_LOG2E = 1.4426950408889634f;
__device__ __forceinline__ int at_crow(int r, int hi) { return (r & 3) + 8 * (r >> 2) + 4 * hi; }
__device__ __forceinline__ float at_rowmax(const f32x16& p0, const f32x16& p1) { float a = fmaxf(p0[0], p1[0]);
#pragma unroll
    for (int r = 1; r < 16; ++r) a = fmaxf(a, fmaxf(p0[r], p1[r]));
    const auto rr = __builtin_amdgcn_permlane32_swap(__float_as_uint(a), __float_as_uint(a), false, false); return fmaxf(__uint_as_float(rr[0]), __uint_as_float(rr[1])); }

__device__ __forceinline__ void ph_attn(InP in, const W& w, int l, LAS unsigned char* L) {
    int tid_ = threadIdx.x; asm volatile("" : "+v"(tid_)); const int lane = tid_ & 63, r32 = lane & 31, hi = lane >> 5, wave = __builtin_amdgcn_readfirstlane(tid_ >> 6);
    const int G_ = fresh_grid();
    for (int ui = blockIdx.x; ui < 256; ui += G_) {
        const int u = (ui + 128) & 255;
        int head, kv, mq, qpos, ntile, nctx, klo; const g2::bf16_t *kbase, *vbase, *ckbase, *cvbase;
        if (u < 128) { const int b = u >> 6, rem = u & 63, pb = (rem >> 1) & 15; kv = rem >> 5; head = kv * 4 + (rem & 1) * 2 + (wave >> 2); qpos = pb * 128 + 32 * (wave & 3) + r32; mq = MP + b * 2048 + qpos;
            klo = pb * 128 - 128 < 0 ? 0 : pb * 128 - 128; const int khi = pb * 128 + 256 > 2048 ? 2048 : pb * 128 + 256; nctx = 4; ntile = 4 + (khi - klo) / 64;
            kbase = w.K() + (size_t)(MP + b * 2048 + klo) * 128; vbase = w.V() + (size_t)(MP + b * 2048 + klo) * 128;
            ckbase = (const g2::bf16_t*)(w.ws + WS_CK) + (size_t)(b * 2 + l) * 256 * 128; cvbase = (const g2::bf16_t*)(w.ws + WS_CV) + (size_t)(b * 2 + l) * 256 * 128; }
        else { const int b = (u - 128) >> 3; head = (u - 128) & 7; kv = head >> 2; qpos = 32 * wave + r32; mq = b * 256 + qpos; klo = 0; nctx = 0; ntile = 4;
            kbase = w.K() + (size_t)(b * 256) * 128; vbase = w.V() + (size_t)(b * 256) * 128; ckbase = kbase; cvbase = vbase; }
        bf16x8_t qr[4];
#pragma unroll
        for (int d0 = 0; d0 < 4; ++d0) qr[d0] = *(const bf16x8_t*)(w.Q() + (size_t)mq * 512 + head * 64 + d0 * 16 + hi * 8);
        float mrun = in->attn_sink[l * 8 + head] * AT_LOG2E, lsum = hi == 0 ? 1.0f : 0.0f;
        f32x16 o[2]; o[0] = f32x16{}; o[1] = f32x16{};
        auto ksrc = [&](int i) { const g2::bf16_t* base = i < nctx ? ckbase + (size_t)(64 * i) * 128 : kbase + (size_t)(64 * (i - nctx)) * 128; return base + (size_t)lane * 128 + kv * 64 + 8 * wave; };
        auto vsrc = [&](int i) { const g2::bf16_t* base = i < nctx ? cvbase + (size_t)(64 * i) * 128 : vbase + (size_t)(64 * (i - nctx)) * 128; return base + (size_t)(16 * (wave & 3) + (lane >> 2)) * 128 + kv * 64 + (wave >> 2) * 32 + (lane & 3) * 8; };
        u32x4 kreg = *(const u32x4*)ksrc(0), vreg = *(const u32x4*)vsrc(0);
        __syncthreads();
        *(LAS u32x4*)(L + AT_KOFF + wave * 1024 + lane * 16) = kreg; *(LAS u32x4*)(L + AT_VOFF + wave * 1024 + lane * 16) = vreg;
        __syncthreads();
#pragma unroll 1
        for (int i = 0; i < ntile; ++i) {
            LAS unsigned char* slot = L + (i & 1) * AT_SLOT;
            if (i + 1 < ntile) { kreg = *(const u32x4*)ksrc(i + 1); vreg = *(const u32x4*)vsrc(i + 1); }
            const int kp0 = klo + 64 * (i - nctx); const int q0 = qpos - r32;
            const bool win = i >= nctx && nctx > 0; const bool skip = win && (kp0 > q0 + 31 + 128 || kp0 + 63 < q0 - 128);
            if (!skip) {
                f32x16 p0 = f32x16{}, p1 = f32x16{};
                { const LAS unsigned char* kb = slot + AT_KOFF + hi * 1024 + r32 * 16;
#pragma unroll
                  for (int d0 = 0; d0 < 4; ++d0) { const bf16x8_t b0 = *(const LAS bf16x8_t*)(kb + d0 * 2048), b1 = *(const LAS bf16x8_t*)(kb + d0 * 2048 + 512);
                      p0 = __builtin_amdgcn_mfma_f32_32x32x16_bf16(b0, qr[d0], p0, 0, 0, 0); p1 = __builtin_amdgcn_mfma_f32_32x32x16_bf16(b1, qr[d0], p1, 0, 0, 0); } }
                if (win && (kp0 + 63 - q0 > 128 || q0 + 31 - kp0 > 128)) {
#pragma unroll
                    for (int r = 0; r < 16; ++r) { const int kk = kp0 + at_crow(r, hi); const int d0_ = qpos - kk, d1_ = qpos - (kk + 32);
                        if (d0_ > 128 || d0_ < -128) p0[r] = -1e30f; if (d1_ > 128 || d1_ < -128) p1[r] = -1e30f; } }
                const float rm = at_rowmax(p0, p1) * AT_C2; const float mnew = fmaxf(mrun, rm); const float alpha = __builtin_amdgcn_exp2f(mrun - mnew); mrun = mnew;
                float psum = 0.f;
#pragma unroll
                for (int r = 0; r < 16; ++r) { p0[r] = __builtin_amdgcn_exp2f(p0[r] * AT_C2 - mnew); p1[r] = __builtin_amdgcn_exp2f(p1[r] * AT_C2 - mnew); psum += p0[r] + p1[r]; }
                lsum = lsum * alpha + psum;
#pragma unroll
                for (int r = 0; r < 16; ++r) { o[0][r] *= alpha; o[1][r] *= alpha; }
                u32x4 pw[4];
#pragma unroll
                for (int s_ = 0; s_ < 4; ++s_) { const f32x16& P = s_ < 2 ? p0 : p1; const int bse = (s_ & 1) * 8;
                    pw[s_] = (u32x4){pg8::cvt_pk_bf16(P[bse], P[bse + 1]), pg8::cvt_pk_bf16(P[bse + 2], P[bse + 3]), pg8::cvt_pk_bf16(P[bse + 4], P[bse + 5]), pg8::cvt_pk_bf16(P[bse + 6], P[bse + 7])}; }
                const unsigned vb = (unsigned)(uintptr_t)(slot + AT_VOFF) + ((lane >> 4) & 1) * 32 + (lane & 3) * 8 + (4 * hi + ((lane & 15) >> 2)) * 64;
#pragma unroll
                for (int d0 = 0; d0 < 2; ++d0) { s16x4 lo[4], hh[4];
#pragma unroll
                    for (int ks = 0; ks < 4; ++ks) {
                        asm volatile("ds_read_b64_tr_b16 %0, %1 offset:%c2" : "=&v"(lo[ks]) : "v"(vb), "i"(d0 * 4096 + ks * 1024) : "memory");
                        asm volatile("ds_read_b64_tr_b16 %0, %1 offset:%c2" : "=&v"(hh[ks]) : "v"(vb), "i"(d0 * 4096 + ks * 1024 + 512) : "memory"); }
                    asm volatile("s_waitcnt lgkmcnt(0)" ::: "memory"); __builtin_amdgcn_sched_barrier(0);
#pragma unroll
                    for (int ks = 0; ks < 4; ++ks) { const bf16x8_t vf = (bf16x8_t){lo[ks][0], lo[ks][1], lo[ks][2], lo[ks][3], hh[ks][0], hh[ks][1], hh[ks][2], hh[ks][3]};
                        o[d0] = __builtin_amdgcn_mfma_f32_32x32x16_bf16(vf, __builtin_bit_cast(bf16x8_t, pw[ks]), o[d0], 0, 0, 0); } }
            }
            if (i + 1 < ntile) { LAS unsigned char* ns = L + ((i + 1) & 1) * AT_SLOT; *(LAS u32x4*)(ns + AT_KOFF + wave * 1024 + lane * 16) = kreg; *(LAS u32x4*)(ns + AT_VOFF + wave * 1024 + lane * 16) = vreg; }
            __syncthreads();
        }
        { const auto rr = __builtin_amdgcn_permlane32_swap(__float_as_uint(lsum), __float_as_uint(lsum), false, false); const float inv = 1.0f / (__uint_as_float(rr[0]) + __uint_as_float(rr[1]));
          g2::bf16_t* gp = w.GATE() + (size_t)mq * 512 + head * 64;
#pragma unroll
          for (int d0 = 0; d0 < 2; ++d0)
#pragma unroll
              for (int rq = 0; rq < 4; ++rq) { g2::bf16_t* p = gp + 32 * d0 + 8 * rq + 4 * hi; const unsigned long long gv = *(const unsigned long long*)p; const unsigned g0 = (unsigned)gv, g1 = (unsigned)(gv >> 32);
                  const float a0 = o[d0][4 * rq] * inv * __uint_as_float(g0 << 16), a1 = o[d0][4 * rq + 1] * inv * __uint_as_float(g0 & 0xffff0000u), a2 = o[d0][4 * rq + 2] * inv * __uint_as_float(g1 << 16), a3 = o[d0][4 * rq + 3] * inv * __uint_as_float(g1 & 0xffff0000u);
                  *(unsigned long long*)p = (unsigned long long)pg8::cvt_pk_bf16(a0, a1) | ((unsigned long long)pg8::cvt_pk_bf16(a2, a3) << 32); } }
    }
}

struct Args { In in; float* out; unsigned char* ws; };
__device__ __forceinline__ W fresh_w() { const __attribute__((address_space(4))) Args* p = (const __attribute__((address_space(4))) Args*)__builtin_amdgcn_kernarg_segment_ptr(); asm volatile("" : "+s"(p)); W w; w.ws = p->ws; w.out = p->out; return w; }
__device__ __forceinline__ InP fresh_in() { InP p = (InP)__builtin_amdgcn_kernarg_segment_ptr(); asm volatile("" : "+s"(p)); return p; }

template <class F> __device__ __forceinline__ void run_stage(const F& f, long n) {
    int tid_ = threadIdx.x; asm volatile("" : "+v"(tid_));
    const long stride_ = (long)fresh_grid() * NTHREADS;
    for (long i = (long)blockIdx.x * NTHREADS + tid_; i < n; i += stride_) f(i);
}

__global__ void __launch_bounds__(NTHREADS, 2) mk_fwd(Args a) {
    extern __shared__ __attribute__((aligned(16))) unsigned char lds[];
    LAS unsigned char* L = (LAS unsigned char*)lds;
    volatile LAS unsigned* MISC = (volatile LAS unsigned*)(L + MISC_OFF);
    for (int u = threadIdx.x; u < (LDS_BYTES - LDSCTL_OFF) / 4; u += NTHREADS) ((LAS unsigned*)(L + LDSCTL_OFF))[u] = 0u;
    __syncthreads();
#define in fresh_in()
#define w fresh_w()
    XcdBarrier bar = xcd_barrier_post((unsigned*)w.ctl() + CW_BAR, MISC + 8);
#define BAR() xcd_barrier(bar)
    run_stage(g2::FMod{in, w}, 2L * 3 * 3072); run_stage(g2::FRope{w}, 2048L * 32); run_stage(FSsmTab{in, w}, 2L * 2 * 32 * 64); run_stage(FCvtCache{in, w}, 2L * 2 * 2 * 256 * 128);
    ph_convert(in, w, L); run_stage(FCvtPool{in, w}, 2L * 512 * 1024);
    BAR();
#pragma unroll 1
    for (int l = 0; l < 2; ++l) {
        ph_rows<false>(in, w, l); BAR();
        { pg8::Gemm g{w.H(), w.win() + (size_t)l * INC * 1024, M, INC, 1024}; pg8::StaticOrder S; S.init(M, INC, (int)gridDim.x, (int)blockIdx.x); Epi1 E{w, l};
          pg8::gemm_phase<Epi1, pg8::StaticOrder, true, true>(L, g, S, E); }
        BAR();
        ph_ssm(in, w, l, L); __syncthreads(); ph_attn(in, w, l, L); __syncthreads(); ph_convpool(in, w, l, L); BAR();
        { pg8::Gemm g{w.YS(), w.wglu() + (size_t)l * 1024 * 512, M, 1024, 512}; pg8::StaticOrder S; S.init(M, 1024, (int)gridDim.x, (int)blockIdx.x); Epi3 E{w};
          pg8::gemm_phase<Epi3, pg8::StaticOrder, true, true>(L, g, S, E); }
        BAR();
        { pg8::Gemm g{w.GATE(), w.wbr() + (size_t)l * 4 * 1024 * 512, 4 * M, 4 * 1024, 512}; Sched4a S{(int)blockIdx.x}; Epi4a E{w};
          pg8::gemm_phase<Epi4a, Sched4a, true, true>(L, g, S, E); }
        BAR();
        { pg8::Gemm g{w.MRG(), w.wout() + (size_t)l * 1024 * 1024, M, 1024, 1024}; pg8::StaticOrder S; S.init(M, 1024, (int)gridDim.x, (int)blockIdx.x); Epi4b E{in, w, l};
          pg8::gemm_phase<Epi4b, pg8::StaticOrder, true, true>(L, g, S, E); }
        BAR();
    }
    ph_rows<true>(in, w, 0);
#undef BAR
#undef in
#undef w
}
}

extern "C" void kernel_launch(void* const* d_in, const int* in_sizes, int n_in, void* d_out, int out_size, void* d_ws, size_t ws_size, hipStream_t stream) {
    static int grid = 0;
    if (grid == 0) {
        if (n_in != 30 || (size_t)out_size != g2::OUT_TOTAL || ws_size < g2::WS_END) { fprintf(stderr, "kernel_launch: unexpected problem shape (n_in %d out %d ws %zu)\n", n_in, out_size, ws_size); grid = -1; return; }
        int dev = 0, cus = 0, per_cu = 0;
        if (hipGetDevice(&dev) != hipSuccess || hipDeviceGetAttribute(&cus, hipDeviceAttributeMultiprocessorCount, dev) != hipSuccess) { grid = -1; return; }
        if (hipFuncSetAttribute((const void*)mk::mk_fwd, hipFuncAttributeMaxDynamicSharedMemorySize, mk::LDS_BYTES) != hipSuccess) { fprintf(stderr, "kernel_launch: hipFuncSetAttribute failed\n"); grid = -1; return; }
        if (hipOccupancyMaxActiveBlocksPerMultiprocessor(&per_cu, (const void*)mk::mk_fwd, mk::NTHREADS, mk::LDS_BYTES) != hipSuccess || per_cu < 1) { fprintf(stderr, "kernel_launch: occupancy query says %d blocks/CU\n", per_cu); (void)hipGetLastError(); grid = -1; return; }
        grid = cus;
    }
    if (grid < 0) return;
    if (hipMemsetAsync((char*)d_ws + g2::WS_CTL, 0, mk::CTL_ZERO_BYTES, stream) != hipSuccess) return;
    mk::Args a{}; const float* ptr[30]; for (int i = 0; i < 30; ++i) ptr[i] = (const float*)d_in[i]; memcpy(&a.in, ptr, sizeof(a.in));
    a.out = (float*)d_out; a.ws = (unsigned char*)d_ws;
    hipLaunchKernelGGL(mk::mk_fwd, dim3(grid), dim3(mk::NTHREADS), mk::LDS_BYTES, stream, a);
}
```

```cpp
#include <hip/hip_runtime.h>
#include <cstdio>
#include <cstring>
#include <cstdint>
#ifdef CPU_EMU
#include <cmath>
#include <cstddef>
#include <cstring>
#define HD_FN inline
#else
#define HD_FN __host__ __device__ __forceinline__
#endif

namespace g2 {
typedef unsigned short bf16_t;
#ifndef CFG_BATCH
#define CFG_BATCH 16
#endif
#ifndef CFG_DEC_BATCH
#define CFG_DEC_BATCH 2
#endif
constexpr int D = 1024, DEPTH = 2, NB_P = CFG_BATCH, L_P = 256, NB_S = CFG_DEC_BATCH, L_S = 2048, PAST = 256;
constexpr int MP = NB_P * L_P, MS = NB_S * L_S, M = MP + MS;
constexpr int GRID_W = 64, NH = 8, WINDOW = 128, CONVK = 31, SG = 32, SC = 16, SP = 64, INC = 8960, NT1 = INC / 256;
constexpr int C_XPOOL = 2816;
constexpr float EPS = 1e-6f;

HD_FN bf16_t f2bf(float f) { unsigned u; memcpy(&u, &f, 4); u = (u + 0x7fffu + ((u >> 16) & 1u)) >> 16; return (bf16_t)u; }
HD_FN float bf2f(bf16_t h) { unsigned u = (unsigned)h << 16; float f; memcpy(&f, &u, 4); return f; }
HD_FN float sigmoidf_(float x) { return 1.0f / (1.0f + expf(-x)); }
HD_FN float siluf_(float x) { return x * sigmoidf_(x); }
HD_FN float geluf_(float x) { return 0.5f * x * (1.0f + tanhf(0.7978845608028654f * (x + 0.044715f * x * x * x))); }

HD_FN int row_path(int m) { return m >= MP; }
HD_FN int row_len(int m) { return m >= MP ? L_S : L_P; }
HD_FN int row_seq0(int m) { return m >= MP ? MP + ((m - MP) / L_S) * L_S : (m / L_P) * L_P; }
HD_FN int row_batch(int m) { return m >= MP ? (m - MP) / L_S : m / L_P; }
HD_FN int row_modj(int m) { return m >= MP ? 1 + (m - MP) / L_S : 0; }

struct In {
    const float *x_prompt, *x_sample, *cache_k, *cache_v, *state_ssm, *c, *c_ctx, *norm_g, *w_ada, *b_ada, *w_in, *attn_sink, *conv_dw, *conv_db,
        *conv_ln_g, *conv_ln_b, *pool_w, *pool_scale, *lam_re, *lam_im, *log_dt, *b_re, *b_im, *c_re, *c_im, *ssm_d, *glu_w, *w_br, *w_out, *final_g;
};
#ifdef CPU_EMU
typedef const In* InP;
#else
typedef const __attribute__((address_space(4))) In* InP;
#endif
constexpr size_t OUT_YP = 0, OUT_YS = (size_t)MP * D, OUT_K = (size_t)M * D, OUT_V = OUT_K + (size_t)NB_P * DEPTH * L_P * 128, OUT_ST = OUT_V + (size_t)NB_P * DEPTH * L_P * 128,
                 OUT_TOTAL = OUT_ST + (size_t)NB_P * DEPTH * 2 * 2 * SG * SP;

constexpr size_t MiB = 1u << 20;
constexpr size_t WS_CTL = 0;
constexpr size_t WS_MOD = 1 * MiB;
constexpr size_t WS_ROPE = WS_MOD + 128 * 1024;
constexpr size_t WS_LAMB = WS_ROPE + 512 * 1024;
constexpr size_t WS_BBAR = WS_LAMB + 64 * 1024;
constexpr size_t WS_WIN = 4 * MiB;
constexpr size_t WS_WGLU = WS_WIN + (size_t)2 * INC * 1024 * 2;
constexpr size_t WS_WBR = WS_WGLU + 2 * MiB;
constexpr size_t WS_WOUT = WS_WBR + 8 * MiB;
constexpr size_t WS_H = WS_WOUT + 4 * MiB;
constexpr size_t WS_Q = WS_H + 16 * MiB;
constexpr size_t WS_XC = WS_Q + 8 * MiB;
constexpr size_t WS_MRGP = WS_H;
constexpr size_t WS_XP = WS_XC + 8 * MiB;
constexpr size_t WS_XS = WS_XP + 8 * MiB;
constexpr size_t WS_K = WS_XS + 8 * MiB;
constexpr size_t WS_V = WS_K + 2 * MiB;
constexpr size_t WS_GATE = WS_V + 2 * MiB;
constexpr size_t WS_GM = WS_GATE + 32 * MiB;
constexpr size_t WS_YS = WS_GM + 64 * MiB;
constexpr size_t WS_MRG = WS_YS + 8 * MiB;
constexpr size_t WS_TMP = WS_MRG + 16 * MiB;
constexpr size_t WS_S = WS_TMP + 16 * MiB;
constexpr size_t WS_END = WS_S + 32 * MiB;
static_assert(WS_END <= 293601280ull, "workspace map exceeds the guaranteed d_ws size");

struct W {
    unsigned char* ws; float* out;
    HD_FN unsigned* ctl() const { return (unsigned*)(ws + WS_CTL); }
    HD_FN float* mod() const { return (float*)(ws + WS_MOD); }
    HD_FN float* ropec() const { return (float*)(ws + WS_ROPE); }
    HD_FN float* ropes() const { return (float*)(ws + WS_ROPE) + 2048 * 32; }
    HD_FN float* lamb() const { return (float*)(ws + WS_LAMB); }
    HD_FN float* bbar() const { return (float*)(ws + WS_BBAR); }
    HD_FN bf16_t* win() const { return (bf16_t*)(ws + WS_WIN); }
    HD_FN bf16_t* wglu() const { return (bf16_t*)(ws + WS_WGLU); }
    HD_FN bf16_t* wbr() const { return (bf16_t*)(ws + WS_WBR); }
    HD_FN bf16_t* wout() const { return (bf16_t*)(ws + WS_WOUT); }
    HD_FN bf16_t* H() const { return (bf16_t*)(ws + WS_H); }
    HD_FN bf16_t* Q() const { return (bf16_t*)(ws + WS_Q); }
    HD_FN bf16_t* XC() const { return (bf16_t*)(ws + WS_XC); }
    HD_FN bf16_t* XP() const { return (bf16_t*)(ws + WS_XP); }
    HD_FN bf16_t* XS() const { return (bf16_t*)(ws + WS_XS); }
    HD_FN bf16_t* K() const { return (bf16_t*)(ws + WS_K); }
    HD_FN bf16_t* V() const { return (bf16_t*)(ws + WS_V); }
    HD_FN bf16_t* GATE() const { return (bf16_t*)(ws + WS_GATE); }
    HD_FN bf16_t* GM() const { return (bf16_t*)(ws + WS_GM); }
    HD_FN bf16_t* YS() const { return (bf16_t*)(ws + WS_YS); }
    HD_FN bf16_t* MRG() const { return (bf16_t*)(ws + WS_MRG); }
    HD_FN float* MRGP() const { return (float*)(ws + WS_MRGP); }
    HD_FN float* TMP() const { return (float*)(ws + WS_TMP); }
    HD_FN float* S() const { return (float*)(ws + WS_S); }
};
HD_FN W make_w(unsigned char* ws, float* out) { W w{}; w.ws = ws; w.out = out; return w; }

HD_FN const float* xrow(InP in, const W& w, int l, int m) { return l == 0 ? (m < MP ? in->x_prompt + (size_t)m * D : in->x_sample + (size_t)(m - MP) * D) : w.out + (size_t)m * D; }

HD_FN int in_orig_col(int row) { const int pn = row >> 8, c = row & 255, bj = c >> 7, cc = c & 127;
    if (pn < 2) return (pn * 4 + (cc >> 5)) * 64 + bj * 32 + (cc & 31);
    if (pn == 2) return cc < 64 ? 512 + (cc >> 5) * 64 + bj * 32 + (cc & 31) : 640 + bj * 64 + (cc - 64);
    if (pn < 5) return 768 + (pn - 3) * 256 + c;
    if (pn < 9) return 1280 + bj * 512 + (pn - 5) * 128 + cc;
    if (pn < 11) return 2304 + (pn - 9) * 256 + c;
    if (pn < 13) return 2816 + (pn - 11) * 256 + c;
    if (pn < 15) return 3328 + (pn - 13) * 256 + c;
    if (pn < 17) return 3840 + (pn - 15) * 256 + c;
    if (pn < 19) return 4352 + (pn - 17) * 256 + c;
    return 4864 + (pn - 19) * 256 + c; }
HD_FN int glu_orig_col(int row) { const int pn = row >> 8, c = row & 255, bj = c >> 7, cc = c & 127; return bj * 512 + pn * 128 + cc; }

struct FMod { InP in; W w;
    HD_FN void operator()(long i) const { int n = i % 3072; int j = (i / 3072) % 3; int l = i / (3 * 3072);
        const float* cv = j == 0 ? in->c_ctx : in->c + (size_t)(j - 1) * D; const float* wa = in->w_ada + (size_t)l * D * 3072;
        float acc = 0.f; for (int k = 0; k < D; ++k) acc += siluf_(cv[k]) * wa[(size_t)k * 3072 + n];
        w.mod()[i] = acc + in->b_ada[l * 3072 + n]; } };
struct FRope { W w;
    HD_FN void operator()(long i) const { int j = i % 32, t = i / 32; float row = (float)(t / GRID_W), col = (float)(t % GRID_W);
        float inv = powf(10000.0f, -(float)(j % 16) / 16.0f); float ang = (j < 16 ? row : col) * inv; w.ropec()[i] = cosf(ang); w.ropes()[i] = sinf(ang); } };
struct FSsmParam { InP in; W w;
    HD_FN void operator()(long i) const { int g = (i / SP) % SG; long ld = i / (SP * SG);
        float lr = in->lam_re[i], li = in->lam_im[i]; float dt = expf(in->log_dt[ld * SG + g]);
        float e = expf(lr * dt), br_ = e * cosf(li * dt), bi_ = e * sinf(li * dt); w.lamb()[2 * i] = br_; w.lamb()[2 * i + 1] = bi_;
        float nr = br_ - 1.0f, ni = bi_; float den = lr * lr + li * li; float fr = (nr * lr + ni * li) / den, fi = (ni * lr - nr * li) / den;
        for (int c = 0; c < SC; ++c) { float xr = in->b_re[i * SC + c], xi = in->b_im[i * SC + c];
            w.bbar()[(i * SC + c) * 2] = fr * xr - fi * xi; w.bbar()[(i * SC + c) * 2 + 1] = fr * xi + fi * xr; } } };
struct FCvtIn { InP in; W w;
    HD_FN void operator()(long i) const { int k = i % 1024; int row = (i / 1024) % INC; int l = i / ((long)INC * 1024); const int oc = in_orig_col(row);
        const float* src = in->w_in + ((size_t)l * D + k) * INC; float v;
        if (oc >= C_XPOOL && oc < C_XPOOL + 512) { const int g = (oc - C_XPOOL) >> 7, co = (oc - C_XPOOL) & 127; const float* pw = in->pool_w + ((size_t)l * 4 + g) * 128 * 128 + co; const float* s = src + C_XPOOL + g * 128;
            float acc = 0.f; for (int ci = 0; ci < 128; ++ci) acc += s[ci] * pw[(size_t)ci * 128]; v = acc * in->pool_scale[l * 512 + g * 128 + co]; }
        else v = src[oc];
        w.win()[i] = f2bf(v); } };
struct FCvtGlu { InP in; W w;
    HD_FN void operator()(long i) const { int k = i % 512; int row = (i / 512) % 1024; int l = i / (512 * 1024); w.wglu()[i] = f2bf(in->glu_w[((size_t)l * 512 + k) * 1024 + glu_orig_col(row)]); } };
struct FCvtBr { InP in; W w;
    HD_FN void operator()(long i) const { int k = i % 512; int d = (i / 512) % 1024; int ln = i / (512 * 1024); w.wbr()[i] = f2bf(in->w_br[((size_t)ln * 512 + k) * 1024 + d]); } };
struct FCvtOut { InP in; W w;
    HD_FN void operator()(long i) const { int k = i % 1024; int d = (i / 1024) % 1024; int l = i / (1024 * 1024); w.wout()[i] = f2bf(in->w_out[((size_t)l * 1024 + k) * 1024 + d]); } };

struct FH { InP in; W w; int l, pad;
    HD_FN void operator()(long m) const { const float* x = xrow(in, w, l, (int)m); float ss = 0.f; for (int k = 0; k < D; ++k) ss += x[k] * x[k];
        float r = 1.0f / sqrtf(ss / D + EPS); const float* mo = w.mod() + ((size_t)l * 3 + row_modj((int)m)) * 3072; const float* g = in->norm_g + l * D;
        for (int k = 0; k < D; ++k) w.H()[(size_t)m * D + k] = f2bf((x[k] * r) * g[k] * (1.0f + mo[1024 + k]) + mo[k]); } };

HD_FN void epi1(const W& w, int l, int m, int pn, int cc, float a0, float a1) {
    if (pn <= 2) { const bool smp = m >= MP; const int t = m - row_seq0(m);
        if (pn < 2 || cc < 64) { const int j = cc & 31; float o1 = a0, o2 = a1;
            if (smp) { const float cs = w.ropec()[t * 32 + j], sn = w.ropes()[t * 32 + j]; o1 = a0 * cs - a1 * sn; o2 = a0 * sn + a1 * cs; }
            if (pn < 2) { const int h = pn * 4 + (cc >> 5); w.Q()[(size_t)m * 512 + h * 64 + j] = f2bf(o1); w.Q()[(size_t)m * 512 + h * 64 + 32 + j] = f2bf(o2); }
            else { const int kv = cc >> 5; w.K()[(size_t)m * 128 + kv * 64 + j] = f2bf(o1); w.K()[(size_t)m * 128 + kv * 64 + 32 + j] = f2bf(o2);
                if (!smp) { float* o = w.out + OUT_K + (((size_t)row_batch(m) * DEPTH + l) * L_P + t) * 128 + kv * 64 + j; o[0] = a0; o[32] = a1; } } }
        else { const int c2 = cc - 64; w.V()[(size_t)m * 128 + c2] = f2bf(a0); w.V()[(size_t)m * 128 + 64 + c2] = f2bf(a1);
            if (!smp) { float* o = w.out + OUT_V + (((size_t)row_batch(m) * DEPTH + l) * L_P + t) * 128 + c2; o[0] = a0; o[64] = a1; } }
        return; }
    if (pn >= 5 && pn < 9) { w.XC()[(size_t)m * 512 + (pn - 5) * 128 + cc] = f2bf(a0 * sigmoidf_(a1)); return; }
    if (pn >= 19) { bf16_t* o = w.GM() + (size_t)m * 4096 + (pn - 19) * 256 + cc; o[0] = f2bf(sigmoidf_(a0)); o[128] = f2bf(sigmoidf_(a1)); return; }
    if (pn == 11 || pn == 12) { bf16_t* o = w.XP() + (size_t)m * 512 + (pn - 11) * 256 + cc; o[0] = f2bf(a0); o[128] = f2bf(a1); return; }
    if (pn == 15 || pn == 16) { bf16_t* o = w.XS() + (size_t)m * 512 + (pn - 15) * 256 + cc; o[0] = f2bf(a0); o[128] = f2bf(a1); return; }
    { const int br = pn < 5 ? 0 : pn < 11 ? 1 : pn < 15 ? 2 : 3; const int t0 = br == 0 ? 3 : br == 1 ? 9 : br == 2 ? 13 : 17;
      bf16_t* o = w.GATE() + ((size_t)br * M + m) * 512 + (pn - t0) * 256 + cc; o[0] = f2bf(siluf_(a0)); o[128] = f2bf(siluf_(a1)); } }
struct FG1 { InP in; W w; int l, pad;
    HD_FN void operator()(long i) const { int cc = i % 128; int pn = (i / 128) % NT1; int m = i / (128 * NT1); const bf16_t* a = w.H() + (size_t)m * D;
        const bf16_t* b0 = w.win() + ((size_t)l * INC + pn * 256 + cc) * D; const bf16_t* b1 = b0 + (size_t)128 * D; float a0 = 0.f, a1 = 0.f;
        for (int k = 0; k < D; ++k) { const float av = bf2f(a[k]); a0 += av * bf2f(b0[k]); a1 += av * bf2f(b1[k]); }
        epi1(w, l, m, pn, cc, a0, a1); } };

struct FAttn { InP in; W w; int l, pad;
    HD_FN void operator()(long i) const { int dp = i % 4, hh = (i / 4) % 8; int m = i / 32; const bool smp = m >= MP; const int L = row_len(m), s0 = row_seq0(m), t = m - s0, kv = hh / 4, bb = row_batch(m);
        const bf16_t* q = w.Q() + (size_t)m * 512 + hh * 64; const float sink = in->attn_sink[l * NH + hh];
        const float* ck = in->cache_k + (((size_t)bb * DEPTH + l) * PAST) * 128 + kv * 64; const float* cvp = in->cache_v + (((size_t)bb * DEPTH + l) * PAST) * 128 + kv * 64;
        int lo, hi; if (!smp) { lo = 0; hi = L - 1; } else { lo = t - WINDOW < 0 ? 0 : t - WINDOW; hi = t + WINDOW > L - 1 ? L - 1 : t + WINDOW; }
        const int nctx = smp ? PAST : 0; float mx = sink;
        for (int pass = 0; pass < 2; ++pass) { float den = 0.f, acc[16];
#pragma unroll
            for (int d = 0; d < 16; ++d) acc[d] = 0.f;
            for (int kk = 0; kk < nctx + (hi - lo + 1); ++kk) { float sc = 0.f;
                if (kk < nctx) { const float* kp = ck + (size_t)kk * 128; for (int d = 0; d < 64; ++d) sc += bf2f(q[d]) * kp[d]; }
                else { const bf16_t* kp = w.K() + (size_t)(s0 + lo + kk - nctx) * 128 + kv * 64; for (int d = 0; d < 64; ++d) sc += bf2f(q[d]) * bf2f(kp[d]); }
                sc *= 0.125f;
                if (pass == 0) { mx = sc > mx ? sc : mx; }
                else { const float p = expf(sc - mx); den += p;
                    if (kk < nctx) { const float* vp = cvp + (size_t)kk * 128 + dp * 16;
#pragma unroll
                        for (int d = 0; d < 16; ++d) acc[d] += p * vp[d]; }
                    else { const bf16_t* vp = w.V() + (size_t)(s0 + lo + kk - nctx) * 128 + kv * 64 + dp * 16;
#pragma unroll
                        for (int d = 0; d < 16; ++d) acc[d] += p * bf2f(vp[d]); } } }
            if (pass == 1) { den += expf(sink - mx); bf16_t* o = w.GATE() + (size_t)m * 512 + hh * 64 + dp * 16;
#pragma unroll
                for (int d = 0; d < 16; ++d) o[d] = f2bf(acc[d] / den * bf2f(o[d])); } } } };
struct FConv { InP in; W w; int l, pad;
    HD_FN void operator()(long i) const { int ch = i % 512; int m = i / 512; const int L = row_len(m), s0 = row_seq0(m), t = m - s0; float acc = in->conv_db[l * 512 + ch];
        for (int j = 0; j < CONVK; ++j) { int tt = t + j - CONVK / 2; if (tt < 0 || tt >= L) continue; acc += bf2f(w.XC()[(size_t)(s0 + tt) * 512 + ch]) * in->conv_dw[((size_t)l * CONVK + j) * 512 + ch]; }
        w.TMP()[i] = acc; } };
struct FConvLn { InP in; W w; int l, pad;
    HD_FN void operator()(long m) const { const float* y = w.TMP() + (size_t)m * 512; float mu = 0.f; for (int k = 0; k < 512; ++k) mu += y[k]; mu /= 512.f;
        float var = 0.f; for (int k = 0; k < 512; ++k) { float d = y[k] - mu; var += d * d; } float r = 1.0f / sqrtf(var / 512.f + EPS); bf16_t* o = w.GATE() + ((size_t)1 * M + m) * 512;
        for (int k = 0; k < 512; ++k) o[k] = f2bf(siluf_((y[k] - mu) * r * in->conv_ln_g[l * 512 + k] + in->conv_ln_b[l * 512 + k]) * bf2f(o[k])); } };
struct FPool { W w;
    HD_FN void operator()(long i) const { int ch = i % 512; int m = i / 512; const int L = row_len(m), s0 = row_seq0(m), t = m - s0; const int wd = 2 << (ch / 128);
        int lo = t - wd / 2 < 0 ? 0 : t - wd / 2, hi = t + wd / 2 > L ? L : t + wd / 2; float sum = 0.f;
        for (int tt = lo; tt < hi; ++tt) sum += bf2f(w.XP()[(size_t)(s0 + tt) * 512 + ch]);
        bf16_t* o = w.GATE() + ((size_t)2 * M + m) * 512 + ch; *o = f2bf((sum / (float)(hi - lo) - bf2f(w.XP()[(size_t)m * 512 + ch])) * bf2f(*o)); } };
struct FSsmBu { W w; int l, dir, m0, pad;
    HD_FN void operator()(long i) const { int p = i % SP, g = (i / SP) % SG; int tl = i / (SP * SG); const bf16_t* x = w.XS() + (size_t)(m0 + tl) * 512 + g * SC;
        const float* bb = w.bbar() + ((((size_t)l * 2 + dir) * SG + g) * SP + p) * SC * 2; float ar = 0.f, ai = 0.f;
        for (int k = 0; k < SC; ++k) { const float xv = bf2f(x[k]); ar += xv * bb[2 * k]; ai += xv * bb[2 * k + 1]; } w.S()[2 * i] = ar; w.S()[2 * i + 1] = ai; } };
struct FSsmScan { InP in; W w; int l, dir, m0, pad;
    HD_FN void operator()(long i) const { int p = i % SP, g = (i / SP) % SG; int s = i / (SP * SG); const int L = row_len(m0); const int bb = row_batch(m0) + s;
        const float* lb = w.lamb() + ((((size_t)l * 2 + dir) * SG + g) * SP + p) * 2; float lr = lb[0], li = lb[1]; float hr = 0.f, hi = 0.f;
        if (m0 >= MP) { const float* st = in->state_ssm + ((((size_t)bb * DEPTH + l) * 2 + dir) * 2) * SG * SP + g * SP + p; hr = st[0]; hi = st[SG * SP]; }
        for (int k = 0; k < L; ++k) { int t = dir == 0 ? k : L - 1 - k; float* S = w.S() + (((size_t)(s * L + t) * SG + g) * SP + p) * 2;
            float nr = lr * hr - li * hi + S[0], ni = lr * hi + li * hr + S[1]; hr = nr; hi = ni; S[0] = hr; S[1] = hi; }
        if (m0 < MP) { float* o = w.out + OUT_ST + ((((size_t)bb * DEPTH + l) * 2 + dir) * 2) * SG * SP + g * SP + p; o[0] = hr; o[SG * SP] = hi; } } };
struct FSsmY { InP in; W w; int l, dir, m0, pad;
    HD_FN void operator()(long i) const { int gc = i % 512; int tl = i / 512; int g = gc / SC, ch = gc % SC; const int m = m0 + tl; const float* S = w.S() + ((size_t)tl * SG + g) * SP * 2;
        const float* cr = in->c_re + ((((size_t)l * 2 + dir) * SG + g) * SC + ch) * SP; const float* cim = in->c_im + ((((size_t)l * 2 + dir) * SG + g) * SC + ch) * SP;
        float acc = 0.f; for (int p = 0; p < SP; ++p) acc += S[2 * p] * cr[p] - S[2 * p + 1] * cim[p];
        float* y = w.TMP() + (size_t)m * 512 + gc;
        if (dir == 0) *y = acc + in->ssm_d[l * 512 + gc] * bf2f(w.XS()[(size_t)m * 512 + gc]); else w.YS()[(size_t)m * 512 + gc] = f2bf(geluf_(*y + acc)); } };
HD_FN void epi3(const W& w, int m, int pn, int cc, float a0, float a1) { bf16_t* o = w.GATE() + ((size_t)3 * M + m) * 512 + pn * 128 + cc; *o = f2bf(a0 * sigmoidf_(a1) * bf2f(*o)); }
struct FG3 { W w; int l, pad;
    HD_FN void operator()(long i) const { int cc = i % 128; int pn = (i / 128) % 4; int m = i / 512; const bf16_t* a = w.YS() + (size_t)m * 512;
        const bf16_t* b0 = w.wglu() + ((size_t)l * 1024 + pn * 256 + cc) * 512; const bf16_t* b1 = b0 + (size_t)128 * 512; float a0 = 0.f, a1 = 0.f;
        for (int k = 0; k < 512; ++k) { const float av = bf2f(a[k]); a0 += av * bf2f(b0[k]); a1 += av * bf2f(b1[k]); }
        epi3(w, m, pn, cc, a0, a1); } };
struct FG4a { W w; int l, pad;
    HD_FN void operator()(long i) const { int d = i % 1024; int m = i / 1024; float mg = 0.f;
        for (int n = 0; n < 4; ++n) { const bf16_t* a = w.GATE() + ((size_t)n * M + m) * 512; const bf16_t* b = w.wbr() + (((size_t)l * 4 + n) * 1024 + d) * 512; float acc = 0.f;
            for (int k = 0; k < 512; ++k) acc += bf2f(a[k]) * bf2f(b[k]); mg += bf2f(w.GM()[(size_t)m * 4096 + n * 1024 + d]) * acc; }
        w.MRG()[i] = f2bf(mg); } };
struct FG4b { InP in; W w; int l, pad;
    HD_FN void operator()(long i) const { int d = i % 1024; int m = i / 1024; const bf16_t* a = w.MRG() + (size_t)m * 1024; const bf16_t* b = w.wout() + ((size_t)l * 1024 + d) * 1024; float acc = 0.f;
        for (int k = 0; k < 1024; ++k) acc += bf2f(a[k]) * bf2f(b[k]);
        const float gate = w.mod()[((size_t)l * 3 + row_modj(m)) * 3072 + 2048 + d]; w.out[i] = xrow(in, w, l, m)[d] + gate * acc; } };
struct FFinal { InP in; W w;
    HD_FN void operator()(long m) const { float* xr = w.out + (size_t)m * D; float ss = 0.f; for (int k = 0; k < D; ++k) ss += xr[k] * xr[k]; float r = 1.0f / sqrtf(ss / D + EPS);
        for (int k = 0; k < D; ++k) xr[k] = xr[k] * r * in->final_g[k]; } };

template <class Runner> inline void forward(InP in, const W& w, Runner& R) {
    R(FMod{in, w}, 2L * 3 * 3072); R(FRope{w}, 2048L * 32); R(FSsmParam{in, w}, 2L * 2 * SG * SP);
    R(FCvtIn{in, w}, 2L * INC * 1024); R(FCvtGlu{in, w}, 2L * 1024 * 512); R(FCvtBr{in, w}, 2L * 4 * 1024 * 512); R(FCvtOut{in, w}, 2L * 1024 * 1024);
    for (int l = 0; l < DEPTH; ++l) {
        R(FH{in, w, l, 0}, (long)M);
        R(FG1{in, w, l, 0}, (long)M * NT1 * 128);
        R(FAttn{in, w, l, 0}, (long)M * 32);
        R(FConv{in, w, l, 0}, (long)M * 512); R(FConvLn{in, w, l, 0}, (long)M);
        R(FPool{w}, (long)M * 512);
        for (int m0 = 0; m0 < M;) { const int L = row_len(m0); int nrows = 2048; if (m0 < MP && m0 + nrows > MP) nrows = MP - m0; const int nseq = nrows / L;
            for (int dir = 0; dir < 2; ++dir) { R(FSsmBu{w, l, dir, m0, 0}, (long)nrows * SG * SP); R(FSsmScan{in, w, l, dir, m0, 0}, (long)nseq * SG * SP); R(FSsmY{in, w, l, dir, m0, 0}, (long)nrows * 512); }
            m0 += nrows; }
        R(FG3{w, l, 0}, (long)M * 512);
        R(FG4a{w, l, 0}, (long)M * 1024);
        R(FG4b{in, w, l, 0}, (long)M * 1024);
    }
    R(FFinal{in, w}, (long)M);
}
}
namespace pg8 {
#define PG8_LAS __attribute__((address_space(3)))
typedef unsigned short bf16_t;
typedef short bf16x8 __attribute__((ext_vector_type(8)));
typedef float f32x4 __attribute__((ext_vector_type(4)));
typedef unsigned u32x4 __attribute__((ext_vector_type(4)));
constexpr int BM = 256, BK = 64, HALF = 128, HTB = HALF * BK * 2  , STAGE_BYTES = 8 * HTB, NXCD = 8, WGM = 8;

__host__ __device__ __forceinline__ int lds_byte(int r, int c) { const int st = (r >> 4) * 2 + (c >> 5), rr = r & 15, cc = c & 31, ob = rr * 64 + cc * 2; return st * 1024 + (ob ^ (((ob >> 9) & 1) << 5)); }
__host__ __device__ __forceinline__ void stage_rc(int b, int& R, int& C) { const int st = b / 1024, sb = b % 1024, swz = sb ^ (((sb >> 9) & 1) << 5); R = (st >> 1) * 16 + swz / 64; C = (st & 1) * 32 + (swz % 64) / 2; }
__host__ __device__ __forceinline__ int perm32(int rho) { const int n = rho >> 4, i = rho & 15; return 8 * (i >> 2) + 4 * n + (i & 3); }

struct Unit { int pm, pn; };
struct Gemm { const bf16_t* A; const bf16_t* Bt; int M, N, K; };

struct StaticOrder {
    int nM, nN, nwg, G, c;
    __host__ __device__ void init(int M, int N, int G_, int c_) { nM = M / BM; nN = N / BM; nwg = nM * nN; G = G_; c = c_; }
    __host__ __device__ bool next(int i, Unit& u) const {
        const long L = (long)i * G + c; if (L >= nwg) return false;
        int wgid = (int)L; { const int q = nwg / NXCD, r = nwg % NXCD, xcd = wgid % NXCD, off = wgid / NXCD; wgid = (xcd < r ? xcd * (q + 1) : r * (q + 1) + (xcd - r) * q) + off; }
        const int nig = WGM * nN, gid = wgid / nig, fm = gid * WGM, gsz = (nM - fm) < WGM ? (nM - fm) : WGM;
        u.pm = fm + ((wgid % nig) % gsz); u.pn = (wgid % nig) / gsz; return true;
    }
    __device__ __forceinline__ void a_ready(const Unit&) const {}
    __device__ __forceinline__ void done(const Unit&) const {}
};

__device__ __forceinline__ unsigned cvt_pk_bf16(float lo, float hi) { unsigned r; asm volatile("v_cvt_pk_bf16_f32 %0, %1, %2" : "=v"(r) : "v"(lo), "v"(hi)); return r; }
typedef float f32x2 __attribute__((ext_vector_type(2)));
template <class Epi, class Sched, bool ALIGN_EPI = false, bool SP2 = false, int NB = 2>
__device__ __forceinline__ void gemm_phase(PG8_LAS unsigned char* lds, const Gemm g, const Sched& S, const Epi& E) {
    int tid_ = threadIdx.x; asm volatile("" : "+v"(tid_));
    const int tid = tid_, wid = __builtin_amdgcn_readfirstlane(tid >> 6), lane = tid & 63, wr = wid >> 2, wc = wid & 3, fr = lane & 15, fq = lane >> 4;
    const int K = g.K, nt = K / BK;
    unsigned voffA[2], voffB[2];
#pragma unroll
    for (int i = 0; i < 2; ++i) { int R, C; stage_rc(tid * 16 + i * 8192, R, C); const int Rb = Epi::PERM ? ((R & ~31) + perm32(R & 31)) : R;
        voffA[i] = (unsigned)(R * K + C) * 2u; voffB[i] = (unsigned)(Rb * K + C) * 2u; }
    const size_t kstep = (size_t)(BK * 2);
    const size_t hstep = (size_t)HALF * K * 2;
    const size_t tstep = 2 * hstep;
    const size_t tstepB = NB == 2 ? tstep : hstep;
    static_assert(NB == 2 || (NB == 1 && SP2), "NB == 1 is implemented for the SP2 loop only");
    const unsigned ldsw = (unsigned)wid * 1024u;
    const int aoff = lds_byte(wr * 64 + fr, fq * 8), boff = lds_byte(wc * 32 + fr, fq * 8);
#define PG8_SA(b, h) (((b) * 2 + (h)) * HTB)
#define PG8_SB(b, h) ((4 + (b) * 2 + (h)) * HTB)
#define PG8_STAGE(bufoff, gbase, voff) do { _Pragma("unroll") for (int _i = 0; _i < 2; ++_i) \
        __builtin_amdgcn_global_load_lds((const unsigned*)((const char*)(gbase) + (voff)[_i]), (PG8_LAS unsigned*)(lds + (bufoff) + ldsw + _i * 8192), 16, 0, 0); } while (0)
#define PG8_LDA(dst, b, h) do { _Pragma("unroll") for (int m = 0; m < 4; ++m) _Pragma("unroll") for (int k = 0; k < 2; ++k) dst[m][k] = *(const PG8_LAS bf16x8*)(lds + PG8_SA(b, h) + aoff + m * 2048 + k * 1024); } while (0)
#define PG8_LDB(dst, b, h) do { _Pragma("unroll") for (int n = 0; n < 2; ++n) _Pragma("unroll") for (int k = 0; k < 2; ++k) dst[n][k] = *(const PG8_LAS bf16x8*)(lds + PG8_SB(b, h) + boff + n * 2048 + k * 1024); } while (0)
#define PG8_MMA(ai, bj, At, Bt) do { __builtin_amdgcn_s_setprio(1); _Pragma("unroll") for (int m = 0; m < 4; ++m) _Pragma("unroll") for (int n = 0; n < 2; ++n) _Pragma("unroll") for (int k = 0; k < 2; ++k) \
        acc[ai][bj][m][n] = __builtin_amdgcn_mfma_f32_16x16x32_bf16(Bt[n][k], At[m][k], acc[ai][bj][m][n], 0, 0, 0); __builtin_amdgcn_s_setprio(0); } while (0)
#define PG8_WAIT_V(n) asm volatile("s_waitcnt vmcnt(" #n ")" ::: "memory")
#define PG8_WAIT_L(n) asm volatile("s_waitcnt lgkmcnt(" #n ")" ::: "memory")
#define PG8_WAIT_VL do { if constexpr (NB == 2) PG8_WAIT_V(8); else PG8_WAIT_V(6); PG8_WAIT_L(0); } while (0)
#define PG8_BAR __builtin_amdgcn_s_barrier()
#define PG8_SCHED __builtin_amdgcn_sched_barrier(0)
    Unit cur, nxt; int ui = 0;
    if (!S.next(0, cur)) return;
    f32x4 acc[2][NB][4][2];
#pragma unroll
    for (int a = 0; a < 2; ++a)
#pragma unroll
        for (int b = 0; b < NB; ++b)
#pragma unroll
            for (int m = 0; m < 4; ++m)
#pragma unroll
                for (int n = 0; n < 2; ++n) acc[a][b][m][n] = (f32x4){0.f, 0.f, 0.f, 0.f};
    bf16x8 At[4][2], B0[2][2], B1[2][2];
    const char* cA = (const char*)g.A + (size_t)cur.pm * tstep; const char* cB = (const char*)g.Bt + (size_t)cur.pn * tstepB;
    S.a_ready(cur);
    if constexpr (SP2) {
        PG8_STAGE(PG8_SB(0, 0), cB, voffB); if constexpr (NB == 2) PG8_STAGE(PG8_SB(0, 1), cB + hstep, voffB); PG8_STAGE(PG8_SA(0, 0), cA, voffA); PG8_STAGE(PG8_SA(0, 1), cA + hstep, voffA);
        if (wr == 1) PG8_BAR;
        PG8_WAIT_V(2); PG8_BAR;
        PG8_STAGE(PG8_SB(1, 0), cB + kstep, voffB); PG8_STAGE(PG8_SA(1, 0), cA + kstep, voffA); if constexpr (NB == 2) PG8_STAGE(PG8_SB(1, 1), cB + hstep + kstep, voffB);
        if constexpr (NB == 2) PG8_WAIT_V(6); else PG8_WAIT_V(4);
        PG8_BAR;
    } else {
        PG8_STAGE(PG8_SB(0, 0), cB, voffB); PG8_STAGE(PG8_SA(0, 0), cA, voffA); PG8_STAGE(PG8_SB(0, 1), cB + hstep, voffB); PG8_STAGE(PG8_SA(0, 1), cA + hstep, voffA);
        if (wr == 1) PG8_BAR;
        PG8_WAIT_V(4); PG8_BAR;
        PG8_STAGE(PG8_SB(1, 0), cB + kstep, voffB); PG8_STAGE(PG8_SA(1, 0), cA + kstep, voffA); PG8_STAGE(PG8_SB(1, 1), cB + hstep + kstep, voffB);
        PG8_WAIT_V(6); PG8_BAR;
    }
    for (;;) {
        const bool has_next = S.next(ui + 1, nxt);
        const char* nA = has_next ? (const char*)g.A + (size_t)nxt.pm * tstep : cA; const char* nB = has_next ? (const char*)g.Bt + (size_t)nxt.pn * tstepB : cB;
        for (int t = 0; t < nt; t += 2) {
            const bool last = (t == nt - 2);
            const char* a1 = cA + (size_t)(t + 1) * kstep;
            const char* a2 = last ? nA : cA + (size_t)(t + 2) * kstep; const char* b2 = last ? nB : cB + (size_t)(t + 2) * kstep;
            const char* a3 = a2 + kstep; const char* b3 = b2 + kstep;
            if (last && has_next) S.a_ready(nxt);
            if constexpr (SP2) {
            PG8_LDB(B0, 0, 0); if constexpr (NB == 2) PG8_LDB(B1, 0, 1); PG8_SCHED; PG8_LDA(At, 0, 0); PG8_STAGE(PG8_SA(1, 1), a1 + hstep, voffA);
            PG8_WAIT_VL; PG8_BAR; PG8_MMA(0, 0, At, B0); if constexpr (NB == 2) PG8_MMA(0, 1, At, B1); PG8_BAR; PG8_SCHED;
            PG8_LDA(At, 0, 1); PG8_STAGE(PG8_SB(0, 0), b2, voffB); if constexpr (NB == 2) PG8_STAGE(PG8_SB(0, 1), b2 + hstep, voffB); PG8_STAGE(PG8_SA(0, 0), a2, voffA);
            PG8_WAIT_VL; PG8_BAR; PG8_MMA(1, 0, At, B0); if constexpr (NB == 2) PG8_MMA(1, 1, At, B1); PG8_BAR; PG8_SCHED;
            PG8_LDB(B0, 1, 0); if constexpr (NB == 2) PG8_LDB(B1, 1, 1); PG8_SCHED; PG8_LDA(At, 1, 0); PG8_STAGE(PG8_SA(0, 1), a2 + hstep, voffA);
            PG8_WAIT_VL; PG8_BAR; PG8_MMA(0, 0, At, B0); if constexpr (NB == 2) PG8_MMA(0, 1, At, B1); PG8_BAR; PG8_SCHED;
            PG8_LDA(At, 1, 1); PG8_STAGE(PG8_SB(1, 0), b3, voffB); if constexpr (NB == 2) PG8_STAGE(PG8_SB(1, 1), b3 + hstep, voffB); PG8_STAGE(PG8_SA(1, 0), a3, voffA);
            PG8_WAIT_VL; PG8_BAR; PG8_MMA(1, 0, At, B0); if constexpr (NB == 2) PG8_MMA(1, 1, At, B1); PG8_BAR; PG8_SCHED;
            } else {
            PG8_LDB(B0, 0, 0); PG8_SCHED; PG8_LDA(At, 0, 0); PG8_STAGE(PG8_SA(1, 1), a1 + hstep, voffA);
            PG8_WAIT_L(8); PG8_BAR; PG8_WAIT_L(0); PG8_MMA(0, 0, At, B0); PG8_BAR; PG8_SCHED;
            PG8_LDB(B1, 0, 1); PG8_STAGE(PG8_SB(0, 0), b2, voffB);
            PG8_BAR; PG8_WAIT_L(0); PG8_MMA(0, 1, At, B1); PG8_BAR;
            PG8_LDA(At, 0, 1); PG8_STAGE(PG8_SA(0, 0), a2, voffA);
            PG8_BAR; PG8_WAIT_L(0); PG8_MMA(1, 0, At, B0); PG8_BAR; PG8_SCHED;
            PG8_STAGE(PG8_SB(0, 1), b2 + hstep, voffB);
            PG8_WAIT_V(6); PG8_BAR; PG8_MMA(1, 1, At, B1); PG8_BAR;
            PG8_LDB(B0, 1, 0); PG8_SCHED; PG8_LDA(At, 1, 0); PG8_STAGE(PG8_SA(0, 1), a2 + hstep, voffA);
            PG8_WAIT_L(8); PG8_BAR; PG8_WAIT_L(0); PG8_MMA(0, 0, At, B0); PG8_BAR; PG8_SCHED;
            PG8_LDB(B1, 1, 1); PG8_STAGE(PG8_SB(1, 0), b3, voffB);
            PG8_BAR; PG8_WAIT_L(0); PG8_MMA(0, 1, At, B1); PG8_BAR;
            PG8_LDA(At, 1, 1); PG8_STAGE(PG8_SA(1, 0), a3, voffA);
            PG8_BAR; PG8_WAIT_L(0); PG8_MMA(1, 0, At, B0); PG8_BAR; PG8_SCHED;
            PG8_STAGE(PG8_SB(1, 1), b3 + hstep, voffB);
            PG8_WAIT_V(6); PG8_BAR; PG8_MMA(1, 1, At, B1); PG8_BAR;
            }
        }
        if constexpr (ALIGN_EPI) { if (wr == 0) PG8_BAR; }
        if constexpr (!Epi::AFTER_DRAIN) { E(acc, cur, wr, wc, fr, fq); S.done(cur); }
        if (!has_next) break;
#pragma unroll
        for (int a = 0; a < 2; ++a)
#pragma unroll
            for (int b = 0; b < NB; ++b)
#pragma unroll
                for (int m = 0; m < 4; ++m)
#pragma unroll
                    for (int n = 0; n < 2; ++n) acc[a][b][m][n] = (f32x4){0.f, 0.f, 0.f, 0.f};
        cur = nxt; cA = nA; cB = nB; ++ui;
        if constexpr (ALIGN_EPI) { if (wr == 1) PG8_BAR; }
    }
    PG8_WAIT_V(0);
    if constexpr (!ALIGN_EPI) { if (wr == 0) PG8_BAR; }
    PG8_BAR;
    if constexpr (Epi::AFTER_DRAIN) { E.fused(acc, cur, wr, wc, fr, fq, lds, wid, lane); S.done(cur); }
#undef PG8_SA
#undef PG8_SB
#undef PG8_STAGE
#undef PG8_LDA
#undef PG8_LDB
#undef PG8_MMA
#undef PG8_WAIT_V
#undef PG8_WAIT_L
#undef PG8_WAIT_VL
#undef PG8_BAR
#undef PG8_SCHED
}
}
#define GAS __attribute__((address_space(1)))
#define LAS __attribute__((address_space(3)))
typedef unsigned short bf16;
typedef unsigned v4u __attribute__((ext_vector_type(4)));
typedef float f32x4 __attribute__((ext_vector_type(4)));
typedef short bf16x8 __attribute__((ext_vector_type(8)));
typedef GAS unsigned gu32;
typedef GAS unsigned long long gu64;
#define RLX_AGENT __ATOMIC_RELAXED, __HIP_MEMORY_SCOPE_AGENT
#define LDS_WAIT() asm volatile("s_waitcnt lgkmcnt(0)" ::: "memory")
#define VM_WAIT() asm volatile("s_waitcnt vmcnt(0)" ::: "memory")
__device__ __forceinline__ unsigned long long rt() { return __builtin_amdgcn_s_memrealtime(); }
__device__ __forceinline__ unsigned f2bf(float f) { unsigned u = __builtin_bit_cast(unsigned, f); return (u + 0x7fffu + ((u >> 16) & 1u)) >> 16; }
__device__ __forceinline__ unsigned pk2(float lo, float hi) { return f2bf(lo) | (f2bf(hi) << 16); }
#define XB_TMO      128
#define XB_XCNT(j)  (256  + 64 * (j))
#define XB_XSUB(j)  (1280 + 64 * (j))
#define XB_XGEN(j)  (2304 + 64 * (j))
#define XB_TOP      3328
#define XB_TOPGEN   3392
#define XCD_BAR_WORDS 3456
#define XB_SPIN_CAP (1u << 18)

__device__ __forceinline__ unsigned xb_ld(unsigned* p)              { return __hip_atomic_load(p, __ATOMIC_RELAXED, __HIP_MEMORY_SCOPE_AGENT); }
__device__ __forceinline__ unsigned xb_add(unsigned* p, unsigned v) { return __hip_atomic_fetch_add(p, v, __ATOMIC_RELAXED, __HIP_MEMORY_SCOPE_AGENT); }
__device__ __forceinline__ unsigned xb_xcc_id() { return (unsigned)__builtin_amdgcn_s_getreg((3 << 11) | 20) & 0xFu; }
#define XB_SPIN(cond, bar) do { unsigned _sp = 0; while (cond) { __builtin_amdgcn_s_sleep(1); \
    if ((++_sp & 255u) == 0u) { if (xb_ld(&(bar)[XB_TMO])) break; if (_sp > XB_SPIN_CAP) { atomicAdd(&(bar)[XB_TMO], 1u); break; } } } } while (0)

struct XcdBarrier {
    unsigned* bar; unsigned x;
    volatile LAS unsigned* st;
};

__device__ __forceinline__ XcdBarrier xcd_barrier_post(unsigned* bar, volatile LAS unsigned* st) {
    XcdBarrier b; b.bar = bar; b.x = xb_xcc_id(); b.st = st;
    if (threadIdx.x == 0) (void)xb_add(&bar[XB_XCNT(b.x)], 1u);
    return b;
}
__device__ __forceinline__ void xcd_barrier_complete(unsigned* bar, unsigned x, unsigned& nloc, unsigned& nx) {
    const unsigned G = gridDim.x * gridDim.y * gridDim.z;
    unsigned sum, cnt, mine, sp = 0u;
    for (;;) {
        sum = 0u; cnt = 0u; mine = 0u;
#pragma unroll
        for (unsigned j = 0; j < 16; ++j) { const unsigned c = xb_ld(&bar[XB_XCNT(j)]); sum += c; cnt += (c > 0u) ? 1u : 0u; mine = (j == x) ? c : mine; }
        if (sum == G) break;
        __builtin_amdgcn_s_sleep(1);
        if ((++sp & 255u) == 0u) { if (xb_ld(&bar[XB_TMO])) break; if (sp > XB_SPIN_CAP) { atomicAdd(&bar[XB_TMO], 1u); break; } }
    }
    nloc = mine > 0u ? mine : 1u; nx = cnt > 0u ? cnt : 1u;
}

__device__ __forceinline__ void xcd_barrier(const XcdBarrier& b) {
    asm volatile("s_waitcnt vmcnt(0)" ::: "memory");
    __syncthreads();
    if (threadIdx.x == 0) {
        unsigned* bar = b.bar; asm volatile("" : "+s"(bar));
        __builtin_amdgcn_s_waitcnt(0);
        unsigned nloc = b.st[0], nx = b.st[1];
        if (nloc == 0u) { xcd_barrier_complete(bar, b.x, nloc, nx); b.st[0] = nloc; b.st[1] = nx; }
        const unsigned old = xb_add(&bar[XB_XSUB(b.x)], 1u);
        const unsigned gen = old / nloc;
        if (old + 1u == (gen + 1u) * nloc) {
            __builtin_amdgcn_fence(__ATOMIC_RELEASE, "agent");
            asm volatile("s_waitcnt vmcnt(0)" ::: "memory");
            const unsigned og = xb_add(&bar[XB_TOP], 1u);
            const unsigned tg = og / nx;
            if (og + 1u == (tg + 1u) * nx) xb_add(&bar[XB_TOPGEN], 1u);
            else XB_SPIN(xb_ld(&bar[XB_TOPGEN]) == tg, bar);
            __builtin_amdgcn_fence(__ATOMIC_ACQUIRE, "agent");
            xb_add(&bar[XB_XGEN(b.x)], 1u);
            asm volatile("s_waitcnt vmcnt(0)" ::: "memory");
        } else {
            XB_SPIN(xb_ld(&bar[XB_XGEN(b.x)]) == gen, bar);
            __builtin_amdgcn_fence(__ATOMIC_ACQUIRE, "agent");
            asm volatile("s_waitcnt vmcnt(0)" ::: "memory");
        }
    }
    __syncthreads();
}
namespace mk {
using pg8::f32x4; using pg8::Unit;
using g2::In; using g2::InP; using g2::W; using g2::M; using g2::MP; using g2::INC;
typedef unsigned u32x4 __attribute__((ext_vector_type(4)));
constexpr int NWAVES = 8, NTHREADS = 512;
constexpr int RING_BYTES = 131072, LDSCTL_OFF = RING_BYTES, MISC_OFF = LDSCTL_OFF + 320, LDS_BYTES = 147456;
constexpr int CW_BAR = 4096; constexpr size_t CTL_ZERO_BYTES = 65536;

__device__ __forceinline__ float fsig(float x) { return __builtin_amdgcn_rcpf(1.0f + __builtin_amdgcn_exp2f(-1.4426950408889634f * x)); }
__device__ __forceinline__ float fsilu(float x) { return x * fsig(x); }
__device__ __forceinline__ u32x4 pack8(const float* v) { u32x4 r; r.x = pg8::cvt_pk_bf16(v[0], v[1]); r.y = pg8::cvt_pk_bf16(v[2], v[3]); r.z = pg8::cvt_pk_bf16(v[4], v[5]); r.w = pg8::cvt_pk_bf16(v[6], v[7]); return r; }
__device__ __forceinline__ void unpack8(u32x4 r, float* v) { v[0] = __uint_as_float(r.x << 16); v[1] = __uint_as_float(r.x & 0xffff0000u); v[2] = __uint_as_float(r.y << 16); v[3] = __uint_as_float(r.y & 0xffff0000u);
    v[4] = __uint_as_float(r.z << 16); v[5] = __uint_as_float(r.z & 0xffff0000u); v[6] = __uint_as_float(r.w << 16); v[7] = __uint_as_float(r.w & 0xffff0000u); }
__device__ __forceinline__ void st16(g2::bf16_t* p, u32x4 v) { *(u32x4*)p = v; }
__device__ __forceinline__ void stf8(float* p, const float* v) { *(f32x4*)p = (f32x4){v[0], v[1], v[2], v[3]}; *(f32x4*)(p + 4) = (f32x4){v[4], v[5], v[6], v[7]}; }
__device__ __forceinline__ void ldf8(const float* p, float* v) { const f32x4 a = *(const f32x4*)p, b = *(const f32x4*)(p + 4); v[0] = a.x; v[1] = a.y; v[2] = a.z; v[3] = a.w; v[4] = b.x; v[5] = b.y; v[6] = b.z; v[7] = b.w; }

#define MK_ROWS_BEGIN _Pragma("unroll") for (int ai = 0; ai < 2; ++ai) _Pragma("unroll") for (int m = 0; m < 4; ++m) { \
        float v0[8], v1[8]; _Pragma("unroll") for (int n = 0; n < 2; ++n) _Pragma("unroll") for (int i = 0; i < 4; ++i) { v0[4 * n + i] = acc[ai][0][m][n][i]; v1[4 * n + i] = acc[ai][1][m][n][i]; }
#define MK_ROWS_END }

struct Epi1 {
    static constexpr bool PERM = true, AFTER_DRAIN = false;
    W w; int l;
    __device__ __forceinline__ void operator()(const f32x4 (&acc)[2][2][4][2], const Unit& u, int wr, int wc, int fr, int fq) const {
        int pn_ = __builtin_amdgcn_readfirstlane(u.pn), pm_ = __builtin_amdgcn_readfirstlane(u.pm); asm volatile("" : "+s"(pn_), "+s"(pm_), "+v"(fr), "+v"(fq));
        const int pn = pn_, cc0 = wc * 32 + fq * 8, rowb = pm_ * 256 + wr * 64 + fr;
#define MK_ROW (rowb + ai * 128 + m * 16)
        if (pn <= 2) {
            if (pn < 2 || wc < 2) {
                MK_ROWS_BEGIN
                    const int row = MK_ROW; const bool smp = row >= MP; const int t = smp ? ((row - MP) & 2047) : (row & 255);
                    float o1[8], o2[8];
                    if (smp) { float cs[8], sn[8]; ldf8(w.ropec() + t * 32 + fq * 8, cs); ldf8(w.ropes() + t * 32 + fq * 8, sn);
#pragma unroll
                        for (int e = 0; e < 8; ++e) { o1[e] = v0[e] * cs[e] - v1[e] * sn[e]; o2[e] = v0[e] * sn[e] + v1[e] * cs[e]; } }
                    else {
#pragma unroll
                        for (int e = 0; e < 8; ++e) { o1[e] = v0[e]; o2[e] = v1[e]; } }
                    if (pn < 2) { g2::bf16_t* q = w.Q() + (size_t)row * 512 + (pn * 4 + wc) * 64 + fq * 8; st16(q, pack8(o1)); st16(q + 32, pack8(o2)); }
                    else { g2::bf16_t* k = w.K() + (size_t)row * 128 + wc * 64 + fq * 8; st16(k, pack8(o1)); st16(k + 32, pack8(o2));
                        if (!smp) { float* o = w.out + g2::OUT_K + (((size_t)(row >> 8) * 2 + l) * 256 + t) * 128 + wc * 64 + fq * 8; stf8(o, v0); stf8(o + 32, v1); } }
                MK_ROWS_END
            } else {
                const int c2 = (wc - 2) * 32 + fq * 8;
                MK_ROWS_BEGIN
                    const int row = MK_ROW; g2::bf16_t* vp = w.V() + (size_t)row * 128 + c2; st16(vp, pack8(v0)); st16(vp + 64, pack8(v1));
                    if (row < MP) { float* o = w.out + g2::OUT_V + (((size_t)(row >> 8) * 2 + l) * 256 + (row & 255)) * 128 + c2; stf8(o, v0); stf8(o + 64, v1); }
                MK_ROWS_END
            }
        } else if (pn >= 19) {
            g2::bf16_t* base = w.GM() + (size_t)(pn - 19) * 256 + cc0;
            MK_ROWS_BEGIN
                float o0[8], o1[8];
#pragma unroll
                for (int e = 0; e < 8; ++e) { o0[e] = fsig(v0[e]); o1[e] = fsig(v1[e]); }
                g2::bf16_t* p = base + (size_t)MK_ROW * 4096; st16(p, pack8(o0)); st16(p + 128, pack8(o1));
            MK_ROWS_END
        } else if (pn >= 5 && pn < 9) {
            g2::bf16_t* base = w.XC() + (pn - 5) * 128 + cc0;
            MK_ROWS_BEGIN
                float o[8];
#pragma unroll
                for (int e = 0; e < 8; ++e) o[e] = v0[e] * fsig(v1[e]);
                st16(base + (size_t)MK_ROW * 512, pack8(o));
            MK_ROWS_END
        } else if (pn == 11 || pn == 12 || pn == 15 || pn == 16) {
            g2::bf16_t* base = (pn < 13 ? w.XP() + (pn - 11) * 256 : w.XS() + (pn - 15) * 256) + cc0;
            MK_ROWS_BEGIN
                g2::bf16_t* p = base + (size_t)MK_ROW * 512; st16(p, pack8(v0)); st16(p + 128, pack8(v1));
            MK_ROWS_END
        } else {
            const int br = pn < 5 ? 0 : pn < 11 ? 1 : pn < 15 ? 2 : 3; const int t0 = br == 0 ? 3 : br == 1 ? 9 : br == 2 ? 13 : 17;
            g2::bf16_t* base = w.GATE() + (size_t)br * M * 512 + (pn - t0) * 256 + cc0;
            MK_ROWS_BEGIN
                float o0[8], o1[8];
#pragma unroll
                for (int e = 0; e < 8; ++e) { o0[e] = fsilu(v0[e]); o1[e] = fsilu(v1[e]); }
                g2::bf16_t* p = base + (size_t)MK_ROW * 512; st16(p, pack8(o0)); st16(p + 128, pack8(o1));
            MK_ROWS_END
        }
#undef MK_ROW
    }
};
#define MK1_ROW(ai, m) (rowb + (ai) * 128 + (m) * 16)
__device__ __forceinline__ int glu_orig_col_v2(int row) { const int t = row >> 7, r = row & 127, gi = r >> 3, e = r & 7; return (e < 4 ? 0 : 512) + 64 * t + 4 * gi + (e & 3); }
struct SchedN1 { int c;
    __device__ __forceinline__ bool next(int i, Unit& u) const { if (i > 0 || c >= 256) return false; const int x = c & 7, slot = c >> 3; u.pm = x * 4 + (slot >> 3); u.pn = slot & 7; return true; }
    __device__ __forceinline__ void a_ready(const Unit&) const {}
    __device__ __forceinline__ void done(const Unit&) const {}
};
struct Epi3 {
    static constexpr bool PERM = true, AFTER_DRAIN = false;
    W w;
    __device__ __forceinline__ void operator()(const f32x4 (&acc)[2][1][4][2], const Unit& u, int wr, int wc, int fr, int fq) const {
        int pn_ = __builtin_amdgcn_readfirstlane(u.pn), pm_ = __builtin_amdgcn_readfirstlane(u.pm); asm volatile("" : "+s"(pn_), "+s"(pm_), "+v"(fr), "+v"(fq));
        const int rowb = pm_ * 256 + wr * 64 + fr; g2::bf16_t* base = w.GATE() + (size_t)3 * M * 512 + 64 * pn_ + 16 * wc + 4 * fq;
        unsigned long long gv[2][4];
#pragma unroll
        for (int ai = 0; ai < 2; ++ai)
#pragma unroll
            for (int m = 0; m < 4; ++m) gv[ai][m] = *(const unsigned long long*)(base + (size_t)MK1_ROW(ai, m) * 512);
#pragma unroll
        for (int ai = 0; ai < 2; ++ai)
#pragma unroll
            for (int m = 0; m < 4; ++m) { const f32x4 v = acc[ai][0][m][0], gt = acc[ai][0][m][1]; const unsigned g0 = (unsigned)gv[ai][m], g1 = (unsigned)(gv[ai][m] >> 32);
                const float o0 = v.x * fsig(gt.x) * __uint_as_float(g0 << 16), o1 = v.y * fsig(gt.y) * __uint_as_float(g0 & 0xffff0000u), o2 = v.z * fsig(gt.z) * __uint_as_float(g1 << 16), o3 = v.w * fsig(gt.w) * __uint_as_float(g1 & 0xffff0000u);
                *(unsigned long long*)(base + (size_t)MK1_ROW(ai, m) * 512) = (unsigned long long)pg8::cvt_pk_bf16(o0, o1) | ((unsigned long long)pg8::cvt_pk_bf16(o2, o3) << 32); }
    }
};
struct Epi4a {
    static constexpr bool PERM = true, AFTER_DRAIN = false;
    W w; mutable f32x4 mg[2][4][2];
    __device__ __forceinline__ void operator()(const f32x4 (&acc)[2][1][4][2], const Unit& u, int wr, int wc, int fr, int fq) const {
        int pn_ = __builtin_amdgcn_readfirstlane(u.pn), pm_ = __builtin_amdgcn_readfirstlane(u.pm); asm volatile("" : "+s"(pn_), "+s"(pm_), "+v"(fr), "+v"(fq));
        const int n_ = pn_ >> 3, pn8 = pn_ & 7, rowb = (pm_ & 31) * 256 + wr * 64 + fr, col = pn8 * 128 + wc * 32 + fq * 8;
        u32x4 gv[2][4];
#pragma unroll
        for (int ai = 0; ai < 2; ++ai)
#pragma unroll
            for (int m = 0; m < 4; ++m) gv[ai][m] = *(const u32x4*)(w.GM() + (size_t)MK1_ROW(ai, m) * 4096 + n_ * 1024 + col);
#pragma unroll
        for (int ai = 0; ai < 2; ++ai)
#pragma unroll
            for (int m = 0; m < 4; ++m) { float g[8]; unpack8(gv[ai][m], g);
                const f32x4 p0 = acc[ai][0][m][0] * (f32x4){g[0], g[1], g[2], g[3]}, p1 = acc[ai][0][m][1] * (f32x4){g[4], g[5], g[6], g[7]};
                if (n_ == 0) { mg[ai][m][0] = p0; mg[ai][m][1] = p1; } else { mg[ai][m][0] += p0; mg[ai][m][1] += p1; }
                if (n_ == 3) { const f32x4 a = mg[ai][m][0], b = mg[ai][m][1]; const float o[8] = {a.x, a.y, a.z, a.w, b.x, b.y, b.z, b.w}; st16(w.MRG() + (size_t)MK1_ROW(ai, m) * 1024 + col, pack8(o)); } }
    }
};
struct Sched4a { int c;
    __device__ __forceinline__ bool next(int i, Unit& u) const { if (c >= 256 || i >= 4) return false; const int x = c & 7, slot = c >> 3; u.pm = x * 4 + (slot >> 3) + 32 * i; u.pn = (slot & 7) + 8 * i; return true; }
    __device__ __forceinline__ void a_ready(const Unit&) const {}
    __device__ __forceinline__ void done(const Unit&) const {}
};
struct Epi4b {
    static constexpr bool PERM = true, AFTER_DRAIN = false;
    InP in; W w; int l;
    __device__ __forceinline__ void operator()(const f32x4 (&acc)[2][1][4][2], const Unit& u, int wr, int wc, int fr, int fq) const {
        int pn_ = __builtin_amdgcn_readfirstlane(u.pn), pm_ = __builtin_amdgcn_readfirstlane(u.pm); asm volatile("" : "+s"(pn_), "+s"(pm_), "+v"(fr), "+v"(fq));
        const int rowb = pm_ * 256 + wr * 64 + fr, col = pn_ * 128 + wc * 32 + fq * 8;
        const float* gt = w.mod() + ((size_t)l * 3 + g2::row_modj(pm_ * 256)) * 3072 + 2048 + col; const f32x4 g0 = *(const f32x4*)gt, g1 = *(const f32x4*)(gt + 4);
        f32x4 xv[2][4][2];
#pragma unroll
        for (int ai = 0; ai < 2; ++ai)
#pragma unroll
            for (int m = 0; m < 4; ++m) { const float* xr = g2::xrow(in, w, l, MK1_ROW(ai, m)) + col; xv[ai][m][0] = *(const f32x4*)xr; xv[ai][m][1] = *(const f32x4*)(xr + 4); }
#pragma unroll
        for (int ai = 0; ai < 2; ++ai)
#pragma unroll
            for (int m = 0; m < 4; ++m) { float* o = w.out + (size_t)MK1_ROW(ai, m) * 1024 + col; *(f32x4*)o = xv[ai][m][0] + g0 * acc[ai][0][m][0]; *(f32x4*)(o + 4) = xv[ai][m][1] + g1 * acc[ai][0][m][1]; }
    }
};

__device__ __forceinline__ int fresh_grid() { int g = (int)gridDim.x; asm volatile("" : "+s"(g)); return g; }
__device__ __forceinline__ float wave_sum(float v) {
    v += __int_as_float(__builtin_amdgcn_ds_swizzle(__float_as_int(v), 0x041f)); v += __int_as_float(__builtin_amdgcn_ds_swizzle(__float_as_int(v), 0x081f));
    v += __int_as_float(__builtin_amdgcn_ds_swizzle(__float_as_int(v), 0x101f)); v += __int_as_float(__builtin_amdgcn_ds_swizzle(__float_as_int(v), 0x201f));
    v += __int_as_float(__builtin_amdgcn_ds_swizzle(__float_as_int(v), 0x401f));
    const auto rr = __builtin_amdgcn_permlane32_swap(__float_as_uint(v), __float_as_uint(v), false, false);
    return __uint_as_float(rr[0]) + __uint_as_float(rr[1]);
}
template <bool FINAL> __device__ __forceinline__ void ph_rows(InP in, const W& w, int l) {
    int tid_ = threadIdx.x; asm volatile("" : "+v"(tid_)); const int lane = tid_ & 63, wave = tid_ >> 6;
    const int gw = blockIdx.x * NWAVES + wave, NGW = fresh_grid() * NWAVES;
    for (int m = gw; m < M; m += NGW) {
        const float* xr = FINAL ? w.out + (size_t)m * 1024 : g2::xrow(in, w, l, m);
        f32x4 v[4]; float s = 0.f;
#pragma unroll
        for (int j = 0; j < 4; ++j) { v[j] = *(const f32x4*)(xr + 256 * j + 4 * lane); s += (v[j].x * v[j].x + v[j].y * v[j].y) + (v[j].z * v[j].z + v[j].w * v[j].w); }
        const float r = 1.0f / sqrtf(wave_sum(s) * (1.0f / 1024.f) + g2::EPS);
        if (FINAL) { const float* g = in->final_g;
#pragma unroll
            for (int j = 0; j < 4; ++j) { const f32x4 gv = *(const f32x4*)(g + 256 * j + 4 * lane); *(f32x4*)(w.out + (size_t)m * 1024 + 256 * j + 4 * lane) = v[j] * r * gv; } }
        else { const float* mo = w.mod() + ((size_t)l * 3 + g2::row_modj(m)) * 3072; const float* g = in->norm_g + l * 1024;
#pragma unroll
            for (int j = 0; j < 4; ++j) { const int k = 256 * j + 4 * lane; const f32x4 gv = *(const f32x4*)(g + k), sc = *(const f32x4*)(mo + 1024 + k), sh = *(const f32x4*)(mo + k);
                const f32x4 o = (v[j] * r) * gv * (sc + 1.0f) + sh; unsigned long long pk = (unsigned long long)pg8::cvt_pk_bf16(o.x, o.y) | ((unsigned long long)pg8::cvt_pk_bf16(o.z, o.w) << 32);
                *(unsigned long long*)(w.H() + (size_t)m * 1024 + k) = pk; } }
    }
}
__device__ __forceinline__ void cvt_item(const float* Wsrc, int ldw, int oc, g2::bf16_t* WT, int K, int k0, LAS float* scr, int lane) {
    float v[64];
#pragma unroll
    for (int kk = 0; kk < 64; ++kk) v[kk] = Wsrc[(size_t)(k0 + kk) * ldw + oc];
#pragma unroll
    for (int kk = 0; kk < 64; ++kk) scr[kk * 64 + (lane ^ (8 * (kk >> 3)))] = v[kk];
    asm volatile("s_waitcnt lgkmcnt(0)" ::: "memory");
    const int c = lane & 7;
#pragma unroll
    for (int j = 0; j < 8; ++j) { const int n = (lane >> 3) + 8 * j; const LAS float* s_ = scr + (8 * c) * 64 + (n ^ (8 * c));
        u32x4 o; o.x = pg8::cvt_pk_bf16(s_[0 * 64], s_[1 * 64]); o.y = pg8::cvt_pk_bf16(s_[2 * 64], s_[3 * 64]); o.z = pg8::cvt_pk_bf16(s_[4 * 64], s_[5 * 64]); o.w = pg8::cvt_pk_bf16(s_[6 * 64], s_[7 * 64]);
        *(u32x4*)(WT + (size_t)n * K + k0 + 8 * c) = o; }
    asm volatile("s_waitcnt lgkmcnt(0)" ::: "memory");
}
__device__ __forceinline__ void ph_convert(InP in, const W& w, LAS unsigned char* L) {
    int tid_ = threadIdx.x; asm volatile("" : "+v"(tid_)); const int lane = tid_ & 63, wave = tid_ >> 6;
    LAS float* scr = (LAS float*)(L + wave * 16384);
    const int gw = blockIdx.x * NWAVES + wave, NGW = fresh_grid() * NWAVES;
    constexpr int I_IN = 16 * (INC / 64), I_GLU = 8 * 16, I_BR = 8 * 16, I_OUT = 16 * 16;
    constexpr int NITEMS = 2 * I_IN + 2 * I_GLU + 8 * I_BR + 2 * I_OUT;
    for (int it = gw; it < NITEMS; it += NGW) {
        int r = it;
        if (r < 2 * I_IN) { const int l = r / I_IN; r -= l * I_IN; const int kb = r / (INC / 64), n0 = (r % (INC / 64)) * 64; const int oca = g2::in_orig_col(n0), ocb = g2::in_orig_col(n0 + 32);
            if (oca >= g2::C_XPOOL && oca < g2::C_XPOOL + 512) continue;
            cvt_item(in->w_in + (size_t)l * 1024 * INC, INC, (lane < 32 ? oca : ocb) + (lane & 31), w.win() + ((size_t)l * INC + n0) * 1024, 1024, kb * 64, scr, lane); continue; }
        r -= 2 * I_IN;
        if (r < 2 * I_GLU) { const int l = r / I_GLU; r -= l * I_GLU; const int kb = r / 16, n0 = (r % 16) * 64;
            cvt_item(in->glu_w + (size_t)l * 512 * 1024, 1024, glu_orig_col_v2(n0 + lane), w.wglu() + ((size_t)l * 1024 + n0) * 512, 512, kb * 64, scr, lane); continue; }
        r -= 2 * I_GLU;
        if (r < 8 * I_BR) { const int ln = r / I_BR; r -= ln * I_BR; const int kb = r / 16, n0 = (r % 16) * 64;
            cvt_item(in->w_br + (size_t)ln * 512 * 1024, 1024, n0 + lane, w.wbr() + ((size_t)ln * 1024 + n0) * 512, 512, kb * 64, scr, lane); continue; }
        r -= 8 * I_BR;
        { const int l = r / I_OUT; r -= l * I_OUT; const int kb = r / 16, n0 = (r % 16) * 64;
          cvt_item(in->w_out + (size_t)l * 1024 * 1024, 1024, n0 + lane, w.wout() + ((size_t)l * 1024 + n0) * 1024, 1024, kb * 64, scr, lane); }
    }
}
__device__ __forceinline__ void ph_mod(InP in, const W& w, LAS unsigned char* L) {
    int tid_ = threadIdx.x; asm volatile("" : "+v"(tid_));
    LAS float* sc = (LAS float*)L;
    LAS float* red = (LAS float*)(L + 12288);
    const int G_ = fresh_grid();
    if ((int)blockIdx.x >= 192) return;
    for (int i = tid_; i < 3 * 1024; i += NTHREADS) { const int j = i >> 10, k = i & 1023; const float v = j == 0 ? in->c_ctx[k] : in->c[(size_t)(j - 1) * 1024 + k]; sc[i] = v * fsig(v); }
    __syncthreads();
    for (int it = blockIdx.x; it < 192; it += G_) { const int l = it / 96, n = (it % 96) * 32 + (tid_ & 31), ks = tid_ >> 5; const float* wa = in->w_ada + ((size_t)l * 1024 + ks * 64) * 3072 + n;
        float a0 = 0.f, a1 = 0.f, a2 = 0.f;
#pragma unroll 16
        for (int kk = 0; kk < 64; ++kk) { const float wv = wa[(size_t)kk * 3072]; const int k = ks * 64 + kk; a0 += sc[k] * wv; a1 += sc[1024 + k] * wv; a2 += sc[2048 + k] * wv; }
        red[(ks * 3 + 0) * 32 + (tid_ & 31)] = a0; red[(ks * 3 + 1) * 32 + (tid_ & 31)] = a1; red[(ks * 3 + 2) * 32 + (tid_ & 31)] = a2;
        __syncthreads();
        if (tid_ < 96) { const int j = tid_ >> 5, cidx = tid_ & 31; float t = 0.f;
#pragma unroll
            for (int q = 0; q < 16; ++q) t += red[(q * 3 + j) * 32 + cidx];
            const int nn = (it % 96) * 32 + cidx; w.mod()[((size_t)l * 3 + j) * 3072 + nn] = t + in->b_ada[l * 3072 + nn]; }
        __syncthreads(); }
}
__device__ __forceinline__ void ph_poolfold(InP in, const W& w, LAS unsigned char* L) {
    int tid_ = threadIdx.x; asm volatile("" : "+v"(tid_));
    LAS float* A = (LAS float*)(L + 16384);
    const int G_ = fresh_grid(); const int vb = G_ - 1 - (int)blockIdx.x;
    for (int it = vb; it < 128; it += G_) { const int l = it >> 6, g = (it >> 4) & 3, k0 = (it & 15) * 64, co = tid_ & 127, kq = tid_ >> 7;
        __syncthreads();
        for (int i = tid_; i < 64 * 128; i += NTHREADS) A[i] = in->w_in[((size_t)l * 1024 + k0 + (i >> 7)) * INC + g2::C_XPOOL + g * 128 + (i & 127)];
        __syncthreads();
        const float* pw = in->pool_w + ((size_t)l * 4 + g) * 128 * 128 + co; float acc[16];
#pragma unroll
        for (int kk = 0; kk < 16; ++kk) acc[kk] = 0.f;
#pragma unroll 4
        for (int ci = 0; ci < 128; ++ci) { const float bv = pw[(size_t)ci * 128];
#pragma unroll
            for (int kk = 0; kk < 16; ++kk) acc[kk] += A[(16 * kq + kk) * 128 + ci] * bv; }
        const float sc_ = in->pool_scale[l * 512 + g * 128 + co]; float o[16];
#pragma unroll
        for (int kk = 0; kk < 16; ++kk) o[kk] = acc[kk] * sc_;
        g2::bf16_t* dst = w.win() + ((size_t)l * INC + 11 * 256 + g * 128 + co) * 1024 + k0 + 16 * kq; st16(dst, pack8(o)); st16(dst + 8, pack8(o + 8)); }
}
template <int WD> __device__ __forceinline__ void pool_strip(const float (&xp)[32], int t0, int Lseq, g2::bf16_t* gp) {
    g2::bf16_t gr[16];
#pragma unroll
    for (int tt = 0; tt < 16; ++tt) gr[tt] = gp[(size_t)tt * 512];
    __builtin_amdgcn_sched_barrier(0);
#pragma unroll
    for (int tt = 0; tt < 16; ++tt) { float sum = 0.f;
#pragma unroll
        for (int i = 0; i < WD; ++i) sum += xp[tt + 8 - WD / 2 + i];
        const int t = t0 + tt; const int lo = t - WD / 2 < 0 ? 0 : t - WD / 2, hi = t + WD / 2 > Lseq ? Lseq : t + WD / 2;
        gp[(size_t)tt * 512] = g2::f2bf((sum / (float)(hi - lo) - xp[tt + 8]) * g2::bf2f(gr[tt])); }
}
__device__ __forceinline__ void ph_convpool(InP in, const W& w, int l, LAS unsigned char* L) {
    int tid_ = threadIdx.x; asm volatile("" : "+v"(tid_)); const int c = tid_, lane = tid_ & 63, wave = tid_ >> 6;
    LAS float* Y = (LAS float*)L;
    const int G_ = fresh_grid();
    for (int u = blockIdx.x; u < M / 16; u += G_) {
        const int m0 = u * 16, s0 = g2::row_seq0(m0), Lseq = g2::row_len(m0), t0 = m0 - s0;
        { float xp[32];
          g2::bf16_t raw[32];
#pragma unroll
          for (int i = 0; i < 32; ++i) { const int t = t0 - 8 + i; const int tc = t < 0 ? 0 : (t >= Lseq ? Lseq - 1 : t); raw[i] = w.XP()[(size_t)(s0 + tc) * 512 + c]; }
          __builtin_amdgcn_sched_barrier(0);
#pragma unroll
          for (int i = 0; i < 32; ++i) { const int t = t0 - 8 + i; xp[i] = (t >= 0 && t < Lseq) ? g2::bf2f(raw[i]) : 0.f; }
          g2::bf16_t* gp = w.GATE() + ((size_t)2 * M + m0) * 512 + c; const int grp = c >> 7;
          if (grp == 0) pool_strip<2>(xp, t0, Lseq, gp); else if (grp == 1) pool_strip<4>(xp, t0, Lseq, gp); else if (grp == 2) pool_strip<8>(xp, t0, Lseq, gp); else pool_strip<16>(xp, t0, Lseq, gp); }
        { float acc[16]; const float bias = in->conv_db[l * 512 + c];
#pragma unroll
          for (int tt = 0; tt < 16; ++tt) acc[tt] = bias;
          float wj[31];
#pragma unroll
          for (int j = 0; j < 31; ++j) wj[j] = in->conv_dw[((size_t)l * 31 + j) * 512 + c];
          float xin[46];
          g2::bf16_t raw[46];
#pragma unroll
          for (int i = 0; i < 46; ++i) { const int t = t0 - 15 + i; const int tc = t < 0 ? 0 : (t >= Lseq ? Lseq - 1 : t); raw[i] = w.XC()[(size_t)(s0 + tc) * 512 + c]; }
          __builtin_amdgcn_sched_barrier(0);
#pragma unroll
          for (int i = 0; i < 46; ++i) { const int t = t0 - 15 + i; xin[i] = (t >= 0 && t < Lseq) ? g2::bf2f(raw[i]) : 0.f; }
#pragma unroll
          for (int i = 0; i < 46; ++i) { const float x = xin[i];
#pragma unroll
              for (int tt = 0; tt < 16; ++tt) { const int j = i - tt; if (j >= 0 && j < 31) acc[tt] += x * wj[j]; } }
#pragma unroll
          for (int tt = 0; tt < 16; ++tt) Y[tt * 512 + c] = acc[tt]; }
        __syncthreads();
#pragma unroll
        for (int q = 0; q < 2; ++q) { const int tt = wave * 2 + q; float y[8]; const f32x4 a = *(const LAS f32x4*)(Y + tt * 512 + 8 * lane), b = *(const LAS f32x4*)(Y + tt * 512 + 8 * lane + 4);
            y[0] = a.x; y[1] = a.y; y[2] = a.z; y[3] = a.w; y[4] = b.x; y[5] = b.y; y[6] = b.z; y[7] = b.w; float s = 0.f;
#pragma unroll
            for (int e = 0; e < 8; ++e) s += y[e];
            const float mu = wave_sum(s) * (1.0f / 512.f); float q2 = 0.f;
#pragma unroll
            for (int e = 0; e < 8; ++e) { y[e] -= mu; q2 += y[e] * y[e]; }
            const float rs = 1.0f / sqrtf(wave_sum(q2) * (1.0f / 512.f) + g2::EPS);
            float lg[8], lb[8], gt[8], o[8]; ldf8(in->conv_ln_g + l * 512 + 8 * lane, lg); ldf8(in->conv_ln_b + l * 512 + 8 * lane, lb);
            g2::bf16_t* gp = w.GATE() + ((size_t)1 * M + m0 + tt) * 512 + 8 * lane; unpack8(*(const u32x4*)gp, gt);
#pragma unroll
            for (int e = 0; e < 8; ++e) o[e] = fsilu(y[e] * rs * lg[e] + lb[e]) * gt[e];
            st16(gp, pack8(o)); }
        __syncthreads();
    }
}


constexpr size_t WS_BB = 3 * g2::MiB, WS_CC = 3 * g2::MiB + 512 * 1024;
struct FSsmTab { InP in; W w;
    __device__ __forceinline__ void operator()(long i) const { const int p = i % 64, g = (i / 64) % 32; const long ld = i / (64 * 32);
        const float lr = in->lam_re[i], li = in->lam_im[i]; const float dt = expf(in->log_dt[ld * 32 + g]);
        const float e = expf(lr * dt), br_ = e * cosf(li * dt), bi_ = e * sinf(li * dt); w.lamb()[2 * i] = br_; w.lamb()[2 * i + 1] = bi_;
        const float nr = br_ - 1.0f, ni = bi_, den = lr * lr + li * li, fr = (nr * lr + ni * li) / den, fi = (ni * lr - nr * li) / den;
        g2::bf16_t* bb = (g2::bf16_t*)(w.ws + WS_BB) + ((size_t)(ld * 32 + g) * 2 * 64 + p) * 16; g2::bf16_t* cc = (g2::bf16_t*)(w.ws + WS_CC) + (size_t)(ld * 32 + g) * 16 * 128 + 2 * p;
        for (int c = 0; c < 16; ++c) { const float xr = in->b_re[i * 16 + c], xi = in->b_im[i * 16 + c]; bb[c] = g2::f2bf(fr * xr - fi * xi); bb[64 * 16 + c] = g2::f2bf(fr * xi + fi * xr);
            cc[c * 128] = g2::f2bf(in->c_re[((ld * 32 + g) * 16 + c) * 64 + p]); cc[c * 128 + 1] = g2::f2bf(-in->c_im[((ld * 32 + g) * 16 + c) * 64 + p]); } } };

typedef short bf16x8_t __attribute__((ext_vector_type(8)));
typedef float f32x2_t __attribute__((ext_vector_type(2)));
constexpr int SSM_WAVE_LDS = 12800, SSM_HROW = 272, SSM_XCH = 8 * SSM_WAVE_LDS;
__device__ __forceinline__ float fgelu(float x) { const float u = 0.7978845608028654f * (x + 0.044715f * x * x * x); return x * fsig(2.0f * u); }

template <int MODE> __device__ __forceinline__ void ssm_pass(const W& w, int l, int dir, int g, int m_lo, int ntok, float& hr, float& hi, LAS unsigned char* wl, int lane, float dval) {
    LAS f32x2_t* BU = (LAS f32x2_t*)wl; LAS unsigned char* Hb = wl + 8192;
    const int ld = l * 2 + dir, fr = lane & 15, fq = lane >> 4;
    const f32x2_t lam = *(const f32x2_t*)(w.lamb() + ((size_t)(ld * 32 + g) * 64 + lane) * 2);
    bf16x8_t bfr[4][2], cfr[4];
    { const g2::bf16_t* bb = (const g2::bf16_t*)(w.ws + WS_BB) + (size_t)(ld * 32 + g) * 2 * 64 * 16;
#pragma unroll
      for (int q = 0; q < 4; ++q)
#pragma unroll
          for (int ri = 0; ri < 2; ++ri) { const bf16x8_t t_ = *(const bf16x8_t*)(bb + ((size_t)ri * 64 + 16 * q + fr) * 16 + 8 * (fq & 1)); bfr[q][ri] = fq < 2 ? t_ : (bf16x8_t){0, 0, 0, 0, 0, 0, 0, 0}; }
      if (MODE != 0) { const g2::bf16_t* cc = (const g2::bf16_t*)(w.ws + WS_CC) + ((size_t)(ld * 32 + g) * 16 + fr) * 128;
#pragma unroll
          for (int ks = 0; ks < 4; ++ks) cfr[ks] = *(const bf16x8_t*)(cc + 32 * ks + 8 * fq); } }
    const int nch = ntok >> 4; const g2::bf16_t* xs = w.XS() + (size_t)g * 16;
    auto chunk_row = [&](int ci) { return dir == 0 ? m_lo + 16 * ci : m_lo + ntok - 16 - 16 * ci; };
    struct Pre { bf16x8_t a; g2::bf16_t x[4]; float yf[4]; };
    auto fetch = [&](int ci, Pre& P) { if (ci < nch) { const int mn = chunk_row(ci); P.a = *(const bf16x8_t*)(xs + (size_t)(mn + fr) * 512 + 8 * (fq & 1));
            if (MODE != 0) {
#pragma unroll
                for (int r = 0; r < 4; ++r) { const size_t o = (size_t)(mn + 4 * fq + r) * 512 + g * 16 + fr; P.x[r] = w.XS()[o]; if (MODE == 2) P.yf[r] = w.TMP()[o]; } } } };
    auto step = [&](int ci, Pre& P) {
        const int mt = chunk_row(ci); const bf16x8_t a = fq < 2 ? P.a : (bf16x8_t){0, 0, 0, 0, 0, 0, 0, 0}; float xc[4], yfc[4];
#pragma unroll
        for (int r = 0; r < 4; ++r) { xc[r] = g2::bf2f(P.x[r]); yfc[r] = P.yf[r]; }
        fetch(ci + 2, P);
#pragma unroll
        for (int q = 0; q < 4; ++q) { const f32x4 z = {0.f, 0.f, 0.f, 0.f};
            const f32x4 dre = __builtin_amdgcn_mfma_f32_16x16x32_bf16(a, bfr[q][0], z, 0, 0, 0), dim = __builtin_amdgcn_mfma_f32_16x16x32_bf16(a, bfr[q][1], z, 0, 0, 0);
#pragma unroll
            for (int r = 0; r < 4; ++r) BU[(4 * fq + r) * 64 + 16 * q + fr] = (f32x2_t){dre[r], dim[r]}; }
        f32x2_t bq[16];
#pragma unroll
        for (int s_ = 0; s_ < 16; ++s_) bq[s_] = BU[(dir == 0 ? s_ : 15 - s_) * 64 + lane];
        unsigned hw[16];
#pragma unroll
        for (int s_ = 0; s_ < 16; ++s_) { const float nr = lam.x * hr - lam.y * hi + bq[s_].x, ni = lam.x * hi + lam.y * hr + bq[s_].y; hr = nr; hi = ni; if (MODE != 0) hw[s_] = pg8::cvt_pk_bf16(hr, hi); }
        if (MODE != 0) {
#pragma unroll
            for (int s_ = 0; s_ < 16; ++s_) *(LAS unsigned*)(Hb + (dir == 0 ? s_ : 15 - s_) * SSM_HROW + lane * 4) = hw[s_];
            f32x4 y = {0.f, 0.f, 0.f, 0.f};
#pragma unroll
            for (int ks = 0; ks < 4; ++ks) { const bf16x8_t ha = *(const LAS bf16x8_t*)(Hb + fr * SSM_HROW + 64 * ks + 16 * fq); y = __builtin_amdgcn_mfma_f32_16x16x32_bf16(ha, cfr[ks], y, 0, 0, 0); }
#pragma unroll
            for (int r = 0; r < 4; ++r) { const size_t o = (size_t)(mt + 4 * fq + r) * 512 + g * 16 + fr;
                if (MODE == 1) w.TMP()[o] = y[r] + dval * xc[r]; else w.YS()[o] = g2::f2bf(fgelu(y[r] + yfc[r])); } }
    };
    Pre PA, PB;
#pragma unroll
    for (int r = 0; r < 4; ++r) { PA.x[r] = 0; PA.yf[r] = 0.f; PB.x[r] = 0; PB.yf[r] = 0.f; }
    PA.a = (bf16x8_t){0, 0, 0, 0, 0, 0, 0, 0}; PB.a = PA.a;
    fetch(0, PA); fetch(1, PB);
#pragma unroll 1
    for (int ci = 0; ci < nch; ci += 2) { step(ci, PA); step(ci + 1, PB); }
}
__device__ __forceinline__ void ph_ssm(InP in, const W& w, int l, LAS unsigned char* L) {
    int tid_ = threadIdx.x; asm volatile("" : "+v"(tid_)); const int lane = tid_ & 63, wave = __builtin_amdgcn_readfirstlane(tid_ >> 6);
    LAS unsigned char* wl = L + wave * SSM_WAVE_LDS; LAS f32x2_t* XCH = (LAS f32x2_t*)(L + SSM_XCH);
    const int G_ = fresh_grid();
    for (int bu = blockIdx.x; bu < 128; bu += G_) {
        if (bu < 64) {
            const int b = bu >> 5, g = bu & 31, m_lo = MP + b * 2048 + wave * 256; const float dval = in->ssm_d[l * 512 + g * 16 + (lane & 15)];
            float ef_r = 0.f, ef_i = 0.f, eb_r = 0.f, eb_i = 0.f;
            ssm_pass<0>(w, l, 0, g, m_lo, 256, ef_r, ef_i, wl, lane, dval); ssm_pass<0>(w, l, 1, g, m_lo, 256, eb_r, eb_i, wl, lane, dval);
            XCH[(wave * 2 + 0) * 64 + lane] = (f32x2_t){ef_r, ef_i}; XCH[(wave * 2 + 1) * 64 + lane] = (f32x2_t){eb_r, eb_i};
            __syncthreads();
            float cr[2], ci[2];
#pragma unroll
            for (int dir = 0; dir < 2; ++dir) { const f32x2_t lam = *(const f32x2_t*)(w.lamb() + ((size_t)((l * 2 + dir) * 32 + g) * 64 + lane) * 2); float pr = lam.x, pi = lam.y;
#pragma unroll
                for (int sq = 0; sq < 8; ++sq) { const float t = pr * pr - pi * pi; pi = 2.f * pr * pi; pr = t; }
                const float* st = in->state_ssm + ((((size_t)b * 2 + l) * 2 + dir) * 2) * 2048 + g * 64 + lane; float hr = st[0], hi = st[2048];
                if (dir == 0) { for (int j = 0; j < wave; ++j) { const f32x2_t e = XCH[(j * 2 + 0) * 64 + lane]; const float t = pr * hr - pi * hi + e.x; hi = pr * hi + pi * hr + e.y; hr = t; } }
                else { for (int j = 7; j > wave; --j) { const f32x2_t e = XCH[(j * 2 + 1) * 64 + lane]; const float t = pr * hr - pi * hi + e.x; hi = pr * hi + pi * hr + e.y; hr = t; } }
                cr[dir] = hr; ci[dir] = hi; }
            ssm_pass<1>(w, l, 0, g, m_lo, 256, cr[0], ci[0], wl, lane, dval); ssm_pass<2>(w, l, 1, g, m_lo, 256, cr[1], ci[1], wl, lane, dval);
            __syncthreads();
        } else {
            const int pair = (bu - 64) * 8 + wave, b = pair >> 5, g = pair & 31, m_lo = b * 256; const float dval = in->ssm_d[l * 512 + g * 16 + (lane & 15)];
            float hr = 0.f, hi = 0.f;
            ssm_pass<1>(w, l, 0, g, m_lo, 256, hr, hi, wl, lane, dval);
            { float* o = w.out + g2::OUT_ST + ((((size_t)b * 2 + l) * 2 + 0) * 2) * 2048 + g * 64 + lane; o[0] = hr; o[2048] = hi; }
            hr = 0.f; hi = 0.f;
            ssm_pass<2>(w, l, 1, g, m_lo, 256, hr, hi, wl, lane, dval);
            { float* o = w.out + g2::OUT_ST + ((((size_t)b * 2 + l) * 2 + 1) * 2) * 2048 + g * 64 + lane; o[0] = hr; o[2048] = hi; }
        }
    }
}


constexpr size_t WS_CK = g2::WS_BBAR, WS_CV = g2::WS_BBAR + 256 * 1024;
struct FCvtCache { InP in; W w;
    __device__ __forceinline__ void operator()(long i) const { const long n = 2L * 2 * 256 * 128; if (i < n) ((g2::bf16_t*)(w.ws + WS_CK))[i] = g2::f2bf(in->cache_k[i]); else ((g2::bf16_t*)(w.ws + WS_CV))[i - n] = g2::f2bf(in->cache_v[i - n]); } };
typedef float f32x16 __attribute__((ext_vector_type(16)));
typedef short s16x4 __attribute__((ext_vector_type(4)));
constexpr int AT_SLOT = 16384, AT_KOFF = 0, AT_VOFF = 8192;
constexpr float AT_C2 = 0.125f * 1.4426950408889634f, AT_LOG2E = 1.4426950408889634f;
__device__ __forceinline__ int at_crow(int r, int hi) { return (r & 3) + 8 * (r >> 2) + 4 * hi; }
__device__ __forceinline__ float at_rowmax(const f32x16& p0, const f32x16& p1) { float a = fmaxf(p0[0], p1[0]);
#pragma unroll
    for (int r = 1; r < 16; ++r) a = fmaxf(a, fmaxf(p0[r], p1[r]));
    const auto rr = __builtin_amdgcn_permlane32_swap(__float_as_uint(a), __float_as_uint(a), false, false); return fmaxf(__uint_as_float(rr[0]), __uint_as_float(rr[1])); }

__device__ __forceinline__ void ph_attn(InP in, const W& w, int l, LAS unsigned char* L) {
    int tid_ = threadIdx.x; asm volatile("" : "+v"(tid_)); const int lane = tid_ & 63, r32 = lane & 31, hi = lane >> 5, wave = __builtin_amdgcn_readfirstlane(tid_ >> 6);
    const int G_ = fresh_grid();
    for (int ui = blockIdx.x; ui < 256; ui += G_) {
        const int u = (ui + 128) & 255;
        int head, kv, mq, qpos, ntile, nctx, klo; const g2::bf16_t *kbase, *vbase, *ckbase, *cvbase;
        if (u < 128) { const int b = u >> 6, rem = u & 63, pb = (rem >> 1) & 15; kv = rem >> 5; head = kv * 4 + (rem & 1) * 2 + (wave >> 2); qpos = pb * 128 + 32 * (wave & 3) + r32; mq = MP + b * 2048 + qpos;
            klo = pb * 128 - 128 < 0 ? 0 : pb * 128 - 128; const int khi = pb * 128 + 256 > 2048 ? 2048 : pb * 128 + 256; nctx = 4; ntile = 4 + (khi - klo) / 64;
            kbase = w.K() + (size_t)(MP + b * 2048 + klo) * 128; vbase = w.V() + (size_t)(MP + b * 2048 + klo) * 128;
            ckbase = (const g2::bf16_t*)(w.ws + WS_CK) + (size_t)(b * 2 + l) * 256 * 128; cvbase = (const g2::bf16_t*)(w.ws + WS_CV) + (size_t)(b * 2 + l) * 256 * 128; }
        else { const int b = (u - 128) >> 3; head = (u - 128) & 7; kv = head >> 2; qpos = 32 * wave + r32; mq = b * 256 + qpos; klo = 0; nctx = 0; ntile = 4;
            kbase = w.K() + (size_t)(b * 256) * 128; vbase = w.V() + (size_t)(b * 256) * 128; ckbase = kbase; cvbase = vbase; }
        bf16x8_t qr[4];
#pragma unroll
        for (int d0 = 0; d0 < 4; ++d0) qr[d0] = *(const bf16x8_t*)(w.Q() + (size_t)mq * 512 + head * 64 + d0 * 16 + hi * 8);
        float mrun = in->attn_sink[l * 8 + head] * AT_LOG2E, lsum = hi == 0 ? 1.0f : 0.0f;
        f32x16 o[2]; o[0] = f32x16{}; o[1] = f32x16{};
        auto ksrc = [&](int i) { const g2::bf16_t* base = i < nctx ? ckbase + (size_t)(64 * i) * 128 : kbase + (size_t)(64 * (i - nctx)) * 128; return base + (size_t)lane * 128 + kv * 64 + 8 * wave; };
        auto vsrc = [&](int i) { const g2::bf16_t* base = i < nctx ? cvbase + (size_t)(64 * i) * 128 : vbase + (size_t)(64 * (i - nctx)) * 128; return base + (size_t)(16 * (wave & 3) + (lane >> 2)) * 128 + kv * 64 + (wave >> 2) * 32 + (lane & 3) * 8; };
        u32x4 kreg = *(const u32x4*)ksrc(0), vreg = *(const u32x4*)vsrc(0);
        __syncthreads();
        *(LAS u32x4*)(L + AT_KOFF + wave * 1024 + lane * 16) = kreg; *(LAS u32x4*)(L + AT_VOFF + wave * 1024 + lane * 16) = vreg;
        __syncthreads();
#pragma unroll 1
        for (int i = 0; i < ntile; ++i) {
            LAS unsigned char* slot = L + (i & 1) * AT_SLOT;
            if (i + 1 < ntile) { kreg = *(const u32x4*)ksrc(i + 1); vreg = *(const u32x4*)vsrc(i + 1); }
            __builtin_amdgcn_sched_barrier(0);
            const int kp0 = klo + 64 * (i - nctx); const int q0 = qpos - r32;
            const bool win = i >= nctx && nctx > 0; const bool skip = win && (kp0 > q0 + 31 + 128 || kp0 + 63 < q0 - 128);
            if (!skip) {
                f32x16 p0 = f32x16{}, p1 = f32x16{};
                { const LAS unsigned char* kb = slot + AT_KOFF + hi * 1024 + r32 * 16;
#pragma unroll
                  for (int d0 = 0; d0 < 4; ++d0) { const bf16x8_t b0 = *(const LAS bf16x8_t*)(kb + d0 * 2048), b1 = *(const LAS bf16x8_t*)(kb + d0 * 2048 + 512);
                      p0 = __builtin_amdgcn_mfma_f32_32x32x16_bf16(b0, qr[d0], p0, 0, 0, 0); p1 = __builtin_amdgcn_mfma_f32_32x32x16_bf16(b1, qr[d0], p1, 0, 0, 0); } }
                if (win && (kp0 + 63 - q0 > 128 || q0 + 31 - kp0 > 128)) {
#pragma unroll
                    for (int r = 0; r < 16; ++r) { const int kk = kp0 + at_crow(r, hi); const int d0_ = qpos - kk, d1_ = qpos - (kk + 32);
                        if (d0_ > 128 || d0_ < -128) p0[r] = -1e30f; if (d1_ > 128 || d1_ < -128) p1[r] = -1e30f; } }
                const float rm = at_rowmax(p0, p1) * AT_C2; const float mnew = fmaxf(mrun, rm); const float alpha = __builtin_amdgcn_exp2f(mrun - mnew); mrun = mnew;
                float psum = 0.f;
#pragma unroll
                for (int r = 0; r < 16; ++r) { p0[r] = __builtin_amdgcn_exp2f(p0[r] * AT_C2 - mnew); p1[r] = __builtin_amdgcn_exp2f(p1[r] * AT_C2 - mnew); psum += p0[r] + p1[r]; }
                lsum = lsum * alpha + psum;
#pragma unroll
                for (int r = 0; r < 16; ++r) { o[0][r] *= alpha; o[1][r] *= alpha; }
                u32x4 pw[4];
#pragma unroll
                for (int s_ = 0; s_ < 4; ++s_) { const f32x16& P = s_ < 2 ? p0 : p1; const int bse = (s_ & 1) * 8;
                    pw[s_] = (u32x4){pg8::cvt_pk_bf16(P[bse], P[bse + 1]), pg8::cvt_pk_bf16(P[bse + 2], P[bse + 3]), pg8::cvt_pk_bf16(P[bse + 4], P[bse + 5]), pg8::cvt_pk_bf16(P[bse + 6], P[bse + 7])}; }
                const unsigned vb = (unsigned)(uintptr_t)(slot + AT_VOFF) + ((lane >> 4) & 1) * 32 + (lane & 3) * 8 + (4 * hi + ((lane & 15) >> 2)) * 64;
#pragma unroll
                for (int d0 = 0; d0 < 2; ++d0) { s16x4 lo[4], hh[4];
#pragma unroll
                    for (int ks = 0; ks < 4; ++ks) {
                        asm volatile("ds_read_b64_tr_b16 %0, %1 offset:%c2" : "=&v"(lo[ks]) : "v"(vb), "i"(d0 * 4096 + ks * 1024) : "memory");
                        asm volatile("ds_read_b64_tr_b16 %0, %1 offset:%c2" : "=&v"(hh[ks]) : "v"(vb), "i"(d0 * 4096 + ks * 1024 + 512) : "memory"); }
                    asm volatile("s_waitcnt lgkmcnt(0)" ::: "memory"); __builtin_amdgcn_sched_barrier(0);
#pragma unroll
                    for (int ks = 0; ks < 4; ++ks) { const bf16x8_t vf = (bf16x8_t){lo[ks][0], lo[ks][1], lo[ks][2], lo[ks][3], hh[ks][0], hh[ks][1], hh[ks][2], hh[ks][3]};
                        o[d0] = __builtin_amdgcn_mfma_f32_32x32x16_bf16(vf, __builtin_bit_cast(bf16x8_t, pw[ks]), o[d0], 0, 0, 0); } }
            }
            if (i + 1 < ntile) { LAS unsigned char* ns = L + ((i + 1) & 1) * AT_SLOT; *(LAS u32x4*)(ns + AT_KOFF + wave * 1024 + lane * 16) = kreg; *(LAS u32x4*)(ns + AT_VOFF + wave * 1024 + lane * 16) = vreg; }
            __syncthreads();
        }
        { const auto rr = __builtin_amdgcn_permlane32_swap(__float_as_uint(lsum), __float_as_uint(lsum), false, false); const float inv = 1.0f / (__uint_as_float(rr[0]) + __uint_as_float(rr[1]));
          g2::bf16_t* gp = w.GATE() + (size_t)mq * 512 + head * 64; unsigned long long gvv[2][4];
#pragma unroll
          for (int d0 = 0; d0 < 2; ++d0)
#pragma unroll
              for (int rq = 0; rq < 4; ++rq) gvv[d0][rq] = *(const unsigned long long*)(gp + 32 * d0 + 8 * rq + 4 * hi);
#pragma unroll
          for (int d0 = 0; d0 < 2; ++d0)
#pragma unroll
              for (int rq = 0; rq < 4; ++rq) { g2::bf16_t* p = gp + 32 * d0 + 8 * rq + 4 * hi; const unsigned long long gv = gvv[d0][rq]; const unsigned g0 = (unsigned)gv, g1 = (unsigned)(gv >> 32);
                  const float a0 = o[d0][4 * rq] * inv * __uint_as_float(g0 << 16), a1 = o[d0][4 * rq + 1] * inv * __uint_as_float(g0 & 0xffff0000u), a2 = o[d0][4 * rq + 2] * inv * __uint_as_float(g1 << 16), a3 = o[d0][4 * rq + 3] * inv * __uint_as_float(g1 & 0xffff0000u);
                  *(unsigned long long*)p = (unsigned long long)pg8::cvt_pk_bf16(a0, a1) | ((unsigned long long)pg8::cvt_pk_bf16(a2, a3) << 32); } }
    }
}

struct Args { In in; float* out; unsigned char* ws; };
__device__ __forceinline__ W fresh_w() { const __attribute__((address_space(4))) Args* p = (const __attribute__((address_space(4))) Args*)__builtin_amdgcn_kernarg_segment_ptr(); asm volatile("" : "+s"(p)); W w; w.ws = p->ws; w.out = p->out; return w; }
__device__ __forceinline__ InP fresh_in() { InP p = (InP)__builtin_amdgcn_kernarg_segment_ptr(); asm volatile("" : "+s"(p)); return p; }

template <class F> __device__ __forceinline__ void run_stage(const F& f, long n) {
    int tid_ = threadIdx.x; asm volatile("" : "+v"(tid_));
    const long stride_ = (long)fresh_grid() * NTHREADS;
    for (long i = (long)blockIdx.x * NTHREADS + tid_; i < n; i += stride_) f(i);
}

__global__ void __launch_bounds__(NTHREADS, 2) mk_fwd(Args a) {
    extern __shared__ __attribute__((aligned(16))) unsigned char lds[];
    LAS unsigned char* L = (LAS unsigned char*)lds;
    volatile LAS unsigned* MISC = (volatile LAS unsigned*)(L + MISC_OFF);
    for (int u = threadIdx.x; u < (LDS_BYTES - LDSCTL_OFF) / 4; u += NTHREADS) ((LAS unsigned*)(L + LDSCTL_OFF))[u] = 0u;
    __syncthreads();
#define in fresh_in()
#define w fresh_w()
    XcdBarrier bar = xcd_barrier_post((unsigned*)w.ctl() + CW_BAR, MISC + 8);
#define BAR() xcd_barrier(bar)
    ph_mod(in, w, L); ph_poolfold(in, w, L); __syncthreads(); run_stage(g2::FRope{w}, 2048L * 32); run_stage(FSsmTab{in, w}, 2L * 2 * 32 * 64); run_stage(FCvtCache{in, w}, 2L * 2 * 2 * 256 * 128);
    ph_convert(in, w, L);
    BAR();
#pragma unroll 1
    for (int l = 0; l < 2; ++l) {
        ph_rows<false>(in, w, l); BAR();
        { pg8::Gemm g{w.H(), w.win() + (size_t)l * INC * 1024, M, INC, 1024}; pg8::StaticOrder S; S.init(M, INC, (int)gridDim.x, (int)blockIdx.x); Epi1 E{w, l};
          pg8::gemm_phase<Epi1, pg8::StaticOrder, true, true>(L, g, S, E); }
        BAR();
        ph_ssm(in, w, l, L); __syncthreads(); ph_attn(in, w, l, L); __syncthreads(); ph_convpool(in, w, l, L); BAR();
        { pg8::Gemm g{w.YS(), w.wglu() + (size_t)l * 1024 * 512, M, 1024, 512}; SchedN1 S{(int)blockIdx.x}; Epi3 E{w};
          pg8::gemm_phase<Epi3, SchedN1, true, true, 1>(L, g, S, E); }
        BAR();
        { pg8::Gemm g{w.GATE(), w.wbr() + (size_t)l * 4 * 1024 * 512, 4 * M, 4 * 1024, 512}; Sched4a S{(int)blockIdx.x}; Epi4a E{w};
          pg8::gemm_phase<Epi4a, Sched4a, true, true, 1>(L, g, S, E); }
        BAR();
        { pg8::Gemm g{w.MRG(), w.wout() + (size_t)l * 1024 * 1024, M, 1024, 1024}; SchedN1 S{(int)blockIdx.x}; Epi4b E{in, w, l};
          pg8::gemm_phase<Epi4b, SchedN1, true, true, 1>(L, g, S, E); }
        BAR();
    }
    ph_rows<true>(in, w, 0);
#undef BAR
#undef in
#undef w
}
}

extern "C" void kernel_launch(void* const* d_in, const int* in_sizes, int n_in, void* d_out, int out_size, void* d_ws, size_t ws_size, hipStream_t stream) {
    static int grid = 0;
    if (grid == 0) {
        if (n_in != 30 || (size_t)out_size != g2::OUT_TOTAL || ws_size < g2::WS_END) { fprintf(stderr, "kernel_launch: unexpected problem shape (n_in %d out %d ws %zu)\n", n_in, out_size, ws_size); grid = -1; return; }
        int dev = 0, cus = 0, per_cu = 0;
        if (hipGetDevice(&dev) != hipSuccess || hipDeviceGetAttribute(&cus, hipDeviceAttributeMultiprocessorCount, dev) != hipSuccess) { grid = -1; return; }
        if (hipFuncSetAttribute((const void*)mk::mk_fwd, hipFuncAttributeMaxDynamicSharedMemorySize, mk::LDS_BYTES) != hipSuccess) { fprintf(stderr, "kernel_launch: hipFuncSetAttribute failed\n"); grid = -1; return; }
        if (hipOccupancyMaxActiveBlocksPerMultiprocessor(&per_cu, (const void*)mk::mk_fwd, mk::NTHREADS, mk::LDS_BYTES) != hipSuccess || per_cu < 1) { fprintf(stderr, "kernel_launch: occupancy query says %d blocks/CU\n", per_cu); (void)hipGetLastError(); grid = -1; return; }
        grid = cus;
    }
    if (grid < 0) return;
    if (hipMemsetAsync((char*)d_ws + g2::WS_CTL, 0, mk::CTL_ZERO_BYTES, stream) != hipSuccess) return;
    mk::Args a{}; const float* ptr[30]; for (int i = 0; i < 30; ++i) ptr[i] = (const float*)d_in[i]; memcpy(&a.in, ptr, sizeof(a.in));
    a.out = (float*)d_out; a.ws = (unsigned char*)d_ws;
    hipLaunchKernelGGL(mk::mk_fwd, dim3(grid), dim3(mk::NTHREADS), mk::LDS_BYTES, stream, a);
}
```

```cpp
#include <hip/hip_runtime.h>
#include <cstdio>
#include <cstring>
#include <cstdint>
#ifdef CPU_EMU
#include <cmath>
#include <cstddef>
#include <cstring>
#define HD_FN inline
#else
#define HD_FN __host__ __device__ __forceinline__
#endif

namespace g2 {
typedef unsigned short bf16_t;
#ifndef CFG_BATCH
#define CFG_BATCH 16
#endif
#ifndef CFG_DEC_BATCH
#define CFG_DEC_BATCH 2
#endif
constexpr int D = 1024, DEPTH = 2, NB_P = CFG_BATCH, L_P = 256, NB_S = CFG_DEC_BATCH, L_S = 2048, PAST = 256;
constexpr int MP = NB_P * L_P, MS = NB_S * L_S, M = MP + MS;
constexpr int GRID_W = 64, NH = 8, WINDOW = 128, CONVK = 31, SG = 32, SC = 16, SP = 64, INC = 8960, NT1 = INC / 256;
constexpr int C_XPOOL = 2816;
constexpr float EPS = 1e-6f;

HD_FN bf16_t f2bf(float f) { unsigned u; memcpy(&u, &f, 4); u = (u + 0x7fffu + ((u >> 16) & 1u)) >> 16; return (bf16_t)u; }
HD_FN float bf2f(bf16_t h) { unsigned u = (unsigned)h << 16; float f; memcpy(&f, &u, 4); return f; }
HD_FN float sigmoidf_(float x) { return 1.0f / (1.0f + expf(-x)); }
HD_FN float siluf_(float x) { return x * sigmoidf_(x); }
HD_FN float geluf_(float x) { return 0.5f * x * (1.0f + tanhf(0.7978845608028654f * (x + 0.044715f * x * x * x))); }

HD_FN int row_path(int m) { return m >= MP; }
HD_FN int row_len(int m) { return m >= MP ? L_S : L_P; }
HD_FN int row_seq0(int m) { return m >= MP ? MP + ((m - MP) / L_S) * L_S : (m / L_P) * L_P; }
HD_FN int row_batch(int m) { return m >= MP ? (m - MP) / L_S : m / L_P; }
HD_FN int row_modj(int m) { return m >= MP ? 1 + (m - MP) / L_S : 0; }

struct In {
    const float *x_prompt, *x_sample, *cache_k, *cache_v, *state_ssm, *c, *c_ctx, *norm_g, *w_ada, *b_ada, *w_in, *attn_sink, *conv_dw, *conv_db,
        *conv_ln_g, *conv_ln_b, *pool_w, *pool_scale, *lam_re, *lam_im, *log_dt, *b_re, *b_im, *c_re, *c_im, *ssm_d, *glu_w, *w_br, *w_out, *final_g;
};
#ifdef CPU_EMU
typedef const In* InP;
#else
typedef const __attribute__((address_space(4))) In* InP;
#endif
constexpr size_t OUT_YP = 0, OUT_YS = (size_t)MP * D, OUT_K = (size_t)M * D, OUT_V = OUT_K + (size_t)NB_P * DEPTH * L_P * 128, OUT_ST = OUT_V + (size_t)NB_P * DEPTH * L_P * 128,
                 OUT_TOTAL = OUT_ST + (size_t)NB_P * DEPTH * 2 * 2 * SG * SP;

constexpr size_t MiB = 1u << 20;
constexpr size_t WS_CTL = 0;
constexpr size_t WS_MOD = 1 * MiB;
constexpr size_t WS_ROPE = WS_MOD + 128 * 1024;
constexpr size_t WS_LAMB = WS_ROPE + 512 * 1024;
constexpr size_t WS_BBAR = WS_LAMB + 64 * 1024;
constexpr size_t WS_WIN = 4 * MiB;
constexpr size_t WS_WGLU = WS_WIN + (size_t)2 * INC * 1024 * 2;
constexpr size_t WS_WBR = WS_WGLU + 2 * MiB;
constexpr size_t WS_WOUT = WS_WBR + 8 * MiB;
constexpr size_t WS_H = WS_WOUT + 4 * MiB;
constexpr size_t WS_Q = WS_H + 16 * MiB;
constexpr size_t WS_XC = WS_Q + 8 * MiB;
constexpr size_t WS_MRGP = WS_H;
constexpr size_t WS_XP = WS_XC + 8 * MiB;
constexpr size_t WS_XS = WS_XP + 8 * MiB;
constexpr size_t WS_K = WS_XS + 8 * MiB;
constexpr size_t WS_V = WS_K + 2 * MiB;
constexpr size_t WS_GATE = WS_V + 2 * MiB;
constexpr size_t WS_GM = WS_GATE + 32 * MiB;
constexpr size_t WS_YS = WS_GM + 64 * MiB;
constexpr size_t WS_MRG = WS_YS + 8 * MiB;
constexpr size_t WS_TMP = WS_MRG + 16 * MiB;
constexpr size_t WS_S = WS_TMP + 16 * MiB;
constexpr size_t WS_END = WS_S + 32 * MiB;
static_assert(WS_END <= 293601280ull, "workspace map exceeds the guaranteed d_ws size");

struct W {
    unsigned char* ws; float* out;
    HD_FN unsigned* ctl() const { return (unsigned*)(ws + WS_CTL); }
    HD_FN float* mod() const { return (float*)(ws + WS_MOD); }
    HD_FN float* ropec() const { return (float*)(ws + WS_ROPE); }
    HD_FN float* ropes() const { return (float*)(ws + WS_ROPE) + 2048 * 32; }
    HD_FN float* lamb() const { return (float*)(ws + WS_LAMB); }
    HD_FN float* bbar() const { return (float*)(ws + WS_BBAR); }
    HD_FN bf16_t* win() const { return (bf16_t*)(ws + WS_WIN); }
    HD_FN bf16_t* wglu() const { return (bf16_t*)(ws + WS_WGLU); }
    HD_FN bf16_t* wbr() const { return (bf16_t*)(ws + WS_WBR); }
    HD_FN bf16_t* wout() const { return (bf16_t*)(ws + WS_WOUT); }
    HD_FN bf16_t* H() const { return (bf16_t*)(ws + WS_H); }
    HD_FN bf16_t* Q() const { return (bf16_t*)(ws + WS_Q); }
    HD_FN bf16_t* XC() const { return (bf16_t*)(ws + WS_XC); }
    HD_FN bf16_t* XP() const { return (bf16_t*)(ws + WS_XP); }
    HD_FN bf16_t* XS() const { return (bf16_t*)(ws + WS_XS); }
    HD_FN bf16_t* K() const { return (bf16_t*)(ws + WS_K); }
    HD_FN bf16_t* V() const { return (bf16_t*)(ws + WS_V); }
    HD_FN bf16_t* GATE() const { return (bf16_t*)(ws + WS_GATE); }
    HD_FN bf16_t* GM() const { return (bf16_t*)(ws + WS_GM); }
    HD_FN bf16_t* YS() const { return (bf16_t*)(ws + WS_YS); }
    HD_FN bf16_t* MRG() const { return (bf16_t*)(ws + WS_MRG); }
    HD_FN float* MRGP() const { return (float*)(ws + WS_MRGP); }
    HD_FN float* TMP() const { return (float*)(ws + WS_TMP); }
    HD_FN float* S() const { return (float*)(ws + WS_S); }
};
HD_FN W make_w(unsigned char* ws, float* out) { W w{}; w.ws = ws; w.out = out; return w; }

HD_FN const float* xrow(InP in, const W& w, int l, int m) { return l == 0 ? (m < MP ? in->x_prompt + (size_t)m * D : in->x_sample + (size_t)(m - MP) * D) : w.out + (size_t)m * D; }

HD_FN int in_orig_col(int row) { const int pn = row >> 8, c = row & 255, bj = c >> 7, cc = c & 127;
    if (pn < 2) return (pn * 4 + (cc >> 5)) * 64 + bj * 32 + (cc & 31);
    if (pn == 2) return cc < 64 ? 512 + (cc >> 5) * 64 + bj * 32 + (cc & 31) : 640 + bj * 64 + (cc - 64);
    if (pn < 5) return 768 + (pn - 3) * 256 + c;
    if (pn < 9) return 1280 + bj * 512 + (pn - 5) * 128 + cc;
    if (pn < 11) return 2304 + (pn - 9) * 256 + c;
    if (pn < 13) return 2816 + (pn - 11) * 256 + c;
    if (pn < 15) return 3328 + (pn - 13) * 256 + c;
    if (pn < 17) return 3840 + (pn - 15) * 256 + c;
    if (pn < 19) return 4352 + (pn - 17) * 256 + c;
    return 4864 + (pn - 19) * 256 + c; }
HD_FN int glu_orig_col(int row) { const int pn = row >> 8, c = row & 255, bj = c >> 7, cc = c & 127; return bj * 512 + pn * 128 + cc; }

struct FMod { InP in; W w;
    HD_FN void operator()(long i) const { int n = i % 3072; int j = (i / 3072) % 3; int l = i / (3 * 3072);
        const float* cv = j == 0 ? in->c_ctx : in->c + (size_t)(j - 1) * D; const float* wa = in->w_ada + (size_t)l * D * 3072;
        float acc = 0.f; for (int k = 0; k < D; ++k) acc += siluf_(cv[k]) * wa[(size_t)k * 3072 + n];
        w.mod()[i] = acc + in->b_ada[l * 3072 + n]; } };
struct FRope { W w;
    HD_FN void operator()(long i) const { int j = i % 32, t = i / 32; float row = (float)(t / GRID_W), col = (float)(t % GRID_W);
        float inv = powf(10000.0f, -(float)(j % 16) / 16.0f); float ang = (j < 16 ? row : col) * inv; w.ropec()[i] = cosf(ang); w.ropes()[i] = sinf(ang); } };
struct FSsmParam { InP in; W w;
    HD_FN void operator()(long i) const { int g = (i / SP) % SG; long ld = i / (SP * SG);
        float lr = in->lam_re[i], li = in->lam_im[i]; float dt = expf(in->log_dt[ld * SG + g]);
        float e = expf(lr * dt), br_ = e * cosf(li * dt), bi_ = e * sinf(li * dt); w.lamb()[2 * i] = br_; w.lamb()[2 * i + 1] = bi_;
        float nr = br_ - 1.0f, ni = bi_; float den = lr * lr + li * li; float fr = (nr * lr + ni * li) / den, fi = (ni * lr - nr * li) / den;
        for (int c = 0; c < SC; ++c) { float xr = in->b_re[i * SC + c], xi = in->b_im[i * SC + c];
            w.bbar()[(i * SC + c) * 2] = fr * xr - fi * xi; w.bbar()[(i * SC + c) * 2 + 1] = fr * xi + fi * xr; } } };
struct FCvtIn { InP in; W w;
    HD_FN void operator()(long i) const { int k = i % 1024; int row = (i / 1024) % INC; int l = i / ((long)INC * 1024); const int oc = in_orig_col(row);
        const float* src = in->w_in + ((size_t)l * D + k) * INC; float v;
        if (oc >= C_XPOOL && oc < C_XPOOL + 512) { const int g = (oc - C_XPOOL) >> 7, co = (oc - C_XPOOL) & 127; const float* pw = in->pool_w + ((size_t)l * 4 + g) * 128 * 128 + co; const float* s = src + C_XPOOL + g * 128;
            float acc = 0.f; for (int ci = 0; ci < 128; ++ci) acc += s[ci] * pw[(size_t)ci * 128]; v = acc * in->pool_scale[l * 512 + g * 128 + co]; }
        else v = src[oc];
        w.win()[i] = f2bf(v); } };
struct FCvtGlu { InP in; W w;
    HD_FN void operator()(long i) const { int k = i % 512; int row = (i / 512) % 1024; int l = i / (512 * 1024); w.wglu()[i] = f2bf(in->glu_w[((size_t)l * 512 + k) * 1024 + glu_orig_col(row)]); } };
struct FCvtBr { InP in; W w;
    HD_FN void operator()(long i) const { int k = i % 512; int d = (i / 512) % 1024; int ln = i / (512 * 1024); w.wbr()[i] = f2bf(in->w_br[((size_t)ln * 512 + k) * 1024 + d]); } };
struct FCvtOut { InP in; W w;
    HD_FN void operator()(long i) const { int k = i % 1024; int d = (i / 1024) % 1024; int l = i / (1024 * 1024); w.wout()[i] = f2bf(in->w_out[((size_t)l * 1024 + k) * 1024 + d]); } };

struct FH { InP in; W w; int l, pad;
    HD_FN void operator()(long m) const { const float* x = xrow(in, w, l, (int)m); float ss = 0.f; for (int k = 0; k < D; ++k) ss += x[k] * x[k];
        float r = 1.0f / sqrtf(ss / D + EPS); const float* mo = w.mod() + ((size_t)l * 3 + row_modj((int)m)) * 3072; const float* g = in->norm_g + l * D;
        for (int k = 0; k < D; ++k) w.H()[(size_t)m * D + k] = f2bf((x[k] * r) * g[k] * (1.0f + mo[1024 + k]) + mo[k]); } };

HD_FN void epi1(const W& w, int l, int m, int pn, int cc, float a0, float a1) {
    if (pn <= 2) { const bool smp = m >= MP; const int t = m - row_seq0(m);
        if (pn < 2 || cc < 64) { const int j = cc & 31; float o1 = a0, o2 = a1;
            if (smp) { const float cs = w.ropec()[t * 32 + j], sn = w.ropes()[t * 32 + j]; o1 = a0 * cs - a1 * sn; o2 = a0 * sn + a1 * cs; }
            if (pn < 2) { const int h = pn * 4 + (cc >> 5); w.Q()[(size_t)m * 512 + h * 64 + j] = f2bf(o1); w.Q()[(size_t)m * 512 + h * 64 + 32 + j] = f2bf(o2); }
            else { const int kv = cc >> 5; w.K()[(size_t)m * 128 + kv * 64 + j] = f2bf(o1); w.K()[(size_t)m * 128 + kv * 64 + 32 + j] = f2bf(o2);
                if (!smp) { float* o = w.out + OUT_K + (((size_t)row_batch(m) * DEPTH + l) * L_P + t) * 128 + kv * 64 + j; o[0] = a0; o[32] = a1; } } }
        else { const int c2 = cc - 64; w.V()[(size_t)m * 128 + c2] = f2bf(a0); w.V()[(size_t)m * 128 + 64 + c2] = f2bf(a1);
            if (!smp) { float* o = w.out + OUT_V + (((size_t)row_batch(m) * DEPTH + l) * L_P + t) * 128 + c2; o[0] = a0; o[64] = a1; } }
        return; }
    if (pn >= 5 && pn < 9) { w.XC()[(size_t)m * 512 + (pn - 5) * 128 + cc] = f2bf(a0 * sigmoidf_(a1)); return; }
    if (pn >= 19) { bf16_t* o = w.GM() + (size_t)m * 4096 + (pn - 19) * 256 + cc; o[0] = f2bf(sigmoidf_(a0)); o[128] = f2bf(sigmoidf_(a1)); return; }
    if (pn == 11 || pn == 12) { bf16_t* o = w.XP() + (size_t)m * 512 + (pn - 11) * 256 + cc; o[0] = f2bf(a0); o[128] = f2bf(a1); return; }
    if (pn == 15 || pn == 16) { bf16_t* o = w.XS() + (size_t)m * 512 + (pn - 15) * 256 + cc; o[0] = f2bf(a0); o[128] = f2bf(a1); return; }
    { const int br = pn < 5 ? 0 : pn < 11 ? 1 : pn < 15 ? 2 : 3; const int t0 = br == 0 ? 3 : br == 1 ? 9 : br == 2 ? 13 : 17;
      bf16_t* o = w.GATE() + ((size_t)br * M + m) * 512 + (pn - t0) * 256 + cc; o[0] = f2bf(siluf_(a0)); o[128] = f2bf(siluf_(a1)); } }
struct FG1 { InP in; W w; int l, pad;
    HD_FN void operator()(long i) const { int cc = i % 128; int pn = (i / 128) % NT1; int m = i / (128 * NT1); const bf16_t* a = w.H() + (size_t)m * D;
        const bf16_t* b0 = w.win() + ((size_t)l * INC + pn * 256 + cc) * D; const bf16_t* b1 = b0 + (size_t)128 * D; float a0 = 0.f, a1 = 0.f;
        for (int k = 0; k < D; ++k) { const float av = bf2f(a[k]); a0 += av * bf2f(b0[k]); a1 += av * bf2f(b1[k]); }
        epi1(w, l, m, pn, cc, a0, a1); } };

struct FAttn { InP in; W w; int l, pad;
    HD_FN void operator()(long i) const { int dp = i % 4, hh = (i / 4) % 8; int m = i / 32; const bool smp = m >= MP; const int L = row_len(m), s0 = row_seq0(m), t = m - s0, kv = hh / 4, bb = row_batch(m);
        const bf16_t* q = w.Q() + (size_t)m * 512 + hh * 64; const float sink = in->attn_sink[l * NH + hh];
        const float* ck = in->cache_k + (((size_t)bb * DEPTH + l) * PAST) * 128 + kv * 64; const float* cvp = in->cache_v + (((size_t)bb * DEPTH + l) * PAST) * 128 + kv * 64;
        int lo, hi; if (!smp) { lo = 0; hi = L - 1; } else { lo = t - WINDOW < 0 ? 0 : t - WINDOW; hi = t + WINDOW > L - 1 ? L - 1 : t + WINDOW; }
        const int nctx = smp ? PAST : 0; float mx = sink;
        for (int pass = 0; pass < 2; ++pass) { float den = 0.f, acc[16];
#pragma unroll
            for (int d = 0; d < 16; ++d) acc[d] = 0.f;
            for (int kk = 0; kk < nctx + (hi - lo + 1); ++kk) { float sc = 0.f;
                if (kk < nctx) { const float* kp = ck + (size_t)kk * 128; for (int d = 0; d < 64; ++d) sc += bf2f(q[d]) * kp[d]; }
                else { const bf16_t* kp = w.K() + (size_t)(s0 + lo + kk - nctx) * 128 + kv * 64; for (int d = 0; d < 64; ++d) sc += bf2f(q[d]) * bf2f(kp[d]); }
                sc *= 0.125f;
                if (pass == 0) { mx = sc > mx ? sc : mx; }
                else { const float p = expf(sc - mx); den += p;
                    if (kk < nctx) { const float* vp = cvp + (size_t)kk * 128 + dp * 16;
#pragma unroll
                        for (int d = 0; d < 16; ++d) acc[d] += p * vp[d]; }
                    else { const bf16_t* vp = w.V() + (size_t)(s0 + lo + kk - nctx) * 128 + kv * 64 + dp * 16;
#pragma unroll
                        for (int d = 0; d < 16; ++d) acc[d] += p * bf2f(vp[d]); } } }
            if (pass == 1) { den += expf(sink - mx); bf16_t* o = w.GATE() + (size_t)m * 512 + hh * 64 + dp * 16;
#pragma unroll
                for (int d = 0; d < 16; ++d) o[d] = f2bf(acc[d] / den * bf2f(o[d])); } } } };
struct FConv { InP in; W w; int l, pad;
    HD_FN void operator()(long i) const { int ch = i % 512; int m = i / 512; const int L = row_len(m), s0 = row_seq0(m), t = m - s0; float acc = in->conv_db[l * 512 + ch];
        for (int j = 0; j < CONVK; ++j) { int tt = t + j - CONVK / 2; if (tt < 0 || tt >= L) continue; acc += bf2f(w.XC()[(size_t)(s0 + tt) * 512 + ch]) * in->conv_dw[((size_t)l * CONVK + j) * 512 + ch]; }
        w.TMP()[i] = acc; } };
struct FConvLn { InP in; W w; int l, pad;
    HD_FN void operator()(long m) const { const float* y = w.TMP() + (size_t)m * 512; float mu = 0.f; for (int k = 0; k < 512; ++k) mu += y[k]; mu /= 512.f;
        float var = 0.f; for (int k = 0; k < 512; ++k) { float d = y[k] - mu; var += d * d; } float r = 1.0f / sqrtf(var / 512.f + EPS); bf16_t* o = w.GATE() + ((size_t)1 * M + m) * 512;
        for (int k = 0; k < 512; ++k) o[k] = f2bf(siluf_((y[k] - mu) * r * in->conv_ln_g[l * 512 + k] + in->conv_ln_b[l * 512 + k]) * bf2f(o[k])); } };
struct FPool { W w;
    HD_FN void operator()(long i) const { int ch = i % 512; int m = i / 512; const int L = row_len(m), s0 = row_seq0(m), t = m - s0; const int wd = 2 << (ch / 128);
        int lo = t - wd / 2 < 0 ? 0 : t - wd / 2, hi = t + wd / 2 > L ? L : t + wd / 2; float sum = 0.f;
        for (int tt = lo; tt < hi; ++tt) sum += bf2f(w.XP()[(size_t)(s0 + tt) * 512 + ch]);
        bf16_t* o = w.GATE() + ((size_t)2 * M + m) * 512 + ch; *o = f2bf((sum / (float)(hi - lo) - bf2f(w.XP()[(size_t)m * 512 + ch])) * bf2f(*o)); } };
struct FSsmBu { W w; int l, dir, m0, pad;
    HD_FN void operator()(long i) const { int p = i % SP, g = (i / SP) % SG; int tl = i / (SP * SG); const bf16_t* x = w.XS() + (size_t)(m0 + tl) * 512 + g * SC;
        const float* bb = w.bbar() + ((((size_t)l * 2 + dir) * SG + g) * SP + p) * SC * 2; float ar = 0.f, ai = 0.f;
        for (int k = 0; k < SC; ++k) { const float xv = bf2f(x[k]); ar += xv * bb[2 * k]; ai += xv * bb[2 * k + 1]; } w.S()[2 * i] = ar; w.S()[2 * i + 1] = ai; } };
struct FSsmScan { InP in; W w; int l, dir, m0, pad;
    HD_FN void operator()(long i) const { int p = i % SP, g = (i / SP) % SG; int s = i / (SP * SG); const int L = row_len(m0); const int bb = row_batch(m0) + s;
        const float* lb = w.lamb() + ((((size_t)l * 2 + dir) * SG + g) * SP + p) * 2; float lr = lb[0], li = lb[1]; float hr = 0.f, hi = 0.f;
        if (m0 >= MP) { const float* st = in->state_ssm + ((((size_t)bb * DEPTH + l) * 2 + dir) * 2) * SG * SP + g * SP + p; hr = st[0]; hi = st[SG * SP]; }
        for (int k = 0; k < L; ++k) { int t = dir == 0 ? k : L - 1 - k; float* S = w.S() + (((size_t)(s * L + t) * SG + g) * SP + p) * 2;
            float nr = lr * hr - li * hi + S[0], ni = lr * hi + li * hr + S[1]; hr = nr; hi = ni; S[0] = hr; S[1] = hi; }
        if (m0 < MP) { float* o = w.out + OUT_ST + ((((size_t)bb * DEPTH + l) * 2 + dir) * 2) * SG * SP + g * SP + p; o[0] = hr; o[SG * SP] = hi; } } };
struct FSsmY { InP in; W w; int l, dir, m0, pad;
    HD_FN void operator()(long i) const { int gc = i % 512; int tl = i / 512; int g = gc / SC, ch = gc % SC; const int m = m0 + tl; const float* S = w.S() + ((size_t)tl * SG + g) * SP * 2;
        const float* cr = in->c_re + ((((size_t)l * 2 + dir) * SG + g) * SC + ch) * SP; const float* cim = in->c_im + ((((size_t)l * 2 + dir) * SG + g) * SC + ch) * SP;
        float acc = 0.f; for (int p = 0; p < SP; ++p) acc += S[2 * p] * cr[p] - S[2 * p + 1] * cim[p];
        float* y = w.TMP() + (size_t)m * 512 + gc;
        if (dir == 0) *y = acc + in->ssm_d[l * 512 + gc] * bf2f(w.XS()[(size_t)m * 512 + gc]); else w.YS()[(size_t)m * 512 + gc] = f2bf(geluf_(*y + acc)); } };
HD_FN void epi3(const W& w, int m, int pn, int cc, float a0, float a1) { bf16_t* o = w.GATE() + ((size_t)3 * M + m) * 512 + pn * 128 + cc; *o = f2bf(a0 * sigmoidf_(a1) * bf2f(*o)); }
struct FG3 { W w; int l, pad;
    HD_FN void operator()(long i) const { int cc = i % 128; int pn = (i / 128) % 4; int m = i / 512; const bf16_t* a = w.YS() + (size_t)m * 512;
        const bf16_t* b0 = w.wglu() + ((size_t)l * 1024 + pn * 256 + cc) * 512; const bf16_t* b1 = b0 + (size_t)128 * 512; float a0 = 0.f, a1 = 0.f;
        for (int k = 0; k < 512; ++k) { const float av = bf2f(a[k]); a0 += av * bf2f(b0[k]); a1 += av * bf2f(b1[k]); }
        epi3(w, m, pn, cc, a0, a1); } };
struct FG4a { W w; int l, pad;
    HD_FN void operator()(long i) const { int d = i % 1024; int m = i / 1024; float mg = 0.f;
        for (int n = 0; n < 4; ++n) { const bf16_t* a = w.GATE() + ((size_t)n * M + m) * 512; const bf16_t* b = w.wbr() + (((size_t)l * 4 + n) * 1024 + d) * 512; float acc = 0.f;
            for (int k = 0; k < 512; ++k) acc += bf2f(a[k]) * bf2f(b[k]); mg += bf2f(w.GM()[(size_t)m * 4096 + n * 1024 + d]) * acc; }
        w.MRG()[i] = f2bf(mg); } };
struct FG4b { InP in; W w; int l, pad;
    HD_FN void operator()(long i) const { int d = i % 1024; int m = i / 1024; const bf16_t* a = w.MRG() + (size_t)m * 1024; const bf16_t* b = w.wout() + ((size_t)l * 1024 + d) * 1024; float acc = 0.f;
        for (int k = 0; k < 1024; ++k) acc += bf2f(a[k]) * bf2f(b[k]);
        const float gate = w.mod()[((size_t)l * 3 + row_modj(m)) * 3072 + 2048 + d]; w.out[i] = xrow(in, w, l, m)[d] + gate * acc; } };
struct FFinal { InP in; W w;
    HD_FN void operator()(long m) const { float* xr = w.out + (size_t)m * D; float ss = 0.f; for (int k = 0; k < D; ++k) ss += xr[k] * xr[k]; float r = 1.0f / sqrtf(ss / D + EPS);
        for (int k = 0; k < D; ++k) xr[k] = xr[k] * r * in->final_g[k]; } };

template <class Runner> inline void forward(InP in, const W& w, Runner& R) {
    R(FMod{in, w}, 2L * 3 * 3072); R(FRope{w}, 2048L * 32); R(FSsmParam{in, w}, 2L * 2 * SG * SP);
    R(FCvtIn{in, w}, 2L * INC * 1024); R(FCvtGlu{in, w}, 2L * 1024 * 512); R(FCvtBr{in, w}, 2L * 4 * 1024 * 512); R(FCvtOut{in, w}, 2L * 1024 * 1024);
    for (int l = 0; l < DEPTH; ++l) {
        R(FH{in, w, l, 0}, (long)M);
        R(FG1{in, w, l, 0}, (long)M * NT1 * 128);
        R(FAttn{in, w, l, 0}, (long)M * 32);
        R(FConv{in, w, l, 0}, (long)M * 512); R(FConvLn{in, w, l, 0}, (long)M);
        R(FPool{w}, (long)M * 512);
        for (int m0 = 0; m0 < M;) { const int L = row_len(m0); int nrows = 2048; if (m0 < MP && m0 + nrows > MP) nrows = MP - m0; const int nseq = nrows / L;
            for (int dir = 0; dir < 2; ++dir) { R(FSsmBu{w, l, dir, m0, 0}, (long)nrows * SG * SP); R(FSsmScan{in, w, l, dir, m0, 0}, (long)nseq * SG * SP); R(FSsmY{in, w, l, dir, m0, 0}, (long)nrows * 512); }
            m0 += nrows; }
        R(FG3{w, l, 0}, (long)M * 512);
        R(FG4a{w, l, 0}, (long)M * 1024);
        R(FG4b{in, w, l, 0}, (long)M * 1024);
    }
    R(FFinal{in, w}, (long)M);
}
}
#define MK_WTAB_OFF (131072 + 512)
__device__ __forceinline__ unsigned mk_hw_wave_slot() { return (unsigned)__builtin_amdgcn_s_getreg(((6 - 1) << 11) | 4) & 63u; }
__device__ __forceinline__ int mk_fresh_tid() { extern __shared__ __attribute__((aligned(16))) unsigned char mk_lds_[];
    const unsigned wv = *(const volatile __attribute__((address_space(3))) unsigned*)((__attribute__((address_space(3))) unsigned char*)mk_lds_ + MK_WTAB_OFF + 4 * mk_hw_wave_slot());
    int t = (int)((unsigned)__builtin_amdgcn_readfirstlane((int)wv) * 64u + __builtin_amdgcn_mbcnt_hi(~0u, __builtin_amdgcn_mbcnt_lo(~0u, 0u))); asm volatile("" : "+v"(t)); return t; }
namespace pg8 {
#define PG8_LAS __attribute__((address_space(3)))
typedef unsigned short bf16_t;
typedef short bf16x8 __attribute__((ext_vector_type(8)));
typedef float f32x4 __attribute__((ext_vector_type(4)));
typedef unsigned u32x4 __attribute__((ext_vector_type(4)));
constexpr int BM = 256, BK = 64, HALF = 128, HTB = HALF * BK * 2  , STAGE_BYTES = 8 * HTB, NXCD = 8, WGM = 8;

__host__ __device__ __forceinline__ int lds_byte(int r, int c) { const int st = (r >> 4) * 2 + (c >> 5), rr = r & 15, cc = c & 31, ob = rr * 64 + cc * 2; return st * 1024 + (ob ^ (((ob >> 9) & 1) << 5)); }
__host__ __device__ __forceinline__ void stage_rc(int b, int& R, int& C) { const int st = b / 1024, sb = b % 1024, swz = sb ^ (((sb >> 9) & 1) << 5); R = (st >> 1) * 16 + swz / 64; C = (st & 1) * 32 + (swz % 64) / 2; }
__host__ __device__ __forceinline__ int perm32(int rho) { const int n = rho >> 4, i = rho & 15; return 8 * (i >> 2) + 4 * n + (i & 3); }

struct Unit { int pm, pn; };
struct Gemm { const bf16_t* A; const bf16_t* Bt; int M, N, K; };

struct StaticOrder {
    int nM, nN, nwg, G, c;
    __host__ __device__ void init(int M, int N, int G_, int c_) { nM = M / BM; nN = N / BM; nwg = nM * nN; G = G_; c = c_; }
    __host__ __device__ bool next(int i, Unit& u) const {
        const long L = (long)i * G + c; if (L >= nwg) return false;
        int wgid = (int)L; { const int q = nwg / NXCD, r = nwg % NXCD, xcd = wgid % NXCD, off = wgid / NXCD; wgid = (xcd < r ? xcd * (q + 1) : r * (q + 1) + (xcd - r) * q) + off; }
        const int nig = WGM * nN, gid = wgid / nig, fm = gid * WGM, gsz = (nM - fm) < WGM ? (nM - fm) : WGM;
        u.pm = fm + ((wgid % nig) % gsz); u.pn = (wgid % nig) / gsz; return true;
    }
    __device__ __forceinline__ void a_ready(const Unit&) const {}
    __device__ __forceinline__ void done(const Unit&) const {}
};

__device__ __forceinline__ unsigned cvt_pk_bf16(float lo, float hi) { unsigned r; asm volatile("v_cvt_pk_bf16_f32 %0, %1, %2" : "=v"(r) : "v"(lo), "v"(hi)); return r; }
typedef float f32x2 __attribute__((ext_vector_type(2)));
template <class Epi, class Sched, bool ALIGN_EPI = false, bool SP2 = false, int NB = 2>
__device__ __forceinline__ void gemm_phase(PG8_LAS unsigned char* lds, const Gemm g, const Sched& S, const Epi& E) {
    const int tid_ = mk_fresh_tid();
    const int tid = tid_, wid = __builtin_amdgcn_readfirstlane(tid >> 6), lane = tid & 63, wr = wid >> 2, wc = wid & 3, fr = lane & 15, fq = lane >> 4;
    const int K = g.K, nt = K / BK;
    unsigned voffA[2], voffB[2];
#pragma unroll
    for (int i = 0; i < 2; ++i) { int R, C; stage_rc(tid * 16 + i * 8192, R, C); const int Rb = Epi::PERM ? ((R & ~31) + perm32(R & 31)) : R;
        voffA[i] = (unsigned)(R * K + C) * 2u; voffB[i] = (unsigned)(Rb * K + C) * 2u; }
    const size_t kstep = (size_t)(BK * 2);
    const size_t hstep = (size_t)HALF * K * 2;
    const size_t tstep = 2 * hstep;
    const size_t tstepB = NB == 2 ? tstep : hstep;
    static_assert(NB == 2 || (NB == 1 && SP2), "NB == 1 is implemented for the SP2 loop only");
    const unsigned ldsw = (unsigned)wid * 1024u;
    const int aoff = lds_byte(wr * 64 + fr, fq * 8), boff = lds_byte(wc * 32 + fr, fq * 8);
#define PG8_SA(b, h) (((b) * 2 + (h)) * HTB)
#define PG8_SB(b, h) ((4 + (b) * 2 + (h)) * HTB)
#define PG8_STAGE(bufoff, gbase, voff) do { _Pragma("unroll") for (int _i = 0; _i < 2; ++_i) \
        __builtin_amdgcn_global_load_lds((const unsigned*)((const char*)(gbase) + (voff)[_i]), (PG8_LAS unsigned*)(lds + (bufoff) + ldsw + _i * 8192), 16, 0, 0); } while (0)
#define PG8_LDA(dst, b, h) do { _Pragma("unroll") for (int m = 0; m < 4; ++m) _Pragma("unroll") for (int k = 0; k < 2; ++k) dst[m][k] = *(const PG8_LAS bf16x8*)(lds + PG8_SA(b, h) + aoff + m * 2048 + k * 1024); } while (0)
#define PG8_LDB(dst, b, h) do { _Pragma("unroll") for (int n = 0; n < 2; ++n) _Pragma("unroll") for (int k = 0; k < 2; ++k) dst[n][k] = *(const PG8_LAS bf16x8*)(lds + PG8_SB(b, h) + boff + n * 2048 + k * 1024); } while (0)
#define PG8_MMA(ai, bj, At, Bt) do { __builtin_amdgcn_s_setprio(1); _Pragma("unroll") for (int m = 0; m < 4; ++m) _Pragma("unroll") for (int n = 0; n < 2; ++n) _Pragma("unroll") for (int k = 0; k < 2; ++k) \
        acc[ai][bj][m][n] = __builtin_amdgcn_mfma_f32_16x16x32_bf16(Bt[n][k], At[m][k], acc[ai][bj][m][n], 0, 0, 0); __builtin_amdgcn_s_setprio(0); } while (0)
#define PG8_WAIT_V(n) asm volatile("s_waitcnt vmcnt(" #n ")" ::: "memory")
#define PG8_WAIT_L(n) asm volatile("s_waitcnt lgkmcnt(" #n ")" ::: "memory")
#define PG8_WAIT_VL do { if constexpr (NB == 2) PG8_WAIT_V(8); else PG8_WAIT_V(6); PG8_WAIT_L(0); } while (0)
#define PG8_BAR __builtin_amdgcn_s_barrier()
#define PG8_SCHED __builtin_amdgcn_sched_barrier(0)
    Unit cur, nxt; int ui = 0;
    if (!S.next(0, cur)) return;
    f32x4 acc[2][NB][4][2];
#pragma unroll
    for (int a = 0; a < 2; ++a)
#pragma unroll
        for (int b = 0; b < NB; ++b)
#pragma unroll
            for (int m = 0; m < 4; ++m)
#pragma unroll
                for (int n = 0; n < 2; ++n) acc[a][b][m][n] = (f32x4){0.f, 0.f, 0.f, 0.f};
    bf16x8 At[4][2], B0[2][2], B1[2][2];
    const char* cA = (const char*)g.A + (size_t)cur.pm * tstep; const char* cB = (const char*)g.Bt + (size_t)cur.pn * tstepB;
    S.a_ready(cur);
    if constexpr (SP2) {
        PG8_STAGE(PG8_SB(0, 0), cB, voffB); if constexpr (NB == 2) PG8_STAGE(PG8_SB(0, 1), cB + hstep, voffB); PG8_STAGE(PG8_SA(0, 0), cA, voffA); PG8_STAGE(PG8_SA(0, 1), cA + hstep, voffA);
        if (wr == 1) PG8_BAR;
        PG8_WAIT_V(2); PG8_BAR;
        PG8_STAGE(PG8_SB(1, 0), cB + kstep, voffB); PG8_STAGE(PG8_SA(1, 0), cA + kstep, voffA); if constexpr (NB == 2) PG8_STAGE(PG8_SB(1, 1), cB + hstep + kstep, voffB);
        if constexpr (NB == 2) PG8_WAIT_V(6); else PG8_WAIT_V(4);
        PG8_BAR;
    } else {
        PG8_STAGE(PG8_SB(0, 0), cB, voffB); PG8_STAGE(PG8_SA(0, 0), cA, voffA); PG8_STAGE(PG8_SB(0, 1), cB + hstep, voffB); PG8_STAGE(PG8_SA(0, 1), cA + hstep, voffA);
        if (wr == 1) PG8_BAR;
        PG8_WAIT_V(4); PG8_BAR;
        PG8_STAGE(PG8_SB(1, 0), cB + kstep, voffB); PG8_STAGE(PG8_SA(1, 0), cA + kstep, voffA); PG8_STAGE(PG8_SB(1, 1), cB + hstep + kstep, voffB);
        PG8_WAIT_V(6); PG8_BAR;
    }
    for (;;) {
        const bool has_next = S.next(ui + 1, nxt);
        const char* nA = has_next ? (const char*)g.A + (size_t)nxt.pm * tstep : cA; const char* nB = has_next ? (const char*)g.Bt + (size_t)nxt.pn * tstepB : cB;
        for (int t = 0; t < nt; t += 2) {
            const bool last = (t == nt - 2);
            const char* a1 = cA + (size_t)(t + 1) * kstep;
            const char* a2 = last ? nA : cA + (size_t)(t + 2) * kstep; const char* b2 = last ? nB : cB + (size_t)(t + 2) * kstep;
            const char* a3 = a2 + kstep; const char* b3 = b2 + kstep;
            if (last && has_next) S.a_ready(nxt);
            if constexpr (SP2) {
            PG8_LDB(B0, 0, 0); if constexpr (NB == 2) PG8_LDB(B1, 0, 1); PG8_SCHED; PG8_LDA(At, 0, 0); PG8_STAGE(PG8_SA(1, 1), a1 + hstep, voffA);
            PG8_WAIT_VL; PG8_BAR; PG8_MMA(0, 0, At, B0); if constexpr (NB == 2) PG8_MMA(0, 1, At, B1); PG8_BAR; PG8_SCHED;
            PG8_LDA(At, 0, 1); PG8_STAGE(PG8_SB(0, 0), b2, voffB); if constexpr (NB == 2) PG8_STAGE(PG8_SB(0, 1), b2 + hstep, voffB); PG8_STAGE(PG8_SA(0, 0), a2, voffA);
            PG8_WAIT_VL; PG8_BAR; PG8_MMA(1, 0, At, B0); if constexpr (NB == 2) PG8_MMA(1, 1, At, B1); PG8_BAR; PG8_SCHED;
            PG8_LDB(B0, 1, 0); if constexpr (NB == 2) PG8_LDB(B1, 1, 1); PG8_SCHED; PG8_LDA(At, 1, 0); PG8_STAGE(PG8_SA(0, 1), a2 + hstep, voffA);
            PG8_WAIT_VL; PG8_BAR; PG8_MMA(0, 0, At, B0); if constexpr (NB == 2) PG8_MMA(0, 1, At, B1); PG8_BAR; PG8_SCHED;
            PG8_LDA(At, 1, 1); PG8_STAGE(PG8_SB(1, 0), b3, voffB); if constexpr (NB == 2) PG8_STAGE(PG8_SB(1, 1), b3 + hstep, voffB); PG8_STAGE(PG8_SA(1, 0), a3, voffA);
            PG8_WAIT_VL; PG8_BAR; PG8_MMA(1, 0, At, B0); if constexpr (NB == 2) PG8_MMA(1, 1, At, B1); PG8_BAR; PG8_SCHED;
            } else {
            PG8_LDB(B0, 0, 0); PG8_SCHED; PG8_LDA(At, 0, 0); PG8_STAGE(PG8_SA(1, 1), a1 + hstep, voffA);
            PG8_WAIT_L(8); PG8_BAR; PG8_WAIT_L(0); PG8_MMA(0, 0, At, B0); PG8_BAR; PG8_SCHED;
            PG8_LDB(B1, 0, 1); PG8_STAGE(PG8_SB(0, 0), b2, voffB);
            PG8_BAR; PG8_WAIT_L(0); PG8_MMA(0, 1, At, B1); PG8_BAR;
            PG8_LDA(At, 0, 1); PG8_STAGE(PG8_SA(0, 0), a2, voffA);
            PG8_BAR; PG8_WAIT_L(0); PG8_MMA(1, 0, At, B0); PG8_BAR; PG8_SCHED;
            PG8_STAGE(PG8_SB(0, 1), b2 + hstep, voffB);
            PG8_WAIT_V(6); PG8_BAR; PG8_MMA(1, 1, At, B1); PG8_BAR;
            PG8_LDB(B0, 1, 0); PG8_SCHED; PG8_LDA(At, 1, 0); PG8_STAGE(PG8_SA(0, 1), a2 + hstep, voffA);
            PG8_WAIT_L(8); PG8_BAR; PG8_WAIT_L(0); PG8_MMA(0, 0, At, B0); PG8_BAR; PG8_SCHED;
            PG8_LDB(B1, 1, 1); PG8_STAGE(PG8_SB(1, 0), b3, voffB);
            PG8_BAR; PG8_WAIT_L(0); PG8_MMA(0, 1, At, B1); PG8_BAR;
            PG8_LDA(At, 1, 1); PG8_STAGE(PG8_SA(1, 0), a3, voffA);
            PG8_BAR; PG8_WAIT_L(0); PG8_MMA(1, 0, At, B0); PG8_BAR; PG8_SCHED;
            PG8_STAGE(PG8_SB(1, 1), b3 + hstep, voffB);
            PG8_WAIT_V(6); PG8_BAR; PG8_MMA(1, 1, At, B1); PG8_BAR;
            }
        }
        if constexpr (ALIGN_EPI) { if (wr == 0) PG8_BAR; }
        if constexpr (!Epi::AFTER_DRAIN) { E(acc, cur, wr, wc, fr, fq); S.done(cur); }
        if (!has_next) break;
#pragma unroll
        for (int a = 0; a < 2; ++a)
#pragma unroll
            for (int b = 0; b < NB; ++b)
#pragma unroll
                for (int m = 0; m < 4; ++m)
#pragma unroll
                    for (int n = 0; n < 2; ++n) acc[a][b][m][n] = (f32x4){0.f, 0.f, 0.f, 0.f};
        cur = nxt; cA = nA; cB = nB; ++ui;
        if constexpr (ALIGN_EPI) { if (wr == 1) PG8_BAR; }
    }
    PG8_WAIT_V(0);
    if constexpr (!ALIGN_EPI) { if (wr == 0) PG8_BAR; }
    PG8_BAR;
    if constexpr (Epi::AFTER_DRAIN) { E.fused(acc, cur, wr, wc, fr, fq, lds, wid, lane); S.done(cur); }
#undef PG8_SA
#undef PG8_SB
#undef PG8_STAGE
#undef PG8_LDA
#undef PG8_LDB
#undef PG8_MMA
#undef PG8_WAIT_V
#undef PG8_WAIT_L
#undef PG8_WAIT_VL
#undef PG8_BAR
#undef PG8_SCHED
}
}
#define GAS __attribute__((address_space(1)))
#define LAS __attribute__((address_space(3)))
typedef unsigned short bf16;
typedef unsigned v4u __attribute__((ext_vector_type(4)));
typedef float f32x4 __attribute__((ext_vector_type(4)));
typedef short bf16x8 __attribute__((ext_vector_type(8)));
typedef GAS unsigned gu32;
typedef GAS unsigned long long gu64;
#define RLX_AGENT __ATOMIC_RELAXED, __HIP_MEMORY_SCOPE_AGENT
#define LDS_WAIT() asm volatile("s_waitcnt lgkmcnt(0)" ::: "memory")
#define VM_WAIT() asm volatile("s_waitcnt vmcnt(0)" ::: "memory")
__device__ __forceinline__ unsigned long long rt() { return __builtin_amdgcn_s_memrealtime(); }
__device__ __forceinline__ unsigned f2bf(float f) { unsigned u = __builtin_bit_cast(unsigned, f); return (u + 0x7fffu + ((u >> 16) & 1u)) >> 16; }
__device__ __forceinline__ unsigned pk2(float lo, float hi) { return f2bf(lo) | (f2bf(hi) << 16); }
#define XB_TMO      128
#define XB_XCNT(j)  (256  + 64 * (j))
#define XB_XSUB(j)  (1280 + 64 * (j))
#define XB_XGEN(j)  (2304 + 64 * (j))
#define XB_TOP      3328
#define XB_TOPGEN   3392
#define XCD_BAR_WORDS 3456
#define XB_SPIN_CAP (1u << 18)

__device__ __forceinline__ unsigned xb_ld(unsigned* p)              { return __hip_atomic_load(p, __ATOMIC_RELAXED, __HIP_MEMORY_SCOPE_AGENT); }
__device__ __forceinline__ unsigned xb_add(unsigned* p, unsigned v) { return __hip_atomic_fetch_add(p, v, __ATOMIC_RELAXED, __HIP_MEMORY_SCOPE_AGENT); }
__device__ __forceinline__ unsigned xb_xcc_id() { return (unsigned)__builtin_amdgcn_s_getreg((3 << 11) | 20) & 0xFu; }
#define XB_SPIN(cond, bar) do { unsigned _sp = 0; while (cond) { __builtin_amdgcn_s_sleep(1); \
    if ((++_sp & 255u) == 0u) { if (xb_ld(&(bar)[XB_TMO])) break; if (_sp > XB_SPIN_CAP) { atomicAdd(&(bar)[XB_TMO], 1u); break; } } } } while (0)

struct XcdBarrier {
    unsigned* bar; unsigned x;
    volatile LAS unsigned* st;
};

__device__ __forceinline__ XcdBarrier xcd_barrier_post(unsigned* bar, volatile LAS unsigned* st) {
    XcdBarrier b; b.bar = bar; b.x = xb_xcc_id(); b.st = st;
    if (threadIdx.x == 0) (void)xb_add(&bar[XB_XCNT(b.x)], 1u);
    return b;
}
__device__ __forceinline__ void xcd_barrier_complete(unsigned* bar, unsigned x, unsigned& nloc, unsigned& nx) {
    const unsigned G = gridDim.x * gridDim.y * gridDim.z;
    unsigned sum, cnt, mine, sp = 0u;
    for (;;) {
        sum = 0u; cnt = 0u; mine = 0u;
#pragma unroll
        for (unsigned j = 0; j < 16; ++j) { const unsigned c = xb_ld(&bar[XB_XCNT(j)]); sum += c; cnt += (c > 0u) ? 1u : 0u; mine = (j == x) ? c : mine; }
        if (sum == G) break;
        __builtin_amdgcn_s_sleep(1);
        if ((++sp & 255u) == 0u) { if (xb_ld(&bar[XB_TMO])) break; if (sp > XB_SPIN_CAP) { atomicAdd(&bar[XB_TMO], 1u); break; } }
    }
    nloc = mine > 0u ? mine : 1u; nx = cnt > 0u ? cnt : 1u;
}

__device__ __forceinline__ void xcd_barrier(const XcdBarrier& b) {
    asm volatile("s_waitcnt vmcnt(0)" ::: "memory");
    __syncthreads();
    if (mk_fresh_tid() == 0) {
        unsigned* bar = b.bar; asm volatile("" : "+s"(bar));
        __builtin_amdgcn_s_waitcnt(0);
        unsigned nloc = b.st[0], nx = b.st[1];
        if (nloc == 0u) { xcd_barrier_complete(bar, b.x, nloc, nx); b.st[0] = nloc; b.st[1] = nx; }
        const unsigned old = xb_add(&bar[XB_XSUB(b.x)], 1u);
        const unsigned gen = old / nloc;
        if (old + 1u == (gen + 1u) * nloc) {
            __builtin_amdgcn_fence(__ATOMIC_RELEASE, "agent");
            asm volatile("s_waitcnt vmcnt(0)" ::: "memory");
            const unsigned og = xb_add(&bar[XB_TOP], 1u);
            const unsigned tg = og / nx;
            if (og + 1u == (tg + 1u) * nx) xb_add(&bar[XB_TOPGEN], 1u);
            else XB_SPIN(xb_ld(&bar[XB_TOPGEN]) == tg, bar);
            __builtin_amdgcn_fence(__ATOMIC_ACQUIRE, "agent");
            xb_add(&bar[XB_XGEN(b.x)], 1u);
            asm volatile("s_waitcnt vmcnt(0)" ::: "memory");
        } else {
            XB_SPIN(xb_ld(&bar[XB_XGEN(b.x)]) == gen, bar);
            __builtin_amdgcn_fence(__ATOMIC_ACQUIRE, "agent");
            asm volatile("s_waitcnt vmcnt(0)" ::: "memory");
        }
    }
    __syncthreads();
}
namespace mk {
using pg8::f32x4; using pg8::Unit;
using g2::In; using g2::InP; using g2::W; using g2::M; using g2::MP; using g2::INC;
typedef unsigned u32x4 __attribute__((ext_vector_type(4)));
constexpr int NWAVES = 8, NTHREADS = 512;
constexpr int RING_BYTES = 131072, LDSCTL_OFF = RING_BYTES, MISC_OFF = LDSCTL_OFF + 320, LDS_BYTES = 147456;
constexpr int CW_BAR = 4096; constexpr size_t CTL_ZERO_BYTES = 65536;

__device__ __forceinline__ float fsig(float x) { return __builtin_amdgcn_rcpf(1.0f + __builtin_amdgcn_exp2f(-1.4426950408889634f * x)); }
__device__ __forceinline__ float fsilu(float x) { return x * fsig(x); }
__device__ __forceinline__ u32x4 pack8(const float* v) { u32x4 r; r.x = pg8::cvt_pk_bf16(v[0], v[1]); r.y = pg8::cvt_pk_bf16(v[2], v[3]); r.z = pg8::cvt_pk_bf16(v[4], v[5]); r.w = pg8::cvt_pk_bf16(v[6], v[7]); return r; }
__device__ __forceinline__ void unpack8(u32x4 r, float* v) { v[0] = __uint_as_float(r.x << 16); v[1] = __uint_as_float(r.x & 0xffff0000u); v[2] = __uint_as_float(r.y << 16); v[3] = __uint_as_float(r.y & 0xffff0000u);
    v[4] = __uint_as_float(r.z << 16); v[5] = __uint_as_float(r.z & 0xffff0000u); v[6] = __uint_as_float(r.w << 16); v[7] = __uint_as_float(r.w & 0xffff0000u); }
__device__ __forceinline__ void st16(g2::bf16_t* p, u32x4 v) { *(u32x4*)p = v; }
__device__ __forceinline__ void stf8(float* p, const float* v) { *(f32x4*)p = (f32x4){v[0], v[1], v[2], v[3]}; *(f32x4*)(p + 4) = (f32x4){v[4], v[5], v[6], v[7]}; }
__device__ __forceinline__ void ldf8(const float* p, float* v) { const f32x4 a = *(const f32x4*)p, b = *(const f32x4*)(p + 4); v[0] = a.x; v[1] = a.y; v[2] = a.z; v[3] = a.w; v[4] = b.x; v[5] = b.y; v[6] = b.z; v[7] = b.w; }

#define MK_ROWS_BEGIN _Pragma("unroll") for (int ai = 0; ai < 2; ++ai) _Pragma("unroll") for (int m = 0; m < 4; ++m) { \
        float v0[8], v1[8]; _Pragma("unroll") for (int n = 0; n < 2; ++n) _Pragma("unroll") for (int i = 0; i < 4; ++i) { v0[4 * n + i] = acc[ai][0][m][n][i]; v1[4 * n + i] = acc[ai][1][m][n][i]; }
#define MK_ROWS_END }

struct Epi1 {
    static constexpr bool PERM = true, AFTER_DRAIN = false;
    W w; int l;
    __device__ __forceinline__ void operator()(const f32x4 (&acc)[2][2][4][2], const Unit& u, int wr, int wc, int fr, int fq) const {
        int pn_ = __builtin_amdgcn_readfirstlane(u.pn), pm_ = __builtin_amdgcn_readfirstlane(u.pm); asm volatile("" : "+s"(pn_), "+s"(pm_), "+v"(fr), "+v"(fq));
        const int pn = pn_, cc0 = wc * 32 + fq * 8, rowb = pm_ * 256 + wr * 64 + fr;
#define MK_ROW (rowb + ai * 128 + m * 16)
        if (pn <= 2) {
            if (pn < 2 || wc < 2) {
                MK_ROWS_BEGIN
                    const int row = MK_ROW; const bool smp = row >= MP; const int t = smp ? ((row - MP) & 2047) : (row & 255);
                    float o1[8], o2[8];
                    if (smp) { float cs[8], sn[8]; ldf8(w.ropec() + t * 32 + fq * 8, cs); ldf8(w.ropes() + t * 32 + fq * 8, sn);
#pragma unroll
                        for (int e = 0; e < 8; ++e) { o1[e] = v0[e] * cs[e] - v1[e] * sn[e]; o2[e] = v0[e] * sn[e] + v1[e] * cs[e]; } }
                    else {
#pragma unroll
                        for (int e = 0; e < 8; ++e) { o1[e] = v0[e]; o2[e] = v1[e]; } }
                    if (pn < 2) { g2::bf16_t* q = w.Q() + (size_t)row * 512 + (pn * 4 + wc) * 64 + fq * 8; st16(q, pack8(o1)); st16(q + 32, pack8(o2)); }
                    else { g2::bf16_t* k = w.K() + (size_t)row * 128 + wc * 64 + fq * 8; st16(k, pack8(o1)); st16(k + 32, pack8(o2));
                        if (!smp) { float* o = w.out + g2::OUT_K + (((size_t)(row >> 8) * 2 + l) * 256 + t) * 128 + wc * 64 + fq * 8; stf8(o, v0); stf8(o + 32, v1); } }
                MK_ROWS_END
            } else {
                const int c2 = (wc - 2) * 32 + fq * 8;
                MK_ROWS_BEGIN
                    const int row = MK_ROW; g2::bf16_t* vp = w.V() + (size_t)row * 128 + c2; st16(vp, pack8(v0)); st16(vp + 64, pack8(v1));
                    if (row < MP) { float* o = w.out + g2::OUT_V + (((size_t)(row >> 8) * 2 + l) * 256 + (row & 255)) * 128 + c2; stf8(o, v0); stf8(o + 64, v1); }
                MK_ROWS_END
            }
        } else if (pn >= 19) {
            g2::bf16_t* base = w.GM() + (size_t)(pn - 19) * 256 + cc0;
            MK_ROWS_BEGIN
                float o0[8], o1[8];
#pragma unroll
                for (int e = 0; e < 8; ++e) { o0[e] = fsig(v0[e]); o1[e] = fsig(v1[e]); }
                g2::bf16_t* p = base + (size_t)MK_ROW * 4096; st16(p, pack8(o0)); st16(p + 128, pack8(o1));
            MK_ROWS_END
        } else if (pn >= 5 && pn < 9) {
            g2::bf16_t* base = w.XC() + (pn - 5) * 128 + cc0;
            MK_ROWS_BEGIN
                float o[8];
#pragma unroll
                for (int e = 0; e < 8; ++e) o[e] = v0[e] * fsig(v1[e]);
                st16(base + (size_t)MK_ROW * 512, pack8(o));
            MK_ROWS_END
        } else if (pn == 11 || pn == 12 || pn == 15 || pn == 16) {
            g2::bf16_t* base = (pn < 13 ? w.XP() + (pn - 11) * 256 : w.XS() + (pn - 15) * 256) + cc0;
            MK_ROWS_BEGIN
                g2::bf16_t* p = base + (size_t)MK_ROW * 512; st16(p, pack8(v0)); st16(p + 128, pack8(v1));
            MK_ROWS_END
        } else {
            const int br = pn < 5 ? 0 : pn < 11 ? 1 : pn < 15 ? 2 : 3; const int t0 = br == 0 ? 3 : br == 1 ? 9 : br == 2 ? 13 : 17;
            g2::bf16_t* base = w.GATE() + (size_t)br * M * 512 + (pn - t0) * 256 + cc0;
            MK_ROWS_BEGIN
                float o0[8], o1[8];
#pragma unroll
                for (int e = 0; e < 8; ++e) { o0[e] = fsilu(v0[e]); o1[e] = fsilu(v1[e]); }
                g2::bf16_t* p = base + (size_t)MK_ROW * 512; st16(p, pack8(o0)); st16(p + 128, pack8(o1));
            MK_ROWS_END
        }
#undef MK_ROW
    }
};
#define MK1_ROW(ai, m) (rowb + (ai) * 128 + (m) * 16)
__device__ __forceinline__ int glu_orig_col_v2(int row) { const int t = row >> 7, r = row & 127, gi = r >> 3, e = r & 7; return (e < 4 ? 0 : 512) + 64 * t + 4 * gi + (e & 3); }
struct SchedN1 { int c;
    __device__ __forceinline__ bool next(int i, Unit& u) const { if (i > 0 || c >= 256) return false; const int x = c & 7, slot = c >> 3; u.pm = x * 4 + (slot >> 3); u.pn = slot & 7; return true; }
    __device__ __forceinline__ void a_ready(const Unit&) const {}
    __device__ __forceinline__ void done(const Unit&) const {}
};
struct Epi3 {
    static constexpr bool PERM = true, AFTER_DRAIN = false;
    W w;
    __device__ __forceinline__ void operator()(const f32x4 (&acc)[2][1][4][2], const Unit& u, int wr, int wc, int fr, int fq) const {
        int pn_ = __builtin_amdgcn_readfirstlane(u.pn), pm_ = __builtin_amdgcn_readfirstlane(u.pm); asm volatile("" : "+s"(pn_), "+s"(pm_), "+v"(fr), "+v"(fq));
        const int rowb = pm_ * 256 + wr * 64 + fr; g2::bf16_t* base = w.GATE() + (size_t)3 * M * 512 + 64 * pn_ + 16 * wc + 4 * fq;
        unsigned long long gv[2][4];
#pragma unroll
        for (int ai = 0; ai < 2; ++ai)
#pragma unroll
            for (int m = 0; m < 4; ++m) gv[ai][m] = *(const unsigned long long*)(base + (size_t)MK1_ROW(ai, m) * 512);
#pragma unroll
        for (int ai = 0; ai < 2; ++ai)
#pragma unroll
            for (int m = 0; m < 4; ++m) { const f32x4 v = acc[ai][0][m][0], gt = acc[ai][0][m][1]; const unsigned g0 = (unsigned)gv[ai][m], g1 = (unsigned)(gv[ai][m] >> 32);
                const float o0 = v.x * fsig(gt.x) * __uint_as_float(g0 << 16), o1 = v.y * fsig(gt.y) * __uint_as_float(g0 & 0xffff0000u), o2 = v.z * fsig(gt.z) * __uint_as_float(g1 << 16), o3 = v.w * fsig(gt.w) * __uint_as_float(g1 & 0xffff0000u);
                *(unsigned long long*)(base + (size_t)MK1_ROW(ai, m) * 512) = (unsigned long long)pg8::cvt_pk_bf16(o0, o1) | ((unsigned long long)pg8::cvt_pk_bf16(o2, o3) << 32); }
    }
};
struct Epi4a {
    static constexpr bool PERM = true, AFTER_DRAIN = false;
    W w; mutable f32x4 mg[2][4][2];
    __device__ __forceinline__ void operator()(const f32x4 (&acc)[2][1][4][2], const Unit& u, int wr, int wc, int fr, int fq) const {
        int pn_ = __builtin_amdgcn_readfirstlane(u.pn), pm_ = __builtin_amdgcn_readfirstlane(u.pm); asm volatile("" : "+s"(pn_), "+s"(pm_), "+v"(fr), "+v"(fq));
        const int n_ = pn_ >> 3, pn8 = pn_ & 7, rowb = (pm_ & 31) * 256 + wr * 64 + fr, col = pn8 * 128 + wc * 32 + fq * 8;
        u32x4 gv[2][4];
#pragma unroll
        for (int ai = 0; ai < 2; ++ai)
#pragma unroll
            for (int m = 0; m < 4; ++m) gv[ai][m] = *(const u32x4*)(w.GM() + (size_t)MK1_ROW(ai, m) * 4096 + n_ * 1024 + col);
#pragma unroll
        for (int ai = 0; ai < 2; ++ai)
#pragma unroll
            for (int m = 0; m < 4; ++m) { float g[8]; unpack8(gv[ai][m], g);
                const f32x4 p0 = acc[ai][0][m][0] * (f32x4){g[0], g[1], g[2], g[3]}, p1 = acc[ai][0][m][1] * (f32x4){g[4], g[5], g[6], g[7]};
                if (n_ == 0) { mg[ai][m][0] = p0; mg[ai][m][1] = p1; } else { mg[ai][m][0] += p0; mg[ai][m][1] += p1; }
                if (n_ == 3) { const f32x4 a = mg[ai][m][0], b = mg[ai][m][1]; const float o[8] = {a.x, a.y, a.z, a.w, b.x, b.y, b.z, b.w}; st16(w.MRG() + (size_t)MK1_ROW(ai, m) * 1024 + col, pack8(o)); } }
    }
};
struct Sched4a { int c;
    __device__ __forceinline__ bool next(int i, Unit& u) const { if (c >= 256 || i >= 4) return false; const int x = c & 7, slot = c >> 3; u.pm = x * 4 + (slot >> 3) + 32 * i; u.pn = (slot & 7) + 8 * i; return true; }
    __device__ __forceinline__ void a_ready(const Unit&) const {}
    __device__ __forceinline__ void done(const Unit&) const {}
};
struct Epi4b {
    static constexpr bool PERM = true, AFTER_DRAIN = false;
    InP in; W w; int l;
    __device__ __forceinline__ void operator()(const f32x4 (&acc)[2][1][4][2], const Unit& u, int wr, int wc, int fr, int fq) const {
        int pn_ = __builtin_amdgcn_readfirstlane(u.pn), pm_ = __builtin_amdgcn_readfirstlane(u.pm); asm volatile("" : "+s"(pn_), "+s"(pm_), "+v"(fr), "+v"(fq));
        const int rowb = pm_ * 256 + wr * 64 + fr, col = pn_ * 128 + wc * 32 + fq * 8;
        const float* gt = w.mod() + ((size_t)l * 3 + g2::row_modj(pm_ * 256)) * 3072 + 2048 + col; const f32x4 g0 = *(const f32x4*)gt, g1 = *(const f32x4*)(gt + 4);
        f32x4 xv[2][4][2];
#pragma unroll
        for (int ai = 0; ai < 2; ++ai)
#pragma unroll
            for (int m = 0; m < 4; ++m) { const float* xr = g2::xrow(in, w, l, MK1_ROW(ai, m)) + col; xv[ai][m][0] = *(const f32x4*)xr; xv[ai][m][1] = *(const f32x4*)(xr + 4); }
#pragma unroll
        for (int ai = 0; ai < 2; ++ai)
#pragma unroll
            for (int m = 0; m < 4; ++m) { float* o = w.out + (size_t)MK1_ROW(ai, m) * 1024 + col; *(f32x4*)o = xv[ai][m][0] + g0 * acc[ai][0][m][0]; *(f32x4*)(o + 4) = xv[ai][m][1] + g1 * acc[ai][0][m][1]; }
    }
};

__device__ __forceinline__ int fresh_grid() { int g = (int)gridDim.x; asm volatile("" : "+s"(g)); return g; }
__device__ __forceinline__ float wave_sum(float v) {
    v += __int_as_float(__builtin_amdgcn_ds_swizzle(__float_as_int(v), 0x041f)); v += __int_as_float(__builtin_amdgcn_ds_swizzle(__float_as_int(v), 0x081f));
    v += __int_as_float(__builtin_amdgcn_ds_swizzle(__float_as_int(v), 0x101f)); v += __int_as_float(__builtin_amdgcn_ds_swizzle(__float_as_int(v), 0x201f));
    v += __int_as_float(__builtin_amdgcn_ds_swizzle(__float_as_int(v), 0x401f));
    const auto rr = __builtin_amdgcn_permlane32_swap(__float_as_uint(v), __float_as_uint(v), false, false);
    return __uint_as_float(rr[0]) + __uint_as_float(rr[1]);
}
template <bool FINAL> __device__ __forceinline__ void ph_rows(InP in, const W& w, int l) {
    const int tid_ = mk_fresh_tid(); const int lane = tid_ & 63, wave = tid_ >> 6;
    const int gw = blockIdx.x * NWAVES + wave, NGW = fresh_grid() * NWAVES;
    for (int m = gw; m < M; m += NGW) {
        const float* xr = FINAL ? w.out + (size_t)m * 1024 : g2::xrow(in, w, l, m);
        f32x4 v[4]; float s = 0.f;
#pragma unroll
        for (int j = 0; j < 4; ++j) { v[j] = *(const f32x4*)(xr + 256 * j + 4 * lane); s += (v[j].x * v[j].x + v[j].y * v[j].y) + (v[j].z * v[j].z + v[j].w * v[j].w); }
        const float r = 1.0f / sqrtf(wave_sum(s) * (1.0f / 1024.f) + g2::EPS);
        if (FINAL) { const float* g = in->final_g;
#pragma unroll
            for (int j = 0; j < 4; ++j) { const f32x4 gv = *(const f32x4*)(g + 256 * j + 4 * lane); *(f32x4*)(w.out + (size_t)m * 1024 + 256 * j + 4 * lane) = v[j] * r * gv; } }
        else { const float* mo = w.mod() + ((size_t)l * 3 + g2::row_modj(m)) * 3072; const float* g = in->norm_g + l * 1024;
#pragma unroll
            for (int j = 0; j < 4; ++j) { const int k = 256 * j + 4 * lane; const f32x4 gv = *(const f32x4*)(g + k), sc = *(const f32x4*)(mo + 1024 + k), sh = *(const f32x4*)(mo + k);
                const f32x4 o = (v[j] * r) * gv * (sc + 1.0f) + sh; unsigned long long pk = (unsigned long long)pg8::cvt_pk_bf16(o.x, o.y) | ((unsigned long long)pg8::cvt_pk_bf16(o.z, o.w) << 32);
                *(unsigned long long*)(w.H() + (size_t)m * 1024 + k) = pk; } }
    }
}
__device__ __forceinline__ void cvt_item(const float* Wsrc, int ldw, int oc, g2::bf16_t* WT, int K, int k0, LAS float* scr, int lane) {
    float v[64];
#pragma unroll
    for (int kk = 0; kk < 64; ++kk) v[kk] = Wsrc[(size_t)(k0 + kk) * ldw + oc];
#pragma unroll
    for (int kk = 0; kk < 64; ++kk) scr[kk * 64 + (lane ^ (8 * (kk >> 3)))] = v[kk];
    asm volatile("s_waitcnt lgkmcnt(0)" ::: "memory");
    const int c = lane & 7;
#pragma unroll
    for (int j = 0; j < 8; ++j) { const int n = (lane >> 3) + 8 * j; const LAS float* s_ = scr + (8 * c) * 64 + (n ^ (8 * c));
        u32x4 o; o.x = pg8::cvt_pk_bf16(s_[0 * 64], s_[1 * 64]); o.y = pg8::cvt_pk_bf16(s_[2 * 64], s_[3 * 64]); o.z = pg8::cvt_pk_bf16(s_[4 * 64], s_[5 * 64]); o.w = pg8::cvt_pk_bf16(s_[6 * 64], s_[7 * 64]);
        *(u32x4*)(WT + (size_t)n * K + k0 + 8 * c) = o; }
    asm volatile("s_waitcnt lgkmcnt(0)" ::: "memory");
}
__device__ __forceinline__ void ph_convert(InP in, const W& w, LAS unsigned char* L) {
    const int tid_ = mk_fresh_tid(); const int lane = tid_ & 63, wave = tid_ >> 6;
    LAS float* scr = (LAS float*)(L + wave * 16384);
    const int gw = blockIdx.x * NWAVES + wave, NGW = fresh_grid() * NWAVES;
    constexpr int I_IN = 16 * (INC / 64), I_GLU = 8 * 16, I_BR = 8 * 16, I_OUT = 16 * 16;
    constexpr int NITEMS = 2 * I_IN + 2 * I_GLU + 8 * I_BR + 2 * I_OUT;
    for (int it = gw; it < NITEMS; it += NGW) {
        int r = it;
        if (r < 2 * I_IN) { const int l = r / I_IN; r -= l * I_IN; const int kb = r / (INC / 64), n0 = (r % (INC / 64)) * 64; const int oca = g2::in_orig_col(n0), ocb = g2::in_orig_col(n0 + 32);
            if (oca >= g2::C_XPOOL && oca < g2::C_XPOOL + 512) continue;
            cvt_item(in->w_in + (size_t)l * 1024 * INC, INC, (lane < 32 ? oca : ocb) + (lane & 31), w.win() + ((size_t)l * INC + n0) * 1024, 1024, kb * 64, scr, lane); continue; }
        r -= 2 * I_IN;
        if (r < 2 * I_GLU) { const int l = r / I_GLU; r -= l * I_GLU; const int kb = r / 16, n0 = (r % 16) * 64;
            cvt_item(in->glu_w + (size_t)l * 512 * 1024, 1024, glu_orig_col_v2(n0 + lane), w.wglu() + ((size_t)l * 1024 + n0) * 512, 512, kb * 64, scr, lane); continue; }
        r -= 2 * I_GLU;
        if (r < 8 * I_BR) { const int ln = r / I_BR; r -= ln * I_BR; const int kb = r / 16, n0 = (r % 16) * 64;
            cvt_item(in->w_br + (size_t)ln * 512 * 1024, 1024, n0 + lane, w.wbr() + ((size_t)ln * 1024 + n0) * 512, 512, kb * 64, scr, lane); continue; }
        r -= 8 * I_BR;
        { const int l = r / I_OUT; r -= l * I_OUT; const int kb = r / 16, n0 = (r % 16) * 64;
          cvt_item(in->w_out + (size_t)l * 1024 * 1024, 1024, n0 + lane, w.wout() + ((size_t)l * 1024 + n0) * 1024, 1024, kb * 64, scr, lane); }
    }
}
__device__ __forceinline__ void ph_mod(InP in, const W& w, LAS unsigned char* L) {
    const int tid_ = mk_fresh_tid();
    LAS float* sc = (LAS float*)L;
    LAS float* red = (LAS float*)(L + 12288);
    const int G_ = fresh_grid();
    if ((int)blockIdx.x >= 192) return;
    for (int i = tid_; i < 3 * 1024; i += NTHREADS) { const int j = i >> 10, k = i & 1023; const float v = j == 0 ? in->c_ctx[k] : in->c[(size_t)(j - 1) * 1024 + k]; sc[i] = v * fsig(v); }
    __syncthreads();
    for (int it = blockIdx.x; it < 192; it += G_) { const int l = it / 96, n = (it % 96) * 32 + (tid_ & 31), ks = tid_ >> 5; const float* wa = in->w_ada + ((size_t)l * 1024 + ks * 64) * 3072 + n;
        float a0 = 0.f, a1 = 0.f, a2 = 0.f;
#pragma unroll 16
        for (int kk = 0; kk < 64; ++kk) { const float wv = wa[(size_t)kk * 3072]; const int k = ks * 64 + kk; a0 += sc[k] * wv; a1 += sc[1024 + k] * wv; a2 += sc[2048 + k] * wv; }
        red[(ks * 3 + 0) * 32 + (tid_ & 31)] = a0; red[(ks * 3 + 1) * 32 + (tid_ & 31)] = a1; red[(ks * 3 + 2) * 32 + (tid_ & 31)] = a2;
        __syncthreads();
        if (tid_ < 96) { const int j = tid_ >> 5, cidx = tid_ & 31; float t = 0.f;
#pragma unroll
            for (int q = 0; q < 16; ++q) t += red[(q * 3 + j) * 32 + cidx];
            const int nn = (it % 96) * 32 + cidx; w.mod()[((size_t)l * 3 + j) * 3072 + nn] = t + in->b_ada[l * 3072 + nn]; }
        __syncthreads(); }
}
__device__ __forceinline__ void ph_poolfold(InP in, const W& w, LAS unsigned char* L) {
    const int tid_ = mk_fresh_tid();
    LAS float* A = (LAS float*)(L + 16384);
    const int G_ = fresh_grid(); const int vb = G_ - 1 - (int)blockIdx.x;
    for (int it = vb; it < 128; it += G_) { const int l = it >> 6, g = (it >> 4) & 3, k0 = (it & 15) * 64, co = tid_ & 127, kq = tid_ >> 7;
        __syncthreads();
        for (int i = tid_; i < 64 * 128; i += NTHREADS) A[i] = in->w_in[((size_t)l * 1024 + k0 + (i >> 7)) * INC + g2::C_XPOOL + g * 128 + (i & 127)];
        __syncthreads();
        const float* pw = in->pool_w + ((size_t)l * 4 + g) * 128 * 128 + co; float acc[16];
#pragma unroll
        for (int kk = 0; kk < 16; ++kk) acc[kk] = 0.f;
#pragma unroll 4
        for (int ci = 0; ci < 128; ++ci) { const float bv = pw[(size_t)ci * 128];
#pragma unroll
            for (int kk = 0; kk < 16; ++kk) acc[kk] += A[(16 * kq + kk) * 128 + ci] * bv; }
        const float sc_ = in->pool_scale[l * 512 + g * 128 + co]; float o[16];
#pragma unroll
        for (int kk = 0; kk < 16; ++kk) o[kk] = acc[kk] * sc_;
        g2::bf16_t* dst = w.win() + ((size_t)l * INC + 11 * 256 + g * 128 + co) * 1024 + k0 + 16 * kq; st16(dst, pack8(o)); st16(dst + 8, pack8(o + 8)); }
}
template <int WD> __device__ __forceinline__ void pool_strip(const float (&xp)[32], int t0, int Lseq, g2::bf16_t* gp) {
    g2::bf16_t gr[16];
#pragma unroll
    for (int tt = 0; tt < 16; ++tt) gr[tt] = gp[(size_t)tt * 512];
    __builtin_amdgcn_sched_barrier(0);
#pragma unroll
    for (int tt = 0; tt < 16; ++tt) { float sum = 0.f;
#pragma unroll
        for (int i = 0; i < WD; ++i) sum += xp[tt + 8 - WD / 2 + i];
        const int t = t0 + tt; const int lo = t - WD / 2 < 0 ? 0 : t - WD / 2, hi = t + WD / 2 > Lseq ? Lseq : t + WD / 2;
        gp[(size_t)tt * 512] = g2::f2bf((sum / (float)(hi - lo) - xp[tt + 8]) * g2::bf2f(gr[tt])); }
}
__device__ __forceinline__ void convpool_unit(InP in, const W& w, int l, LAS unsigned char* L, int u, int tid_) {
    const int c = tid_, lane = tid_ & 63, wave = tid_ >> 6;
    LAS float* Y = (LAS float*)L;
    {
        const int m0 = u * 16, s0 = g2::row_seq0(m0), Lseq = g2::row_len(m0), t0 = m0 - s0;
        { float xp[32];
          g2::bf16_t raw[32];
#pragma unroll
          for (int i = 0; i < 32; ++i) { const int t = t0 - 8 + i; const int tc = t < 0 ? 0 : (t >= Lseq ? Lseq - 1 : t); raw[i] = w.XP()[(size_t)(s0 + tc) * 512 + c]; }
          __builtin_amdgcn_sched_barrier(0);
#pragma unroll
          for (int i = 0; i < 32; ++i) { const int t = t0 - 8 + i; xp[i] = (t >= 0 && t < Lseq) ? g2::bf2f(raw[i]) : 0.f; }
          g2::bf16_t* gp = w.GATE() + ((size_t)2 * M + m0) * 512 + c; const int grp = c >> 7;
          if (grp == 0) pool_strip<2>(xp, t0, Lseq, gp); else if (grp == 1) pool_strip<4>(xp, t0, Lseq, gp); else if (grp == 2) pool_strip<8>(xp, t0, Lseq, gp); else pool_strip<16>(xp, t0, Lseq, gp); }
        { float acc[16]; const float bias = in->conv_db[l * 512 + c];
#pragma unroll
          for (int tt = 0; tt < 16; ++tt) acc[tt] = bias;
          float wj[31];
#pragma unroll
          for (int j = 0; j < 31; ++j) wj[j] = in->conv_dw[((size_t)l * 31 + j) * 512 + c];
          float xin[46];
          g2::bf16_t raw[46];
#pragma unroll
          for (int i = 0; i < 46; ++i) { const int t = t0 - 15 + i; const int tc = t < 0 ? 0 : (t >= Lseq ? Lseq - 1 : t); raw[i] = w.XC()[(size_t)(s0 + tc) * 512 + c]; }
          __builtin_amdgcn_sched_barrier(0);
#pragma unroll
          for (int i = 0; i < 46; ++i) { const int t = t0 - 15 + i; xin[i] = (t >= 0 && t < Lseq) ? g2::bf2f(raw[i]) : 0.f; }
#pragma unroll
          for (int i = 0; i < 46; ++i) { const float x = xin[i];
#pragma unroll
              for (int tt = 0; tt < 16; ++tt) { const int j = i - tt; if (j >= 0 && j < 31) acc[tt] += x * wj[j]; } }
#pragma unroll
          for (int tt = 0; tt < 16; ++tt) Y[tt * 512 + c] = acc[tt]; }
        __syncthreads();
#pragma unroll
        for (int q = 0; q < 2; ++q) { const int tt = wave * 2 + q; float y[8]; const f32x4 a = *(const LAS f32x4*)(Y + tt * 512 + 8 * lane), b = *(const LAS f32x4*)(Y + tt * 512 + 8 * lane + 4);
            y[0] = a.x; y[1] = a.y; y[2] = a.z; y[3] = a.w; y[4] = b.x; y[5] = b.y; y[6] = b.z; y[7] = b.w; float s = 0.f;
#pragma unroll
            for (int e = 0; e < 8; ++e) s += y[e];
            const float mu = wave_sum(s) * (1.0f / 512.f); float q2 = 0.f;
#pragma unroll
            for (int e = 0; e < 8; ++e) { y[e] -= mu; q2 += y[e] * y[e]; }
            const float rs = 1.0f / sqrtf(wave_sum(q2) * (1.0f / 512.f) + g2::EPS);
            float lg[8], lb[8], gt[8], o[8]; ldf8(in->conv_ln_g + l * 512 + 8 * lane, lg); ldf8(in->conv_ln_b + l * 512 + 8 * lane, lb);
            g2::bf16_t* gp = w.GATE() + ((size_t)1 * M + m0 + tt) * 512 + 8 * lane; unpack8(*(const u32x4*)gp, gt);
#pragma unroll
            for (int e = 0; e < 8; ++e) o[e] = fsilu(y[e] * rs * lg[e] + lb[e]) * gt[e];
            st16(gp, pack8(o)); }
        __syncthreads();
    }
}


constexpr size_t WS_BB = 3 * g2::MiB, WS_CC = 3 * g2::MiB + 512 * 1024;
struct FSsmTab { InP in; W w;
    __device__ __forceinline__ void operator()(long i) const { const int p = i % 64, g = (i / 64) % 32; const long ld = i / (64 * 32);
        const float lr = in->lam_re[i], li = in->lam_im[i]; const float dt = expf(in->log_dt[ld * 32 + g]);
        const float e = expf(lr * dt), br_ = e * cosf(li * dt), bi_ = e * sinf(li * dt); w.lamb()[2 * i] = br_; w.lamb()[2 * i + 1] = bi_;
        const float nr = br_ - 1.0f, ni = bi_, den = lr * lr + li * li, fr = (nr * lr + ni * li) / den, fi = (ni * lr - nr * li) / den;
        g2::bf16_t* bb = (g2::bf16_t*)(w.ws + WS_BB) + ((size_t)(ld * 32 + g) * 2 * 64 + p) * 16; g2::bf16_t* cc = (g2::bf16_t*)(w.ws + WS_CC) + (size_t)(ld * 32 + g) * 16 * 128 + 2 * p;
        for (int c = 0; c < 16; ++c) { const float xr = in->b_re[i * 16 + c], xi = in->b_im[i * 16 + c]; bb[c] = g2::f2bf(fr * xr - fi * xi); bb[64 * 16 + c] = g2::f2bf(fr * xi + fi * xr);
            cc[c * 128] = g2::f2bf(in->c_re[((ld * 32 + g) * 16 + c) * 64 + p]); cc[c * 128 + 1] = g2::f2bf(-in->c_im[((ld * 32 + g) * 16 + c) * 64 + p]); } } };

typedef short bf16x8_t __attribute__((ext_vector_type(8)));
typedef float f32x2_t __attribute__((ext_vector_type(2)));
constexpr int SSM_WAVE_LDS = 12800, SSM_HROW = 272, SSM_XCH = 8 * SSM_WAVE_LDS;
__device__ __forceinline__ float fgelu(float x) { const float u = 0.7978845608028654f * (x + 0.044715f * x * x * x); return x * fsig(2.0f * u); }

template <int MODE> __device__ __forceinline__ void ssm_pass(const W& w, int l, int dir, int g, int m_lo, int ntok, float& hr, float& hi, LAS unsigned char* wl, int lane, float dval) {
    LAS f32x2_t* BU = (LAS f32x2_t*)wl; LAS unsigned char* Hb = wl + 8192;
    const int ld = l * 2 + dir, fr = lane & 15, fq = lane >> 4;
    const f32x2_t lam = *(const f32x2_t*)(w.lamb() + ((size_t)(ld * 32 + g) * 64 + lane) * 2);
    bf16x8_t bfr[4][2], cfr[4];
    { const g2::bf16_t* bb = (const g2::bf16_t*)(w.ws + WS_BB) + (size_t)(ld * 32 + g) * 2 * 64 * 16;
#pragma unroll
      for (int q = 0; q < 4; ++q)
#pragma unroll
          for (int ri = 0; ri < 2; ++ri) { const bf16x8_t t_ = *(const bf16x8_t*)(bb + ((size_t)ri * 64 + 16 * q + fr) * 16 + 8 * (fq & 1)); bfr[q][ri] = fq < 2 ? t_ : (bf16x8_t){0, 0, 0, 0, 0, 0, 0, 0}; }
      if (MODE != 0) { const g2::bf16_t* cc = (const g2::bf16_t*)(w.ws + WS_CC) + ((size_t)(ld * 32 + g) * 16 + fr) * 128;
#pragma unroll
          for (int ks = 0; ks < 4; ++ks) cfr[ks] = *(const bf16x8_t*)(cc + 32 * ks + 8 * fq); } }
    const int nch = ntok >> 4; const g2::bf16_t* xs = w.XS() + (size_t)g * 16;
    auto chunk_row = [&](int ci) { return dir == 0 ? m_lo + 16 * ci : m_lo + ntok - 16 - 16 * ci; };
    struct Pre { bf16x8_t a; g2::bf16_t x[4]; float yf[4]; };
    auto fetch = [&](int ci, Pre& P) { if (ci < nch) { const int mn = chunk_row(ci); P.a = *(const bf16x8_t*)(xs + (size_t)(mn + fr) * 512 + 8 * (fq & 1));
            if (MODE != 0) {
#pragma unroll
                for (int r = 0; r < 4; ++r) { const size_t o = (size_t)(mn + 4 * fq + r) * 512 + g * 16 + fr; P.x[r] = w.XS()[o]; if (MODE == 2) P.yf[r] = w.TMP()[o]; } } } };
    auto step = [&](int ci, Pre& P) {
        const int mt = chunk_row(ci); const bf16x8_t a = fq < 2 ? P.a : (bf16x8_t){0, 0, 0, 0, 0, 0, 0, 0}; float xc[4], yfc[4];
#pragma unroll
        for (int r = 0; r < 4; ++r) { xc[r] = g2::bf2f(P.x[r]); yfc[r] = P.yf[r]; }
        fetch(ci + 2, P);
#pragma unroll
        for (int q = 0; q < 4; ++q) { const f32x4 z = {0.f, 0.f, 0.f, 0.f};
            const f32x4 dre = __builtin_amdgcn_mfma_f32_16x16x32_bf16(a, bfr[q][0], z, 0, 0, 0), dim = __builtin_amdgcn_mfma_f32_16x16x32_bf16(a, bfr[q][1], z, 0, 0, 0);
#pragma unroll
            for (int r = 0; r < 4; ++r) BU[(4 * fq + r) * 64 + 16 * q + fr] = (f32x2_t){dre[r], dim[r]}; }
        f32x2_t bq[16];
#pragma unroll
        for (int s_ = 0; s_ < 16; ++s_) bq[s_] = BU[(dir == 0 ? s_ : 15 - s_) * 64 + lane];
        unsigned hw[16];
#pragma unroll
        for (int s_ = 0; s_ < 16; ++s_) { const float nr = lam.x * hr - lam.y * hi + bq[s_].x, ni = lam.x * hi + lam.y * hr + bq[s_].y; hr = nr; hi = ni; if (MODE != 0) hw[s_] = pg8::cvt_pk_bf16(hr, hi); }
        if (MODE != 0) {
#pragma unroll
            for (int s_ = 0; s_ < 16; ++s_) *(LAS unsigned*)(Hb + (dir == 0 ? s_ : 15 - s_) * SSM_HROW + lane * 4) = hw[s_];
            f32x4 y = {0.f, 0.f, 0.f, 0.f};
#pragma unroll
            for (int ks = 0; ks < 4; ++ks) { const bf16x8_t ha = *(const LAS bf16x8_t*)(Hb + fr * SSM_HROW + 64 * ks + 16 * fq); y = __builtin_amdgcn_mfma_f32_16x16x32_bf16(ha, cfr[ks], y, 0, 0, 0); }
#pragma unroll
            for (int r = 0; r < 4; ++r) { const size_t o = (size_t)(mt + 4 * fq + r) * 512 + g * 16 + fr;
                if (MODE == 1) w.TMP()[o] = y[r] + dval * xc[r]; else w.YS()[o] = g2::f2bf(fgelu(y[r] + yfc[r])); } }
    };
    Pre PA, PB;
#pragma unroll
    for (int r = 0; r < 4; ++r) { PA.x[r] = 0; PA.yf[r] = 0.f; PB.x[r] = 0; PB.yf[r] = 0.f; }
    PA.a = (bf16x8_t){0, 0, 0, 0, 0, 0, 0, 0}; PB.a = PA.a;
    fetch(0, PA); fetch(1, PB);
#pragma unroll 1
    for (int ci = 0; ci < nch; ci += 2) { step(ci, PA); step(ci + 1, PB); }
}
__device__ __forceinline__ void cmul(float& ar, float& ai, float br, float bi) { const float t = ar * br - ai * bi; ai = ar * bi + ai * br; ar = t; }
__device__ __forceinline__ void ssm_pass0(const W& w, int l, int dir, int g, int m_lo, int ntok, float& er, float& ei, LAS unsigned char* wl, int lane) {
    LAS f32x2_t* BU = (LAS f32x2_t*)wl;
    const int ld = l * 2 + dir, fr = lane & 15, fq = lane >> 4;
    bf16x8_t bfr[4][2];
    { const g2::bf16_t* bb = (const g2::bf16_t*)(w.ws + WS_BB) + (size_t)(ld * 32 + g) * 2 * 64 * 16;
#pragma unroll
      for (int q = 0; q < 4; ++q)
#pragma unroll
          for (int ri = 0; ri < 2; ++ri) { const bf16x8_t t_ = *(const bf16x8_t*)(bb + ((size_t)ri * 64 + 16 * q + fr) * 16 + 8 * (fq & 1)); bfr[q][ri] = fq < 2 ? t_ : (bf16x8_t){0, 0, 0, 0, 0, 0, 0, 0}; } }
    float l1r[4], l1i[4], l16r[4], l16i[4], wr_[4], wi_[4], sr[4], si[4];
#pragma unroll
    for (int q = 0; q < 4; ++q) { const f32x2_t lam = *(const f32x2_t*)(w.lamb() + ((size_t)(ld * 32 + g) * 64 + 16 * q + fr) * 2); l1r[q] = lam.x; l1i[q] = lam.y;
        float p4r = lam.x, p4i = lam.y; cmul(p4r, p4i, p4r, p4i); cmul(p4r, p4i, p4r, p4i);
        float p16r = p4r, p16i = p4i; cmul(p16r, p16i, p16r, p16i); cmul(p16r, p16i, p16r, p16i);
        l16r[q] = p16r; l16i[q] = p16i;
        const int k = dir == 0 ? 3 - fq : fq; float ar = 1.f, ai = 0.f; for (int j = 0; j < k; ++j) cmul(ar, ai, p4r, p4i);
        wr_[q] = ar; wi_[q] = ai; sr[q] = 0.f; si[q] = 0.f; }
    const int nch = ntok >> 4; const g2::bf16_t* xs = w.XS() + (size_t)g * 16;
    auto chunk_row = [&](int ci) { return dir == 0 ? m_lo + 16 * ci : m_lo + ntok - 16 - 16 * ci; };
    auto fetch = [&](int ci, bf16x8_t& a) { if (ci < nch) a = *(const bf16x8_t*)(xs + (size_t)(chunk_row(ci) + fr) * 512 + 8 * (fq & 1)); };
    auto step = [&](int ci, bf16x8_t& abuf) {
        const bf16x8_t a = fq < 2 ? abuf : (bf16x8_t){0, 0, 0, 0, 0, 0, 0, 0};
        fetch(ci + 2, abuf);
#pragma unroll
        for (int q = 0; q < 4; ++q) { const f32x4 z = {0.f, 0.f, 0.f, 0.f};
            const f32x4 dre = __builtin_amdgcn_mfma_f32_16x16x32_bf16(a, bfr[q][0], z, 0, 0, 0), dim = __builtin_amdgcn_mfma_f32_16x16x32_bf16(a, bfr[q][1], z, 0, 0, 0);
            float hr, hi;
            if (dir == 0) { hr = dre[0]; hi = dim[0];
#pragma unroll
                for (int r = 1; r < 4; ++r) { cmul(hr, hi, l1r[q], l1i[q]); hr += dre[r]; hi += dim[r]; } }
            else { hr = dre[3]; hi = dim[3];
#pragma unroll
                for (int r = 2; r >= 0; --r) { cmul(hr, hi, l1r[q], l1i[q]); hr += dre[r]; hi += dim[r]; } }
            cmul(sr[q], si[q], l16r[q], l16i[q]); sr[q] += hr; si[q] += hi; }
    };
    bf16x8_t A0 = (bf16x8_t){0, 0, 0, 0, 0, 0, 0, 0}, A1 = A0; fetch(0, A0); fetch(1, A1);
#pragma unroll 1
    for (int ci = 0; ci < nch; ci += 2) { step(ci, A0); step(ci + 1, A1); }
#pragma unroll
    for (int q = 0; q < 4; ++q) { cmul(sr[q], si[q], wr_[q], wi_[q]); BU[fq * 64 + 16 * q + fr] = (f32x2_t){sr[q], si[q]}; }
    const f32x2_t e0 = BU[lane], e1 = BU[64 + lane], e2 = BU[128 + lane], e3 = BU[192 + lane];
    er = (e0.x + e1.x) + (e2.x + e3.x); ei = (e0.y + e1.y) + (e2.y + e3.y);
}
__device__ __forceinline__ void ssm_unit(InP in, const W& w, int l, LAS unsigned char* L, int bu, int tid_) {
    const int lane = tid_ & 63, wave = __builtin_amdgcn_readfirstlane(tid_ >> 6);
    LAS unsigned char* wl = L + wave * SSM_WAVE_LDS; LAS f32x2_t* XCH = (LAS f32x2_t*)(L + SSM_XCH);
    {
        if (bu < 64) {
            const int b = bu >> 5, g = bu & 31, m_lo = MP + b * 2048 + wave * 256; const float dval = in->ssm_d[l * 512 + g * 16 + (lane & 15)];
            float ef_r = 0.f, ef_i = 0.f, eb_r = 0.f, eb_i = 0.f;
            ssm_pass0(w, l, 0, g, m_lo, 256, ef_r, ef_i, wl, lane); ssm_pass0(w, l, 1, g, m_lo, 256, eb_r, eb_i, wl, lane);
            XCH[(wave * 2 + 0) * 64 + lane] = (f32x2_t){ef_r, ef_i}; XCH[(wave * 2 + 1) * 64 + lane] = (f32x2_t){eb_r, eb_i};
            __syncthreads();
            float cr[2], ci[2];
#pragma unroll
            for (int dir = 0; dir < 2; ++dir) { const f32x2_t lam = *(const f32x2_t*)(w.lamb() + ((size_t)((l * 2 + dir) * 32 + g) * 64 + lane) * 2); float pr = lam.x, pi = lam.y;
#pragma unroll
                for (int sq = 0; sq < 8; ++sq) { const float t = pr * pr - pi * pi; pi = 2.f * pr * pi; pr = t; }
                const float* st = in->state_ssm + ((((size_t)b * 2 + l) * 2 + dir) * 2) * 2048 + g * 64 + lane; float hr = st[0], hi = st[2048];
                if (dir == 0) { for (int j = 0; j < wave; ++j) { const f32x2_t e = XCH[(j * 2 + 0) * 64 + lane]; const float t = pr * hr - pi * hi + e.x; hi = pr * hi + pi * hr + e.y; hr = t; } }
                else { for (int j = 7; j > wave; --j) { const f32x2_t e = XCH[(j * 2 + 1) * 64 + lane]; const float t = pr * hr - pi * hi + e.x; hi = pr * hi + pi * hr + e.y; hr = t; } }
                cr[dir] = hr; ci[dir] = hi; }
            ssm_pass<1>(w, l, 0, g, m_lo, 256, cr[0], ci[0], wl, lane, dval); ssm_pass<2>(w, l, 1, g, m_lo, 256, cr[1], ci[1], wl, lane, dval);
            __syncthreads();
        } else {
            const int pair = (bu - 64) * 8 + wave, b = pair >> 5, g = pair & 31, m_lo = b * 256; const float dval = in->ssm_d[l * 512 + g * 16 + (lane & 15)];
            float hr = 0.f, hi = 0.f;
            ssm_pass<1>(w, l, 0, g, m_lo, 256, hr, hi, wl, lane, dval);
            { float* o = w.out + g2::OUT_ST + ((((size_t)b * 2 + l) * 2 + 0) * 2) * 2048 + g * 64 + lane; o[0] = hr; o[2048] = hi; }
            hr = 0.f; hi = 0.f;
            ssm_pass<2>(w, l, 1, g, m_lo, 256, hr, hi, wl, lane, dval);
            { float* o = w.out + g2::OUT_ST + ((((size_t)b * 2 + l) * 2 + 1) * 2) * 2048 + g * 64 + lane; o[0] = hr; o[2048] = hi; }
        }
    }
}


constexpr size_t WS_CK = g2::WS_BBAR, WS_CV = g2::WS_BBAR + 256 * 1024;
struct FCvtCache { InP in; W w;
    __device__ __forceinline__ void operator()(long i) const { const long n = 2L * 2 * 256 * 128; if (i < n) ((g2::bf16_t*)(w.ws + WS_CK))[i] = g2::f2bf(in->cache_k[i]); else ((g2::bf16_t*)(w.ws + WS_CV))[i - n] = g2::f2bf(in->cache_v[i - n]); } };
typedef float f32x16 __attribute__((ext_vector_type(16)));
typedef short s16x4 __attribute__((ext_vector_type(4)));
constexpr int AT_SLOT = 16384, AT_KOFF = 0, AT_VOFF = 8192;
constexpr float AT_C2 = 0.125f * 1.4426950408889634f, AT_LOG2E = 1.4426950408889634f;
__device__ __forceinline__ int at_crow(int r, int hi) { return (r & 3) + 8 * (r >> 2) + 4 * hi; }
__device__ __forceinline__ float at_rowmax(const f32x16& p0, const f32x16& p1) { float a = fmaxf(p0[0], p1[0]);
#pragma unroll
    for (int r = 1; r < 16; ++r) a = fmaxf(a, fmaxf(p0[r], p1[r]));
    const auto rr = __builtin_amdgcn_permlane32_swap(__float_as_uint(a), __float_as_uint(a), false, false); return fmaxf(__uint_as_float(rr[0]), __uint_as_float(rr[1])); }

__device__ __forceinline__ void attn_unit(InP in, const W& w, int l, LAS unsigned char* L, int u, int tid_) {
    const int lane = tid_ & 63, r32 = lane & 31, hi = lane >> 5, wave = __builtin_amdgcn_readfirstlane(tid_ >> 6);
    {
        int head, kv, mq, qpos, ntile, nctx, klo; const g2::bf16_t *kbase, *vbase, *ckbase, *cvbase;
        if (u < 128) { const int b = u >> 6, rem = u & 63, pb = (rem >> 1) & 15; kv = rem >> 5; head = kv * 4 + (rem & 1) * 2 + (wave >> 2); qpos = pb * 128 + 32 * (wave & 3) + r32; mq = MP + b * 2048 + qpos;
            klo = pb * 128 - 128 < 0 ? 0 : pb * 128 - 128; const int khi = pb * 128 + 256 > 2048 ? 2048 : pb * 128 + 256; nctx = 4; ntile = 4 + (khi - klo) / 64;
            kbase = w.K() + (size_t)(MP + b * 2048 + klo) * 128; vbase = w.V() + (size_t)(MP + b * 2048 + klo) * 128;
            ckbase = (const g2::bf16_t*)(w.ws + WS_CK) + (size_t)(b * 2 + l) * 256 * 128; cvbase = (const g2::bf16_t*)(w.ws + WS_CV) + (size_t)(b * 2 + l) * 256 * 128; }
        else { const int b = (u - 128) >> 3; head = (u - 128) & 7; kv = head >> 2; qpos = 32 * wave + r32; mq = b * 256 + qpos; klo = 0; nctx = 0; ntile = 4;
            kbase = w.K() + (size_t)(b * 256) * 128; vbase = w.V() + (size_t)(b * 256) * 128; ckbase = kbase; cvbase = vbase; }
        bf16x8_t qr[4];
#pragma unroll
        for (int d0 = 0; d0 < 4; ++d0) qr[d0] = *(const bf16x8_t*)(w.Q() + (size_t)mq * 512 + head * 64 + d0 * 16 + hi * 8);
        float mrun = in->attn_sink[l * 8 + head] * AT_LOG2E, lsum = hi == 0 ? 1.0f : 0.0f;
        f32x16 o[2]; o[0] = f32x16{}; o[1] = f32x16{};
        auto ksrc = [&](int i) { const g2::bf16_t* base = i < nctx ? ckbase + (size_t)(64 * i) * 128 : kbase + (size_t)(64 * (i - nctx)) * 128; return base + (size_t)lane * 128 + kv * 64 + 8 * wave; };
        auto vsrc = [&](int i) { const g2::bf16_t* base = i < nctx ? cvbase + (size_t)(64 * i) * 128 : vbase + (size_t)(64 * (i - nctx)) * 128; return base + (size_t)(16 * (wave & 3) + (lane >> 2)) * 128 + kv * 64 + (wave >> 2) * 32 + (lane & 3) * 8; };
        u32x4 kreg = *(const u32x4*)ksrc(0), vreg = *(const u32x4*)vsrc(0);
        __syncthreads();
        *(LAS u32x4*)(L + AT_KOFF + wave * 1024 + lane * 16) = kreg; *(LAS u32x4*)(L + AT_VOFF + wave * 1024 + lane * 16) = vreg;
        __syncthreads();
#pragma unroll 1
        for (int i = 0; i < ntile; ++i) {
            LAS unsigned char* slot = L + (i & 1) * AT_SLOT;
            if (i + 1 < ntile) { kreg = *(const u32x4*)ksrc(i + 1); vreg = *(const u32x4*)vsrc(i + 1); }
            __builtin_amdgcn_sched_barrier(0);
            const int kp0 = klo + 64 * (i - nctx); const int q0 = qpos - r32;
            const bool win = i >= nctx && nctx > 0; const bool skip = win && (kp0 > q0 + 31 + 128 || kp0 + 63 < q0 - 128);
            if (!skip) {
                f32x16 p0 = f32x16{}, p1 = f32x16{};
                { const LAS unsigned char* kb = slot + AT_KOFF + hi * 1024 + r32 * 16;
#pragma unroll
                  for (int d0 = 0; d0 < 4; ++d0) { const bf16x8_t b0 = *(const LAS bf16x8_t*)(kb + d0 * 2048), b1 = *(const LAS bf16x8_t*)(kb + d0 * 2048 + 512);
                      p0 = __builtin_amdgcn_mfma_f32_32x32x16_bf16(b0, qr[d0], p0, 0, 0, 0); p1 = __builtin_amdgcn_mfma_f32_32x32x16_bf16(b1, qr[d0], p1, 0, 0, 0); } }
                if (win && (kp0 + 63 - q0 > 128 || q0 + 31 - kp0 > 128)) {
#pragma unroll
                    for (int r = 0; r < 16; ++r) { const int kk = kp0 + at_crow(r, hi); const int d0_ = qpos - kk, d1_ = qpos - (kk + 32);
                        if (d0_ > 128 || d0_ < -128) p0[r] = -1e30f; if (d1_ > 128 || d1_ < -128) p1[r] = -1e30f; } }
                const float rm = at_rowmax(p0, p1) * AT_C2; const float mnew = fmaxf(mrun, rm); const float alpha = __builtin_amdgcn_exp2f(mrun - mnew); mrun = mnew;
                float psum = 0.f;
#pragma unroll
                for (int r = 0; r < 16; ++r) { p0[r] = __builtin_amdgcn_exp2f(p0[r] * AT_C2 - mnew); p1[r] = __builtin_amdgcn_exp2f(p1[r] * AT_C2 - mnew); psum += p0[r] + p1[r]; }
                lsum = lsum * alpha + psum;
#pragma unroll
                for (int r = 0; r < 16; ++r) { o[0][r] *= alpha; o[1][r] *= alpha; }
                u32x4 pw[4];
#pragma unroll
                for (int s_ = 0; s_ < 4; ++s_) { const f32x16& P = s_ < 2 ? p0 : p1; const int bse = (s_ & 1) * 8;
                    pw[s_] = (u32x4){pg8::cvt_pk_bf16(P[bse], P[bse + 1]), pg8::cvt_pk_bf16(P[bse + 2], P[bse + 3]), pg8::cvt_pk_bf16(P[bse + 4], P[bse + 5]), pg8::cvt_pk_bf16(P[bse + 6], P[bse + 7])}; }
                const unsigned vb = (unsigned)(uintptr_t)(slot + AT_VOFF) + ((lane >> 4) & 1) * 32 + (lane & 3) * 8 + (4 * hi + ((lane & 15) >> 2)) * 64;
#pragma unroll
                for (int d0 = 0; d0 < 2; ++d0) { s16x4 lo[4], hh[4];
#pragma unroll
                    for (int ks = 0; ks < 4; ++ks) {
                        asm volatile("ds_read_b64_tr_b16 %0, %1 offset:%c2" : "=&v"(lo[ks]) : "v"(vb), "i"(d0 * 4096 + ks * 1024) : "memory");
                        asm volatile("ds_read_b64_tr_b16 %0, %1 offset:%c2" : "=&v"(hh[ks]) : "v"(vb), "i"(d0 * 4096 + ks * 1024 + 512) : "memory"); }
                    asm volatile("s_waitcnt lgkmcnt(0)" ::: "memory"); __builtin_amdgcn_sched_barrier(0);
#pragma unroll
                    for (int ks = 0; ks < 4; ++ks) { const bf16x8_t vf = (bf16x8_t){lo[ks][0], lo[ks][1], lo[ks][2], lo[ks][3], hh[ks][0], hh[ks][1], hh[ks][2], hh[ks][3]};
                        o[d0] = __builtin_amdgcn_mfma_f32_32x32x16_bf16(vf, __builtin_bit_cast(bf16x8_t, pw[ks]), o[d0], 0, 0, 0); } }
            }
            if (i + 1 < ntile) { LAS unsigned char* ns = L + ((i + 1) & 1) * AT_SLOT; *(LAS u32x4*)(ns + AT_KOFF + wave * 1024 + lane * 16) = kreg; *(LAS u32x4*)(ns + AT_VOFF + wave * 1024 + lane * 16) = vreg; }
            __syncthreads();
        }
        { const auto rr = __builtin_amdgcn_permlane32_swap(__float_as_uint(lsum), __float_as_uint(lsum), false, false); const float inv = 1.0f / (__uint_as_float(rr[0]) + __uint_as_float(rr[1]));
          g2::bf16_t* gp = w.GATE() + (size_t)mq * 512 + head * 64; unsigned long long gvv[2][4];
#pragma unroll
          for (int d0 = 0; d0 < 2; ++d0)
#pragma unroll
              for (int rq = 0; rq < 4; ++rq) gvv[d0][rq] = *(const unsigned long long*)(gp + 32 * d0 + 8 * rq + 4 * hi);
#pragma unroll
          for (int d0 = 0; d0 < 2; ++d0)
#pragma unroll
              for (int rq = 0; rq < 4; ++rq) { g2::bf16_t* p = gp + 32 * d0 + 8 * rq + 4 * hi; const unsigned long long gv = gvv[d0][rq]; const unsigned g0 = (unsigned)gv, g1 = (unsigned)(gv >> 32);
                  const float a0 = o[d0][4 * rq] * inv * __uint_as_float(g0 << 16), a1 = o[d0][4 * rq + 1] * inv * __uint_as_float(g0 & 0xffff0000u), a2 = o[d0][4 * rq + 2] * inv * __uint_as_float(g1 << 16), a3 = o[d0][4 * rq + 3] * inv * __uint_as_float(g1 & 0xffff0000u);
                  *(unsigned long long*)p = (unsigned long long)pg8::cvt_pk_bf16(a0, a1) | ((unsigned long long)pg8::cvt_pk_bf16(a2, a3) << 32); } }
    }
}


constexpr int CW_QUEUE = 2048, MIX_UNITS = 128 + 256 + 512;
__device__ __forceinline__ void ph_mixers(InP in, const W& w, int l, LAS unsigned char* L, volatile LAS unsigned* MISC) {
    const int tid_ = mk_fresh_tid();
    unsigned* ctr = w.ctl() + CW_QUEUE + 64 * l;
    for (;;) {
        __syncthreads();
        if (tid_ == 0) MISC[0] = __hip_atomic_fetch_add(ctr, 1u, __ATOMIC_RELAXED, __HIP_MEMORY_SCOPE_AGENT);
        __syncthreads();
        const int idx = (int)__builtin_amdgcn_readfirstlane(MISC[0]);
        if (idx >= MIX_UNITS) break;
        if (idx < 128) ssm_unit(in, w, l, L, idx, tid_);
        else if (idx < 384) attn_unit(in, w, l, L, idx - 128, tid_);
        else convpool_unit(in, w, l, L, idx - 384, tid_);
    }
}
struct Args { In in; float* out; unsigned char* ws; };
__device__ __forceinline__ W fresh_w() { const __attribute__((address_space(4))) Args* p = (const __attribute__((address_space(4))) Args*)__builtin_amdgcn_kernarg_segment_ptr(); asm volatile("" : "+s"(p)); W w; w.ws = p->ws; w.out = p->out; return w; }
__device__ __forceinline__ InP fresh_in() { InP p = (InP)__builtin_amdgcn_kernarg_segment_ptr(); asm volatile("" : "+s"(p)); return p; }

template <class F> __device__ __forceinline__ void run_stage(const F& f, long n) {
    const int tid_ = mk_fresh_tid();
    const long stride_ = (long)fresh_grid() * NTHREADS;
    for (long i = (long)blockIdx.x * NTHREADS + tid_; i < n; i += stride_) f(i);
}

__global__ void __launch_bounds__(NTHREADS, 2) mk_fwd(Args a) {
    extern __shared__ __attribute__((aligned(16))) unsigned char lds[];
    LAS unsigned char* L = (LAS unsigned char*)lds;
    volatile LAS unsigned* MISC = (volatile LAS unsigned*)(L + MISC_OFF);
    for (int u = threadIdx.x; u < (LDS_BYTES - LDSCTL_OFF) / 4; u += NTHREADS) ((LAS unsigned*)(L + LDSCTL_OFF))[u] = 0u;
    __syncthreads();
    if ((threadIdx.x & 63) == 0) *(volatile LAS unsigned*)(L + MK_WTAB_OFF + 4 * mk_hw_wave_slot()) = threadIdx.x >> 6;
    __syncthreads();
#define in fresh_in()
#define w fresh_w()
    (void)xcd_barrier_post((unsigned*)w.ctl() + CW_BAR, MISC + 8);
#define BAR() do { XcdBarrier b_; b_.bar = (unsigned*)w.ctl() + CW_BAR; b_.x = xb_xcc_id(); b_.st = MISC + 8; xcd_barrier(b_); } while (0)
    ph_mod(in, w, L); ph_poolfold(in, w, L); __syncthreads(); run_stage(g2::FRope{w}, 2048L * 32); run_stage(FSsmTab{in, w}, 2L * 2 * 32 * 64); run_stage(FCvtCache{in, w}, 2L * 2 * 2 * 256 * 128);
    ph_convert(in, w, L);
    BAR();
#pragma unroll 1
    for (int l = 0; l < 2; ++l) {
        ph_rows<false>(in, w, l); BAR();
        { pg8::Gemm g{w.H(), w.win() + (size_t)l * INC * 1024, M, INC, 1024}; pg8::StaticOrder S; S.init(M, INC, (int)gridDim.x, (int)blockIdx.x); Epi1 E{w, l};
          pg8::gemm_phase<Epi1, pg8::StaticOrder, true, true>(L, g, S, E); }
        BAR();
        ph_mixers(in, w, l, L, MISC); BAR();
        { pg8::Gemm g{w.YS(), w.wglu() + (size_t)l * 1024 * 512, M, 1024, 512}; SchedN1 S{(int)blockIdx.x}; Epi3 E{w};
          pg8::gemm_phase<Epi3, SchedN1, true, true, 1>(L, g, S, E); }
        BAR();
        { pg8::Gemm g{w.GATE(), w.wbr() + (size_t)l * 4 * 1024 * 512, 4 * M, 4 * 1024, 512}; Sched4a S{(int)blockIdx.x}; Epi4a E{w};
          pg8::gemm_phase<Epi4a, Sched4a, true, true, 1>(L, g, S, E); }
        BAR();
        { pg8::Gemm g{w.MRG(), w.wout() + (size_t)l * 1024 * 1024, M, 1024, 1024}; SchedN1 S{(int)blockIdx.x}; Epi4b E{in, w, l};
          pg8::gemm_phase<Epi4b, SchedN1, true, true, 1>(L, g, S, E); }
        BAR();
    }
    ph_rows<true>(in, w, 0);
#undef BAR
#undef in
#undef w
}
}

extern "C" void kernel_launch(void* const* d_in, const int* in_sizes, int n_in, void* d_out, int out_size, void* d_ws, size_t ws_size, hipStream_t stream) {
    static int grid = 0;
    if (grid == 0) {
        if (n_in != 30 || (size_t)out_size != g2::OUT_TOTAL || ws_size < g2::WS_END) { fprintf(stderr, "kernel_launch: unexpected problem shape (n_in %d out %d ws %zu)\n", n_in, out_size, ws_size); grid = -1; return; }
        int dev = 0, cus = 0, per_cu = 0;
        if (hipGetDevice(&dev) != hipSuccess || hipDeviceGetAttribute(&cus, hipDeviceAttributeMultiprocessorCount, dev) != hipSuccess) { grid = -1; return; }
        if (hipFuncSetAttribute((const void*)mk::mk_fwd, hipFuncAttributeMaxDynamicSharedMemorySize, mk::LDS_BYTES) != hipSuccess) { fprintf(stderr, "kernel_launch: hipFuncSetAttribute failed\n"); grid = -1; return; }
        if (hipOccupancyMaxActiveBlocksPerMultiprocessor(&per_cu, (const void*)mk::mk_fwd, mk::NTHREADS, mk::LDS_BYTES) != hipSuccess || per_cu < 1) { fprintf(stderr, "kernel_launch: occupancy query says %d blocks/CU\n", per_cu); (void)hipGetLastError(); grid = -1; return; }
        grid = cus;
    }
    if (grid < 0) return;
    if (hipMemsetAsync((char*)d_ws + g2::WS_CTL, 0, mk::CTL_ZERO_BYTES, stream) != hipSuccess) return;
    mk::Args a{}; const float* ptr[30]; for (int i = 0; i < 30; ++i) ptr[i] = (const float*)d_in[i]; memcpy(&a.in, ptr, sizeof(a.in));
    a.out = (float*)d_out; a.ws = (unsigned char*)d_ws;
    hipLaunchKernelGGL(mk::mk_fwd, dim3(grid), dim3(mk::NTHREADS), mk::LDS_BYTES, stream, a);
}
```

```cpp
#include <hip/hip_runtime.h>
#include <cstdio>
#include <cstring>
#include <cstdint>
#ifdef CPU_EMU
#include <cmath>
#include <cstddef>
#include <cstring>
#define HD_FN inline
#else
#define HD_FN __host__ __device__ __forceinline__
#endif

namespace g2 {
typedef unsigned short bf16_t;
#ifndef CFG_BATCH
#define CFG_BATCH 16
#endif
#ifndef CFG_DEC_BATCH
#define CFG_DEC_BATCH 2
#endif
constexpr int D = 1024, DEPTH = 2, NB_P = CFG_BATCH, L_P = 256, NB_S = CFG_DEC_BATCH, L_S = 2048, PAST = 256;
constexpr int MP = NB_P * L_P, MS = NB_S * L_S, M = MP + MS;
constexpr int GRID_W = 64, NH = 8, WINDOW = 128, CONVK = 31, SG = 32, SC = 16, SP = 64, INC = 8960, NT1 = INC / 256;
constexpr int C_XPOOL = 2816;
constexpr float EPS = 1e-6f;

HD_FN bf16_t f2bf(float f) { unsigned u; memcpy(&u, &f, 4); u = (u + 0x7fffu + ((u >> 16) & 1u)) >> 16; return (bf16_t)u; }
HD_FN float bf2f(bf16_t h) { unsigned u = (unsigned)h << 16; float f; memcpy(&f, &u, 4); return f; }
HD_FN float sigmoidf_(float x) { return 1.0f / (1.0f + expf(-x)); }
HD_FN float siluf_(float x) { return x * sigmoidf_(x); }
HD_FN float geluf_(float x) { return 0.5f * x * (1.0f + tanhf(0.7978845608028654f * (x + 0.044715f * x * x * x))); }

HD_FN int row_path(int m) { return m >= MP; }
HD_FN int row_len(int m) { return m >= MP ? L_S : L_P; }
HD_FN int row_seq0(int m) { return m >= MP ? MP + ((m - MP) / L_S) * L_S : (m / L_P) * L_P; }
HD_FN int row_batch(int m) { return m >= MP ? (m - MP) / L_S : m / L_P; }
HD_FN int row_modj(int m) { return m >= MP ? 1 + (m - MP) / L_S : 0; }

struct In {
    const float *x_prompt, *x_sample, *cache_k, *cache_v, *state_ssm, *c, *c_ctx, *norm_g, *w_ada, *b_ada, *w_in, *attn_sink, *conv_dw, *conv_db,
        *conv_ln_g, *conv_ln_b, *pool_w, *pool_scale, *lam_re, *lam_im, *log_dt, *b_re, *b_im, *c_re, *c_im, *ssm_d, *glu_w, *w_br, *w_out, *final_g;
};
#ifdef CPU_EMU
typedef const In* InP;
#else
typedef const __attribute__((address_space(4))) In* InP;
#endif
constexpr size_t OUT_YP = 0, OUT_YS = (size_t)MP * D, OUT_K = (size_t)M * D, OUT_V = OUT_K + (size_t)NB_P * DEPTH * L_P * 128, OUT_ST = OUT_V + (size_t)NB_P * DEPTH * L_P * 128,
                 OUT_TOTAL = OUT_ST + (size_t)NB_P * DEPTH * 2 * 2 * SG * SP;

constexpr size_t MiB = 1u << 20;
constexpr size_t WS_CTL = 0;
constexpr size_t WS_MOD = 1 * MiB;
constexpr size_t WS_ROPE = WS_MOD + 128 * 1024;
constexpr size_t WS_LAMB = WS_ROPE + 512 * 1024;
constexpr size_t WS_BBAR = WS_LAMB + 64 * 1024;
constexpr size_t WS_WIN = 4 * MiB;
constexpr size_t WS_WGLU = WS_WIN + (size_t)2 * INC * 1024 * 2;
constexpr size_t WS_WBR = WS_WGLU + 2 * MiB;
constexpr size_t WS_WOUT = WS_WBR + 8 * MiB;
constexpr size_t WS_H = WS_WOUT + 4 * MiB;
constexpr size_t WS_Q = WS_H + 16 * MiB;
constexpr size_t WS_XC = WS_Q + 8 * MiB;
constexpr size_t WS_MRGP = WS_H;
constexpr size_t WS_XP = WS_XC + 8 * MiB;
constexpr size_t WS_XS = WS_XP + 8 * MiB;
constexpr size_t WS_K = WS_XS + 8 * MiB;
constexpr size_t WS_V = WS_K + 2 * MiB;
constexpr size_t WS_GATE = WS_V + 2 * MiB;
constexpr size_t WS_GM = WS_GATE + 32 * MiB;
constexpr size_t WS_YS = WS_GM + 64 * MiB;
constexpr size_t WS_MRG = WS_YS + 8 * MiB;
constexpr size_t WS_TMP = WS_MRG + 16 * MiB;
constexpr size_t WS_S = WS_TMP + 16 * MiB;
constexpr size_t WS_END = WS_S + 32 * MiB;
static_assert(WS_END <= 293601280ull, "workspace map exceeds the guaranteed d_ws size");

struct W {
    unsigned char* ws; float* out;
    HD_FN unsigned* ctl() const { return (unsigned*)(ws + WS_CTL); }
    HD_FN float* mod() const { return (float*)(ws + WS_MOD); }
    HD_FN float* ropec() const { return (float*)(ws + WS_ROPE); }
    HD_FN float* ropes() const { return (float*)(ws + WS_ROPE) + 2048 * 32; }
    HD_FN float* lamb() const { return (float*)(ws + WS_LAMB); }
    HD_FN float* bbar() const { return (float*)(ws + WS_BBAR); }
    HD_FN bf16_t* win() const { return (bf16_t*)(ws + WS_WIN); }
    HD_FN bf16_t* wglu() const { return (bf16_t*)(ws + WS_WGLU); }
    HD_FN bf16_t* wbr() const { return (bf16_t*)(ws + WS_WBR); }
    HD_FN bf16_t* wout() const { return (bf16_t*)(ws + WS_WOUT); }
    HD_FN bf16_t* H() const { return (bf16_t*)(ws + WS_H); }
    HD_FN bf16_t* Q() const { return (bf16_t*)(ws + WS_Q); }
    HD_FN bf16_t* XC() const { return (bf16_t*)(ws + WS_XC); }
    HD_FN bf16_t* XP() const { return (bf16_t*)(ws + WS_XP); }
    HD_FN bf16_t* XS() const { return (bf16_t*)(ws + WS_XS); }
    HD_FN bf16_t* K() const { return (bf16_t*)(ws + WS_K); }
    HD_FN bf16_t* V() const { return (bf16_t*)(ws + WS_V); }
    HD_FN bf16_t* GATE() const { return (bf16_t*)(ws + WS_GATE); }
    HD_FN bf16_t* GM() const { return (bf16_t*)(ws + WS_GM); }
    HD_FN bf16_t* YS() const { return (bf16_t*)(ws + WS_YS); }
    HD_FN bf16_t* MRG() const { return (bf16_t*)(ws + WS_MRG); }
    HD_FN float* MRGP() const { return (float*)(ws + WS_MRGP); }
    HD_FN float* TMP() const { return (float*)(ws + WS_TMP); }
    HD_FN float* S() const { return (float*)(ws + WS_S); }
};
HD_FN W make_w(unsigned char* ws, float* out) { W w{}; w.ws = ws; w.out = out; return w; }

HD_FN const float* xrow(InP in, const W& w, int l, int m) { return l == 0 ? (m < MP ? in->x_prompt + (size_t)m * D : in->x_sample + (size_t)(m - MP) * D) : w.out + (size_t)m * D; }

HD_FN int in_orig_col(int row) { const int pn = row >> 8, c = row & 255, bj = c >> 7, cc = c & 127;
    if (pn < 2) return (pn * 4 + (cc >> 5)) * 64 + bj * 32 + (cc & 31);
    if (pn == 2) return cc < 64 ? 512 + (cc >> 5) * 64 + bj * 32 + (cc & 31) : 640 + bj * 64 + (cc - 64);
    if (pn < 5) return 768 + (pn - 3) * 256 + c;
    if (pn < 9) return 1280 + bj * 512 + (pn - 5) * 128 + cc;
    if (pn < 11) return 2304 + (pn - 9) * 256 + c;
    if (pn < 13) return 2816 + (pn - 11) * 256 + c;
    if (pn < 15) return 3328 + (pn - 13) * 256 + c;
    if (pn < 17) return 3840 + (pn - 15) * 256 + c;
    if (pn < 19) return 4352 + (pn - 17) * 256 + c;
    return 4864 + (pn - 19) * 256 + c; }
HD_FN int glu_orig_col(int row) { const int pn = row >> 8, c = row & 255, bj = c >> 7, cc = c & 127; return bj * 512 + pn * 128 + cc; }

struct FMod { InP in; W w;
    HD_FN void operator()(long i) const { int n = i % 3072; int j = (i / 3072) % 3; int l = i / (3 * 3072);
        const float* cv = j == 0 ? in->c_ctx : in->c + (size_t)(j - 1) * D; const float* wa = in->w_ada + (size_t)l * D * 3072;
        float acc = 0.f; for (int k = 0; k < D; ++k) acc += siluf_(cv[k]) * wa[(size_t)k * 3072 + n];
        w.mod()[i] = acc + in->b_ada[l * 3072 + n]; } };
struct FRope { W w;
    HD_FN void operator()(long i) const { int j = i % 32, t = i / 32; float row = (float)(t / GRID_W), col = (float)(t % GRID_W);
        float inv = powf(10000.0f, -(float)(j % 16) / 16.0f); float ang = (j < 16 ? row : col) * inv; w.ropec()[i] = cosf(ang); w.ropes()[i] = sinf(ang); } };
struct FSsmParam { InP in; W w;
    HD_FN void operator()(long i) const { int g = (i / SP) % SG; long ld = i / (SP * SG);
        float lr = in->lam_re[i], li = in->lam_im[i]; float dt = expf(in->log_dt[ld * SG + g]);
        float e = expf(lr * dt), br_ = e * cosf(li * dt), bi_ = e * sinf(li * dt); w.lamb()[2 * i] = br_; w.lamb()[2 * i + 1] = bi_;
        float nr = br_ - 1.0f, ni = bi_; float den = lr * lr + li * li; float fr = (nr * lr + ni * li) / den, fi = (ni * lr - nr * li) / den;
        for (int c = 0; c < SC; ++c) { float xr = in->b_re[i * SC + c], xi = in->b_im[i * SC + c];
            w.bbar()[(i * SC + c) * 2] = fr * xr - fi * xi; w.bbar()[(i * SC + c) * 2 + 1] = fr * xi + fi * xr; } } };
struct FCvtIn { InP in; W w;
    HD_FN void operator()(long i) const { int k = i % 1024; int row = (i / 1024) % INC; int l = i / ((long)INC * 1024); const int oc = in_orig_col(row);
        const float* src = in->w_in + ((size_t)l * D + k) * INC; float v;
        if (oc >= C_XPOOL && oc < C_XPOOL + 512) { const int g = (oc - C_XPOOL) >> 7, co = (oc - C_XPOOL) & 127; const float* pw = in->pool_w + ((size_t)l * 4 + g) * 128 * 128 + co; const float* s = src + C_XPOOL + g * 128;
            float acc = 0.f; for (int ci = 0; ci < 128; ++ci) acc += s[ci] * pw[(size_t)ci * 128]; v = acc * in->pool_scale[l * 512 + g * 128 + co]; }
        else v = src[oc];
        w.win()[i] = f2bf(v); } };
struct FCvtGlu { InP in; W w;
    HD_FN void operator()(long i) const { int k = i % 512; int row = (i / 512) % 1024; int l = i / (512 * 1024); w.wglu()[i] = f2bf(in->glu_w[((size_t)l * 512 + k) * 1024 + glu_orig_col(row)]); } };
struct FCvtBr { InP in; W w;
    HD_FN void operator()(long i) const { int k = i % 512; int d = (i / 512) % 1024; int ln = i / (512 * 1024); w.wbr()[i] = f2bf(in->w_br[((size_t)ln * 512 + k) * 1024 + d]); } };
struct FCvtOut { InP in; W w;
    HD_FN void operator()(long i) const { int k = i % 1024; int d = (i / 1024) % 1024; int l = i / (1024 * 1024); w.wout()[i] = f2bf(in->w_out[((size_t)l * 1024 + k) * 1024 + d]); } };

struct FH { InP in; W w; int l, pad;
    HD_FN void operator()(long m) const { const float* x = xrow(in, w, l, (int)m); float ss = 0.f; for (int k = 0; k < D; ++k) ss += x[k] * x[k];
        float r = 1.0f / sqrtf(ss / D + EPS); const float* mo = w.mod() + ((size_t)l * 3 + row_modj((int)m)) * 3072; const float* g = in->norm_g + l * D;
        for (int k = 0; k < D; ++k) w.H()[(size_t)m * D + k] = f2bf((x[k] * r) * g[k] * (1.0f + mo[1024 + k]) + mo[k]); } };

HD_FN void epi1(const W& w, int l, int m, int pn, int cc, float a0, float a1) {
    if (pn <= 2) { const bool smp = m >= MP; const int t = m - row_seq0(m);
        if (pn < 2 || cc < 64) { const int j = cc & 31; float o1 = a0, o2 = a1;
            if (smp) { const float cs = w.ropec()[t * 32 + j], sn = w.ropes()[t * 32 + j]; o1 = a0 * cs - a1 * sn; o2 = a0 * sn + a1 * cs; }
            if (pn < 2) { const int h = pn * 4 + (cc >> 5); w.Q()[(size_t)m * 512 + h * 64 + j] = f2bf(o1); w.Q()[(size_t)m * 512 + h * 64 + 32 + j] = f2bf(o2); }
            else { const int kv = cc >> 5; w.K()[(size_t)m * 128 + kv * 64 + j] = f2bf(o1); w.K()[(size_t)m * 128 + kv * 64 + 32 + j] = f2bf(o2);
                if (!smp) { float* o = w.out + OUT_K + (((size_t)row_batch(m) * DEPTH + l) * L_P + t) * 128 + kv * 64 + j; o[0] = a0; o[32] = a1; } } }
        else { const int c2 = cc - 64; w.V()[(size_t)m * 128 + c2] = f2bf(a0); w.V()[(size_t)m * 128 + 64 + c2] = f2bf(a1);
            if (!smp) { float* o = w.out + OUT_V + (((size_t)row_batch(m) * DEPTH + l) * L_P + t) * 128 + c2; o[0] = a0; o[64] = a1; } }
        return; }
    if (pn >= 5 && pn < 9) { w.XC()[(size_t)m * 512 + (pn - 5) * 128 + cc] = f2bf(a0 * sigmoidf_(a1)); return; }
    if (pn >= 19) { bf16_t* o = w.GM() + (size_t)m * 4096 + (pn - 19) * 256 + cc; o[0] = f2bf(sigmoidf_(a0)); o[128] = f2bf(sigmoidf_(a1)); return; }
    if (pn == 11 || pn == 12) { bf16_t* o = w.XP() + (size_t)m * 512 + (pn - 11) * 256 + cc; o[0] = f2bf(a0); o[128] = f2bf(a1); return; }
    if (pn == 15 || pn == 16) { bf16_t* o = w.XS() + (size_t)m * 512 + (pn - 15) * 256 + cc; o[0] = f2bf(a0); o[128] = f2bf(a1); return; }
    { const int br = pn < 5 ? 0 : pn < 11 ? 1 : pn < 15 ? 2 : 3; const int t0 = br == 0 ? 3 : br == 1 ? 9 : br == 2 ? 13 : 17;
      bf16_t* o = w.GATE() + ((size_t)br * M + m) * 512 + (pn - t0) * 256 + cc; o[0] = f2bf(siluf_(a0)); o[128] = f2bf(siluf_(a1)); } }
struct FG1 { InP in; W w; int l, pad;
    HD_FN void operator()(long i) const { int cc = i % 128; int pn = (i / 128) % NT1; int m = i / (128 * NT1); const bf16_t* a = w.H() + (size_t)m * D;
        const bf16_t* b0 = w.win() + ((size_t)l * INC + pn * 256 + cc) * D; const bf16_t* b1 = b0 + (size_t)128 * D; float a0 = 0.f, a1 = 0.f;
        for (int k = 0; k < D; ++k) { const float av = bf2f(a[k]); a0 += av * bf2f(b0[k]); a1 += av * bf2f(b1[k]); }
        epi1(w, l, m, pn, cc, a0, a1); } };

struct FAttn { InP in; W w; int l, pad;
    HD_FN void operator()(long i) const { int dp = i % 4, hh = (i / 4) % 8; int m = i / 32; const bool smp = m >= MP; const int L = row_len(m), s0 = row_seq0(m), t = m - s0, kv = hh / 4, bb = row_batch(m);
        const bf16_t* q = w.Q() + (size_t)m * 512 + hh * 64; const float sink = in->attn_sink[l * NH + hh];
        const float* ck = in->cache_k + (((size_t)bb * DEPTH + l) * PAST) * 128 + kv * 64; const float* cvp = in->cache_v + (((size_t)bb * DEPTH + l) * PAST) * 128 + kv * 64;
        int lo, hi; if (!smp) { lo = 0; hi = L - 1; } else { lo = t - WINDOW < 0 ? 0 : t - WINDOW; hi = t + WINDOW > L - 1 ? L - 1 : t + WINDOW; }
        const int nctx = smp ? PAST : 0; float mx = sink;
        for (int pass = 0; pass < 2; ++pass) { float den = 0.f, acc[16];
#pragma unroll
            for (int d = 0; d < 16; ++d) acc[d] = 0.f;
            for (int kk = 0; kk < nctx + (hi - lo + 1); ++kk) { float sc = 0.f;
                if (kk < nctx) { const float* kp = ck + (size_t)kk * 128; for (int d = 0; d < 64; ++d) sc += bf2f(q[d]) * kp[d]; }
                else { const bf16_t* kp = w.K() + (size_t)(s0 + lo + kk - nctx) * 128 + kv * 64; for (int d = 0; d < 64; ++d) sc += bf2f(q[d]) * bf2f(kp[d]); }
                sc *= 0.125f;
                if (pass == 0) { mx = sc > mx ? sc : mx; }
                else { const float p = expf(sc - mx); den += p;
                    if (kk < nctx) { const float* vp = cvp + (size_t)kk * 128 + dp * 16;
#pragma unroll
                        for (int d = 0; d < 16; ++d) acc[d] += p * vp[d]; }
                    else { const bf16_t* vp = w.V() + (size_t)(s0 + lo + kk - nctx) * 128 + kv * 64 + dp * 16;
#pragma unroll
                        for (int d = 0; d < 16; ++d) acc[d] += p * bf2f(vp[d]); } } }
            if (pass == 1) { den += expf(sink - mx); bf16_t* o = w.GATE() + (size_t)m * 512 + hh * 64 + dp * 16;
#pragma unroll
                for (int d = 0; d < 16; ++d) o[d] = f2bf(acc[d] / den * bf2f(o[d])); } } } };
struct FConv { InP in; W w; int l, pad;
    HD_FN void operator()(long i) const { int ch = i % 512; int m = i / 512; const int L = row_len(m), s0 = row_seq0(m), t = m - s0; float acc = in->conv_db[l * 512 + ch];
        for (int j = 0; j < CONVK; ++j) { int tt = t + j - CONVK / 2; if (tt < 0 || tt >= L) continue; acc += bf2f(w.XC()[(size_t)(s0 + tt) * 512 + ch]) * in->conv_dw[((size_t)l * CONVK + j) * 512 + ch]; }
        w.TMP()[i] = acc; } };
struct FConvLn { InP in; W w; int l, pad;
    HD_FN void operator()(long m) const { const float* y = w.TMP() + (size_t)m * 512; float mu = 0.f; for (int k = 0; k < 512; ++k) mu += y[k]; mu /= 512.f;
        float var = 0.f; for (int k = 0; k < 512; ++k) { float d = y[k] - mu; var += d * d; } float r = 1.0f / sqrtf(var / 512.f + EPS); bf16_t* o = w.GATE() + ((size_t)1 * M + m) * 512;
        for (int k = 0; k < 512; ++k) o[k] = f2bf(siluf_((y[k] - mu) * r * in->conv_ln_g[l * 512 + k] + in->conv_ln_b[l * 512 + k]) * bf2f(o[k])); } };
struct FPool { W w;
    HD_FN void operator()(long i) const { int ch = i % 512; int m = i / 512; const int L = row_len(m), s0 = row_seq0(m), t = m - s0; const int wd = 2 << (ch / 128);
        int lo = t - wd / 2 < 0 ? 0 : t - wd / 2, hi = t + wd / 2 > L ? L : t + wd / 2; float sum = 0.f;
        for (int tt = lo; tt < hi; ++tt) sum += bf2f(w.XP()[(size_t)(s0 + tt) * 512 + ch]);
        bf16_t* o = w.GATE() + ((size_t)2 * M + m) * 512 + ch; *o = f2bf((sum / (float)(hi - lo) - bf2f(w.XP()[(size_t)m * 512 + ch])) * bf2f(*o)); } };
struct FSsmBu { W w; int l, dir, m0, pad;
    HD_FN void operator()(long i) const { int p = i % SP, g = (i / SP) % SG; int tl = i / (SP * SG); const bf16_t* x = w.XS() + (size_t)(m0 + tl) * 512 + g * SC;
        const float* bb = w.bbar() + ((((size_t)l * 2 + dir) * SG + g) * SP + p) * SC * 2; float ar = 0.f, ai = 0.f;
        for (int k = 0; k < SC; ++k) { const float xv = bf2f(x[k]); ar += xv * bb[2 * k]; ai += xv * bb[2 * k + 1]; } w.S()[2 * i] = ar; w.S()[2 * i + 1] = ai; } };
struct FSsmScan { InP in; W w; int l, dir, m0, pad;
    HD_FN void operator()(long i) const { int p = i % SP, g = (i / SP) % SG; int s = i / (SP * SG); const int L = row_len(m0); const int bb = row_batch(m0) + s;
        const float* lb = w.lamb() + ((((size_t)l * 2 + dir) * SG + g) * SP + p) * 2; float lr = lb[0], li = lb[1]; float hr = 0.f, hi = 0.f;
        if (m0 >= MP) { const float* st = in->state_ssm + ((((size_t)bb * DEPTH + l) * 2 + dir) * 2) * SG * SP + g * SP + p; hr = st[0]; hi = st[SG * SP]; }
        for (int k = 0; k < L; ++k) { int t = dir == 0 ? k : L - 1 - k; float* S = w.S() + (((size_t)(s * L + t) * SG + g) * SP + p) * 2;
            float nr = lr * hr - li * hi + S[0], ni = lr * hi + li * hr + S[1]; hr = nr; hi = ni; S[0] = hr; S[1] = hi; }
        if (m0 < MP) { float* o = w.out + OUT_ST + ((((size_t)bb * DEPTH + l) * 2 + dir) * 2) * SG * SP + g * SP + p; o[0] = hr; o[SG * SP] = hi; } } };
struct FSsmY { InP in; W w; int l, dir, m0, pad;
    HD_FN void operator()(long i) const { int gc = i % 512; int tl = i / 512; int g = gc / SC, ch = gc % SC; const int m = m0 + tl; const float* S = w.S() + ((size_t)tl * SG + g) * SP * 2;
        const float* cr = in->c_re + ((((size_t)l * 2 + dir) * SG + g) * SC + ch) * SP; const float* cim = in->c_im + ((((size_t)l * 2 + dir) * SG + g) * SC + ch) * SP;
        float acc = 0.f; for (int p = 0; p < SP; ++p) acc += S[2 * p] * cr[p] - S[2 * p + 1] * cim[p];
        float* y = w.TMP() + (size_t)m * 512 + gc;
        if (dir == 0) *y = acc + in->ssm_d[l * 512 + gc] * bf2f(w.XS()[(size_t)m * 512 + gc]); else w.YS()[(size_t)m * 512 + gc] = f2bf(geluf_(*y + acc)); } };
HD_FN void epi3(const W& w, int m, int pn, int cc, float a0, float a1) { bf16_t* o = w.GATE() + ((size_t)3 * M + m) * 512 + pn * 128 + cc; *o = f2bf(a0 * sigmoidf_(a1) * bf2f(*o)); }
struct FG3 { W w; int l, pad;
    HD_FN void operator()(long i) const { int cc = i % 128; int pn = (i / 128) % 4; int m = i / 512; const bf16_t* a = w.YS() + (size_t)m * 512;
        const bf16_t* b0 = w.wglu() + ((size_t)l * 1024 + pn * 256 + cc) * 512; const bf16_t* b1 = b0 + (size_t)128 * 512; float a0 = 0.f, a1 = 0.f;
        for (int k = 0; k < 512; ++k) { const float av = bf2f(a[k]); a0 += av * bf2f(b0[k]); a1 += av * bf2f(b1[k]); }
        epi3(w, m, pn, cc, a0, a1); } };
struct FG4a { W w; int l, pad;
    HD_FN void operator()(long i) const { int d = i % 1024; int m = i / 1024; float mg = 0.f;
        for (int n = 0; n < 4; ++n) { const bf16_t* a = w.GATE() + ((size_t)n * M + m) * 512; const bf16_t* b = w.wbr() + (((size_t)l * 4 + n) * 1024 + d) * 512; float acc = 0.f;
            for (int k = 0; k < 512; ++k) acc += bf2f(a[k]) * bf2f(b[k]); mg += bf2f(w.GM()[(size_t)m * 4096 + n * 1024 + d]) * acc; }
        w.MRG()[i] = f2bf(mg); } };
struct FG4b { InP in; W w; int l, pad;
    HD_FN void operator()(long i) const { int d = i % 1024; int m = i / 1024; const bf16_t* a = w.MRG() + (size_t)m * 1024; const bf16_t* b = w.wout() + ((size_t)l * 1024 + d) * 1024; float acc = 0.f;
        for (int k = 0; k < 1024; ++k) acc += bf2f(a[k]) * bf2f(b[k]);
        const float gate = w.mod()[((size_t)l * 3 + row_modj(m)) * 3072 + 2048 + d]; w.out[i] = xrow(in, w, l, m)[d] + gate * acc; } };
struct FFinal { InP in; W w;
    HD_FN void operator()(long m) const { float* xr = w.out + (size_t)m * D; float ss = 0.f; for (int k = 0; k < D; ++k) ss += xr[k] * xr[k]; float r = 1.0f / sqrtf(ss / D + EPS);
        for (int k = 0; k < D; ++k) xr[k] = xr[k] * r * in->final_g[k]; } };

template <class Runner> inline void forward(InP in, const W& w, Runner& R) {
    R(FMod{in, w}, 2L * 3 * 3072); R(FRope{w}, 2048L * 32); R(FSsmParam{in, w}, 2L * 2 * SG * SP);
    R(FCvtIn{in, w}, 2L * INC * 1024); R(FCvtGlu{in, w}, 2L * 1024 * 512); R(FCvtBr{in, w}, 2L * 4 * 1024 * 512); R(FCvtOut{in, w}, 2L * 1024 * 1024);
    for (int l = 0; l < DEPTH; ++l) {
        R(FH{in, w, l, 0}, (long)M);
        R(FG1{in, w, l, 0}, (long)M * NT1 * 128);
        R(FAttn{in, w, l, 0}, (long)M * 32);
        R(FConv{in, w, l, 0}, (long)M * 512); R(FConvLn{in, w, l, 0}, (long)M);
        R(FPool{w}, (long)M * 512);
        for (int m0 = 0; m0 < M;) { const int L = row_len(m0); int nrows = 2048; if (m0 < MP && m0 + nrows > MP) nrows = MP - m0; const int nseq = nrows / L;
            for (int dir = 0; dir < 2; ++dir) { R(FSsmBu{w, l, dir, m0, 0}, (long)nrows * SG * SP); R(FSsmScan{in, w, l, dir, m0, 0}, (long)nseq * SG * SP); R(FSsmY{in, w, l, dir, m0, 0}, (long)nrows * 512); }
            m0 += nrows; }
        R(FG3{w, l, 0}, (long)M * 512);
        R(FG4a{w, l, 0}, (long)M * 1024);
        R(FG4b{in, w, l, 0}, (long)M * 1024);
    }
    R(FFinal{in, w}, (long)M);
}
}
#define MK_WTAB_OFF (131072 + 512)
__device__ __forceinline__ unsigned mk_hw_wave_slot() { return (unsigned)__builtin_amdgcn_s_getreg(((6 - 1) << 11) | 4) & 63u; }
__device__ __forceinline__ int mk_fresh_tid() { extern __shared__ __attribute__((aligned(16))) unsigned char mk_lds_[];
    const unsigned wv = *(const volatile __attribute__((address_space(3))) unsigned*)((__attribute__((address_space(3))) unsigned char*)mk_lds_ + MK_WTAB_OFF + 4 * mk_hw_wave_slot());
    unsigned ln; asm volatile("v_mbcnt_lo_u32_b32 %0, -1, 0\n\tv_mbcnt_hi_u32_b32 %0, -1, %0" : "=v"(ln));
    int t = (int)((unsigned)__builtin_amdgcn_readfirstlane((int)wv) * 64u + ln); return t; }
namespace pg8 {
#define PG8_LAS __attribute__((address_space(3)))
typedef unsigned short bf16_t;
typedef short bf16x8 __attribute__((ext_vector_type(8)));
typedef float f32x4 __attribute__((ext_vector_type(4)));
typedef unsigned u32x4 __attribute__((ext_vector_type(4)));
constexpr int BM = 256, BK = 64, HALF = 128, HTB = HALF * BK * 2  , STAGE_BYTES = 8 * HTB, NXCD = 8, WGM = 8;

__host__ __device__ __forceinline__ int lds_byte(int r, int c) { const int st = (r >> 4) * 2 + (c >> 5), rr = r & 15, cc = c & 31, ob = rr * 64 + cc * 2; return st * 1024 + (ob ^ (((ob >> 9) & 1) << 5)); }
__host__ __device__ __forceinline__ void stage_rc(int b, int& R, int& C) { const int st = b / 1024, sb = b % 1024, swz = sb ^ (((sb >> 9) & 1) << 5); R = (st >> 1) * 16 + swz / 64; C = (st & 1) * 32 + (swz % 64) / 2; }
__host__ __device__ __forceinline__ int perm32(int rho) { const int n = rho >> 4, i = rho & 15; return 8 * (i >> 2) + 4 * n + (i & 3); }

struct Unit { int pm, pn; };
struct Gemm { const bf16_t* A; const bf16_t* Bt; int M, N, K; };

struct StaticOrder {
    int nM, nN, nwg, G, c;
    __host__ __device__ void init(int M, int N, int G_, int c_) { nM = M / BM; nN = N / BM; nwg = nM * nN; G = G_; c = c_; }
    __host__ __device__ bool next(int i, Unit& u) const {
        const long L = (long)i * G + c; if (L >= nwg) return false;
        int wgid = (int)L; { const int q = nwg / NXCD, r = nwg % NXCD, xcd = wgid % NXCD, off = wgid / NXCD; wgid = (xcd < r ? xcd * (q + 1) : r * (q + 1) + (xcd - r) * q) + off; }
        const int nig = WGM * nN, gid = wgid / nig, fm = gid * WGM, gsz = (nM - fm) < WGM ? (nM - fm) : WGM;
        u.pm = fm + ((wgid % nig) % gsz); u.pn = (wgid % nig) / gsz; return true;
    }
    __device__ __forceinline__ void a_ready(const Unit&) const {}
    __device__ __forceinline__ void done(const Unit&) const {}
};

__device__ __forceinline__ unsigned cvt_pk_bf16(float lo, float hi) { unsigned r; asm volatile("v_cvt_pk_bf16_f32 %0, %1, %2" : "=v"(r) : "v"(lo), "v"(hi)); return r; }
typedef float f32x2 __attribute__((ext_vector_type(2)));
template <class Epi, class Sched, bool ALIGN_EPI = false, bool SP2 = false, int NB = 2>
__device__ __forceinline__ void gemm_phase(PG8_LAS unsigned char* lds, const Gemm g, const Sched& S, const Epi& E) {
    const int tid_ = mk_fresh_tid();
    const int tid = tid_, wid = __builtin_amdgcn_readfirstlane(tid >> 6), lane = tid & 63, wr = wid >> 2, wc = wid & 3, fr = lane & 15, fq = lane >> 4;
    const int K = g.K, nt = K / BK;
    unsigned voffA[2], voffB[2];
#pragma unroll
    for (int i = 0; i < 2; ++i) { int R, C; stage_rc(tid * 16 + i * 8192, R, C); const int Rb = Epi::PERM ? ((R & ~31) + perm32(R & 31)) : R;
        voffA[i] = (unsigned)(R * K + C) * 2u; voffB[i] = (unsigned)(Rb * K + C) * 2u; }
    const size_t kstep = (size_t)(BK * 2);
    const size_t hstep = (size_t)HALF * K * 2;
    const size_t tstep = 2 * hstep;
    const size_t tstepB = NB == 2 ? tstep : hstep;
    static_assert(NB == 2 || (NB == 1 && SP2), "NB == 1 is implemented for the SP2 loop only");
    const unsigned ldsw = (unsigned)wid * 1024u;
    const int aoff = lds_byte(wr * 64 + fr, fq * 8), boff = lds_byte(wc * 32 + fr, fq * 8);
#define PG8_SA(b, h) (((b) * 2 + (h)) * HTB)
#define PG8_SB(b, h) ((4 + (b) * 2 + (h)) * HTB)
#define PG8_STAGE(bufoff, gbase, voff) do { _Pragma("unroll") for (int _i = 0; _i < 2; ++_i) \
        __builtin_amdgcn_global_load_lds((const unsigned*)((const char*)(gbase) + (voff)[_i]), (PG8_LAS unsigned*)(lds + (bufoff) + ldsw + _i * 8192), 16, 0, 0); } while (0)
#define PG8_LDA(dst, b, h) do { _Pragma("unroll") for (int m = 0; m < 4; ++m) _Pragma("unroll") for (int k = 0; k < 2; ++k) dst[m][k] = *(const PG8_LAS bf16x8*)(lds + PG8_SA(b, h) + aoff + m * 2048 + k * 1024); } while (0)
#define PG8_LDB(dst, b, h) do { _Pragma("unroll") for (int n = 0; n < 2; ++n) _Pragma("unroll") for (int k = 0; k < 2; ++k) dst[n][k] = *(const PG8_LAS bf16x8*)(lds + PG8_SB(b, h) + boff + n * 2048 + k * 1024); } while (0)
#define PG8_MMA(ai, bj, At, Bt) do { __builtin_amdgcn_s_setprio(1); _Pragma("unroll") for (int m = 0; m < 4; ++m) _Pragma("unroll") for (int n = 0; n < 2; ++n) _Pragma("unroll") for (int k = 0; k < 2; ++k) \
        acc[ai][bj][m][n] = __builtin_amdgcn_mfma_f32_16x16x32_bf16(Bt[n][k], At[m][k], acc[ai][bj][m][n], 0, 0, 0); __builtin_amdgcn_s_setprio(0); } while (0)
#define PG8_WAIT_V(n) asm volatile("s_waitcnt vmcnt(" #n ")" ::: "memory")
#define PG8_WAIT_L(n) asm volatile("s_waitcnt lgkmcnt(" #n ")" ::: "memory")
#define PG8_WAIT_VL do { if constexpr (NB == 2) PG8_WAIT_V(8); else PG8_WAIT_V(6); PG8_WAIT_L(0); } while (0)
#define PG8_BAR __builtin_amdgcn_s_barrier()
#define PG8_SCHED __builtin_amdgcn_sched_barrier(0)
    Unit cur, nxt; int ui = 0;
    if (!S.next(0, cur)) return;
    f32x4 acc[2][NB][4][2];
#pragma unroll
    for (int a = 0; a < 2; ++a)
#pragma unroll
        for (int b = 0; b < NB; ++b)
#pragma unroll
            for (int m = 0; m < 4; ++m)
#pragma unroll
                for (int n = 0; n < 2; ++n) acc[a][b][m][n] = (f32x4){0.f, 0.f, 0.f, 0.f};
    bf16x8 At[4][2], B0[2][2], B1[2][2];
    const char* cA = (const char*)g.A + (size_t)cur.pm * tstep; const char* cB = (const char*)g.Bt + (size_t)cur.pn * tstepB;
    S.a_ready(cur);
    if constexpr (SP2) {
        PG8_STAGE(PG8_SB(0, 0), cB, voffB); if constexpr (NB == 2) PG8_STAGE(PG8_SB(0, 1), cB + hstep, voffB); PG8_STAGE(PG8_SA(0, 0), cA, voffA); PG8_STAGE(PG8_SA(0, 1), cA + hstep, voffA);
        if (wr == 1) PG8_BAR;
        PG8_WAIT_V(2); PG8_BAR;
        PG8_STAGE(PG8_SB(1, 0), cB + kstep, voffB); PG8_STAGE(PG8_SA(1, 0), cA + kstep, voffA); if constexpr (NB == 2) PG8_STAGE(PG8_SB(1, 1), cB + hstep + kstep, voffB);
        if constexpr (NB == 2) PG8_WAIT_V(6); else PG8_WAIT_V(4);
        PG8_BAR;
    } else {
        PG8_STAGE(PG8_SB(0, 0), cB, voffB); PG8_STAGE(PG8_SA(0, 0), cA, voffA); PG8_STAGE(PG8_SB(0, 1), cB + hstep, voffB); PG8_STAGE(PG8_SA(0, 1), cA + hstep, voffA);
        if (wr == 1) PG8_BAR;
        PG8_WAIT_V(4); PG8_BAR;
        PG8_STAGE(PG8_SB(1, 0), cB + kstep, voffB); PG8_STAGE(PG8_SA(1, 0), cA + kstep, voffA); PG8_STAGE(PG8_SB(1, 1), cB + hstep + kstep, voffB);
        PG8_WAIT_V(6); PG8_BAR;
    }
    for (;;) {
        const bool has_next = S.next(ui + 1, nxt);
        const char* nA = has_next ? (const char*)g.A + (size_t)nxt.pm * tstep : cA; const char* nB = has_next ? (const char*)g.Bt + (size_t)nxt.pn * tstepB : cB;
        for (int t = 0; t < nt; t += 2) {
            const bool last = (t == nt - 2);
            const char* a1 = cA + (size_t)(t + 1) * kstep;
            const char* a2 = last ? nA : cA + (size_t)(t + 2) * kstep; const char* b2 = last ? nB : cB + (size_t)(t + 2) * kstep;
            const char* a3 = a2 + kstep; const char* b3 = b2 + kstep;
            if (last && has_next) S.a_ready(nxt);
            if constexpr (SP2) {
            PG8_LDB(B0, 0, 0); if constexpr (NB == 2) PG8_LDB(B1, 0, 1); PG8_SCHED; PG8_LDA(At, 0, 0); PG8_STAGE(PG8_SA(1, 1), a1 + hstep, voffA);
            PG8_WAIT_VL; PG8_BAR; PG8_MMA(0, 0, At, B0); if constexpr (NB == 2) PG8_MMA(0, 1, At, B1); PG8_BAR; PG8_SCHED;
            PG8_LDA(At, 0, 1); PG8_STAGE(PG8_SB(0, 0), b2, voffB); if constexpr (NB == 2) PG8_STAGE(PG8_SB(0, 1), b2 + hstep, voffB); PG8_STAGE(PG8_SA(0, 0), a2, voffA);
            PG8_WAIT_VL; PG8_BAR; PG8_MMA(1, 0, At, B0); if constexpr (NB == 2) PG8_MMA(1, 1, At, B1); PG8_BAR; PG8_SCHED;
            PG8_LDB(B0, 1, 0); if constexpr (NB == 2) PG8_LDB(B1, 1, 1); PG8_SCHED; PG8_LDA(At, 1, 0); PG8_STAGE(PG8_SA(0, 1), a2 + hstep, voffA);
            PG8_WAIT_VL; PG8_BAR; PG8_MMA(0, 0, At, B0); if constexpr (NB == 2) PG8_MMA(0, 1, At, B1); PG8_BAR; PG8_SCHED;
            PG8_LDA(At, 1, 1); PG8_STAGE(PG8_SB(1, 0), b3, voffB); if constexpr (NB == 2) PG8_STAGE(PG8_SB(1, 1), b3 + hstep, voffB); PG8_STAGE(PG8_SA(1, 0), a3, voffA);
            PG8_WAIT_VL; PG8_BAR; PG8_MMA(1, 0, At, B0); if constexpr (NB == 2) PG8_MMA(1, 1, At, B1); PG8_BAR; PG8_SCHED;
            } else {
            PG8_LDB(B0, 0, 0); PG8_SCHED; PG8_LDA(At, 0, 0); PG8_STAGE(PG8_SA(1, 1), a1 + hstep, voffA);
            PG8_WAIT_L(8); PG8_BAR; PG8_WAIT_L(0); PG8_MMA(0, 0, At, B0); PG8_BAR; PG8_SCHED;
            PG8_LDB(B1, 0, 1); PG8_STAGE(PG8_SB(0, 0), b2, voffB);
            PG8_BAR; PG8_WAIT_L(0); PG8_MMA(0, 1, At, B1); PG8_BAR;
            PG8_LDA(At, 0, 1); PG8_STAGE(PG8_SA(0, 0), a2, voffA);
            PG8_BAR; PG8_WAIT_L(0); PG8_MMA(1, 0, At, B0); PG8_BAR; PG8_SCHED;
            PG8_STAGE(PG8_SB(0, 1), b2 + hstep, voffB);
            PG8_WAIT_V(6); PG8_BAR; PG8_MMA(1, 1, At, B1); PG8_BAR;
            PG8_LDB(B0, 1, 0); PG8_SCHED; PG8_LDA(At, 1, 0); PG8_STAGE(PG8_SA(0, 1), a2 + hstep, voffA);
            PG8_WAIT_L(8); PG8_BAR; PG8_WAIT_L(0); PG8_MMA(0, 0, At, B0); PG8_BAR; PG8_SCHED;
            PG8_LDB(B1, 1, 1); PG8_STAGE(PG8_SB(1, 0), b3, voffB);
            PG8_BAR; PG8_WAIT_L(0); PG8_MMA(0, 1, At, B1); PG8_BAR;
            PG8_LDA(At, 1, 1); PG8_STAGE(PG8_SA(1, 0), a3, voffA);
            PG8_BAR; PG8_WAIT_L(0); PG8_MMA(1, 0, At, B0); PG8_BAR; PG8_SCHED;
            PG8_STAGE(PG8_SB(1, 1), b3 + hstep, voffB);
            PG8_WAIT_V(6); PG8_BAR; PG8_MMA(1, 1, At, B1); PG8_BAR;
            }
        }
        if constexpr (ALIGN_EPI) { if (wr == 0) PG8_BAR; }
        if constexpr (!Epi::AFTER_DRAIN) { E(acc, cur, wr, wc, fr, fq); S.done(cur); }
        if (!has_next) break;
#pragma unroll
        for (int a = 0; a < 2; ++a)
#pragma unroll
            for (int b = 0; b < NB; ++b)
#pragma unroll
                for (int m = 0; m < 4; ++m)
#pragma unroll
                    for (int n = 0; n < 2; ++n) acc[a][b][m][n] = (f32x4){0.f, 0.f, 0.f, 0.f};
        cur = nxt; cA = nA; cB = nB; ++ui;
        if constexpr (ALIGN_EPI) { if (wr == 1) PG8_BAR; }
    }
    PG8_WAIT_V(0);
    if constexpr (!ALIGN_EPI) { if (wr == 0) PG8_BAR; }
    PG8_BAR;
    if constexpr (Epi::AFTER_DRAIN) { E.fused(acc, cur, wr, wc, fr, fq, lds, wid, lane); S.done(cur); }
#undef PG8_SA
#undef PG8_SB
#undef PG8_STAGE
#undef PG8_LDA
#undef PG8_LDB
#undef PG8_MMA
#undef PG8_WAIT_V
#undef PG8_WAIT_L
#undef PG8_WAIT_VL
#undef PG8_BAR
#undef PG8_SCHED
}
}
namespace pg8 {
template <class Epi, class Sched>
__device__ __forceinline__ void gemm_phase_n1(PG8_LAS unsigned char* lds, const Gemm g, const Sched& S, const Epi& E) {
    const int tid_ = mk_fresh_tid();
    const int tid = tid_, wid = __builtin_amdgcn_readfirstlane(tid >> 6), lane = tid & 63, wr = wid >> 2, wc = wid & 3, fr = lane & 15, fq = lane >> 4;
    const int K = g.K, nt = K / BK;
    unsigned voffA[2], voffB[2];
#pragma unroll
    for (int i = 0; i < 2; ++i) { int R, C; stage_rc(tid * 16 + i * 8192, R, C); const int Rb = Epi::PERM ? ((R & ~31) + perm32(R & 31)) : R;
        voffA[i] = (unsigned)(R * K + C) * 2u; voffB[i] = (unsigned)(Rb * K + C) * 2u; }
    const size_t kstep = (size_t)(BK * 2), hstep = (size_t)HALF * K * 2, tstep = 2 * hstep;
    const unsigned ldsw = (unsigned)wid * 1024u;
    const int aoff = lds_byte(wr * 64 + fr, fq * 8), boff = lds_byte(wc * 32 + fr, fq * 8);
#define N1_SA(b, h) (((b) * 2 + (h)) * HTB)
#define N1_SB(b) ((4 + (b) * 2) * HTB)
#define N1_STAGE(bufoff, gbase, voff) do { _Pragma("unroll") for (int _i = 0; _i < 2; ++_i) \
        __builtin_amdgcn_global_load_lds((const unsigned*)((const char*)(gbase) + (voff)[_i]), (PG8_LAS unsigned*)(lds + (bufoff) + ldsw + _i * 8192), 16, 0, 0); } while (0)
#define N1_STAGE3(b, pa, pb) do { N1_STAGE(N1_SB(b), pb, voffB); N1_STAGE(N1_SA(b, 0), pa, voffA); N1_STAGE(N1_SA(b, 1), (pa) + hstep, voffA); } while (0)
#define N1_LDA(dst, b, h) do { _Pragma("unroll") for (int m = 0; m < 4; ++m) _Pragma("unroll") for (int k = 0; k < 2; ++k) dst[m][k] = *(const PG8_LAS bf16x8*)(lds + N1_SA(b, h) + aoff + m * 2048 + k * 1024); } while (0)
#define N1_LDB(dst, b) do { _Pragma("unroll") for (int n = 0; n < 2; ++n) _Pragma("unroll") for (int k = 0; k < 2; ++k) dst[n][k] = *(const PG8_LAS bf16x8*)(lds + N1_SB(b) + boff + n * 2048 + k * 1024); } while (0)
#define N1_MMA(ai, At) do { _Pragma("unroll") for (int m = 0; m < 4; ++m) _Pragma("unroll") for (int n = 0; n < 2; ++n) _Pragma("unroll") for (int k = 0; k < 2; ++k) \
        acc[ai][0][m][n] = __builtin_amdgcn_mfma_f32_16x16x32_bf16(B0[n][k], At[m][k], acc[ai][0][m][n], 0, 0, 0); } while (0)
#define N1_WAIT_V(n) asm volatile("s_waitcnt vmcnt(" #n ")" ::: "memory")
#define N1_WAIT_L0 asm volatile("s_waitcnt lgkmcnt(0)" ::: "memory")
#define N1_BAR __builtin_amdgcn_s_barrier()
#define N1_TILE(b, sa, sb) do { N1_LDB(B0, b); N1_LDA(At0, b, 0); N1_LDA(At1, b, 1); N1_WAIT_L0; N1_BAR; \
        if (sa) { N1_STAGE3(b, sa, sb); } __builtin_amdgcn_sched_barrier(0); N1_MMA(0, At0); N1_MMA(1, At1); __builtin_amdgcn_sched_barrier(0); \
        if (sa) N1_WAIT_V(6); else N1_WAIT_V(0); N1_BAR; } while (0)
    Unit cur, nxt; int ui = 0;
    if (!S.next(0, cur)) return;
    f32x4 acc[2][1][4][2];
#pragma unroll
    for (int a = 0; a < 2; ++a)
#pragma unroll
        for (int m = 0; m < 4; ++m)
#pragma unroll
            for (int n = 0; n < 2; ++n) acc[a][0][m][n] = (f32x4){0.f, 0.f, 0.f, 0.f};
    bf16x8 At0[4][2], At1[4][2], B0[2][2];
    const char* cA = (const char*)g.A + (size_t)cur.pm * tstep; const char* cB = (const char*)g.Bt + (size_t)cur.pn * hstep;
    S.a_ready(cur);
    N1_STAGE3(0, cA, cB); N1_STAGE3(1, cA + kstep, cB + kstep);
    N1_WAIT_V(6); N1_BAR;
    for (;;) {
        const bool has_next = S.next(ui + 1, nxt);
        const char* nA = has_next ? (const char*)g.A + (size_t)nxt.pm * tstep : (const char*)nullptr; const char* nB = has_next ? (const char*)g.Bt + (size_t)nxt.pn * hstep : (const char*)nullptr;
        for (int t = 0; t < nt; t += 2) {
            const bool last = (t == nt - 2);
            const char* a2 = last ? nA : cA + (size_t)(t + 2) * kstep; const char* b2 = last ? nB : cB + (size_t)(t + 2) * kstep;
            const char* a3 = a2 ? a2 + kstep : a2; const char* b3 = b2 ? b2 + kstep : b2;
            if (last && has_next) S.a_ready(nxt);
            N1_TILE(0, a2, b2);
            N1_TILE(1, a3, b3);
        }
        { const int t2_ = mk_fresh_tid() & 63; E(acc, cur, wr, wc, t2_ & 15, t2_ >> 4); }
        S.done(cur);
        if (!has_next) break;
#pragma unroll
        for (int a = 0; a < 2; ++a)
#pragma unroll
            for (int m = 0; m < 4; ++m)
#pragma unroll
                for (int n = 0; n < 2; ++n) acc[a][0][m][n] = (f32x4){0.f, 0.f, 0.f, 0.f};
        cur = nxt; cA = nA; cB = nB; ++ui;
    }
    N1_WAIT_V(0); N1_BAR;
#undef N1_SA
#undef N1_SB
#undef N1_STAGE
#undef N1_STAGE3
#undef N1_LDA
#undef N1_LDB
#undef N1_MMA
#undef N1_WAIT_V
#undef N1_WAIT_L0
#undef N1_BAR
#undef N1_TILE
}
}
#define GAS __attribute__((address_space(1)))
#define LAS __attribute__((address_space(3)))
typedef unsigned short bf16;
typedef unsigned v4u __attribute__((ext_vector_type(4)));
typedef float f32x4 __attribute__((ext_vector_type(4)));
typedef short bf16x8 __attribute__((ext_vector_type(8)));
typedef GAS unsigned gu32;
typedef GAS unsigned long long gu64;
#define RLX_AGENT __ATOMIC_RELAXED, __HIP_MEMORY_SCOPE_AGENT
#define LDS_WAIT() asm volatile("s_waitcnt lgkmcnt(0)" ::: "memory")
#define VM_WAIT() asm volatile("s_waitcnt vmcnt(0)" ::: "memory")
__device__ __forceinline__ unsigned long long rt() { return __builtin_amdgcn_s_memrealtime(); }
__device__ __forceinline__ unsigned f2bf(float f) { unsigned u = __builtin_bit_cast(unsigned, f); return (u + 0x7fffu + ((u >> 16) & 1u)) >> 16; }
__device__ __forceinline__ unsigned pk2(float lo, float hi) { return f2bf(lo) | (f2bf(hi) << 16); }
#define XB_TMO      128
#define XB_XCNT(j)  (256  + 64 * (j))
#define XB_XSUB(j)  (1280 + 64 * (j))
#define XB_XGEN(j)  (2304 + 64 * (j))
#define XB_TOP      3328
#define XB_TOPGEN   3392
#define XCD_BAR_WORDS 3456
#define XB_SPIN_CAP (1u << 18)

__device__ __forceinline__ unsigned xb_ld(unsigned* p)              { return __hip_atomic_load(p, __ATOMIC_RELAXED, __HIP_MEMORY_SCOPE_AGENT); }
__device__ __forceinline__ unsigned xb_add(unsigned* p, unsigned v) { return __hip_atomic_fetch_add(p, v, __ATOMIC_RELAXED, __HIP_MEMORY_SCOPE_AGENT); }
__device__ __forceinline__ unsigned xb_xcc_id() { return (unsigned)__builtin_amdgcn_s_getreg((3 << 11) | 20) & 0xFu; }
#define XB_SPIN(cond, bar) do { unsigned _sp = 0; while (cond) { __builtin_amdgcn_s_sleep(1); \
    if ((++_sp & 255u) == 0u) { if (xb_ld(&(bar)[XB_TMO])) break; if (_sp > XB_SPIN_CAP) { atomicAdd(&(bar)[XB_TMO], 1u); break; } } } } while (0)

struct XcdBarrier {
    unsigned* bar; unsigned x;
    volatile LAS unsigned* st;
};

__device__ __forceinline__ XcdBarrier xcd_barrier_post(unsigned* bar, volatile LAS unsigned* st) {
    XcdBarrier b; b.bar = bar; b.x = xb_xcc_id(); b.st = st;
    if (threadIdx.x == 0) (void)xb_add(&bar[XB_XCNT(b.x)], 1u);
    return b;
}
__device__ __forceinline__ void xcd_barrier_complete(unsigned* bar, unsigned x, unsigned& nloc, unsigned& nx) {
    const unsigned G = gridDim.x * gridDim.y * gridDim.z;
    unsigned sum, cnt, mine, sp = 0u;
    for (;;) {
        sum = 0u; cnt = 0u; mine = 0u;
#pragma unroll
        for (unsigned j = 0; j < 16; ++j) { const unsigned c = xb_ld(&bar[XB_XCNT(j)]); sum += c; cnt += (c > 0u) ? 1u : 0u; mine = (j == x) ? c : mine; }
        if (sum == G) break;
        __builtin_amdgcn_s_sleep(1);
        if ((++sp & 255u) == 0u) { if (xb_ld(&bar[XB_TMO])) break; if (sp > XB_SPIN_CAP) { atomicAdd(&bar[XB_TMO], 1u); break; } }
    }
    nloc = mine > 0u ? mine : 1u; nx = cnt > 0u ? cnt : 1u;
}

__device__ __forceinline__ void xcd_barrier(const XcdBarrier& b) {
    asm volatile("s_waitcnt vmcnt(0)" ::: "memory");
    __syncthreads();
    if (mk_fresh_tid() == 0) {
        unsigned* bar = b.bar; asm volatile("" : "+s"(bar));
        __builtin_amdgcn_s_waitcnt(0);
        unsigned nloc = b.st[0], nx = b.st[1];
        if (nloc == 0u) { xcd_barrier_complete(bar, b.x, nloc, nx); b.st[0] = nloc; b.st[1] = nx; }
        const unsigned old = xb_add(&bar[XB_XSUB(b.x)], 1u);
        const unsigned gen = old / nloc;
        if (old + 1u == (gen + 1u) * nloc) {
            __builtin_amdgcn_fence(__ATOMIC_RELEASE, "agent");
            asm volatile("s_waitcnt vmcnt(0)" ::: "memory");
            const unsigned og = xb_add(&bar[XB_TOP], 1u);
            const unsigned tg = og / nx;
            if (og + 1u == (tg + 1u) * nx) xb_add(&bar[XB_TOPGEN], 1u);
            else XB_SPIN(xb_ld(&bar[XB_TOPGEN]) == tg, bar);
            __builtin_amdgcn_fence(__ATOMIC_ACQUIRE, "agent");
            xb_add(&bar[XB_XGEN(b.x)], 1u);
            asm volatile("s_waitcnt vmcnt(0)" ::: "memory");
        } else {
            XB_SPIN(xb_ld(&bar[XB_XGEN(b.x)]) == gen, bar);
            __builtin_amdgcn_fence(__ATOMIC_ACQUIRE, "agent");
            asm volatile("s_waitcnt vmcnt(0)" ::: "memory");
        }
    }
    __syncthreads();
}
namespace mk {
using pg8::f32x4; using pg8::Unit;
using g2::In; using g2::InP; using g2::W; using g2::M; using g2::MP; using g2::INC;
typedef unsigned u32x4 __attribute__((ext_vector_type(4)));
constexpr int NWAVES = 8, NTHREADS = 512;
constexpr int RING_BYTES = 131072, LDSCTL_OFF = RING_BYTES, MISC_OFF = LDSCTL_OFF + 320, LDS_BYTES = 147456;
constexpr int CW_BAR = 4096, CW_QUEUE = 2048; constexpr size_t CTL_ZERO_BYTES = 65536;

__device__ __forceinline__ float fsig(float x) { return __builtin_amdgcn_rcpf(1.0f + __builtin_amdgcn_exp2f(-1.4426950408889634f * x)); }
__device__ __forceinline__ float fsilu(float x) { return x * fsig(x); }
__device__ __forceinline__ u32x4 pack8(const float* v) { u32x4 r; r.x = pg8::cvt_pk_bf16(v[0], v[1]); r.y = pg8::cvt_pk_bf16(v[2], v[3]); r.z = pg8::cvt_pk_bf16(v[4], v[5]); r.w = pg8::cvt_pk_bf16(v[6], v[7]); return r; }
__device__ __forceinline__ void unpack8(u32x4 r, float* v) { v[0] = __uint_as_float(r.x << 16); v[1] = __uint_as_float(r.x & 0xffff0000u); v[2] = __uint_as_float(r.y << 16); v[3] = __uint_as_float(r.y & 0xffff0000u);
    v[4] = __uint_as_float(r.z << 16); v[5] = __uint_as_float(r.z & 0xffff0000u); v[6] = __uint_as_float(r.w << 16); v[7] = __uint_as_float(r.w & 0xffff0000u); }
__device__ __forceinline__ void st16(g2::bf16_t* p, u32x4 v) { *(u32x4*)p = v; }
__device__ __forceinline__ void stf8(float* p, const float* v) { *(f32x4*)p = (f32x4){v[0], v[1], v[2], v[3]}; *(f32x4*)(p + 4) = (f32x4){v[4], v[5], v[6], v[7]}; }
__device__ __forceinline__ void ldf8(const float* p, float* v) { const f32x4 a = *(const f32x4*)p, b = *(const f32x4*)(p + 4); v[0] = a.x; v[1] = a.y; v[2] = a.z; v[3] = a.w; v[4] = b.x; v[5] = b.y; v[6] = b.z; v[7] = b.w; }

#define MK_ROWS_BEGIN _Pragma("unroll") for (int ai = 0; ai < 2; ++ai) _Pragma("unroll") for (int m = 0; m < 4; ++m) { \
        float v0[8], v1[8]; _Pragma("unroll") for (int n = 0; n < 2; ++n) _Pragma("unroll") for (int i = 0; i < 4; ++i) { v0[4 * n + i] = acc[ai][0][m][n][i]; v1[4 * n + i] = acc[ai][1][m][n][i]; }
#define MK_ROWS_END }

struct Epi1 {
    static constexpr bool PERM = true, AFTER_DRAIN = false;
    W w; int l;
    __device__ __forceinline__ void operator()(const f32x4 (&acc)[2][2][4][2], const Unit& u, int wr, int wc, int fr, int fq) const {
        int pn_ = __builtin_amdgcn_readfirstlane(u.pn), pm_ = __builtin_amdgcn_readfirstlane(u.pm); asm volatile("" : "+s"(pn_), "+s"(pm_), "+v"(fr), "+v"(fq));
        const int pn = pn_, cc0 = wc * 32 + fq * 8, rowb = pm_ * 256 + wr * 64 + fr;
#define MK_ROW (rowb + ai * 128 + m * 16)
        if (pn <= 2) {
            if (pn < 2 || wc < 2) {
                MK_ROWS_BEGIN
                    const int row = MK_ROW; const bool smp = row >= MP; const int t = smp ? ((row - MP) & 2047) : (row & 255);
                    float o1[8], o2[8];
                    if (smp) { float cs[8], sn[8]; ldf8(w.ropec() + t * 32 + fq * 8, cs); ldf8(w.ropes() + t * 32 + fq * 8, sn);
#pragma unroll
                        for (int e = 0; e < 8; ++e) { o1[e] = v0[e] * cs[e] - v1[e] * sn[e]; o2[e] = v0[e] * sn[e] + v1[e] * cs[e]; } }
                    else {
#pragma unroll
                        for (int e = 0; e < 8; ++e) { o1[e] = v0[e]; o2[e] = v1[e]; } }
                    if (pn < 2) { g2::bf16_t* q = w.Q() + (size_t)row * 512 + (pn * 4 + wc) * 64 + fq * 8; st16(q, pack8(o1)); st16(q + 32, pack8(o2)); }
                    else { g2::bf16_t* k = w.K() + (size_t)row * 128 + wc * 64 + fq * 8; st16(k, pack8(o1)); st16(k + 32, pack8(o2));
                        if (!smp) { float* o = w.out + g2::OUT_K + (((size_t)(row >> 8) * 2 + l) * 256 + t) * 128 + wc * 64 + fq * 8; stf8(o, v0); stf8(o + 32, v1); } }
                MK_ROWS_END
            } else {
                const int c2 = (wc - 2) * 32 + fq * 8;
                MK_ROWS_BEGIN
                    const int row = MK_ROW; g2::bf16_t* vp = w.V() + (size_t)row * 128 + c2; st16(vp, pack8(v0)); st16(vp + 64, pack8(v1));
                    if (row < MP) { float* o = w.out + g2::OUT_V + (((size_t)(row >> 8) * 2 + l) * 256 + (row & 255)) * 128 + c2; stf8(o, v0); stf8(o + 64, v1); }
                MK_ROWS_END
            }
        } else if (pn >= 19) {
            g2::bf16_t* base = w.GM() + (size_t)(pn - 19) * 256 + cc0;
            MK_ROWS_BEGIN
                float o0[8], o1[8];
#pragma unroll
                for (int e = 0; e < 8; ++e) { o0[e] = fsig(v0[e]); o1[e] = fsig(v1[e]); }
                g2::bf16_t* p = base + (size_t)MK_ROW * 4096; st16(p, pack8(o0)); st16(p + 128, pack8(o1));
            MK_ROWS_END
        } else if (pn >= 5 && pn < 9) {
            g2::bf16_t* base = w.XC() + (pn - 5) * 128 + cc0;
            MK_ROWS_BEGIN
                float o[8];
#pragma unroll
                for (int e = 0; e < 8; ++e) o[e] = v0[e] * fsig(v1[e]);
                st16(base + (size_t)MK_ROW * 512, pack8(o));
            MK_ROWS_END
        } else if (pn == 11 || pn == 12 || pn == 15 || pn == 16) {
            g2::bf16_t* base = (pn < 13 ? w.XP() + (pn - 11) * 256 : w.XS() + (pn - 15) * 256) + cc0;
            MK_ROWS_BEGIN
                g2::bf16_t* p = base + (size_t)MK_ROW * 512; st16(p, pack8(v0)); st16(p + 128, pack8(v1));
            MK_ROWS_END
        } else {
            const int br = pn < 5 ? 0 : pn < 11 ? 1 : pn < 15 ? 2 : 3; const int t0 = br == 0 ? 3 : br == 1 ? 9 : br == 2 ? 13 : 17;
            g2::bf16_t* base = w.GATE() + (size_t)br * M * 512 + (pn - t0) * 256 + cc0;
            MK_ROWS_BEGIN
                float o0[8], o1[8];
#pragma unroll
                for (int e = 0; e < 8; ++e) { o0[e] = fsilu(v0[e]); o1[e] = fsilu(v1[e]); }
                g2::bf16_t* p = base + (size_t)MK_ROW * 512; st16(p, pack8(o0)); st16(p + 128, pack8(o1));
            MK_ROWS_END
        }
#undef MK_ROW
    }
};
#define MK1_ROW(ai, m) (rowb + (ai) * 128 + (m) * 16)
__device__ __forceinline__ int glu_orig_col_v2(int row) { const int t = row >> 7, r = row & 127, gi = r >> 3, e = r & 7; return (e < 4 ? 0 : 512) + 64 * t + 4 * gi + (e & 3); }
struct SchedN1 { int c;
    __device__ __forceinline__ bool next(int i, Unit& u) const { if (i > 0 || c >= 256) return false; const int x = c & 7, slot = c >> 3; u.pm = x * 4 + (slot >> 3); u.pn = slot & 7; return true; }
    __device__ __forceinline__ void a_ready(const Unit&) const {}
    __device__ __forceinline__ void done(const Unit&) const {}
};
struct Epi3 {
    static constexpr bool PERM = true, AFTER_DRAIN = false;
    W w;
    __device__ __forceinline__ void operator()(const f32x4 (&acc)[2][1][4][2], const Unit& u, int wr, int wc, int fr, int fq) const {
        int pn_ = __builtin_amdgcn_readfirstlane(u.pn), pm_ = __builtin_amdgcn_readfirstlane(u.pm); asm volatile("" : "+s"(pn_), "+s"(pm_), "+v"(fr), "+v"(fq));
        const int rowb = pm_ * 256 + wr * 64 + fr; g2::bf16_t* base = w.GATE() + (size_t)3 * M * 512 + 64 * pn_ + 16 * wc + 4 * fq;
        unsigned long long gv[2][4];
#pragma unroll
        for (int ai = 0; ai < 2; ++ai)
#pragma unroll
            for (int m = 0; m < 4; ++m) gv[ai][m] = *(const unsigned long long*)(base + (size_t)MK1_ROW(ai, m) * 512);
#pragma unroll
        for (int ai = 0; ai < 2; ++ai)
#pragma unroll
            for (int m = 0; m < 4; ++m) { const f32x4 v = acc[ai][0][m][0], gt = acc[ai][0][m][1]; const unsigned g0 = (unsigned)gv[ai][m], g1 = (unsigned)(gv[ai][m] >> 32);
                const float o0 = v.x * fsig(gt.x) * __uint_as_float(g0 << 16), o1 = v.y * fsig(gt.y) * __uint_as_float(g0 & 0xffff0000u), o2 = v.z * fsig(gt.z) * __uint_as_float(g1 << 16), o3 = v.w * fsig(gt.w) * __uint_as_float(g1 & 0xffff0000u);
                *(unsigned long long*)(base + (size_t)MK1_ROW(ai, m) * 512) = (unsigned long long)pg8::cvt_pk_bf16(o0, o1) | ((unsigned long long)pg8::cvt_pk_bf16(o2, o3) << 32); }
    }
};
struct Epi4a {
    static constexpr bool PERM = true, AFTER_DRAIN = false;
    W w; mutable f32x4 mg[2][4][2];
    __device__ __forceinline__ void operator()(const f32x4 (&acc)[2][1][4][2], const Unit& u, int wr, int wc, int fr, int fq) const {
        int pn_ = __builtin_amdgcn_readfirstlane(u.pn), pm_ = __builtin_amdgcn_readfirstlane(u.pm); asm volatile("" : "+s"(pn_), "+s"(pm_), "+v"(fr), "+v"(fq));
        const int n_ = pn_ >> 3, pn8 = pn_ & 7, rowb = (pm_ & 31) * 256 + wr * 64 + fr, col = pn8 * 128 + wc * 32 + fq * 8;
        u32x4 gv[2][4];
#pragma unroll
        for (int ai = 0; ai < 2; ++ai)
#pragma unroll
            for (int m = 0; m < 4; ++m) gv[ai][m] = *(const u32x4*)(w.GM() + (size_t)MK1_ROW(ai, m) * 4096 + n_ * 1024 + col);
#pragma unroll
        for (int ai = 0; ai < 2; ++ai)
#pragma unroll
            for (int m = 0; m < 4; ++m) { float g[8]; unpack8(gv[ai][m], g);
                const f32x4 p0 = acc[ai][0][m][0] * (f32x4){g[0], g[1], g[2], g[3]}, p1 = acc[ai][0][m][1] * (f32x4){g[4], g[5], g[6], g[7]};
                if (n_ == 0) { mg[ai][m][0] = p0; mg[ai][m][1] = p1; } else { mg[ai][m][0] += p0; mg[ai][m][1] += p1; }
                if (n_ == 3) { const f32x4 a = mg[ai][m][0], b = mg[ai][m][1]; const float o[8] = {a.x, a.y, a.z, a.w, b.x, b.y, b.z, b.w}; st16(w.MRG() + (size_t)MK1_ROW(ai, m) * 1024 + col, pack8(o)); } }
    }
};
struct Sched4a { int c;
    __device__ __forceinline__ bool next(int i, Unit& u) const { if (c >= 256 || i >= 4) return false; const int x = c & 7, slot = c >> 3; u.pm = x * 4 + (slot >> 3) + 32 * i; u.pn = (slot & 7) + 8 * i; return true; }
    __device__ __forceinline__ void a_ready(const Unit&) const {}
    __device__ __forceinline__ void done(const Unit&) const {}
};
struct Epi4b {
    static constexpr bool PERM = true, AFTER_DRAIN = false;
    InP in; W w; int l;
    __device__ __forceinline__ void operator()(const f32x4 (&acc)[2][1][4][2], const Unit& u, int wr, int wc, int fr, int fq) const {
        int pn_ = __builtin_amdgcn_readfirstlane(u.pn), pm_ = __builtin_amdgcn_readfirstlane(u.pm); asm volatile("" : "+s"(pn_), "+s"(pm_), "+v"(fr), "+v"(fq));
        const int rowb = pm_ * 256 + wr * 64 + fr, col = pn_ * 128 + wc * 32 + fq * 8;
        const float* gt = w.mod() + ((size_t)l * 3 + g2::row_modj(pm_ * 256)) * 3072 + 2048 + col; const f32x4 g0 = *(const f32x4*)gt, g1 = *(const f32x4*)(gt + 4);
        f32x4 xv[2][4][2];
#pragma unroll
        for (int ai = 0; ai < 2; ++ai)
#pragma unroll
            for (int m = 0; m < 4; ++m) { const float* xr = g2::xrow(in, w, l, MK1_ROW(ai, m)) + col; xv[ai][m][0] = *(const f32x4*)xr; xv[ai][m][1] = *(const f32x4*)(xr + 4); }
#pragma unroll
        for (int ai = 0; ai < 2; ++ai)
#pragma unroll
            for (int m = 0; m < 4; ++m) { float* o = w.out + (size_t)MK1_ROW(ai, m) * 1024 + col; *(f32x4*)o = xv[ai][m][0] + g0 * acc[ai][0][m][0]; *(f32x4*)(o + 4) = xv[ai][m][1] + g1 * acc[ai][0][m][1]; }
    }
};

__device__ __forceinline__ int fresh_grid() { int g = (int)gridDim.x; asm volatile("" : "+s"(g)); return g; }
__device__ __forceinline__ float wave_sum(float v) {
    v += __int_as_float(__builtin_amdgcn_ds_swizzle(__float_as_int(v), 0x041f)); v += __int_as_float(__builtin_amdgcn_ds_swizzle(__float_as_int(v), 0x081f));
    v += __int_as_float(__builtin_amdgcn_ds_swizzle(__float_as_int(v), 0x101f)); v += __int_as_float(__builtin_amdgcn_ds_swizzle(__float_as_int(v), 0x201f));
    v += __int_as_float(__builtin_amdgcn_ds_swizzle(__float_as_int(v), 0x401f));
    const auto rr = __builtin_amdgcn_permlane32_swap(__float_as_uint(v), __float_as_uint(v), false, false);
    return __uint_as_float(rr[0]) + __uint_as_float(rr[1]);
}
template <bool FINAL> __device__ __forceinline__ void ph_rows(InP in, const W& w, int l) {
    const int tid_ = mk_fresh_tid(); const int lane = tid_ & 63, wave = tid_ >> 6;
    const int gw = blockIdx.x * NWAVES + wave, NGW = fresh_grid() * NWAVES;
    for (int m0 = 4 * gw; m0 < M; m0 += 4 * NGW) {
        f32x4 v[4][4], pg[4], ps[4], ph[4];
#pragma unroll
        for (int q = 0; q < 4; ++q) { const float* xr = FINAL ? w.out + (size_t)(m0 + q) * 1024 : g2::xrow(in, w, l, m0 + q);
#pragma unroll
            for (int j = 0; j < 4; ++j) v[q][j] = *(const f32x4*)(xr + 256 * j + 4 * lane); }
        if (FINAL) {
#pragma unroll
            for (int j = 0; j < 4; ++j) pg[j] = *(const f32x4*)(in->final_g + 256 * j + 4 * lane); }
        else { const float* mo = w.mod() + ((size_t)l * 3 + g2::row_modj(m0)) * 3072; const float* g = in->norm_g + l * 1024;
#pragma unroll
            for (int j = 0; j < 4; ++j) { const int k = 256 * j + 4 * lane; pg[j] = *(const f32x4*)(g + k); ps[j] = *(const f32x4*)(mo + 1024 + k); ph[j] = *(const f32x4*)(mo + k); } }
        __builtin_amdgcn_sched_barrier(0);
#pragma unroll
        for (int q = 0; q < 4; ++q) { float s = 0.f;
#pragma unroll
            for (int j = 0; j < 4; ++j) s += (v[q][j].x * v[q][j].x + v[q][j].y * v[q][j].y) + (v[q][j].z * v[q][j].z + v[q][j].w * v[q][j].w);
            const float r = 1.0f / sqrtf(wave_sum(s) * (1.0f / 1024.f) + g2::EPS);
            if (FINAL) {
#pragma unroll
                for (int j = 0; j < 4; ++j) *(f32x4*)(w.out + (size_t)(m0 + q) * 1024 + 256 * j + 4 * lane) = v[q][j] * r * pg[j]; }
            else {
#pragma unroll
                for (int j = 0; j < 4; ++j) { const int k = 256 * j + 4 * lane; const f32x4 o = (v[q][j] * r) * pg[j] * (ps[j] + 1.0f) + ph[j];
                    *(unsigned long long*)(w.H() + (size_t)(m0 + q) * 1024 + k) = (unsigned long long)pg8::cvt_pk_bf16(o.x, o.y) | ((unsigned long long)pg8::cvt_pk_bf16(o.z, o.w) << 32); } } }
    }
}
__device__ __forceinline__ void cvt_item(const float* Wsrc, int ldw, int oc, g2::bf16_t* WT, int K, int k0, LAS float* scr, int lane) {
    float v[64];
#pragma unroll
    for (int kk = 0; kk < 64; ++kk) v[kk] = Wsrc[(size_t)(k0 + kk) * ldw + oc];
#pragma unroll
    for (int kk = 0; kk < 64; ++kk) scr[kk * 64 + (lane ^ (8 * (kk >> 3)))] = v[kk];
    asm volatile("s_waitcnt lgkmcnt(0)" ::: "memory");
    const int c = lane & 7;
#pragma unroll
    for (int j = 0; j < 8; ++j) { const int n = (lane >> 3) + 8 * j; const LAS float* s_ = scr + (8 * c) * 64 + (n ^ (8 * c));
        u32x4 o; o.x = pg8::cvt_pk_bf16(s_[0 * 64], s_[1 * 64]); o.y = pg8::cvt_pk_bf16(s_[2 * 64], s_[3 * 64]); o.z = pg8::cvt_pk_bf16(s_[4 * 64], s_[5 * 64]); o.w = pg8::cvt_pk_bf16(s_[6 * 64], s_[7 * 64]);
        *(u32x4*)(WT + (size_t)n * K + k0 + 8 * c) = o; }
    asm volatile("s_waitcnt lgkmcnt(0)" ::: "memory");
}
constexpr int CV_I_IN = 16 * (INC / 64), CV_I_GLU = 8 * 16, CV_I_BR = 8 * 16, CV_I_OUT = 16 * 16;
__device__ __forceinline__ void cvt_in_item(InP in, const W& w, int l, int r, LAS float* scr, int lane) {
    const int kb = r / (INC / 64), n0 = (r % (INC / 64)) * 64; const int oca = g2::in_orig_col(n0), ocb = g2::in_orig_col(n0 + 32);
    if (oca >= g2::C_XPOOL && oca < g2::C_XPOOL + 512) return;
    cvt_item(in->w_in + (size_t)l * 1024 * INC, INC, (lane < 32 ? oca : ocb) + (lane & 31), w.win() + ((size_t)l * INC + n0) * 1024, 1024, kb * 64, scr, lane);
}
__device__ __forceinline__ void ph_convert(InP in, const W& w, LAS unsigned char* L) {
    const int tid_ = mk_fresh_tid(); const int lane = tid_ & 63, wave = tid_ >> 6;
    LAS float* scr = (LAS float*)(L + wave * 16384);
    const int gw = blockIdx.x * NWAVES + wave, NGW = fresh_grid() * NWAVES;
    for (int it = gw; it < CV_I_IN; it += NGW) cvt_in_item(in, w, 0, it, scr, lane);
}
constexpr int CV_DEF_WAVE_ITEMS = CV_I_IN + 2 * CV_I_GLU + 8 * CV_I_BR + 2 * CV_I_OUT, CV_DEF_BLOCK_ITEMS = CV_DEF_WAVE_ITEMS / 8;
static_assert(CV_DEF_WAVE_ITEMS % 8 == 0, "deferred conversion items come in groups of 8 (one per wave)");
__device__ __forceinline__ void cvt_deferred_item(InP in, const W& w, LAS unsigned char* L, int bi, int tid_) {
    const int lane = tid_ & 63, wave = tid_ >> 6; LAS float* scr = (LAS float*)(L + wave * 16384);
    int r = bi * 8 + wave;
    if (r < CV_I_IN) { cvt_in_item(in, w, 1, r, scr, lane); return; }
    r -= CV_I_IN;
    if (r < 2 * CV_I_GLU) { const int l = r / CV_I_GLU; r -= l * CV_I_GLU; const int kb = r / 16, n0 = (r % 16) * 64;
        cvt_item(in->glu_w + (size_t)l * 512 * 1024, 1024, glu_orig_col_v2(n0 + lane), w.wglu() + ((size_t)l * 1024 + n0) * 512, 512, kb * 64, scr, lane); return; }
    r -= 2 * CV_I_GLU;
    if (r < 8 * CV_I_BR) { const int ln = r / CV_I_BR; r -= ln * CV_I_BR; const int kb = r / 16, n0 = (r % 16) * 64;
        cvt_item(in->w_br + (size_t)ln * 512 * 1024, 1024, n0 + lane, w.wbr() + ((size_t)ln * 1024 + n0) * 512, 512, kb * 64, scr, lane); return; }
    r -= 8 * CV_I_BR;
    { const int l = r / CV_I_OUT; r -= l * CV_I_OUT; const int kb = r / 16, n0 = (r % 16) * 64;
      cvt_item(in->w_out + (size_t)l * 1024 * 1024, 1024, n0 + lane, w.wout() + ((size_t)l * 1024 + n0) * 1024, 1024, kb * 64, scr, lane); }
}
__device__ __forceinline__ void ph_mod(InP in, const W& w, LAS unsigned char* L) {
    const int tid_ = mk_fresh_tid();
    LAS float* sc = (LAS float*)L;
    LAS float* red = (LAS float*)(L + 12288);
    const int G_ = fresh_grid();
    if ((int)blockIdx.x >= 192) return;
    for (int i = tid_; i < 3 * 1024; i += NTHREADS) { const int j = i >> 10, k = i & 1023; const float v = j == 0 ? in->c_ctx[k] : in->c[(size_t)(j - 1) * 1024 + k]; sc[i] = v * fsig(v); }
    __syncthreads();
    for (int it = blockIdx.x; it < 192; it += G_) { const int l = it / 96, n = (it % 96) * 32 + (tid_ & 31), ks = tid_ >> 5; const float* wa = in->w_ada + ((size_t)l * 1024 + ks * 64) * 3072 + n;
        float a0 = 0.f, a1 = 0.f, a2 = 0.f;
#pragma unroll 16
        for (int kk = 0; kk < 64; ++kk) { const float wv = wa[(size_t)kk * 3072]; const int k = ks * 64 + kk; a0 += sc[k] * wv; a1 += sc[1024 + k] * wv; a2 += sc[2048 + k] * wv; }
        red[(ks * 3 + 0) * 32 + (tid_ & 31)] = a0; red[(ks * 3 + 1) * 32 + (tid_ & 31)] = a1; red[(ks * 3 + 2) * 32 + (tid_ & 31)] = a2;
        __syncthreads();
        if (tid_ < 96) { const int j = tid_ >> 5, cidx = tid_ & 31; float t = 0.f;
#pragma unroll
            for (int q = 0; q < 16; ++q) t += red[(q * 3 + j) * 32 + cidx];
            const int nn = (it % 96) * 32 + cidx; w.mod()[((size_t)l * 3 + j) * 3072 + nn] = t + in->b_ada[l * 3072 + nn]; }
        __syncthreads(); }
}
__device__ __forceinline__ void poolfold_item(InP in, const W& w, LAS unsigned char* L, int it, int tid_) {
    LAS float* A = (LAS float*)(L + 16384);
    LAS float* B = (LAS float*)(L + 16384 + 32768);
    const int l = it >> 6, g = (it >> 4) & 3, k0 = (it & 15) * 64, cg = tid_ & 31, kg = tid_ >> 5;
    __syncthreads();
    for (int i = tid_; i < 64 * 32; i += NTHREADS) *(LAS f32x4*)(A + 4 * i) = *(const f32x4*)(in->w_in + ((size_t)l * 1024 + k0 + (i >> 5)) * INC + g2::C_XPOOL + g * 128 + 4 * (i & 31));
    for (int i = tid_; i < 128 * 32; i += NTHREADS) *(LAS f32x4*)(B + 4 * i) = *(const f32x4*)(in->pool_w + ((size_t)l * 4 + g) * 128 * 128 + 4 * i);
    __syncthreads();
    f32x4 acc[4];
#pragma unroll
    for (int kk = 0; kk < 4; ++kk) acc[kk] = (f32x4){0.f, 0.f, 0.f, 0.f};
#pragma unroll 2
    for (int ci = 0; ci < 128; ci += 4) { f32x4 bv[4], av[4];
#pragma unroll
        for (int j = 0; j < 4; ++j) bv[j] = *(const LAS f32x4*)(B + (ci + j) * 128 + 4 * cg);
#pragma unroll
        for (int kk = 0; kk < 4; ++kk) av[kk] = *(const LAS f32x4*)(A + (4 * kg + kk) * 128 + ci);
#pragma unroll
        for (int kk = 0; kk < 4; ++kk) acc[kk] += bv[0] * av[kk].x + bv[1] * av[kk].y + bv[2] * av[kk].z + bv[3] * av[kk].w; }
    const f32x4 sc_ = *(const f32x4*)(in->pool_scale + l * 512 + g * 128 + 4 * cg);
#pragma unroll
    for (int kk = 0; kk < 4; ++kk) acc[kk] = acc[kk] * sc_;
    g2::bf16_t* dst = w.win() + ((size_t)l * INC + 11 * 256 + g * 128 + 4 * cg) * 1024 + k0 + 4 * kg;
    *(unsigned long long*)(dst) = (unsigned long long)pg8::cvt_pk_bf16(acc[0].x, acc[1].x) | ((unsigned long long)pg8::cvt_pk_bf16(acc[2].x, acc[3].x) << 32);
    *(unsigned long long*)(dst + 1024) = (unsigned long long)pg8::cvt_pk_bf16(acc[0].y, acc[1].y) | ((unsigned long long)pg8::cvt_pk_bf16(acc[2].y, acc[3].y) << 32);
    *(unsigned long long*)(dst + 2048) = (unsigned long long)pg8::cvt_pk_bf16(acc[0].z, acc[1].z) | ((unsigned long long)pg8::cvt_pk_bf16(acc[2].z, acc[3].z) << 32);
    *(unsigned long long*)(dst + 3072) = (unsigned long long)pg8::cvt_pk_bf16(acc[0].w, acc[1].w) | ((unsigned long long)pg8::cvt_pk_bf16(acc[2].w, acc[3].w) << 32);
}
__device__ __forceinline__ void ph_poolfold(InP in, const W& w, LAS unsigned char* L) {
    const int tid_ = mk_fresh_tid(); const int G_ = fresh_grid();
    for (int it = G_ - 1 - (int)blockIdx.x; it < 64; it += G_) poolfold_item(in, w, L, it, tid_);
}
constexpr int CW_CVTQ = CW_QUEUE + 64 * 2, CV_IN_BLOCK_ITEMS = CV_I_IN / 8, DEF_ITEMS = 64 + (CV_DEF_BLOCK_ITEMS - CV_IN_BLOCK_ITEMS);
__device__ __forceinline__ void ph_deferred(InP in, const W& w, LAS unsigned char* L, volatile LAS unsigned* MISC) {
    const int tid_ = mk_fresh_tid(); unsigned* ctr = w.ctl() + CW_CVTQ;
    for (;;) {
        __syncthreads();
        if (tid_ == 0) MISC[0] = __hip_atomic_fetch_add(ctr, 1u, __ATOMIC_RELAXED, __HIP_MEMORY_SCOPE_AGENT);
        __syncthreads();
        const int idx = (int)__builtin_amdgcn_readfirstlane(MISC[0]);
        if (idx >= DEF_ITEMS) break;
        int t_ = tid_; asm volatile("" : "+v"(t_));
        if (idx < 64) poolfold_item(in, w, L, 64 + idx, t_); else cvt_deferred_item(in, w, L, idx - 64 + CV_IN_BLOCK_ITEMS, t_);
    }
}
__device__ __forceinline__ void convpool_unit(InP in, const W& w, int l, LAS unsigned char* L, int u, int tid_) {
    const int c = tid_, lane = tid_ & 63, wave = tid_ >> 6;
    LAS float* Y = (LAS float*)L;
    const int m0 = u * 16, s0 = g2::row_seq0(m0), Lseq = g2::row_len(m0), t0 = m0 - s0;
    g2::bf16_t rawp[32], gr[16]; g2::bf16_t* gp2 = w.GATE() + ((size_t)2 * M + m0) * 512 + c;
#pragma unroll
    for (int i = 0; i < 32; ++i) { const int t = t0 - 8 + i; const int tc = t < 0 ? 0 : (t >= Lseq ? Lseq - 1 : t); rawp[i] = w.XP()[(size_t)(s0 + tc) * 512 + c]; }
#pragma unroll
    for (int tt = 0; tt < 16; ++tt) gr[tt] = gp2[(size_t)tt * 512];
    g2::bf16_t rawc[46];
#pragma unroll
    for (int i = 0; i < 46; ++i) { const int t = t0 - 15 + i; const int tc = t < 0 ? 0 : (t >= Lseq ? Lseq - 1 : t); rawc[i] = w.XC()[(size_t)(s0 + tc) * 512 + c]; }
    __builtin_amdgcn_sched_barrier(0);
    { float xp[32];
#pragma unroll
      for (int i = 0; i < 32; ++i) { const int t = t0 - 8 + i; xp[i] = (t >= 0 && t < Lseq) ? g2::bf2f(rawp[i]) : 0.f; }
      const int grp = c >> 7;
#pragma unroll
      for (int tt = 0; tt < 16; ++tt) { float s2 = xp[tt + 7] + xp[tt + 8], s4 = s2 + xp[tt + 6] + xp[tt + 9], s8 = s4 + (xp[tt + 4] + xp[tt + 5]) + (xp[tt + 10] + xp[tt + 11]);
          float s16 = s8 + ((xp[tt] + xp[tt + 1]) + (xp[tt + 2] + xp[tt + 3])) + ((xp[tt + 12] + xp[tt + 13]) + (xp[tt + 14] + xp[tt + 15]));
          const float sum = grp == 0 ? s2 : grp == 1 ? s4 : grp == 2 ? s8 : s16; const int hw = 1 << grp;
          const int t = t0 + tt; const int lo = t - hw < 0 ? 0 : t - hw, hi = t + hw > Lseq ? Lseq : t + hw;
          gp2[(size_t)tt * 512] = g2::f2bf((sum / (float)(hi - lo) - xp[tt + 8]) * g2::bf2f(gr[tt])); } }
    float wj[31];
#pragma unroll
    for (int j = 0; j < 31; ++j) wj[j] = in->conv_dw[((size_t)l * 31 + j) * 512 + c];
    const float bias = in->conv_db[l * 512 + c];
    float lg[8], lb[8]; ldf8(in->conv_ln_g + l * 512 + 8 * lane, lg); ldf8(in->conv_ln_b + l * 512 + 8 * lane, lb);
    u32x4 gt1[2];
#pragma unroll
    for (int q = 0; q < 2; ++q) gt1[q] = *(const u32x4*)(w.GATE() + ((size_t)1 * M + m0 + wave * 2 + q) * 512 + 8 * lane);
    __builtin_amdgcn_sched_barrier(0);
    { float acc[16];
#pragma unroll
      for (int tt = 0; tt < 16; ++tt) acc[tt] = bias;
#pragma unroll
      for (int i = 0; i < 46; ++i) { const int t = t0 - 15 + i; const float x = (t >= 0 && t < Lseq) ? g2::bf2f(rawc[i]) : 0.f;
#pragma unroll
          for (int tt = 0; tt < 16; ++tt) { const int j = i - tt; if (j >= 0 && j < 31) acc[tt] += x * wj[j]; } }
#pragma unroll
      for (int tt = 0; tt < 16; ++tt) Y[tt * 512 + c] = acc[tt]; }
    __syncthreads();
#pragma unroll
    for (int q = 0; q < 2; ++q) { const int tt = wave * 2 + q; float y[8]; const f32x4 a = *(const LAS f32x4*)(Y + tt * 512 + 8 * lane), b = *(const LAS f32x4*)(Y + tt * 512 + 8 * lane + 4);
        y[0] = a.x; y[1] = a.y; y[2] = a.z; y[3] = a.w; y[4] = b.x; y[5] = b.y; y[6] = b.z; y[7] = b.w; float s_ = 0.f;
#pragma unroll
        for (int e = 0; e < 8; ++e) s_ += y[e];
        const float mu = wave_sum(s_) * (1.0f / 512.f); float q2 = 0.f;
#pragma unroll
        for (int e = 0; e < 8; ++e) { y[e] -= mu; q2 += y[e] * y[e]; }
        const float rs = 1.0f / sqrtf(wave_sum(q2) * (1.0f / 512.f) + g2::EPS);
        float gt[8], o[8]; unpack8(gt1[q], gt);
#pragma unroll
        for (int e = 0; e < 8; ++e) o[e] = fsilu(y[e] * rs * lg[e] + lb[e]) * gt[e];
        st16(w.GATE() + ((size_t)1 * M + m0 + tt) * 512 + 8 * lane, pack8(o)); }
    __syncthreads();
}

constexpr size_t WS_BB = 3 * g2::MiB, WS_CC = 3 * g2::MiB + 512 * 1024;
struct FSsmTab { InP in; W w;
    __device__ __forceinline__ void operator()(long i) const { const int p = i % 64, g = (i / 64) % 32; const long ld = i / (64 * 32);
        const float lr = in->lam_re[i], li = in->lam_im[i]; const float dt = expf(in->log_dt[ld * 32 + g]);
        const float e = expf(lr * dt), br_ = e * cosf(li * dt), bi_ = e * sinf(li * dt); w.lamb()[2 * i] = br_; w.lamb()[2 * i + 1] = bi_;
        const float nr = br_ - 1.0f, ni = bi_, den = lr * lr + li * li, fr = (nr * lr + ni * li) / den, fi = (ni * lr - nr * li) / den;
        g2::bf16_t* bb = (g2::bf16_t*)(w.ws + WS_BB) + ((size_t)(ld * 32 + g) * 2 * 64 + p) * 16; g2::bf16_t* cc = (g2::bf16_t*)(w.ws + WS_CC) + (size_t)(ld * 32 + g) * 16 * 128 + 2 * p;
        for (int c = 0; c < 16; ++c) { const float xr = in->b_re[i * 16 + c], xi = in->b_im[i * 16 + c]; bb[c] = g2::f2bf(fr * xr - fi * xi); bb[64 * 16 + c] = g2::f2bf(fr * xi + fi * xr);
            cc[c * 128] = g2::f2bf(in->c_re[((ld * 32 + g) * 16 + c) * 64 + p]); cc[c * 128 + 1] = g2::f2bf(-in->c_im[((ld * 32 + g) * 16 + c) * 64 + p]); } } };

typedef short bf16x8_t __attribute__((ext_vector_type(8)));
typedef float f32x2_t __attribute__((ext_vector_type(2)));
constexpr int SSM_WAVE_LDS = 12800, SSM_HROW = 272, SSM_XCH = 8 * SSM_WAVE_LDS;
__device__ __forceinline__ float fgelu(float x) { const float u = 0.7978845608028654f * (x + 0.044715f * x * x * x); return x * fsig(2.0f * u); }

template <int MODE> __device__ __forceinline__ void ssm_pass(const W& w, int l, int dir, int g, int m_lo, int ntok, float& hr, float& hi, LAS unsigned char* wl, int lane, float dval) {
    LAS f32x2_t* BU = (LAS f32x2_t*)wl; LAS unsigned char* Hb = wl + 8192;
    const int ld = l * 2 + dir, fr = lane & 15, fq = lane >> 4;
    const f32x2_t lam = *(const f32x2_t*)(w.lamb() + ((size_t)(ld * 32 + g) * 64 + lane) * 2);
    bf16x8_t bfr[4][2], cfr[4];
    { const g2::bf16_t* bb = (const g2::bf16_t*)(w.ws + WS_BB) + (size_t)(ld * 32 + g) * 2 * 64 * 16;
#pragma unroll
      for (int q = 0; q < 4; ++q)
#pragma unroll
          for (int ri = 0; ri < 2; ++ri) { const bf16x8_t t_ = *(const bf16x8_t*)(bb + ((size_t)ri * 64 + 16 * q + fr) * 16 + 8 * (fq & 1)); bfr[q][ri] = fq < 2 ? t_ : (bf16x8_t){0, 0, 0, 0, 0, 0, 0, 0}; }
      if (MODE != 0) { const g2::bf16_t* cc = (const g2::bf16_t*)(w.ws + WS_CC) + ((size_t)(ld * 32 + g) * 16 + fr) * 128;
#pragma unroll
          for (int ks = 0; ks < 4; ++ks) cfr[ks] = *(const bf16x8_t*)(cc + 32 * ks + 8 * fq); } }
    const int nch = ntok >> 4; const g2::bf16_t* xs = w.XS() + (size_t)g * 16;
    auto chunk_row = [&](int ci) { return dir == 0 ? m_lo + 16 * ci : m_lo + ntok - 16 - 16 * ci; };
    struct Pre { bf16x8_t a; g2::bf16_t x[4]; float yf[4]; };
    auto fetch = [&](int ci, Pre& P) { if (ci < nch) { const int mn = chunk_row(ci); P.a = *(const bf16x8_t*)(xs + (size_t)(mn + fr) * 512 + 8 * (fq & 1));
            if (MODE != 0) {
#pragma unroll
                for (int r = 0; r < 4; ++r) { const size_t o = (size_t)(mn + 4 * fq + r) * 512 + g * 16 + fr; P.x[r] = w.XS()[o]; if (MODE == 2) P.yf[r] = w.TMP()[o]; } } } };
    auto step = [&](int ci, Pre& P) {
        const int mt = chunk_row(ci); const bf16x8_t a = fq < 2 ? P.a : (bf16x8_t){0, 0, 0, 0, 0, 0, 0, 0}; float xc[4], yfc[4];
#pragma unroll
        for (int r = 0; r < 4; ++r) { xc[r] = g2::bf2f(P.x[r]); yfc[r] = P.yf[r]; }
        fetch(ci + 2, P);
#pragma unroll
        for (int q = 0; q < 4; ++q) { const f32x4 z = {0.f, 0.f, 0.f, 0.f};
            const f32x4 dre = __builtin_amdgcn_mfma_f32_16x16x32_bf16(a, bfr[q][0], z, 0, 0, 0), dim = __builtin_amdgcn_mfma_f32_16x16x32_bf16(a, bfr[q][1], z, 0, 0, 0);
#pragma unroll
            for (int r = 0; r < 4; ++r) BU[(4 * fq + r) * 64 + 16 * q + fr] = (f32x2_t){dre[r], dim[r]}; }
        f32x2_t bq[16];
#pragma unroll
        for (int s_ = 0; s_ < 16; ++s_) bq[s_] = BU[(dir == 0 ? s_ : 15 - s_) * 64 + lane];
        unsigned hw[16];
#pragma unroll
        for (int s_ = 0; s_ < 16; ++s_) { const float nr = lam.x * hr - lam.y * hi + bq[s_].x, ni = lam.x * hi + lam.y * hr + bq[s_].y; hr = nr; hi = ni; if (MODE != 0) hw[s_] = pg8::cvt_pk_bf16(hr, hi); }
        if (MODE != 0) {
#pragma unroll
            for (int s_ = 0; s_ < 16; ++s_) *(LAS unsigned*)(Hb + (dir == 0 ? s_ : 15 - s_) * SSM_HROW + lane * 4) = hw[s_];
            f32x4 y = {0.f, 0.f, 0.f, 0.f};
#pragma unroll
            for (int ks = 0; ks < 4; ++ks) { const bf16x8_t ha = *(const LAS bf16x8_t*)(Hb + fr * SSM_HROW + 64 * ks + 16 * fq); y = __builtin_amdgcn_mfma_f32_16x16x32_bf16(ha, cfr[ks], y, 0, 0, 0); }
#pragma unroll
            for (int r = 0; r < 4; ++r) { const size_t o = (size_t)(mt + 4 * fq + r) * 512 + g * 16 + fr;
                if (MODE == 1) w.TMP()[o] = y[r] + dval * xc[r]; else w.YS()[o] = g2::f2bf(fgelu(y[r] + yfc[r])); } }
    };
    Pre PA, PB;
#pragma unroll
    for (int r = 0; r < 4; ++r) { PA.x[r] = 0; PA.yf[r] = 0.f; PB.x[r] = 0; PB.yf[r] = 0.f; }
    PA.a = (bf16x8_t){0, 0, 0, 0, 0, 0, 0, 0}; PB.a = PA.a;
    fetch(0, PA); fetch(1, PB);
#pragma unroll 1
    for (int ci = 0; ci < nch; ci += 2) { step(ci, PA); step(ci + 1, PB); }
}
__device__ __forceinline__ void cmul(float& ar, float& ai, float br, float bi) { const float t = ar * br - ai * bi; ai = ar * bi + ai * br; ar = t; }
template <int DIR> __device__ __forceinline__ void ssm_pass0_dir(const W& w, int l, int g, const bf16x8_t (&A)[16], float& er, float& ei, LAS f32x2_t* BU, int lane) {
    const int fr = lane & 15, fq = lane >> 4, ld = l * 2 + DIR;
    bf16x8_t bfr[4][2];
    { const g2::bf16_t* bb = (const g2::bf16_t*)(w.ws + WS_BB) + (size_t)(ld * 32 + g) * 2 * 64 * 16;
#pragma unroll
      for (int q = 0; q < 4; ++q)
#pragma unroll
          for (int ri = 0; ri < 2; ++ri) { const bf16x8_t t_ = *(const bf16x8_t*)(bb + ((size_t)ri * 64 + 16 * q + fr) * 16 + 8 * (fq & 1)); bfr[q][ri] = fq < 2 ? t_ : (bf16x8_t){0, 0, 0, 0, 0, 0, 0, 0}; } }
    float l1r[4], l1i[4], l16r[4], l16i[4], wr_[4], wi_[4], sr[4], si[4];
#pragma unroll
    for (int q = 0; q < 4; ++q) { const f32x2_t lam = *(const f32x2_t*)(w.lamb() + ((size_t)(ld * 32 + g) * 64 + 16 * q + fr) * 2); l1r[q] = lam.x; l1i[q] = lam.y;
        float p4r = lam.x, p4i = lam.y; cmul(p4r, p4i, p4r, p4i); cmul(p4r, p4i, p4r, p4i);
        float p8r = p4r, p8i = p4i; cmul(p8r, p8i, p8r, p8i);
        float p16r = p8r, p16i = p8i; cmul(p16r, p16i, p16r, p16i);
        l16r[q] = p16r; l16i[q] = p16i;
        const int k = DIR == 0 ? 3 - fq : fq;
        float p12r = p8r, p12i = p8i; cmul(p12r, p12i, p4r, p4i);
        wr_[q] = k == 0 ? 1.f : k == 1 ? p4r : k == 2 ? p8r : p12r; wi_[q] = k == 0 ? 0.f : k == 1 ? p4i : k == 2 ? p8i : p12i; sr[q] = 0.f; si[q] = 0.f; }
#pragma unroll
    for (int cc = 0; cc < 16; ++cc) { const bf16x8_t a = fq < 2 ? A[DIR == 0 ? cc : 15 - cc] : (bf16x8_t){0, 0, 0, 0, 0, 0, 0, 0};
#pragma unroll
        for (int q = 0; q < 4; ++q) { const f32x4 z = {0.f, 0.f, 0.f, 0.f};
            const f32x4 dre = __builtin_amdgcn_mfma_f32_16x16x32_bf16(a, bfr[q][0], z, 0, 0, 0), dim = __builtin_amdgcn_mfma_f32_16x16x32_bf16(a, bfr[q][1], z, 0, 0, 0);
            float hr, hi;
            if (DIR == 0) { hr = dre[0]; hi = dim[0];
#pragma unroll
                for (int r = 1; r < 4; ++r) { cmul(hr, hi, l1r[q], l1i[q]); hr += dre[r]; hi += dim[r]; } }
            else { hr = dre[3]; hi = dim[3];
#pragma unroll
                for (int r = 2; r >= 0; --r) { cmul(hr, hi, l1r[q], l1i[q]); hr += dre[r]; hi += dim[r]; } }
            cmul(sr[q], si[q], l16r[q], l16i[q]); sr[q] += hr; si[q] += hi; }
        __builtin_amdgcn_sched_barrier(0); }
#pragma unroll
    for (int q = 0; q < 4; ++q) { cmul(sr[q], si[q], wr_[q], wi_[q]); BU[(DIR * 4 + fq) * 64 + 16 * q + fr] = (f32x2_t){sr[q], si[q]}; }
    const f32x2_t e0 = BU[(DIR * 4 + 0) * 64 + lane], e1 = BU[(DIR * 4 + 1) * 64 + lane], e2 = BU[(DIR * 4 + 2) * 64 + lane], e3 = BU[(DIR * 4 + 3) * 64 + lane];
    er = (e0.x + e1.x) + (e2.x + e3.x); ei = (e0.y + e1.y) + (e2.y + e3.y);
}
template <int DIR> __device__ __forceinline__ void ssm_pass0_dir(const W& w, int l, int g, float& er, float& ei, LAS unsigned char* wl, int lane) {
    const int fr = lane & 15, fq = lane >> 4, ld = l * 2 + DIR; LAS f32x2_t* XB = (LAS f32x2_t*)(wl + 8192);
    bf16x8_t bfr[4][2];
    { const g2::bf16_t* bb = (const g2::bf16_t*)(w.ws + WS_BB) + (size_t)(ld * 32 + g) * 2 * 64 * 16;
#pragma unroll
      for (int q = 0; q < 4; ++q)
#pragma unroll
          for (int ri = 0; ri < 2; ++ri) { const bf16x8_t t_ = *(const bf16x8_t*)(bb + ((size_t)ri * 64 + 16 * q + fr) * 16 + 8 * (fq & 1)); bfr[q][ri] = fq < 2 ? t_ : (bf16x8_t){0, 0, 0, 0, 0, 0, 0, 0}; } }
    float l1r[4], l1i[4], l16r[4], l16i[4], wr_[4], wi_[4], sr[4], si[4];
#pragma unroll
    for (int q = 0; q < 4; ++q) { const f32x2_t lam = *(const f32x2_t*)(w.lamb() + ((size_t)(ld * 32 + g) * 64 + 16 * q + fr) * 2); l1r[q] = lam.x; l1i[q] = lam.y;
        float p4r = lam.x, p4i = lam.y; cmul(p4r, p4i, p4r, p4i); cmul(p4r, p4i, p4r, p4i);
        float p8r = p4r, p8i = p4i; cmul(p8r, p8i, p8r, p8i);
        float p16r = p8r, p16i = p8i; cmul(p16r, p16i, p16r, p16i);
        l16r[q] = p16r; l16i[q] = p16i;
        const int k = DIR == 0 ? 3 - fq : fq;
        float p12r = p8r, p12i = p8i; cmul(p12r, p12i, p4r, p4i);
        wr_[q] = k == 0 ? 1.f : k == 1 ? p4r : k == 2 ? p8r : p12r; wi_[q] = k == 0 ? 0.f : k == 1 ? p4i : k == 2 ? p8i : p12i; sr[q] = 0.f; si[q] = 0.f; }
    const LAS bf16x8_t* AS = (const LAS bf16x8_t*)wl + (lane & 31);
    bf16x8_t a_n = AS[(DIR == 0 ? 0 : 15) * 32];
#pragma unroll 1
    for (int cc = 0; cc < 16; ++cc) { const bf16x8_t a = fq < 2 ? a_n : (bf16x8_t){0, 0, 0, 0, 0, 0, 0, 0};
        if (cc + 1 < 16) a_n = AS[(DIR == 0 ? cc + 1 : 14 - cc) * 32];
#pragma unroll
        for (int q = 0; q < 4; ++q) { const f32x4 z = {0.f, 0.f, 0.f, 0.f};
            const f32x4 dre = __builtin_amdgcn_mfma_f32_16x16x32_bf16(a, bfr[q][0], z, 0, 0, 0), dim = __builtin_amdgcn_mfma_f32_16x16x32_bf16(a, bfr[q][1], z, 0, 0, 0);
            float hr, hi;
            if (DIR == 0) { hr = dre[0]; hi = dim[0];
#pragma unroll
                for (int r = 1; r < 4; ++r) { cmul(hr, hi, l1r[q], l1i[q]); hr += dre[r]; hi += dim[r]; } }
            else { hr = dre[3]; hi = dim[3];
#pragma unroll
                for (int r = 2; r >= 0; --r) { cmul(hr, hi, l1r[q], l1i[q]); hr += dre[r]; hi += dim[r]; } }
            cmul(sr[q], si[q], l16r[q], l16i[q]); sr[q] += hr; si[q] += hi; } }
#pragma unroll
    for (int q = 0; q < 4; ++q) { cmul(sr[q], si[q], wr_[q], wi_[q]); XB[(DIR * 4 + fq) * 64 + 16 * q + fr] = (f32x2_t){sr[q], si[q]}; }
    const f32x2_t e0 = XB[(DIR * 4 + 0) * 64 + lane], e1 = XB[(DIR * 4 + 1) * 64 + lane], e2 = XB[(DIR * 4 + 2) * 64 + lane], e3 = XB[(DIR * 4 + 3) * 64 + lane];
    er = (e0.x + e1.x) + (e2.x + e3.x); ei = (e0.y + e1.y) + (e2.y + e3.y);
}
__device__ __forceinline__ void ssm_pass0(const W& w, int l, int g, int m_lo, float (&er)[2], float (&ei)[2], LAS unsigned char* wl, int lane) {
    const int fr = lane & 15, fq = lane >> 4; const g2::bf16_t* xs = w.XS() + (size_t)g * 16;
    { bf16x8_t A[16];
#pragma unroll
      for (int ci = 0; ci < 16; ++ci) A[ci] = *(const bf16x8_t*)(xs + (size_t)(m_lo + 16 * ci + fr) * 512 + 8 * (fq & 1));
      LAS bf16x8_t* AS = (LAS bf16x8_t*)wl + (lane & 31);
#pragma unroll
      for (int ci = 0; ci < 16; ++ci) AS[ci * 32] = A[ci]; }
    ssm_pass0_dir<0>(w, l, g, er[0], ei[0], wl, lane); ssm_pass0_dir<1>(w, l, g, er[1], ei[1], wl, lane);
}
__device__ __forceinline__ void ssm_unit(InP in, const W& w, int l, LAS unsigned char* L, int bu, int tid_) {
    const int lane = tid_ & 63, wave = __builtin_amdgcn_readfirstlane(tid_ >> 6);
    LAS unsigned char* wl = L + wave * SSM_WAVE_LDS; LAS f32x2_t* XCH = (LAS f32x2_t*)(L + SSM_XCH);
    {
        if (bu < 64) {
            const int b = bu >> 5, g = bu & 31, m_lo = MP + b * 2048 + wave * 256; const float dval = in->ssm_d[l * 512 + g * 16 + (lane & 15)];
            float e_r[2], e_i[2];
            ssm_pass0(w, l, g, m_lo, e_r, e_i, wl, lane);
            XCH[(wave * 2 + 0) * 64 + lane] = (f32x2_t){e_r[0], e_i[0]}; XCH[(wave * 2 + 1) * 64 + lane] = (f32x2_t){e_r[1], e_i[1]};
            __syncthreads();
            float cr[2], ci[2];
#pragma unroll
            for (int dir = 0; dir < 2; ++dir) { const f32x2_t lam = *(const f32x2_t*)(w.lamb() + ((size_t)((l * 2 + dir) * 32 + g) * 64 + lane) * 2); float pr = lam.x, pi = lam.y;
#pragma unroll
                for (int sq = 0; sq < 8; ++sq) { const float t = pr * pr - pi * pi; pi = 2.f * pr * pi; pr = t; }
                const float* st = in->state_ssm + ((((size_t)b * 2 + l) * 2 + dir) * 2) * 2048 + g * 64 + lane; float hr = st[0], hi = st[2048];
                if (dir == 0) { for (int j = 0; j < wave; ++j) { const f32x2_t e = XCH[(j * 2 + 0) * 64 + lane]; const float t = pr * hr - pi * hi + e.x; hi = pr * hi + pi * hr + e.y; hr = t; } }
                else { for (int j = 7; j > wave; --j) { const f32x2_t e = XCH[(j * 2 + 1) * 64 + lane]; const float t = pr * hr - pi * hi + e.x; hi = pr * hi + pi * hr + e.y; hr = t; } }
                cr[dir] = hr; ci[dir] = hi; }
            ssm_pass<1>(w, l, 0, g, m_lo, 256, cr[0], ci[0], wl, lane, dval); ssm_pass<2>(w, l, 1, g, m_lo, 256, cr[1], ci[1], wl, lane, dval);
            __syncthreads();
        } else {
            const int pair = (bu - 64) * 8 + wave, b = pair >> 5, g = pair & 31, m_lo = b * 256; const float dval = in->ssm_d[l * 512 + g * 16 + (lane & 15)];
            float hr = 0.f, hi = 0.f;
            ssm_pass<1>(w, l, 0, g, m_lo, 256, hr, hi, wl, lane, dval);
            { float* o = w.out + g2::OUT_ST + ((((size_t)b * 2 + l) * 2 + 0) * 2) * 2048 + g * 64 + lane; o[0] = hr; o[2048] = hi; }
            hr = 0.f; hi = 0.f;
            ssm_pass<2>(w, l, 1, g, m_lo, 256, hr, hi, wl, lane, dval);
            { float* o = w.out + g2::OUT_ST + ((((size_t)b * 2 + l) * 2 + 1) * 2) * 2048 + g * 64 + lane; o[0] = hr; o[2048] = hi; }
        }
    }
}


constexpr size_t WS_CK = g2::WS_BBAR, WS_CV = g2::WS_BBAR + 256 * 1024;
struct FCvtCache { InP in; W w;
    __device__ __forceinline__ void operator()(long i) const { const long n = 2L * 2 * 256 * 128; if (i < n) ((g2::bf16_t*)(w.ws + WS_CK))[i] = g2::f2bf(in->cache_k[i]); else ((g2::bf16_t*)(w.ws + WS_CV))[i - n] = g2::f2bf(in->cache_v[i - n]); } };
typedef float f32x16 __attribute__((ext_vector_type(16)));
typedef short s16x4 __attribute__((ext_vector_type(4)));
constexpr int AT_SLOT = 16384, AT_KOFF = 0, AT_VOFF = 8192;
constexpr float AT_C2 = 0.125f * 1.4426950408889634f, AT_LOG2E = 1.4426950408889634f;
__device__ __forceinline__ int at_crow(int r, int hi) { return (r & 3) + 8 * (r >> 2) + 4 * hi; }
__device__ __forceinline__ float at_rowmax(const f32x16& p0, const f32x16& p1) { float a = fmaxf(p0[0], p1[0]);
#pragma unroll
    for (int r = 1; r < 16; ++r) a = fmaxf(a, fmaxf(p0[r], p1[r]));
    const auto rr = __builtin_amdgcn_permlane32_swap(__float_as_uint(a), __float_as_uint(a), false, false); return fmaxf(__uint_as_float(rr[0]), __uint_as_float(rr[1])); }

__device__ __forceinline__ void attn_unit(InP in, const W& w, int l, LAS unsigned char* L, int u, int tid_) {
    const int lane = tid_ & 63, r32 = lane & 31, hi = lane >> 5, wave = __builtin_amdgcn_readfirstlane(tid_ >> 6);
    {
        int head, kv, mq, qpos, ntile, nctx, klo; const g2::bf16_t *kbase, *vbase, *ckbase, *cvbase;
        if (u < 128) { const int b = u >> 6, rem = u & 63, pb = (rem >> 1) & 15; kv = rem >> 5; head = kv * 4 + (rem & 1) * 2 + (wave >> 2); qpos = pb * 128 + 32 * (wave & 3) + r32; mq = MP + b * 2048 + qpos;
            klo = pb * 128 - 128 < 0 ? 0 : pb * 128 - 128; const int khi = pb * 128 + 256 > 2048 ? 2048 : pb * 128 + 256; nctx = 4; ntile = 4 + (khi - klo) / 64;
            kbase = w.K() + (size_t)(MP + b * 2048 + klo) * 128; vbase = w.V() + (size_t)(MP + b * 2048 + klo) * 128;
            ckbase = (const g2::bf16_t*)(w.ws + WS_CK) + (size_t)(b * 2 + l) * 256 * 128; cvbase = (const g2::bf16_t*)(w.ws + WS_CV) + (size_t)(b * 2 + l) * 256 * 128; }
        else { const int b = (u - 128) >> 3; head = (u - 128) & 7; kv = head >> 2; qpos = 32 * wave + r32; mq = b * 256 + qpos; klo = 0; nctx = 0; ntile = 4;
            kbase = w.K() + (size_t)(b * 256) * 128; vbase = w.V() + (size_t)(b * 256) * 128; ckbase = kbase; cvbase = vbase; }
        bf16x8_t qr[4];
#pragma unroll
        for (int d0 = 0; d0 < 4; ++d0) qr[d0] = *(const bf16x8_t*)(w.Q() + (size_t)mq * 512 + head * 64 + d0 * 16 + hi * 8);
        float mrun = in->attn_sink[l * 8 + head] * AT_LOG2E, lsum = hi == 0 ? 1.0f : 0.0f;
        f32x16 o[2]; o[0] = f32x16{}; o[1] = f32x16{};
        auto ksrc = [&](int i) { const g2::bf16_t* base = i < nctx ? ckbase + (size_t)(64 * i) * 128 : kbase + (size_t)(64 * (i - nctx)) * 128; return base + (size_t)lane * 128 + kv * 64 + 8 * wave; };
        auto vsrc = [&](int i) { const g2::bf16_t* base = i < nctx ? cvbase + (size_t)(64 * i) * 128 : vbase + (size_t)(64 * (i - nctx)) * 128; return base + (size_t)(16 * (wave & 3) + (lane >> 2)) * 128 + kv * 64 + (wave >> 2) * 32 + (lane & 3) * 8; };
        u32x4 kreg = *(const u32x4*)ksrc(0), vreg = *(const u32x4*)vsrc(0);
        __syncthreads();
        *(LAS u32x4*)(L + AT_KOFF + wave * 1024 + lane * 16) = kreg; *(LAS u32x4*)(L + AT_VOFF + wave * 1024 + lane * 16) = vreg;
        __syncthreads();
#pragma unroll 1
        for (int i = 0; i < ntile; ++i) {
            LAS unsigned char* slot = L + (i & 1) * AT_SLOT;
            if (i + 1 < ntile) { kreg = *(const u32x4*)ksrc(i + 1); vreg = *(const u32x4*)vsrc(i + 1); }
            __builtin_amdgcn_sched_barrier(0);
            const int kp0 = klo + 64 * (i - nctx); const int q0 = qpos - r32;
            const bool win = i >= nctx && nctx > 0; const bool skip = win && (kp0 > q0 + 31 + 128 || kp0 + 63 < q0 - 128);
            if (!skip) {
                f32x16 p0 = f32x16{}, p1 = f32x16{};
                { const LAS unsigned char* kb = slot + AT_KOFF + hi * 1024 + r32 * 16;
#pragma unroll
                  for (int d0 = 0; d0 < 4; ++d0) { const bf16x8_t b0 = *(const LAS bf16x8_t*)(kb + d0 * 2048), b1 = *(const LAS bf16x8_t*)(kb + d0 * 2048 + 512);
                      p0 = __builtin_amdgcn_mfma_f32_32x32x16_bf16(b0, qr[d0], p0, 0, 0, 0); p1 = __builtin_amdgcn_mfma_f32_32x32x16_bf16(b1, qr[d0], p1, 0, 0, 0); } }
                if (win && (kp0 + 63 - q0 > 128 || q0 + 31 - kp0 > 128)) {
#pragma unroll
                    for (int r = 0; r < 16; ++r) { const int kk = kp0 + at_crow(r, hi); const int d0_ = qpos - kk, d1_ = qpos - (kk + 32);
                        if (d0_ > 128 || d0_ < -128) p0[r] = -1e30f; if (d1_ > 128 || d1_ < -128) p1[r] = -1e30f; } }
                const float rm = at_rowmax(p0, p1) * AT_C2; const float mnew = fmaxf(mrun, rm); const float alpha = __builtin_amdgcn_exp2f(mrun - mnew); mrun = mnew;
                float psum = 0.f;
#pragma unroll
                for (int r = 0; r < 16; ++r) { p0[r] = __builtin_amdgcn_exp2f(p0[r] * AT_C2 - mnew); p1[r] = __builtin_amdgcn_exp2f(p1[r] * AT_C2 - mnew); psum += p0[r] + p1[r]; }
                lsum = lsum * alpha + psum;
#pragma unroll
                for (int r = 0; r < 16; ++r) { o[0][r] *= alpha; o[1][r] *= alpha; }
                u32x4 pw[4];
#pragma unroll
                for (int s_ = 0; s_ < 4; ++s_) { const f32x16& P = s_ < 2 ? p0 : p1; const int bse = (s_ & 1) * 8;
                    pw[s_] = (u32x4){pg8::cvt_pk_bf16(P[bse], P[bse + 1]), pg8::cvt_pk_bf16(P[bse + 2], P[bse + 3]), pg8::cvt_pk_bf16(P[bse + 4], P[bse + 5]), pg8::cvt_pk_bf16(P[bse + 6], P[bse + 7])}; }
                const unsigned vb = (unsigned)(uintptr_t)(slot + AT_VOFF) + ((lane >> 4) & 1) * 32 + (lane & 3) * 8 + (4 * hi + ((lane & 15) >> 2)) * 64;
#pragma unroll
                for (int d0 = 0; d0 < 2; ++d0) { s16x4 lo[4], hh[4];
#pragma unroll
                    for (int ks = 0; ks < 4; ++ks) {
                        asm volatile("ds_read_b64_tr_b16 %0, %1 offset:%c2" : "=&v"(lo[ks]) : "v"(vb), "i"(d0 * 4096 + ks * 1024) : "memory");
                        asm volatile("ds_read_b64_tr_b16 %0, %1 offset:%c2" : "=&v"(hh[ks]) : "v"(vb), "i"(d0 * 4096 + ks * 1024 + 512) : "memory"); }
                    asm volatile("s_waitcnt lgkmcnt(0)" ::: "memory"); __builtin_amdgcn_sched_barrier(0);
#pragma unroll
                    for (int ks = 0; ks < 4; ++ks) { const bf16x8_t vf = (bf16x8_t){lo[ks][0], lo[ks][1], lo[ks][2], lo[ks][3], hh[ks][0], hh[ks][1], hh[ks][2], hh[ks][3]};
                        o[d0] = __builtin_amdgcn_mfma_f32_32x32x16_bf16(vf, __builtin_bit_cast(bf16x8_t, pw[ks]), o[d0], 0, 0, 0); } }
            }
            if (i + 1 < ntile) { LAS unsigned char* ns = L + ((i + 1) & 1) * AT_SLOT; *(LAS u32x4*)(ns + AT_KOFF + wave * 1024 + lane * 16) = kreg; *(LAS u32x4*)(ns + AT_VOFF + wave * 1024 + lane * 16) = vreg; }
            __syncthreads();
        }
        { const auto rr = __builtin_amdgcn_permlane32_swap(__float_as_uint(lsum), __float_as_uint(lsum), false, false); const float inv = 1.0f / (__uint_as_float(rr[0]) + __uint_as_float(rr[1]));
          g2::bf16_t* gp = w.GATE() + (size_t)mq * 512 + head * 64; unsigned long long gvv[2][4];
#pragma unroll
          for (int d0 = 0; d0 < 2; ++d0)
#pragma unroll
              for (int rq = 0; rq < 4; ++rq) gvv[d0][rq] = *(const unsigned long long*)(gp + 32 * d0 + 8 * rq + 4 * hi);
#pragma unroll
          for (int d0 = 0; d0 < 2; ++d0)
#pragma unroll
              for (int rq = 0; rq < 4; ++rq) { g2::bf16_t* p = gp + 32 * d0 + 8 * rq + 4 * hi; const unsigned long long gv = gvv[d0][rq]; const unsigned g0 = (unsigned)gv, g1 = (unsigned)(gv >> 32);
                  const float a0 = o[d0][4 * rq] * inv * __uint_as_float(g0 << 16), a1 = o[d0][4 * rq + 1] * inv * __uint_as_float(g0 & 0xffff0000u), a2 = o[d0][4 * rq + 2] * inv * __uint_as_float(g1 << 16), a3 = o[d0][4 * rq + 3] * inv * __uint_as_float(g1 & 0xffff0000u);
                  *(unsigned long long*)p = (unsigned long long)pg8::cvt_pk_bf16(a0, a1) | ((unsigned long long)pg8::cvt_pk_bf16(a2, a3) << 32); } }
    }
}


constexpr int MIX_UNITS = 128 + 256 + 512;
__device__ __forceinline__ void ph_mixers(InP in, const W& w, int l, LAS unsigned char* L, volatile LAS unsigned* MISC) {
    const int tid_ = mk_fresh_tid();
    unsigned* ctr = w.ctl() + CW_QUEUE + 64 * l;
    for (;;) {
        __syncthreads();
        if (tid_ == 0) MISC[0] = __hip_atomic_fetch_add(ctr, 1u, __ATOMIC_RELAXED, __HIP_MEMORY_SCOPE_AGENT);
        __syncthreads();
        const int idx = (int)__builtin_amdgcn_readfirstlane(MISC[0]);
        if (idx >= MIX_UNITS + (l == 0 ? CV_IN_BLOCK_ITEMS : 0)) break;
        if (idx >= MIX_UNITS) { int t2_ = tid_; asm volatile("" : "+v"(t2_)); cvt_deferred_item(in, w, L, idx - MIX_UNITS, t2_); continue; }
        int t_ = tid_; asm volatile("" : "+v"(t_));
        if (idx < 128) ssm_unit(in, w, l, L, idx, t_);
        else if (idx < 384) attn_unit(in, w, l, L, idx - 128, t_);
        else convpool_unit(in, w, l, L, idx - 384, t_);
    }
}
struct Args { In in; float* out; unsigned char* ws; };
__device__ __forceinline__ W fresh_w() { const __attribute__((address_space(4))) Args* p = (const __attribute__((address_space(4))) Args*)__builtin_amdgcn_kernarg_segment_ptr(); asm volatile("" : "+s"(p)); W w; w.ws = p->ws; w.out = p->out; return w; }
__device__ __forceinline__ InP fresh_in() { InP p = (InP)__builtin_amdgcn_kernarg_segment_ptr(); asm volatile("" : "+s"(p)); return p; }

template <class F> __device__ __forceinline__ void run_stage(const F& f, long n) {
    const int tid_ = mk_fresh_tid();
    const long stride_ = (long)fresh_grid() * NTHREADS;
    for (long i = (long)blockIdx.x * NTHREADS + tid_; i < n; i += stride_) f(i);
}

__global__ void __launch_bounds__(NTHREADS, 2) mk_fwd(Args a) {
    extern __shared__ __attribute__((aligned(16))) unsigned char lds[];
    LAS unsigned char* L = (LAS unsigned char*)lds;
    volatile LAS unsigned* MISC = (volatile LAS unsigned*)(L + MISC_OFF);
    for (int u = threadIdx.x; u < (LDS_BYTES - LDSCTL_OFF) / 4; u += NTHREADS) ((LAS unsigned*)(L + LDSCTL_OFF))[u] = 0u;
    __syncthreads();
    if ((threadIdx.x & 63) == 0) *(volatile LAS unsigned*)(L + MK_WTAB_OFF + 4 * mk_hw_wave_slot()) = threadIdx.x >> 6;
    __syncthreads();
#define in fresh_in()
#define w fresh_w()
    (void)xcd_barrier_post((unsigned*)w.ctl() + CW_BAR, MISC + 8);
#define BAR() do { XcdBarrier b_; b_.bar = (unsigned*)w.ctl() + CW_BAR; b_.x = xb_xcc_id(); b_.st = MISC + 8; xcd_barrier(b_); } while (0)
    ph_mod(in, w, L); ph_poolfold(in, w, L); __syncthreads(); run_stage(g2::FRope{w}, 2048L * 32); run_stage(FSsmTab{in, w}, 2L * 2 * 32 * 64); run_stage(FCvtCache{in, w}, 2L * 2 * 2 * 256 * 128);
    ph_convert(in, w, L);
    BAR();
#pragma unroll 1
    for (int l = 0; l < 2; ++l) {
        ph_rows<false>(in, w, l); BAR();
        { pg8::Gemm g{w.H(), w.win() + (size_t)l * INC * 1024, M, INC, 1024}; pg8::StaticOrder S; S.init(M, INC, (int)gridDim.x, (int)blockIdx.x); Epi1 E{w, l};
          pg8::gemm_phase<Epi1, pg8::StaticOrder, true, true>(L, g, S, E); }
        if (l == 0) ph_deferred(in, w, L, MISC);
        BAR();
        ph_mixers(in, w, l, L, MISC); BAR();
        { pg8::Gemm g{w.YS(), w.wglu() + (size_t)l * 1024 * 512, M, 1024, 512}; SchedN1 S{(int)blockIdx.x}; Epi3 E{w};
          pg8::gemm_phase<Epi3, SchedN1, true, true, 1>(L, g, S, E); }
        BAR();
        { pg8::Gemm g{w.GATE(), w.wbr() + (size_t)l * 4 * 1024 * 512, 4 * M, 4 * 1024, 512}; Sched4a S{(int)blockIdx.x}; Epi4a E{w};
          pg8::gemm_phase<Epi4a, Sched4a, true, true, 1>(L, g, S, E); }
        BAR();
        { pg8::Gemm g{w.MRG(), w.wout() + (size_t)l * 1024 * 1024, M, 1024, 1024}; SchedN1 S{(int)blockIdx.x}; Epi4b E{in, w, l};
          pg8::gemm_phase<Epi4b, SchedN1, true, true, 1>(L, g, S, E); }
        BAR();
    }
    ph_rows<true>(in, w, 0);
#undef BAR
#undef in
#undef w
}
}

extern "C" void kernel_launch(void* const* d_in, const int* in_sizes, int n_in, void* d_out, int out_size, void* d_ws, size_t ws_size, hipStream_t stream) {
    static int grid = 0;
    if (grid == 0) {
        if (n_in != 30 || (size_t)out_size != g2::OUT_TOTAL || ws_size < g2::WS_END) { fprintf(stderr, "kernel_launch: unexpected problem shape (n_in %d out %d ws %zu)\n", n_in, out_size, ws_size); grid = -1; return; }
        int dev = 0, cus = 0, per_cu = 0;
        if (hipGetDevice(&dev) != hipSuccess || hipDeviceGetAttribute(&cus, hipDeviceAttributeMultiprocessorCount, dev) != hipSuccess) { grid = -1; return; }
        if (hipFuncSetAttribute((const void*)mk::mk_fwd, hipFuncAttributeMaxDynamicSharedMemorySize, mk::LDS_BYTES) != hipSuccess) { fprintf(stderr, "kernel_launch: hipFuncSetAttribute failed\n"); grid = -1; return; }
        if (hipOccupancyMaxActiveBlocksPerMultiprocessor(&per_cu, (const void*)mk::mk_fwd, mk::NTHREADS, mk::LDS_BYTES) != hipSuccess || per_cu < 1) { fprintf(stderr, "kernel_launch: occupancy query says %d blocks/CU\n", per_cu); (void)hipGetLastError(); grid = -1; return; }
        grid = cus;
    }
    if (grid < 0) return;
    if (hipMemsetAsync((char*)d_ws + g2::WS_CTL, 0, mk::CTL_ZERO_BYTES, stream) != hipSuccess) return;
    mk::Args a{}; const float* ptr[30]; for (int i = 0; i < 30; ++i) ptr[i] = (const float*)d_in[i]; memcpy(&a.in, ptr, sizeof(a.in));
    a.out = (float*)d_out; a.ws = (unsigned char*)d_ws;
    hipLaunchKernelGGL(mk::mk_fwd, dim3(grid), dim3(mk::NTHREADS), mk::LDS_BYTES, stream, a);
}
```

```cpp
#include <hip/hip_runtime.h>
#include <cstdio>
#include <cstring>
#include <cstdint>
#ifdef CPU_EMU
#include <cmath>
#include <cstddef>
#include <cstring>
#define HD_FN inline
#else
#define HD_FN __host__ __device__ __forceinline__
#endif

namespace g2 {
typedef unsigned short bf16_t;
#ifndef CFG_BATCH
#define CFG_BATCH 16
#endif
#ifndef CFG_DEC_BATCH
#define CFG_DEC_BATCH 2
#endif
constexpr int D = 1024, DEPTH = 2, NB_P = CFG_BATCH, L_P = 256, NB_S = CFG_DEC_BATCH, L_S = 2048, PAST = 256;
constexpr int MP = NB_P * L_P, MS = NB_S * L_S, M = MP + MS;
constexpr int GRID_W = 64, NH = 8, WINDOW = 128, CONVK = 31, SG = 32, SC = 16, SP = 64, INC = 8960, NT1 = INC / 256;
constexpr int C_XPOOL = 2816;
constexpr float EPS = 1e-6f;

HD_FN bf16_t f2bf(float f) { unsigned u; memcpy(&u, &f, 4); u = (u + 0x7fffu + ((u >> 16) & 1u)) >> 16; return (bf16_t)u; }
HD_FN float bf2f(bf16_t h) { unsigned u = (unsigned)h << 16; float f; memcpy(&f, &u, 4); return f; }
HD_FN float sigmoidf_(float x) { return 1.0f / (1.0f + expf(-x)); }
HD_FN float siluf_(float x) { return x * sigmoidf_(x); }
HD_FN float geluf_(float x) { return 0.5f * x * (1.0f + tanhf(0.7978845608028654f * (x + 0.044715f * x * x * x))); }

HD_FN int row_path(int m) { return m >= MP; }
HD_FN int row_len(int m) { return m >= MP ? L_S : L_P; }
HD_FN int row_seq0(int m) { return m >= MP ? MP + ((m - MP) / L_S) * L_S : (m / L_P) * L_P; }
HD_FN int row_batch(int m) { return m >= MP ? (m - MP) / L_S : m / L_P; }
HD_FN int row_modj(int m) { return m >= MP ? 1 + (m - MP) / L_S : 0; }

struct In {
    const float *x_prompt, *x_sample, *cache_k, *cache_v, *state_ssm, *c, *c_ctx, *norm_g, *w_ada, *b_ada, *w_in, *attn_sink, *conv_dw, *conv_db,
        *conv_ln_g, *conv_ln_b, *pool_w, *pool_scale, *lam_re, *lam_im, *log_dt, *b_re, *b_im, *c_re, *c_im, *ssm_d, *glu_w, *w_br, *w_out, *final_g;
};
#ifdef CPU_EMU
typedef const In* InP;
#else
typedef const __attribute__((address_space(4))) In* InP;
#endif
constexpr size_t OUT_YP = 0, OUT_YS = (size_t)MP * D, OUT_K = (size_t)M * D, OUT_V = OUT_K + (size_t)NB_P * DEPTH * L_P * 128, OUT_ST = OUT_V + (size_t)NB_P * DEPTH * L_P * 128,
                 OUT_TOTAL = OUT_ST + (size_t)NB_P * DEPTH * 2 * 2 * SG * SP;

constexpr size_t MiB = 1u << 20;
constexpr size_t WS_CTL = 0;
constexpr size_t WS_MOD = 1 * MiB;
constexpr size_t WS_ROPE = WS_MOD + 128 * 1024;
constexpr size_t WS_LAMB = WS_ROPE + 512 * 1024;
constexpr size_t WS_BBAR = WS_LAMB + 64 * 1024;
constexpr size_t WS_WIN = 4 * MiB;
constexpr size_t WS_WGLU = WS_WIN + (size_t)2 * INC * 1024 * 2;
constexpr size_t WS_WBR = WS_WGLU + 2 * MiB;
constexpr size_t WS_WOUT = WS_WBR + 8 * MiB;
constexpr size_t WS_H = WS_WOUT + 4 * MiB;
constexpr size_t WS_Q = WS_H + 16 * MiB;
constexpr size_t WS_XC = WS_Q + 8 * MiB;
constexpr size_t WS_MRGP = WS_H;
constexpr size_t WS_XP = WS_XC + 8 * MiB;
constexpr size_t WS_XS = WS_XP + 8 * MiB;
constexpr size_t WS_K = WS_XS + 8 * MiB;
constexpr size_t WS_V = WS_K + 2 * MiB;
constexpr size_t WS_GATE = WS_V + 2 * MiB;
constexpr size_t WS_GM = WS_GATE + 32 * MiB;
constexpr size_t WS_YS = WS_GM + 64 * MiB;
constexpr size_t WS_MRG = WS_YS + 8 * MiB;
constexpr size_t WS_TMP = WS_MRG + 16 * MiB;
constexpr size_t WS_S = WS_TMP + 16 * MiB;
constexpr size_t WS_END = WS_S + 32 * MiB;
static_assert(WS_END <= 293601280ull, "workspace map exceeds the guaranteed d_ws size");

struct W {
    unsigned char* ws; float* out;
    HD_FN unsigned* ctl() const { return (unsigned*)(ws + WS_CTL); }
    HD_FN float* mod() const { return (float*)(ws + WS_MOD); }
    HD_FN float* ropec() const { return (float*)(ws + WS_ROPE); }
    HD_FN float* ropes() const { return (float*)(ws + WS_ROPE) + 2048 * 32; }
    HD_FN float* lamb() const { return (float*)(ws + WS_LAMB); }
    HD_FN float* bbar() const { return (float*)(ws + WS_BBAR); }
    HD_FN bf16_t* win() const { return (bf16_t*)(ws + WS_WIN); }
    HD_FN bf16_t* wglu() const { return (bf16_t*)(ws + WS_WGLU); }
    HD_FN bf16_t* wbr() const { return (bf16_t*)(ws + WS_WBR); }
    HD_FN bf16_t* wout() const { return (bf16_t*)(ws + WS_WOUT); }
    HD_FN bf16_t* H() const { return (bf16_t*)(ws + WS_H); }
    HD_FN bf16_t* Q() const { return (bf16_t*)(ws + WS_Q); }
    HD_FN bf16_t* XC() const { return (bf16_t*)(ws + WS_XC); }
    HD_FN bf16_t* XP() const { return (bf16_t*)(ws + WS_XP); }
    HD_FN bf16_t* XS() const { return (bf16_t*)(ws + WS_XS); }
    HD_FN bf16_t* K() const { return (bf16_t*)(ws + WS_K); }
    HD_FN bf16_t* V() const { return (bf16_t*)(ws + WS_V); }
    HD_FN bf16_t* GATE() const { return (bf16_t*)(ws + WS_GATE); }
    HD_FN bf16_t* GM() const { return (bf16_t*)(ws + WS_GM); }
    HD_FN bf16_t* YS() const { return (bf16_t*)(ws + WS_YS); }
    HD_FN bf16_t* MRG() const { return (bf16_t*)(ws + WS_MRG); }
    HD_FN float* MRGP() const { return (float*)(ws + WS_MRGP); }
    HD_FN float* TMP() const { return (float*)(ws + WS_TMP); }
    HD_FN float* S() const { return (float*)(ws + WS_S); }
};
HD_FN W make_w(unsigned char* ws, float* out) { W w{}; w.ws = ws; w.out = out; return w; }

HD_FN const float* xrow(InP in, const W& w, int l, int m) { return l == 0 ? (m < MP ? in->x_prompt + (size_t)m * D : in->x_sample + (size_t)(m - MP) * D) : w.out + (size_t)m * D; }

HD_FN int in_orig_col(int row) { const int pn = row >> 8, c = row & 255, bj = c >> 7, cc = c & 127;
    if (pn < 2) return (pn * 4 + (cc >> 5)) * 64 + bj * 32 + (cc & 31);
    if (pn == 2) return cc < 64 ? 512 + (cc >> 5) * 64 + bj * 32 + (cc & 31) : 640 + bj * 64 + (cc - 64);
    if (pn < 5) return 768 + (pn - 3) * 256 + c;
    if (pn < 9) return 1280 + bj * 512 + (pn - 5) * 128 + cc;
    if (pn < 11) return 2304 + (pn - 9) * 256 + c;
    if (pn < 13) return 2816 + (pn - 11) * 256 + c;
    if (pn < 15) return 3328 + (pn - 13) * 256 + c;
    if (pn < 17) return 3840 + (pn - 15) * 256 + c;
    if (pn < 19) return 4352 + (pn - 17) * 256 + c;
    return 4864 + (pn - 19) * 256 + c; }
HD_FN int glu_orig_col(int row) { const int pn = row >> 8, c = row & 255, bj = c >> 7, cc = c & 127; return bj * 512 + pn * 128 + cc; }

struct FMod { InP in; W w;
    HD_FN void operator()(long i) const { int n = i % 3072; int j = (i / 3072) % 3; int l = i / (3 * 3072);
        const float* cv = j == 0 ? in->c_ctx : in->c + (size_t)(j - 1) * D; const float* wa = in->w_ada + (size_t)l * D * 3072;
        float acc = 0.f; for (int k = 0; k < D; ++k) acc += siluf_(cv[k]) * wa[(size_t)k * 3072 + n];
        w.mod()[i] = acc + in->b_ada[l * 3072 + n]; } };
struct FRope { W w;
    HD_FN void operator()(long i) const { int j = i % 32, t = i / 32; float row = (float)(t / GRID_W), col = (float)(t % GRID_W);
        float inv = powf(10000.0f, -(float)(j % 16) / 16.0f); float ang = (j < 16 ? row : col) * inv; w.ropec()[i] = cosf(ang); w.ropes()[i] = sinf(ang); } };
struct FSsmParam { InP in; W w;
    HD_FN void operator()(long i) const { int g = (i / SP) % SG; long ld = i / (SP * SG);
        float lr = in->lam_re[i], li = in->lam_im[i]; float dt = expf(in->log_dt[ld * SG + g]);
        float e = expf(lr * dt), br_ = e * cosf(li * dt), bi_ = e * sinf(li * dt); w.lamb()[2 * i] = br_; w.lamb()[2 * i + 1] = bi_;
        float nr = br_ - 1.0f, ni = bi_; float den = lr * lr + li * li; float fr = (nr * lr + ni * li) / den, fi = (ni * lr - nr * li) / den;
        for (int c = 0; c < SC; ++c) { float xr = in->b_re[i * SC + c], xi = in->b_im[i * SC + c];
            w.bbar()[(i * SC + c) * 2] = fr * xr - fi * xi; w.bbar()[(i * SC + c) * 2 + 1] = fr * xi + fi * xr; } } };
struct FCvtIn { InP in; W w;
    HD_FN void operator()(long i) const { int k = i % 1024; int row = (i / 1024) % INC; int l = i / ((long)INC * 1024); const int oc = in_orig_col(row);
        const float* src = in->w_in + ((size_t)l * D + k) * INC; float v;
        if (oc >= C_XPOOL && oc < C_XPOOL + 512) { const int g = (oc - C_XPOOL) >> 7, co = (oc - C_XPOOL) & 127; const float* pw = in->pool_w + ((size_t)l * 4 + g) * 128 * 128 + co; const float* s = src + C_XPOOL + g * 128;
            float acc = 0.f; for (int ci = 0; ci < 128; ++ci) acc += s[ci] * pw[(size_t)ci * 128]; v = acc * in->pool_scale[l * 512 + g * 128 + co]; }
        else v = src[oc];
        w.win()[i] = f2bf(v); } };
struct FCvtGlu { InP in; W w;
    HD_FN void operator()(long i) const { int k = i % 512; int row = (i / 512) % 1024; int l = i / (512 * 1024); w.wglu()[i] = f2bf(in->glu_w[((size_t)l * 512 + k) * 1024 + glu_orig_col(row)]); } };
struct FCvtBr { InP in; W w;
    HD_FN void operator()(long i) const { int k = i % 512; int d = (i / 512) % 1024; int ln = i / (512 * 1024); w.wbr()[i] = f2bf(in->w_br[((size_t)ln * 512 + k) * 1024 + d]); } };
struct FCvtOut { InP in; W w;
    HD_FN void operator()(long i) const { int k = i % 1024; int d = (i / 1024) % 1024; int l = i / (1024 * 1024); w.wout()[i] = f2bf(in->w_out[((size_t)l * 1024 + k) * 1024 + d]); } };

struct FH { InP in; W w; int l, pad;
    HD_FN void operator()(long m) const { const float* x = xrow(in, w, l, (int)m); float ss = 0.f; for (int k = 0; k < D; ++k) ss += x[k] * x[k];
        float r = 1.0f / sqrtf(ss / D + EPS); const float* mo = w.mod() + ((size_t)l * 3 + row_modj((int)m)) * 3072; const float* g = in->norm_g + l * D;
        for (int k = 0; k < D; ++k) w.H()[(size_t)m * D + k] = f2bf((x[k] * r) * g[k] * (1.0f + mo[1024 + k]) + mo[k]); } };

HD_FN void epi1(const W& w, int l, int m, int pn, int cc, float a0, float a1) {
    if (pn <= 2) { const bool smp = m >= MP; const int t = m - row_seq0(m);
        if (pn < 2 || cc < 64) { const int j = cc & 31; float o1 = a0, o2 = a1;
            if (smp) { const float cs = w.ropec()[t * 32 + j], sn = w.ropes()[t * 32 + j]; o1 = a0 * cs - a1 * sn; o2 = a0 * sn + a1 * cs; }
            if (pn < 2) { const int h = pn * 4 + (cc >> 5); w.Q()[(size_t)m * 512 + h * 64 + j] = f2bf(o1); w.Q()[(size_t)m * 512 + h * 64 + 32 + j] = f2bf(o2); }
            else { const int kv = cc >> 5; w.K()[(size_t)m * 128 + kv * 64 + j] = f2bf(o1); w.K()[(size_t)m * 128 + kv * 64 + 32 + j] = f2bf(o2);
                if (!smp) { float* o = w.out + OUT_K + (((size_t)row_batch(m) * DEPTH + l) * L_P + t) * 128 + kv * 64 + j; o[0] = a0; o[32] = a1; } } }
        else { const int c2 = cc - 64; w.V()[(size_t)m * 128 + c2] = f2bf(a0); w.V()[(size_t)m * 128 + 64 + c2] = f2bf(a1);
            if (!smp) { float* o = w.out + OUT_V + (((size_t)row_batch(m) * DEPTH + l) * L_P + t) * 128 + c2; o[0] = a0; o[64] = a1; } }
        return; }
    if (pn >= 5 && pn < 9) { w.XC()[(size_t)m * 512 + (pn - 5) * 128 + cc] = f2bf(a0 * sigmoidf_(a1)); return; }
    if (pn >= 19) { bf16_t* o = w.GM() + (size_t)m * 4096 + (pn - 19) * 256 + cc; o[0] = f2bf(sigmoidf_(a0)); o[128] = f2bf(sigmoidf_(a1)); return; }
    if (pn == 11 || pn == 12) { bf16_t* o = w.XP() + (size_t)m * 512 + (pn - 11) * 256 + cc; o[0] = f2bf(a0); o[128] = f2bf(a1); return; }
    if (pn == 15 || pn == 16) { bf16_t* o = w.XS() + (size_t)m * 512 + (pn - 15) * 256 + cc; o[0] = f2bf(a0); o[128] = f2bf(a1); return; }
    { const int br = pn < 5 ? 0 : pn < 11 ? 1 : pn < 15 ? 2 : 3; const int t0 = br == 0 ? 3 : br == 1 ? 9 : br == 2 ? 13 : 17;
      bf16_t* o = w.GATE() + ((size_t)br * M + m) * 512 + (pn - t0) * 256 + cc; o[0] = f2bf(siluf_(a0)); o[128] = f2bf(siluf_(a1)); } }
struct FG1 { InP in; W w; int l, pad;
    HD_FN void operator()(long i) const { int cc = i % 128; int pn = (i / 128) % NT1; int m = i / (128 * NT1); const bf16_t* a = w.H() + (size_t)m * D;
        const bf16_t* b0 = w.win() + ((size_t)l * INC + pn * 256 + cc) * D; const bf16_t* b1 = b0 + (size_t)128 * D; float a0 = 0.f, a1 = 0.f;
        for (int k = 0; k < D; ++k) { const float av = bf2f(a[k]); a0 += av * bf2f(b0[k]); a1 += av * bf2f(b1[k]); }
        epi1(w, l, m, pn, cc, a0, a1); } };

struct FAttn { InP in; W w; int l, pad;
    HD_FN void operator()(long i) const { int dp = i % 4, hh = (i / 4) % 8; int m = i / 32; const bool smp = m >= MP; const int L = row_len(m), s0 = row_seq0(m), t = m - s0, kv = hh / 4, bb = row_batch(m);
        const bf16_t* q = w.Q() + (size_t)m * 512 + hh * 64; const float sink = in->attn_sink[l * NH + hh];
        const float* ck = in->cache_k + (((size_t)bb * DEPTH + l) * PAST) * 128 + kv * 64; const float* cvp = in->cache_v + (((size_t)bb * DEPTH + l) * PAST) * 128 + kv * 64;
        int lo, hi; if (!smp) { lo = 0; hi = L - 1; } else { lo = t - WINDOW < 0 ? 0 : t - WINDOW; hi = t + WINDOW > L - 1 ? L - 1 : t + WINDOW; }
        const int nctx = smp ? PAST : 0; float mx = sink;
        for (int pass = 0; pass < 2; ++pass) { float den = 0.f, acc[16];
#pragma unroll
            for (int d = 0; d < 16; ++d) acc[d] = 0.f;
            for (int kk = 0; kk < nctx + (hi - lo + 1); ++kk) { float sc = 0.f;
                if (kk < nctx) { const float* kp = ck + (size_t)kk * 128; for (int d = 0; d < 64; ++d) sc += bf2f(q[d]) * kp[d]; }
                else { const bf16_t* kp = w.K() + (size_t)(s0 + lo + kk - nctx) * 128 + kv * 64; for (int d = 0; d < 64; ++d) sc += bf2f(q[d]) * bf2f(kp[d]); }
                sc *= 0.125f;
                if (pass == 0) { mx = sc > mx ? sc : mx; }
                else { const float p = expf(sc - mx); den += p;
                    if (kk < nctx) { const float* vp = cvp + (size_t)kk * 128 + dp * 16;
#pragma unroll
                        for (int d = 0; d < 16; ++d) acc[d] += p * vp[d]; }
                    else { const bf16_t* vp = w.V() + (size_t)(s0 + lo + kk - nctx) * 128 + kv * 64 + dp * 16;
#pragma unroll
                        for (int d = 0; d < 16; ++d) acc[d] += p * bf2f(vp[d]); } } }
            if (pass == 1) { den += expf(sink - mx); bf16_t* o = w.GATE() + (size_t)m * 512 + hh * 64 + dp * 16;
#pragma unroll
                for (int d = 0; d < 16; ++d) o[d] = f2bf(acc[d] / den * bf2f(o[d])); } } } };
struct FConv { InP in; W w; int l, pad;
    HD_FN void operator()(long i) const { int ch = i % 512; int m = i / 512; const int L = row_len(m), s0 = row_seq0(m), t = m - s0; float acc = in->conv_db[l * 512 + ch];
        for (int j = 0; j < CONVK; ++j) { int tt = t + j - CONVK / 2; if (tt < 0 || tt >= L) continue; acc += bf2f(w.XC()[(size_t)(s0 + tt) * 512 + ch]) * in->conv_dw[((size_t)l * CONVK + j) * 512 + ch]; }
        w.TMP()[i] = acc; } };
struct FConvLn { InP in; W w; int l, pad;
    HD_FN void operator()(long m) const { const float* y = w.TMP() + (size_t)m * 512; float mu = 0.f; for (int k = 0; k < 512; ++k) mu += y[k]; mu /= 512.f;
        float var = 0.f; for (int k = 0; k < 512; ++k) { float d = y[k] - mu; var += d * d; } float r = 1.0f / sqrtf(var / 512.f + EPS); bf16_t* o = w.GATE() + ((size_t)1 * M + m) * 512;
        for (int k = 0; k < 512; ++k) o[k] = f2bf(siluf_((y[k] - mu) * r * in->conv_ln_g[l * 512 + k] + in->conv_ln_b[l * 512 + k]) * bf2f(o[k])); } };
struct FPool { W w;
    HD_FN void operator()(long i) const { int ch = i % 512; int m = i / 512; const int L = row_len(m), s0 = row_seq0(m), t = m - s0; const int wd = 2 << (ch / 128);
        int lo = t - wd / 2 < 0 ? 0 : t - wd / 2, hi = t + wd / 2 > L ? L : t + wd / 2; float sum = 0.f;
        for (int tt = lo; tt < hi; ++tt) sum += bf2f(w.XP()[(size_t)(s0 + tt) * 512 + ch]);
        bf16_t* o = w.GATE() + ((size_t)2 * M + m) * 512 + ch; *o = f2bf((sum / (float)(hi - lo) - bf2f(w.XP()[(size_t)m * 512 + ch])) * bf2f(*o)); } };
struct FSsmBu { W w; int l, dir, m0, pad;
    HD_FN void operator()(long i) const { int p = i % SP, g = (i / SP) % SG; int tl = i / (SP * SG); const bf16_t* x = w.XS() + (size_t)(m0 + tl) * 512 + g * SC;
        const float* bb = w.bbar() + ((((size_t)l * 2 + dir) * SG + g) * SP + p) * SC * 2; float ar = 0.f, ai = 0.f;
        for (int k = 0; k < SC; ++k) { const float xv = bf2f(x[k]); ar += xv * bb[2 * k]; ai += xv * bb[2 * k + 1]; } w.S()[2 * i] = ar; w.S()[2 * i + 1] = ai; } };
struct FSsmScan { InP in; W w; int l, dir, m0, pad;
    HD_FN void operator()(long i) const { int p = i % SP, g = (i / SP) % SG; int s = i / (SP * SG); const int L = row_len(m0); const int bb = row_batch(m0) + s;
        const float* lb = w.lamb() + ((((size_t)l * 2 + dir) * SG + g) * SP + p) * 2; float lr = lb[0], li = lb[1]; float hr = 0.f, hi = 0.f;
        if (m0 >= MP) { const float* st = in->state_ssm + ((((size_t)bb * DEPTH + l) * 2 + dir) * 2) * SG * SP + g * SP + p; hr = st[0]; hi = st[SG * SP]; }
        for (int k = 0; k < L; ++k) { int t = dir == 0 ? k : L - 1 - k; float* S = w.S() + (((size_t)(s * L + t) * SG + g) * SP + p) * 2;
            float nr = lr * hr - li * hi + S[0], ni = lr * hi + li * hr + S[1]; hr = nr; hi = ni; S[0] = hr; S[1] = hi; }
        if (m0 < MP) { float* o = w.out + OUT_ST + ((((size_t)bb * DEPTH + l) * 2 + dir) * 2) * SG * SP + g * SP + p; o[0] = hr; o[SG * SP] = hi; } } };
struct FSsmY { InP in; W w; int l, dir, m0, pad;
    HD_FN void operator()(long i) const { int gc = i % 512; int tl = i / 512; int g = gc / SC, ch = gc % SC; const int m = m0 + tl; const float* S = w.S() + ((size_t)tl * SG + g) * SP * 2;
        const float* cr = in->c_re + ((((size_t)l * 2 + dir) * SG + g) * SC + ch) * SP; const float* cim = in->c_im + ((((size_t)l * 2 + dir) * SG + g) * SC + ch) * SP;
        float acc = 0.f; for (int p = 0; p < SP; ++p) acc += S[2 * p] * cr[p] - S[2 * p + 1] * cim[p];
        float* y = w.TMP() + (size_t)m * 512 + gc;
        if (dir == 0) *y = acc + in->ssm_d[l * 512 + gc] * bf2f(w.XS()[(size_t)m * 512 + gc]); else w.YS()[(size_t)m * 512 + gc] = f2bf(geluf_(*y + acc)); } };
HD_FN void epi3(const W& w, int m, int pn, int cc, float a0, float a1) { bf16_t* o = w.GATE() + ((size_t)3 * M + m) * 512 + pn * 128 + cc; *o = f2bf(a0 * sigmoidf_(a1) * bf2f(*o)); }
struct FG3 { W w; int l, pad;
    HD_FN void operator()(long i) const { int cc = i % 128; int pn = (i / 128) % 4; int m = i / 512; const bf16_t* a = w.YS() + (size_t)m * 512;
        const bf16_t* b0 = w.wglu() + ((size_t)l * 1024 + pn * 256 + cc) * 512; const bf16_t* b1 = b0 + (size_t)128 * 512; float a0 = 0.f, a1 = 0.f;
        for (int k = 0; k < 512; ++k) { const float av = bf2f(a[k]); a0 += av * bf2f(b0[k]); a1 += av * bf2f(b1[k]); }
        epi3(w, m, pn, cc, a0, a1); } };
struct FG4a { W w; int l, pad;
    HD_FN void operator()(long i) const { int d = i % 1024; int m = i / 1024; float mg = 0.f;
        for (int n = 0; n < 4; ++n) { const bf16_t* a = w.GATE() + ((size_t)n * M + m) * 512; const bf16_t* b = w.wbr() + (((size_t)l * 4 + n) * 1024 + d) * 512; float acc = 0.f;
            for (int k = 0; k < 512; ++k) acc += bf2f(a[k]) * bf2f(b[k]); mg += bf2f(w.GM()[(size_t)m * 4096 + n * 1024 + d]) * acc; }
        w.MRG()[i] = f2bf(mg); } };
struct FG4b { InP in; W w; int l, pad;
    HD_FN void operator()(long i) const { int d = i % 1024; int m = i / 1024; const bf16_t* a = w.MRG() + (size_t)m * 1024; const bf16_t* b = w.wout() + ((size_t)l * 1024 + d) * 1024; float acc = 0.f;
        for (int k = 0; k < 1024; ++k) acc += bf2f(a[k]) * bf2f(b[k]);
        const float gate = w.mod()[((size_t)l * 3 + row_modj(m)) * 3072 + 2048 + d]; w.out[i] = xrow(in, w, l, m)[d] + gate * acc; } };
struct FFinal { InP in; W w;
    HD_FN void operator()(long m) const { float* xr = w.out + (size_t)m * D; float ss = 0.f; for (int k = 0; k < D; ++k) ss += xr[k] * xr[k]; float r = 1.0f / sqrtf(ss / D + EPS);
        for (int k = 0; k < D; ++k) xr[k] = xr[k] * r * in->final_g[k]; } };

template <class Runner> inline void forward(InP in, const W& w, Runner& R) {
    R(FMod{in, w}, 2L * 3 * 3072); R(FRope{w}, 2048L * 32); R(FSsmParam{in, w}, 2L * 2 * SG * SP);
    R(FCvtIn{in, w}, 2L * INC * 1024); R(FCvtGlu{in, w}, 2L * 1024 * 512); R(FCvtBr{in, w}, 2L * 4 * 1024 * 512); R(FCvtOut{in, w}, 2L * 1024 * 1024);
    for (int l = 0; l < DEPTH; ++l) {
        R(FH{in, w, l, 0}, (long)M);
        R(FG1{in, w, l, 0}, (long)M * NT1 * 128);
        R(FAttn{in, w, l, 0}, (long)M * 32);
        R(FConv{in, w, l, 0}, (long)M * 512); R(FConvLn{in, w, l, 0}, (long)M);
        R(FPool{w}, (long)M * 512);
        for (int m0 = 0; m0 < M;) { const int L = row_len(m0); int nrows = 2048; if (m0 < MP && m0 + nrows > MP) nrows = MP - m0; const int nseq = nrows / L;
            for (int dir = 0; dir < 2; ++dir) { R(FSsmBu{w, l, dir, m0, 0}, (long)nrows * SG * SP); R(FSsmScan{in, w, l, dir, m0, 0}, (long)nseq * SG * SP); R(FSsmY{in, w, l, dir, m0, 0}, (long)nrows * 512); }
            m0 += nrows; }
        R(FG3{w, l, 0}, (long)M * 512);
        R(FG4a{w, l, 0}, (long)M * 1024);
        R(FG4b{in, w, l, 0}, (long)M * 1024);
    }
    R(FFinal{in, w}, (long)M);
}
}
#define MK_WTAB_OFF (131072 + 512)
__device__ __forceinline__ unsigned mk_hw_wave_slot() { return (unsigned)__builtin_amdgcn_s_getreg(((6 - 1) << 11) | 4) & 63u; }
__device__ __forceinline__ int mk_fresh_tid() { extern __shared__ __attribute__((aligned(16))) unsigned char mk_lds_[];
    const unsigned wv = *(const volatile __attribute__((address_space(3))) unsigned*)((__attribute__((address_space(3))) unsigned char*)mk_lds_ + MK_WTAB_OFF + 4 * mk_hw_wave_slot());
    unsigned ln; asm volatile("v_mbcnt_lo_u32_b32 %0, -1, 0\n\tv_mbcnt_hi_u32_b32 %0, -1, %0" : "=v"(ln));
    int t = (int)((unsigned)__builtin_amdgcn_readfirstlane((int)wv) * 64u + ln); return t; }
namespace pg8 {
#define PG8_LAS __attribute__((address_space(3)))
typedef unsigned short bf16_t;
typedef short bf16x8 __attribute__((ext_vector_type(8)));
typedef float f32x4 __attribute__((ext_vector_type(4)));
typedef unsigned u32x4 __attribute__((ext_vector_type(4)));
constexpr int BM = 256, BK = 64, HALF = 128, HTB = HALF * BK * 2  , STAGE_BYTES = 8 * HTB, NXCD = 8, WGM = 8;

__host__ __device__ __forceinline__ int lds_byte(int r, int c) { const int st = (r >> 4) * 2 + (c >> 5), rr = r & 15, cc = c & 31, ob = rr * 64 + cc * 2; return st * 1024 + (ob ^ (((ob >> 9) & 1) << 5)); }
__host__ __device__ __forceinline__ void stage_rc(int b, int& R, int& C) { const int st = b / 1024, sb = b % 1024, swz = sb ^ (((sb >> 9) & 1) << 5); R = (st >> 1) * 16 + swz / 64; C = (st & 1) * 32 + (swz % 64) / 2; }
__host__ __device__ __forceinline__ int perm32(int rho) { const int n = rho >> 4, i = rho & 15; return 8 * (i >> 2) + 4 * n + (i & 3); }

struct Unit { int pm, pn; };
struct Gemm { const bf16_t* A; const bf16_t* Bt; int M, N, K; };

struct StaticOrder {
    int nM, nN, nwg, G, c;
    __host__ __device__ void init(int M, int N, int G_, int c_) { nM = M / BM; nN = N / BM; nwg = nM * nN; G = G_; c = c_; }
    __host__ __device__ bool next(int i, Unit& u) const {
        const long L = (long)i * G + c; if (L >= nwg) return false;
        int wgid = (int)L; { const int q = nwg / NXCD, r = nwg % NXCD, xcd = wgid % NXCD, off = wgid / NXCD; wgid = (xcd < r ? xcd * (q + 1) : r * (q + 1) + (xcd - r) * q) + off; }
        const int nig = WGM * nN, gid = wgid / nig, fm = gid * WGM, gsz = (nM - fm) < WGM ? (nM - fm) : WGM;
        u.pm = fm + ((wgid % nig) % gsz); u.pn = (wgid % nig) / gsz; return true;
    }
    __device__ __forceinline__ void a_ready(const Unit&) const {}
    __device__ __forceinline__ void done(const Unit&) const {}
};

__device__ __forceinline__ unsigned cvt_pk_bf16(float lo, float hi) { unsigned r; asm volatile("v_cvt_pk_bf16_f32 %0, %1, %2" : "=v"(r) : "v"(lo), "v"(hi)); return r; }
typedef float f32x2 __attribute__((ext_vector_type(2)));
template <class Epi, class Sched, bool ALIGN_EPI = false, bool SP2 = false, int NB = 2>
__device__ __forceinline__ void gemm_phase(PG8_LAS unsigned char* lds, const Gemm g, const Sched& S, const Epi& E) {
    const int tid_ = mk_fresh_tid();
    const int tid = tid_, wid = __builtin_amdgcn_readfirstlane(tid >> 6), lane = tid & 63, wr = wid >> 2, wc = wid & 3, fr = lane & 15, fq = lane >> 4;
    const int K = g.K, nt = K / BK;
    unsigned voffA[2], voffB[2];
#pragma unroll
    for (int i = 0; i < 2; ++i) { int R, C; stage_rc(tid * 16 + i * 8192, R, C); const int Rb = Epi::PERM ? ((R & ~31) + perm32(R & 31)) : R;
        voffA[i] = (unsigned)(R * K + C) * 2u; voffB[i] = (unsigned)(Rb * K + C) * 2u; }
    const size_t kstep = (size_t)(BK * 2);
    const size_t hstep = (size_t)HALF * K * 2;
    const size_t tstep = 2 * hstep;
    const size_t tstepB = NB == 2 ? tstep : hstep;
    static_assert(NB == 2 || (NB == 1 && SP2), "NB == 1 is implemented for the SP2 loop only");
    const unsigned ldsw = (unsigned)wid * 1024u;
    const int aoff = lds_byte(wr * 64 + fr, fq * 8), boff = lds_byte(wc * 32 + fr, fq * 8);
#define PG8_SA(b, h) (((b) * 2 + (h)) * HTB)
#define PG8_SB(b, h) ((4 + (b) * 2 + (h)) * HTB)
#define PG8_STAGE(bufoff, gbase, voff) do { _Pragma("unroll") for (int _i = 0; _i < 2; ++_i) \
        __builtin_amdgcn_global_load_lds((const unsigned*)((const char*)(gbase) + (voff)[_i]), (PG8_LAS unsigned*)(lds + (bufoff) + ldsw + _i * 8192), 16, 0, 0); } while (0)
#define PG8_LDA(dst, b, h) do { _Pragma("unroll") for (int m = 0; m < 4; ++m) _Pragma("unroll") for (int k = 0; k < 2; ++k) dst[m][k] = *(const PG8_LAS bf16x8*)(lds + PG8_SA(b, h) + aoff + m * 2048 + k * 1024); } while (0)
#define PG8_LDB(dst, b, h) do { _Pragma("unroll") for (int n = 0; n < 2; ++n) _Pragma("unroll") for (int k = 0; k < 2; ++k) dst[n][k] = *(const PG8_LAS bf16x8*)(lds + PG8_SB(b, h) + boff + n * 2048 + k * 1024); } while (0)
#define PG8_MMA(ai, bj, At, Bt) do { __builtin_amdgcn_s_setprio(1); _Pragma("unroll") for (int m = 0; m < 4; ++m) _Pragma("unroll") for (int n = 0; n < 2; ++n) _Pragma("unroll") for (int k = 0; k < 2; ++k) \
        acc[ai][bj][m][n] = __builtin_amdgcn_mfma_f32_16x16x32_bf16(Bt[n][k], At[m][k], acc[ai][bj][m][n], 0, 0, 0); __builtin_amdgcn_s_setprio(0); } while (0)
#define PG8_WAIT_V(n) asm volatile("s_waitcnt vmcnt(" #n ")" ::: "memory")
#define PG8_WAIT_L(n) asm volatile("s_waitcnt lgkmcnt(" #n ")" ::: "memory")
#define PG8_WAIT_VL do { if constexpr (NB == 2) PG8_WAIT_V(8); else PG8_WAIT_V(6); PG8_WAIT_L(0); } while (0)
#define PG8_BAR __builtin_amdgcn_s_barrier()
#define PG8_SCHED __builtin_amdgcn_sched_barrier(0)
    Unit cur, nxt; int ui = 0;
    if (!S.next(0, cur)) return;
    f32x4 acc[2][NB][4][2];
#pragma unroll
    for (int a = 0; a < 2; ++a)
#pragma unroll
        for (int b = 0; b < NB; ++b)
#pragma unroll
            for (int m = 0; m < 4; ++m)
#pragma unroll
                for (int n = 0; n < 2; ++n) acc[a][b][m][n] = (f32x4){0.f, 0.f, 0.f, 0.f};
    bf16x8 At[4][2], B0[2][2], B1[2][2];
    const char* cA = (const char*)g.A + (size_t)cur.pm * tstep; const char* cB = (const char*)g.Bt + (size_t)cur.pn * tstepB;
    S.a_ready(cur);
    if constexpr (SP2) {
        PG8_STAGE(PG8_SB(0, 0), cB, voffB); if constexpr (NB == 2) PG8_STAGE(PG8_SB(0, 1), cB + hstep, voffB); PG8_STAGE(PG8_SA(0, 0), cA, voffA); PG8_STAGE(PG8_SA(0, 1), cA + hstep, voffA);
        if (wr == 1) PG8_BAR;
        PG8_WAIT_V(2); PG8_BAR;
        PG8_STAGE(PG8_SB(1, 0), cB + kstep, voffB); PG8_STAGE(PG8_SA(1, 0), cA + kstep, voffA); if constexpr (NB == 2) PG8_STAGE(PG8_SB(1, 1), cB + hstep + kstep, voffB);
        if constexpr (NB == 2) PG8_WAIT_V(6); else PG8_WAIT_V(4);
        PG8_BAR;
    } else {
        PG8_STAGE(PG8_SB(0, 0), cB, voffB); PG8_STAGE(PG8_SA(0, 0), cA, voffA); PG8_STAGE(PG8_SB(0, 1), cB + hstep, voffB); PG8_STAGE(PG8_SA(0, 1), cA + hstep, voffA);
        if (wr == 1) PG8_BAR;
        PG8_WAIT_V(4); PG8_BAR;
        PG8_STAGE(PG8_SB(1, 0), cB + kstep, voffB); PG8_STAGE(PG8_SA(1, 0), cA + kstep, voffA); PG8_STAGE(PG8_SB(1, 1), cB + hstep + kstep, voffB);
        PG8_WAIT_V(6); PG8_BAR;
    }
    for (;;) {
        const bool has_next = S.next(ui + 1, nxt);
        const char* nA = has_next ? (const char*)g.A + (size_t)nxt.pm * tstep : cA; const char* nB = has_next ? (const char*)g.Bt + (size_t)nxt.pn * tstepB : cB;
        for (int t = 0; t < nt; t += 2) {
            const bool last = (t == nt - 2);
            const char* a1 = cA + (size_t)(t + 1) * kstep;
            const char* a2 = last ? nA : cA + (size_t)(t + 2) * kstep; const char* b2 = last ? nB : cB + (size_t)(t + 2) * kstep;
            const char* a3 = a2 + kstep; const char* b3 = b2 + kstep;
            if (last && has_next) S.a_ready(nxt);
            if constexpr (SP2) {
            PG8_LDB(B0, 0, 0); if constexpr (NB == 2) PG8_LDB(B1, 0, 1); PG8_SCHED; PG8_LDA(At, 0, 0); PG8_STAGE(PG8_SA(1, 1), a1 + hstep, voffA);
            PG8_WAIT_VL; PG8_BAR; PG8_MMA(0, 0, At, B0); if constexpr (NB == 2) PG8_MMA(0, 1, At, B1); PG8_BAR; PG8_SCHED;
            PG8_LDA(At, 0, 1); PG8_STAGE(PG8_SB(0, 0), b2, voffB); if constexpr (NB == 2) PG8_STAGE(PG8_SB(0, 1), b2 + hstep, voffB); PG8_STAGE(PG8_SA(0, 0), a2, voffA);
            PG8_WAIT_VL; PG8_BAR; PG8_MMA(1, 0, At, B0); if constexpr (NB == 2) PG8_MMA(1, 1, At, B1); PG8_BAR; PG8_SCHED;
            PG8_LDB(B0, 1, 0); if constexpr (NB == 2) PG8_LDB(B1, 1, 1); PG8_SCHED; PG8_LDA(At, 1, 0); PG8_STAGE(PG8_SA(0, 1), a2 + hstep, voffA);
            PG8_WAIT_VL; PG8_BAR; PG8_MMA(0, 0, At, B0); if constexpr (NB == 2) PG8_MMA(0, 1, At, B1); PG8_BAR; PG8_SCHED;
            PG8_LDA(At, 1, 1); PG8_STAGE(PG8_SB(1, 0), b3, voffB); if constexpr (NB == 2) PG8_STAGE(PG8_SB(1, 1), b3 + hstep, voffB); PG8_STAGE(PG8_SA(1, 0), a3, voffA);
            PG8_WAIT_VL; PG8_BAR; PG8_MMA(1, 0, At, B0); if constexpr (NB == 2) PG8_MMA(1, 1, At, B1); PG8_BAR; PG8_SCHED;
            } else {
            PG8_LDB(B0, 0, 0); PG8_SCHED; PG8_LDA(At, 0, 0); PG8_STAGE(PG8_SA(1, 1), a1 + hstep, voffA);
            PG8_WAIT_L(8); PG8_BAR; PG8_WAIT_L(0); PG8_MMA(0, 0, At, B0); PG8_BAR; PG8_SCHED;
            PG8_LDB(B1, 0, 1); PG8_STAGE(PG8_SB(0, 0), b2, voffB);
            PG8_BAR; PG8_WAIT_L(0); PG8_MMA(0, 1, At, B1); PG8_BAR;
            PG8_LDA(At, 0, 1); PG8_STAGE(PG8_SA(0, 0), a2, voffA);
            PG8_BAR; PG8_WAIT_L(0); PG8_MMA(1, 0, At, B0); PG8_BAR; PG8_SCHED;
            PG8_STAGE(PG8_SB(0, 1), b2 + hstep, voffB);
            PG8_WAIT_V(6); PG8_BAR; PG8_MMA(1, 1, At, B1); PG8_BAR;
            PG8_LDB(B0, 1, 0); PG8_SCHED; PG8_LDA(At, 1, 0); PG8_STAGE(PG8_SA(0, 1), a2 + hstep, voffA);
            PG8_WAIT_L(8); PG8_BAR; PG8_WAIT_L(0); PG8_MMA(0, 0, At, B0); PG8_BAR; PG8_SCHED;
            PG8_LDB(B1, 1, 1); PG8_STAGE(PG8_SB(1, 0), b3, voffB);
            PG8_BAR; PG8_WAIT_L(0); PG8_MMA(0, 1, At, B1); PG8_BAR;
            PG8_LDA(At, 1, 1); PG8_STAGE(PG8_SA(1, 0), a3, voffA);
            PG8_BAR; PG8_WAIT_L(0); PG8_MMA(1, 0, At, B0); PG8_BAR; PG8_SCHED;
            PG8_STAGE(PG8_SB(1, 1), b3 + hstep, voffB);
            PG8_WAIT_V(6); PG8_BAR; PG8_MMA(1, 1, At, B1); PG8_BAR;
            }
        }
        if constexpr (ALIGN_EPI) { if (wr == 0) PG8_BAR; }
        if constexpr (!Epi::AFTER_DRAIN) { E(acc, cur, wr, wc, fr, fq); S.done(cur); }
        if (!has_next) break;
#pragma unroll
        for (int a = 0; a < 2; ++a)
#pragma unroll
            for (int b = 0; b < NB; ++b)
#pragma unroll
                for (int m = 0; m < 4; ++m)
#pragma unroll
                    for (int n = 0; n < 2; ++n) acc[a][b][m][n] = (f32x4){0.f, 0.f, 0.f, 0.f};
        cur = nxt; cA = nA; cB = nB; ++ui;
        if constexpr (ALIGN_EPI) { if (wr == 1) PG8_BAR; }
    }
    PG8_WAIT_V(0);
    if constexpr (!ALIGN_EPI) { if (wr == 0) PG8_BAR; }
    PG8_BAR;
    if constexpr (Epi::AFTER_DRAIN) { E.fused(acc, cur, wr, wc, fr, fq, lds, wid, lane); S.done(cur); }
#undef PG8_SA
#undef PG8_SB
#undef PG8_STAGE
#undef PG8_LDA
#undef PG8_LDB
#undef PG8_MMA
#undef PG8_WAIT_V
#undef PG8_WAIT_L
#undef PG8_WAIT_VL
#undef PG8_BAR
#undef PG8_SCHED
}
}
namespace pg8 {
template <class Epi, class Sched>
__device__ __forceinline__ void gemm_phase_n1(PG8_LAS unsigned char* lds, const Gemm g, const Sched& S, const Epi& E) {
    const int tid_ = mk_fresh_tid();
    const int tid = tid_, wid = __builtin_amdgcn_readfirstlane(tid >> 6), lane = tid & 63, wr = wid >> 2, wc = wid & 3, fr = lane & 15, fq = lane >> 4;
    const int K = g.K, nt = K / BK;
    unsigned voffA[2], voffB[2];
#pragma unroll
    for (int i = 0; i < 2; ++i) { int R, C; stage_rc(tid * 16 + i * 8192, R, C); const int Rb = Epi::PERM ? ((R & ~31) + perm32(R & 31)) : R;
        voffA[i] = (unsigned)(R * K + C) * 2u; voffB[i] = (unsigned)(Rb * K + C) * 2u; }
    const size_t kstep = (size_t)(BK * 2), hstep = (size_t)HALF * K * 2, tstep = 2 * hstep;
    const unsigned ldsw = (unsigned)wid * 1024u;
    const int aoff = lds_byte(wr * 64 + fr, fq * 8), boff = lds_byte(wc * 32 + fr, fq * 8);
#define N1_SA(b, h) (((b) * 2 + (h)) * HTB)
#define N1_SB(b) ((4 + (b) * 2) * HTB)
#define N1_STAGE(bufoff, gbase, voff) do { _Pragma("unroll") for (int _i = 0; _i < 2; ++_i) \
        __builtin_amdgcn_global_load_lds((const unsigned*)((const char*)(gbase) + (voff)[_i]), (PG8_LAS unsigned*)(lds + (bufoff) + ldsw + _i * 8192), 16, 0, 0); } while (0)
#define N1_STAGE3(b, pa, pb) do { N1_STAGE(N1_SB(b), pb, voffB); N1_STAGE(N1_SA(b, 0), pa, voffA); N1_STAGE(N1_SA(b, 1), (pa) + hstep, voffA); } while (0)
#define N1_LDA(dst, b, h) do { _Pragma("unroll") for (int m = 0; m < 4; ++m) _Pragma("unroll") for (int k = 0; k < 2; ++k) dst[m][k] = *(const PG8_LAS bf16x8*)(lds + N1_SA(b, h) + aoff + m * 2048 + k * 1024); } while (0)
#define N1_LDB(dst, b) do { _Pragma("unroll") for (int n = 0; n < 2; ++n) _Pragma("unroll") for (int k = 0; k < 2; ++k) dst[n][k] = *(const PG8_LAS bf16x8*)(lds + N1_SB(b) + boff + n * 2048 + k * 1024); } while (0)
#define N1_MMA(ai, At) do { _Pragma("unroll") for (int m = 0; m < 4; ++m) _Pragma("unroll") for (int n = 0; n < 2; ++n) _Pragma("unroll") for (int k = 0; k < 2; ++k) \
        acc[ai][0][m][n] = __builtin_amdgcn_mfma_f32_16x16x32_bf16(B0[n][k], At[m][k], acc[ai][0][m][n], 0, 0, 0); } while (0)
#define N1_WAIT_V(n) asm volatile("s_waitcnt vmcnt(" #n ")" ::: "memory")
#define N1_WAIT_L0 asm volatile("s_waitcnt lgkmcnt(0)" ::: "memory")
#define N1_BAR __builtin_amdgcn_s_barrier()
#define N1_TILE(b, sa, sb) do { N1_LDB(B0, b); N1_LDA(At0, b, 0); N1_LDA(At1, b, 1); N1_WAIT_L0; N1_BAR; \
        if (sa) { N1_STAGE3(b, sa, sb); } __builtin_amdgcn_sched_barrier(0); N1_MMA(0, At0); N1_MMA(1, At1); __builtin_amdgcn_sched_barrier(0); \
        if (sa) N1_WAIT_V(6); else N1_WAIT_V(0); N1_BAR; } while (0)
    Unit cur, nxt; int ui = 0;
    if (!S.next(0, cur)) return;
    f32x4 acc[2][1][4][2];
#pragma unroll
    for (int a = 0; a < 2; ++a)
#pragma unroll
        for (int m = 0; m < 4; ++m)
#pragma unroll
            for (int n = 0; n < 2; ++n) acc[a][0][m][n] = (f32x4){0.f, 0.f, 0.f, 0.f};
    bf16x8 At0[4][2], At1[4][2], B0[2][2];
    const char* cA = (const char*)g.A + (size_t)cur.pm * tstep; const char* cB = (const char*)g.Bt + (size_t)cur.pn * hstep;
    S.a_ready(cur);
    N1_STAGE3(0, cA, cB); N1_STAGE3(1, cA + kstep, cB + kstep);
    N1_WAIT_V(6); N1_BAR;
    for (;;) {
        const bool has_next = S.next(ui + 1, nxt);
        const char* nA = has_next ? (const char*)g.A + (size_t)nxt.pm * tstep : (const char*)nullptr; const char* nB = has_next ? (const char*)g.Bt + (size_t)nxt.pn * hstep : (const char*)nullptr;
        for (int t = 0; t < nt; t += 2) {
            const bool last = (t == nt - 2);
            const char* a2 = last ? nA : cA + (size_t)(t + 2) * kstep; const char* b2 = last ? nB : cB + (size_t)(t + 2) * kstep;
            const char* a3 = a2 ? a2 + kstep : a2; const char* b3 = b2 ? b2 + kstep : b2;
            if (last && has_next) S.a_ready(nxt);
            N1_TILE(0, a2, b2);
            N1_TILE(1, a3, b3);
        }
        { const int t2_ = mk_fresh_tid() & 63; E(acc, cur, wr, wc, t2_ & 15, t2_ >> 4); }
        S.done(cur);
        if (!has_next) break;
#pragma unroll
        for (int a = 0; a < 2; ++a)
#pragma unroll
            for (int m = 0; m < 4; ++m)
#pragma unroll
                for (int n = 0; n < 2; ++n) acc[a][0][m][n] = (f32x4){0.f, 0.f, 0.f, 0.f};
        cur = nxt; cA = nA; cB = nB; ++ui;
    }
    N1_WAIT_V(0); N1_BAR;
#undef N1_SA
#undef N1_SB
#undef N1_STAGE
#undef N1_STAGE3
#undef N1_LDA
#undef N1_LDB
#undef N1_MMA
#undef N1_WAIT_V
#undef N1_WAIT_L0
#undef N1_BAR
#undef N1_TILE
}
}
#define GAS __attribute__((address_space(1)))
#define LAS __attribute__((address_space(3)))
typedef unsigned short bf16;
typedef unsigned v4u __attribute__((ext_vector_type(4)));
typedef float f32x4 __attribute__((ext_vector_type(4)));
typedef short bf16x8 __attribute__((ext_vector_type(8)));
typedef GAS unsigned gu32;
typedef GAS unsigned long long gu64;
#define RLX_AGENT __ATOMIC_RELAXED, __HIP_MEMORY_SCOPE_AGENT
#define LDS_WAIT() asm volatile("s_waitcnt lgkmcnt(0)" ::: "memory")
#define VM_WAIT() asm volatile("s_waitcnt vmcnt(0)" ::: "memory")
__device__ __forceinline__ unsigned long long rt() { return __builtin_amdgcn_s_memrealtime(); }
__device__ __forceinline__ unsigned f2bf(float f) { unsigned u = __builtin_bit_cast(unsigned, f); return (u + 0x7fffu + ((u >> 16) & 1u)) >> 16; }
__device__ __forceinline__ unsigned pk2(float lo, float hi) { return f2bf(lo) | (f2bf(hi) << 16); }
#define XB_TMO      128
#define XB_XCNT(j)  (256  + 64 * (j))
#define XB_XSUB(j)  (1280 + 64 * (j))
#define XB_XGEN(j)  (2304 + 64 * (j))
#define XB_TOP      3328
#define XB_TOPGEN   3392
#define XCD_BAR_WORDS 3456
#define XB_SPIN_CAP (1u << 18)

__device__ __forceinline__ unsigned xb_ld(unsigned* p)              { return __hip_atomic_load(p, __ATOMIC_RELAXED, __HIP_MEMORY_SCOPE_AGENT); }
__device__ __forceinline__ unsigned xb_add(unsigned* p, unsigned v) { return __hip_atomic_fetch_add(p, v, __ATOMIC_RELAXED, __HIP_MEMORY_SCOPE_AGENT); }
__device__ __forceinline__ unsigned xb_xcc_id() { return (unsigned)__builtin_amdgcn_s_getreg((3 << 11) | 20) & 0xFu; }
#define XB_SPIN(cond, bar) do { unsigned _sp = 0; while (cond) { __builtin_amdgcn_s_sleep(1); \
    if ((++_sp & 255u) == 0u) { if (xb_ld(&(bar)[XB_TMO])) break; if (_sp > XB_SPIN_CAP) { atomicAdd(&(bar)[XB_TMO], 1u); break; } } } } while (0)

struct XcdBarrier {
    unsigned* bar; unsigned x;
    volatile LAS unsigned* st;
};

__device__ __forceinline__ XcdBarrier xcd_barrier_post(unsigned* bar, volatile LAS unsigned* st) {
    XcdBarrier b; b.bar = bar; b.x = xb_xcc_id(); b.st = st;
    if (threadIdx.x == 0) (void)xb_add(&bar[XB_XCNT(b.x)], 1u);
    return b;
}
__device__ __forceinline__ void xcd_barrier_complete(unsigned* bar, unsigned x, unsigned& nloc, unsigned& nx) {
    const unsigned G = gridDim.x * gridDim.y * gridDim.z;
    unsigned sum, cnt, mine, sp = 0u;
    for (;;) {
        sum = 0u; cnt = 0u; mine = 0u;
#pragma unroll
        for (unsigned j = 0; j < 16; ++j) { const unsigned c = xb_ld(&bar[XB_XCNT(j)]); sum += c; cnt += (c > 0u) ? 1u : 0u; mine = (j == x) ? c : mine; }
        if (sum == G) break;
        __builtin_amdgcn_s_sleep(1);
        if ((++sp & 255u) == 0u) { if (xb_ld(&bar[XB_TMO])) break; if (sp > XB_SPIN_CAP) { atomicAdd(&bar[XB_TMO], 1u); break; } }
    }
    nloc = mine > 0u ? mine : 1u; nx = cnt > 0u ? cnt : 1u;
}

__device__ __forceinline__ void xcd_barrier(const XcdBarrier& b) {
    asm volatile("s_waitcnt vmcnt(0)" ::: "memory");
    __syncthreads();
    if (mk_fresh_tid() == 0) {
        unsigned* bar = b.bar; asm volatile("" : "+s"(bar));
        __builtin_amdgcn_s_waitcnt(0);
        unsigned nloc = b.st[0], nx = b.st[1];
        if (nloc == 0u) { xcd_barrier_complete(bar, b.x, nloc, nx); b.st[0] = nloc; b.st[1] = nx; }
        const unsigned old = xb_add(&bar[XB_XSUB(b.x)], 1u);
        const unsigned gen = old / nloc;
        if (old + 1u == (gen + 1u) * nloc) {
            __builtin_amdgcn_fence(__ATOMIC_RELEASE, "agent");
            asm volatile("s_waitcnt vmcnt(0)" ::: "memory");
            const unsigned og = xb_add(&bar[XB_TOP], 1u);
            const unsigned tg = og / nx;
            if (og + 1u == (tg + 1u) * nx) xb_add(&bar[XB_TOPGEN], 1u);
            else XB_SPIN(xb_ld(&bar[XB_TOPGEN]) == tg, bar);
            __builtin_amdgcn_fence(__ATOMIC_ACQUIRE, "agent");
            xb_add(&bar[XB_XGEN(b.x)], 1u);
            asm volatile("s_waitcnt vmcnt(0)" ::: "memory");
        } else {
            XB_SPIN(xb_ld(&bar[XB_XGEN(b.x)]) == gen, bar);
            __builtin_amdgcn_fence(__ATOMIC_ACQUIRE, "agent");
            asm volatile("s_waitcnt vmcnt(0)" ::: "memory");
        }
    }
    __syncthreads();
}
namespace mk {
using pg8::f32x4; using pg8::Unit;
using g2::In; using g2::InP; using g2::W; using g2::M; using g2::MP; using g2::INC;
typedef unsigned u32x4 __attribute__((ext_vector_type(4)));
constexpr int NWAVES = 8, NTHREADS = 512;
constexpr int RING_BYTES = 131072, LDSCTL_OFF = RING_BYTES, MISC_OFF = LDSCTL_OFF + 320, LDS_BYTES = 147456;
constexpr int CW_BAR = 4096, CW_QUEUE = 2048; constexpr size_t CTL_ZERO_BYTES = 65536;

__device__ __forceinline__ float fsig(float x) { return __builtin_amdgcn_rcpf(1.0f + __builtin_amdgcn_exp2f(-1.4426950408889634f * x)); }
__device__ __forceinline__ float fsilu(float x) { return x * fsig(x); }
__device__ __forceinline__ u32x4 pack8(const float* v) { u32x4 r; r.x = pg8::cvt_pk_bf16(v[0], v[1]); r.y = pg8::cvt_pk_bf16(v[2], v[3]); r.z = pg8::cvt_pk_bf16(v[4], v[5]); r.w = pg8::cvt_pk_bf16(v[6], v[7]); return r; }
__device__ __forceinline__ void unpack8(u32x4 r, float* v) { v[0] = __uint_as_float(r.x << 16); v[1] = __uint_as_float(r.x & 0xffff0000u); v[2] = __uint_as_float(r.y << 16); v[3] = __uint_as_float(r.y & 0xffff0000u);
    v[4] = __uint_as_float(r.z << 16); v[5] = __uint_as_float(r.z & 0xffff0000u); v[6] = __uint_as_float(r.w << 16); v[7] = __uint_as_float(r.w & 0xffff0000u); }
__device__ __forceinline__ void st16(g2::bf16_t* p, u32x4 v) { *(u32x4*)p = v; }
__device__ __forceinline__ void stf8(float* p, const float* v) { *(f32x4*)p = (f32x4){v[0], v[1], v[2], v[3]}; *(f32x4*)(p + 4) = (f32x4){v[4], v[5], v[6], v[7]}; }
__device__ __forceinline__ void ldf8(const float* p, float* v) { const f32x4 a = *(const f32x4*)p, b = *(const f32x4*)(p + 4); v[0] = a.x; v[1] = a.y; v[2] = a.z; v[3] = a.w; v[4] = b.x; v[5] = b.y; v[6] = b.z; v[7] = b.w; }

#define MK_ROWS_BEGIN _Pragma("unroll") for (int ai = 0; ai < 2; ++ai) _Pragma("unroll") for (int m = 0; m < 4; ++m) { \
        float v0[8], v1[8]; _Pragma("unroll") for (int n = 0; n < 2; ++n) _Pragma("unroll") for (int i = 0; i < 4; ++i) { v0[4 * n + i] = acc[ai][0][m][n][i]; v1[4 * n + i] = acc[ai][1][m][n][i]; }
#define MK_ROWS_END }

struct Epi1 {
    static constexpr bool PERM = true, AFTER_DRAIN = false;
    W w; int l;
    __device__ __forceinline__ void operator()(const f32x4 (&acc)[2][2][4][2], const Unit& u, int wr, int wc, int fr, int fq) const {
        int pn_ = __builtin_amdgcn_readfirstlane(u.pn), pm_ = __builtin_amdgcn_readfirstlane(u.pm); asm volatile("" : "+s"(pn_), "+s"(pm_), "+v"(fr), "+v"(fq));
        const int pn = pn_, cc0 = wc * 32 + fq * 8, rowb = pm_ * 256 + wr * 64 + fr;
#define MK_ROW (rowb + ai * 128 + m * 16)
        if (pn <= 2) {
            if (pn < 2 || wc < 2) {
                MK_ROWS_BEGIN
                    const int row = MK_ROW; const bool smp = row >= MP; const int t = smp ? ((row - MP) & 2047) : (row & 255);
                    float o1[8], o2[8];
                    if (smp) { float cs[8], sn[8]; ldf8(w.ropec() + t * 32 + fq * 8, cs); ldf8(w.ropes() + t * 32 + fq * 8, sn);
#pragma unroll
                        for (int e = 0; e < 8; ++e) { o1[e] = v0[e] * cs[e] - v1[e] * sn[e]; o2[e] = v0[e] * sn[e] + v1[e] * cs[e]; } }
                    else {
#pragma unroll
                        for (int e = 0; e < 8; ++e) { o1[e] = v0[e]; o2[e] = v1[e]; } }
                    if (pn < 2) { g2::bf16_t* q = w.Q() + (size_t)row * 512 + (pn * 4 + wc) * 64 + fq * 8; st16(q, pack8(o1)); st16(q + 32, pack8(o2)); }
                    else { g2::bf16_t* k = w.K() + (size_t)row * 128 + wc * 64 + fq * 8; st16(k, pack8(o1)); st16(k + 32, pack8(o2));
                        if (!smp) { float* o = w.out + g2::OUT_K + (((size_t)(row >> 8) * 2 + l) * 256 + t) * 128 + wc * 64 + fq * 8; stf8(o, v0); stf8(o + 32, v1); } }
                MK_ROWS_END
            } else {
                const int c2 = (wc - 2) * 32 + fq * 8;
                MK_ROWS_BEGIN
                    const int row = MK_ROW; g2::bf16_t* vp = w.V() + (size_t)row * 128 + c2; st16(vp, pack8(v0)); st16(vp + 64, pack8(v1));
                    if (row < MP) { float* o = w.out + g2::OUT_V + (((size_t)(row >> 8) * 2 + l) * 256 + (row & 255)) * 128 + c2; stf8(o, v0); stf8(o + 64, v1); }
                MK_ROWS_END
            }
        } else if (pn >= 19) {
            g2::bf16_t* base = w.GM() + (size_t)(pn - 19) * 256 + cc0;
            MK_ROWS_BEGIN
                float o0[8], o1[8];
#pragma unroll
                for (int e = 0; e < 8; ++e) { o0[e] = fsig(v0[e]); o1[e] = fsig(v1[e]); }
                g2::bf16_t* p = base + (size_t)MK_ROW * 4096; st16(p, pack8(o0)); st16(p + 128, pack8(o1));
            MK_ROWS_END
        } else if (pn >= 5 && pn < 9) {
            g2::bf16_t* base = w.XC() + (pn - 5) * 128 + cc0;
            MK_ROWS_BEGIN
                float o[8];
#pragma unroll
                for (int e = 0; e < 8; ++e) o[e] = v0[e] * fsig(v1[e]);
                st16(base + (size_t)MK_ROW * 512, pack8(o));
            MK_ROWS_END
        } else if (pn == 11 || pn == 12 || pn == 15 || pn == 16) {
            g2::bf16_t* base = (pn < 13 ? w.XP() + (pn - 11) * 256 : w.XS() + (pn - 15) * 256) + cc0;
            MK_ROWS_BEGIN
                g2::bf16_t* p = base + (size_t)MK_ROW * 512; st16(p, pack8(v0)); st16(p + 128, pack8(v1));
            MK_ROWS_END
        } else {
            const int br = pn < 5 ? 0 : pn < 11 ? 1 : pn < 15 ? 2 : 3; const int t0 = br == 0 ? 3 : br == 1 ? 9 : br == 2 ? 13 : 17;
            g2::bf16_t* base = w.GATE() + (size_t)br * M * 512 + (pn - t0) * 256 + cc0;
            MK_ROWS_BEGIN
                float o0[8], o1[8];
#pragma unroll
                for (int e = 0; e < 8; ++e) { o0[e] = fsilu(v0[e]); o1[e] = fsilu(v1[e]); }
                g2::bf16_t* p = base + (size_t)MK_ROW * 512; st16(p, pack8(o0)); st16(p + 128, pack8(o1));
            MK_ROWS_END
        }
#undef MK_ROW
    }
};
#define MK1_ROW(ai, m) (rowb + (ai) * 128 + (m) * 16)
__device__ __forceinline__ int glu_orig_col_v2(int row) { const int t = row >> 7, r = row & 127, gi = r >> 3, e = r & 7; return (e < 4 ? 0 : 512) + 64 * t + 4 * gi + (e & 3); }
struct SchedN1 { int c;
    __device__ __forceinline__ bool next(int i, Unit& u) const { if (i > 0 || c >= 256) return false; const int x = c & 7, slot = c >> 3; u.pm = x * 4 + (slot >> 3); u.pn = slot & 7; return true; }
    __device__ __forceinline__ void a_ready(const Unit&) const {}
    __device__ __forceinline__ void done(const Unit&) const {}
};
struct Epi3 {
    static constexpr bool PERM = true, AFTER_DRAIN = false;
    W w;
    __device__ __forceinline__ void operator()(const f32x4 (&acc)[2][1][4][2], const Unit& u, int wr, int wc, int fr, int fq) const {
        int pn_ = __builtin_amdgcn_readfirstlane(u.pn), pm_ = __builtin_amdgcn_readfirstlane(u.pm); asm volatile("" : "+s"(pn_), "+s"(pm_), "+v"(fr), "+v"(fq));
        const int rowb = pm_ * 256 + wr * 64 + fr; g2::bf16_t* base = w.GATE() + (size_t)3 * M * 512 + 64 * pn_ + 16 * wc + 4 * fq;
        unsigned long long gv[2][4];
#pragma unroll
        for (int ai = 0; ai < 2; ++ai)
#pragma unroll
            for (int m = 0; m < 4; ++m) gv[ai][m] = *(const unsigned long long*)(base + (size_t)MK1_ROW(ai, m) * 512);
#pragma unroll
        for (int ai = 0; ai < 2; ++ai)
#pragma unroll
            for (int m = 0; m < 4; ++m) { const f32x4 v = acc[ai][0][m][0], gt = acc[ai][0][m][1]; const unsigned g0 = (unsigned)gv[ai][m], g1 = (unsigned)(gv[ai][m] >> 32);
                const float o0 = v.x * fsig(gt.x) * __uint_as_float(g0 << 16), o1 = v.y * fsig(gt.y) * __uint_as_float(g0 & 0xffff0000u), o2 = v.z * fsig(gt.z) * __uint_as_float(g1 << 16), o3 = v.w * fsig(gt.w) * __uint_as_float(g1 & 0xffff0000u);
                *(unsigned long long*)(base + (size_t)MK1_ROW(ai, m) * 512) = (unsigned long long)pg8::cvt_pk_bf16(o0, o1) | ((unsigned long long)pg8::cvt_pk_bf16(o2, o3) << 32); }
    }
};
struct Epi4a {
    static constexpr bool PERM = true, AFTER_DRAIN = false;
    W w; mutable f32x4 mg[2][4][2];
    __device__ __forceinline__ void operator()(const f32x4 (&acc)[2][1][4][2], const Unit& u, int wr, int wc, int fr, int fq) const {
        int pn_ = __builtin_amdgcn_readfirstlane(u.pn), pm_ = __builtin_amdgcn_readfirstlane(u.pm); asm volatile("" : "+s"(pn_), "+s"(pm_), "+v"(fr), "+v"(fq));
        const int n_ = pn_ >> 3, pn8 = pn_ & 7, rowb = (pm_ & 31) * 256 + wr * 64 + fr, col = pn8 * 128 + wc * 32 + fq * 8;
        u32x4 gv[2][4];
#pragma unroll
        for (int ai = 0; ai < 2; ++ai)
#pragma unroll
            for (int m = 0; m < 4; ++m) gv[ai][m] = *(const u32x4*)(w.GM() + (size_t)MK1_ROW(ai, m) * 4096 + n_ * 1024 + col);
#pragma unroll
        for (int ai = 0; ai < 2; ++ai)
#pragma unroll
            for (int m = 0; m < 4; ++m) { float g[8]; unpack8(gv[ai][m], g);
                const f32x4 p0 = acc[ai][0][m][0] * (f32x4){g[0], g[1], g[2], g[3]}, p1 = acc[ai][0][m][1] * (f32x4){g[4], g[5], g[6], g[7]};
                if (n_ == 0) { mg[ai][m][0] = p0; mg[ai][m][1] = p1; } else { mg[ai][m][0] += p0; mg[ai][m][1] += p1; }
                if (n_ == 3) { const f32x4 a = mg[ai][m][0], b = mg[ai][m][1]; const float o[8] = {a.x, a.y, a.z, a.w, b.x, b.y, b.z, b.w}; st16(w.MRG() + (size_t)MK1_ROW(ai, m) * 1024 + col, pack8(o)); } }
    }
};
struct Sched4a { int c;
    __device__ __forceinline__ bool next(int i, Unit& u) const { if (c >= 256 || i >= 4) return false; const int x = c & 7, slot = c >> 3; u.pm = x * 4 + (slot >> 3) + 32 * i; u.pn = (slot & 7) + 8 * i; return true; }
    __device__ __forceinline__ void a_ready(const Unit&) const {}
    __device__ __forceinline__ void done(const Unit&) const {}
};
constexpr int CW_PANEL = 10240, RMS_P_OFF = 133120, RMS_S_OFF = RMS_P_OFF + 4096;
constexpr size_t WS_RMSX = g2::WS_S + 4 * g2::MiB;
struct Epi4b {
    static constexpr bool PERM = true, AFTER_DRAIN = false;
    InP in; W w; int l;
    __device__ __forceinline__ void operator()(const f32x4 (&acc)[2][1][4][2], const Unit& u, int wr, int wc, int fr, int fq) const {
        int pn_ = __builtin_amdgcn_readfirstlane(u.pn), pm_ = __builtin_amdgcn_readfirstlane(u.pm); asm volatile("" : "+s"(pn_), "+s"(pm_), "+v"(fr), "+v"(fq));
        extern __shared__ __attribute__((aligned(16))) unsigned char lds_e_[]; LAS float* P = (LAS float*)((LAS unsigned char*)lds_e_ + RMS_P_OFF); LAS float* S = (LAS float*)((LAS unsigned char*)lds_e_ + RMS_S_OFF);
        const int rowb = pm_ * 256 + wr * 64 + fr, col = pn_ * 128 + wc * 32 + fq * 8, tid_ = mk_fresh_tid();
        const float* gt = w.mod() + ((size_t)l * 3 + g2::row_modj(pm_ * 256)) * 3072 + 2048 + col; const f32x4 g0 = *(const f32x4*)gt, g1 = *(const f32x4*)(gt + 4);
        f32x4 xn[2][4][2];
#pragma unroll
        for (int ai = 0; ai < 2; ++ai)
#pragma unroll
            for (int m = 0; m < 4; ++m) { const float* xr = g2::xrow(in, w, l, MK1_ROW(ai, m)) + col; xn[ai][m][0] = *(const f32x4*)xr; xn[ai][m][1] = *(const f32x4*)(xr + 4); }
#pragma unroll
        for (int ai = 0; ai < 2; ++ai)
#pragma unroll
            for (int m = 0; m < 4; ++m) { xn[ai][m][0] += g0 * acc[ai][0][m][0]; xn[ai][m][1] += g1 * acc[ai][0][m][1];
                const f32x4 a = xn[ai][m][0], b = xn[ai][m][1]; float s = (a.x * a.x + a.y * a.y) + (a.z * a.z + a.w * a.w) + (b.x * b.x + b.y * b.y) + (b.z * b.z + b.w * b.w);
                s += __int_as_float(__builtin_amdgcn_ds_swizzle(__float_as_int(s), 0x401f));
                { const auto rr = __builtin_amdgcn_permlane32_swap(__float_as_uint(s), __float_as_uint(s), false, false); s = __uint_as_float(rr[0]) + __uint_as_float(rr[1]); }
                if (fq == 0) P[(ai * 128 + wr * 64 + m * 16 + fr) * 4 + wc] = s; }
        if (l == 0) {
#pragma unroll
            for (int ai = 0; ai < 2; ++ai)
#pragma unroll
                for (int m = 0; m < 4; ++m) { float* o = w.out + (size_t)MK1_ROW(ai, m) * 1024 + col; *(f32x4*)o = xn[ai][m][0]; *(f32x4*)(o + 4) = xn[ai][m][1]; } }
        __syncthreads();
        float* slots = (float*)(w.ws + WS_RMSX) + ((size_t)l * M + pm_ * 256) * 8; unsigned* cnt = w.ctl() + CW_PANEL + 16 * (l * 32 + pm_);
        if (tid_ < 256) { const f32x4 p4 = *(const LAS f32x4*)(P + tid_ * 4); __hip_atomic_store(slots + (size_t)tid_ * 8 + pn_, (p4.x + p4.y) + (p4.z + p4.w), __ATOMIC_RELAXED, __HIP_MEMORY_SCOPE_AGENT); }
        asm volatile("s_waitcnt vmcnt(0)" ::: "memory");
        __syncthreads();
        if (tid_ == 0) { __hip_atomic_fetch_add(cnt, 1u, __ATOMIC_RELAXED, __HIP_MEMORY_SCOPE_AGENT);
            unsigned sp = 0; while (__hip_atomic_load(cnt, __ATOMIC_RELAXED, __HIP_MEMORY_SCOPE_AGENT) < 8u && ++sp < (1u << 22)) __builtin_amdgcn_s_sleep(1);
            __builtin_amdgcn_fence(__ATOMIC_ACQUIRE, "agent"); asm volatile("s_waitcnt vmcnt(0)" ::: "memory"); }
        __syncthreads();
        if (tid_ < 256) { const f32x4 a = *(const f32x4*)(slots + (size_t)tid_ * 8), b = *(const f32x4*)(slots + (size_t)tid_ * 8 + 4); S[tid_] = 1.0f / sqrtf(((a.x + a.y) + (a.z + a.w) + (b.x + b.y) + (b.z + b.w)) * (1.0f / 1024.f) + g2::EPS); }
        __syncthreads();
        if (l == 0) { const float* mo = w.mod() + ((size_t)1 * 3 + g2::row_modj(pm_ * 256)) * 3072; float ng[8], sc[8], sh[8]; ldf8(in->norm_g + 1024 + col, ng); ldf8(mo + 1024 + col, sc); ldf8(mo + col, sh);
#pragma unroll
            for (int ai = 0; ai < 2; ++ai)
#pragma unroll
                for (int m = 0; m < 4; ++m) { const float rr = S[ai * 128 + wr * 64 + m * 16 + fr]; const f32x4 a = xn[ai][m][0], b = xn[ai][m][1]; const float xv[8] = {a.x, a.y, a.z, a.w, b.x, b.y, b.z, b.w}; float o[8];
#pragma unroll
                    for (int e = 0; e < 8; ++e) o[e] = (xv[e] * rr) * ng[e] * (1.0f + sc[e]) + sh[e];
                    st16(w.H() + (size_t)MK1_ROW(ai, m) * 1024 + col, pack8(o)); } }
        else { float fg[8]; ldf8(in->final_g + col, fg); const f32x4 f0 = {fg[0], fg[1], fg[2], fg[3]}, f1 = {fg[4], fg[5], fg[6], fg[7]};
#pragma unroll
            for (int ai = 0; ai < 2; ++ai)
#pragma unroll
                for (int m = 0; m < 4; ++m) { const float rr = S[ai * 128 + wr * 64 + m * 16 + fr]; float* o = w.out + (size_t)MK1_ROW(ai, m) * 1024 + col; *(f32x4*)o = xn[ai][m][0] * rr * f0; *(f32x4*)(o + 4) = xn[ai][m][1] * rr * f1; } }
    }
};

__device__ __forceinline__ int fresh_grid() { int g = (int)gridDim.x; asm volatile("" : "+s"(g)); return g; }
__device__ __forceinline__ float wave_sum(float v) {
    v += __int_as_float(__builtin_amdgcn_ds_swizzle(__float_as_int(v), 0x041f)); v += __int_as_float(__builtin_amdgcn_ds_swizzle(__float_as_int(v), 0x081f));
    v += __int_as_float(__builtin_amdgcn_ds_swizzle(__float_as_int(v), 0x101f)); v += __int_as_float(__builtin_amdgcn_ds_swizzle(__float_as_int(v), 0x201f));
    v += __int_as_float(__builtin_amdgcn_ds_swizzle(__float_as_int(v), 0x401f));
    const auto rr = __builtin_amdgcn_permlane32_swap(__float_as_uint(v), __float_as_uint(v), false, false);
    return __uint_as_float(rr[0]) + __uint_as_float(rr[1]);
}
template <bool FINAL> __device__ __forceinline__ void ph_rows(InP in, const W& w, int l) {
    const int tid_ = mk_fresh_tid(); const int lane = tid_ & 63, wave = tid_ >> 6;
    const int gw = blockIdx.x * NWAVES + wave, NGW = fresh_grid() * NWAVES;
    for (int m0 = 4 * gw; m0 < M; m0 += 4 * NGW) {
        f32x4 v[4][4], pg[4], ps[4], ph[4];
#pragma unroll
        for (int q = 0; q < 4; ++q) { const float* xr = FINAL ? w.out + (size_t)(m0 + q) * 1024 : g2::xrow(in, w, l, m0 + q);
#pragma unroll
            for (int j = 0; j < 4; ++j) v[q][j] = *(const f32x4*)(xr + 256 * j + 4 * lane); }
        if (FINAL) {
#pragma unroll
            for (int j = 0; j < 4; ++j) pg[j] = *(const f32x4*)(in->final_g + 256 * j + 4 * lane); }
        else { const float* mo = w.mod() + ((size_t)l * 3 + g2::row_modj(m0)) * 3072; const float* g = in->norm_g + l * 1024;
#pragma unroll
            for (int j = 0; j < 4; ++j) { const int k = 256 * j + 4 * lane; pg[j] = *(const f32x4*)(g + k); ps[j] = *(const f32x4*)(mo + 1024 + k); ph[j] = *(const f32x4*)(mo + k); } }
        __builtin_amdgcn_sched_barrier(0);
#pragma unroll
        for (int q = 0; q < 4; ++q) { float s = 0.f;
#pragma unroll
            for (int j = 0; j < 4; ++j) s += (v[q][j].x * v[q][j].x + v[q][j].y * v[q][j].y) + (v[q][j].z * v[q][j].z + v[q][j].w * v[q][j].w);
            const float r = 1.0f / sqrtf(wave_sum(s) * (1.0f / 1024.f) + g2::EPS);
            if (FINAL) {
#pragma unroll
                for (int j = 0; j < 4; ++j) *(f32x4*)(w.out + (size_t)(m0 + q) * 1024 + 256 * j + 4 * lane) = v[q][j] * r * pg[j]; }
            else {
#pragma unroll
                for (int j = 0; j < 4; ++j) { const int k = 256 * j + 4 * lane; const f32x4 o = (v[q][j] * r) * pg[j] * (ps[j] + 1.0f) + ph[j];
                    *(unsigned long long*)(w.H() + (size_t)(m0 + q) * 1024 + k) = (unsigned long long)pg8::cvt_pk_bf16(o.x, o.y) | ((unsigned long long)pg8::cvt_pk_bf16(o.z, o.w) << 32); } } }
    }
}
__device__ __forceinline__ void cvt_item(const float* Wsrc, int ldw, int oc, g2::bf16_t* WT, int K, int k0, LAS float* scr, int lane) {
    float v[64];
#pragma unroll
    for (int kk = 0; kk < 64; ++kk) v[kk] = Wsrc[(size_t)(k0 + kk) * ldw + oc];
#pragma unroll
    for (int kk = 0; kk < 64; ++kk) scr[kk * 64 + (lane ^ (8 * (kk >> 3)))] = v[kk];
    asm volatile("s_waitcnt lgkmcnt(0)" ::: "memory");
    const int c = lane & 7;
#pragma unroll
    for (int j = 0; j < 8; ++j) { const int n = (lane >> 3) + 8 * j; const LAS float* s_ = scr + (8 * c) * 64 + (n ^ (8 * c));
        u32x4 o; o.x = pg8::cvt_pk_bf16(s_[0 * 64], s_[1 * 64]); o.y = pg8::cvt_pk_bf16(s_[2 * 64], s_[3 * 64]); o.z = pg8::cvt_pk_bf16(s_[4 * 64], s_[5 * 64]); o.w = pg8::cvt_pk_bf16(s_[6 * 64], s_[7 * 64]);
        *(u32x4*)(WT + (size_t)n * K + k0 + 8 * c) = o; }
    asm volatile("s_waitcnt lgkmcnt(0)" ::: "memory");
}
constexpr int CV_I_IN = 16 * (INC / 64), CV_I_GLU = 8 * 16, CV_I_BR = 8 * 16, CV_I_OUT = 16 * 16;
__device__ __forceinline__ void cvt_in_item(InP in, const W& w, int l, int r, LAS float* scr, int lane) {
    const int kb = r / (INC / 64), n0 = (r % (INC / 64)) * 64; const int oca = g2::in_orig_col(n0), ocb = g2::in_orig_col(n0 + 32);
    if (oca >= g2::C_XPOOL && oca < g2::C_XPOOL + 512) return;
    cvt_item(in->w_in + (size_t)l * 1024 * INC, INC, (lane < 32 ? oca : ocb) + (lane & 31), w.win() + ((size_t)l * INC + n0) * 1024, 1024, kb * 64, scr, lane);
}
__device__ __forceinline__ void ph_convert(InP in, const W& w, LAS unsigned char* L) {
    const int tid_ = mk_fresh_tid(); const int lane = tid_ & 63, wave = tid_ >> 6;
    LAS float* scr = (LAS float*)(L + wave * 16384);
    const int gw = blockIdx.x * NWAVES + wave, NGW = fresh_grid() * NWAVES;
    for (int it = gw; it < CV_I_IN; it += NGW) cvt_in_item(in, w, 0, it, scr, lane);
}
constexpr int CV_DEF_WAVE_ITEMS = CV_I_IN + 2 * CV_I_GLU + 8 * CV_I_BR + 2 * CV_I_OUT, CV_DEF_BLOCK_ITEMS = CV_DEF_WAVE_ITEMS / 8;
static_assert(CV_DEF_WAVE_ITEMS % 8 == 0, "deferred conversion items come in groups of 8 (one per wave)");
__device__ __forceinline__ void cvt_deferred_item(InP in, const W& w, LAS unsigned char* L, int bi, int tid_) {
    const int lane = tid_ & 63, wave = tid_ >> 6; LAS float* scr = (LAS float*)(L + wave * 16384);
    int r = bi * 8 + wave;
    if (r < CV_I_IN) { cvt_in_item(in, w, 1, r, scr, lane); return; }
    r -= CV_I_IN;
    if (r < 2 * CV_I_GLU) { const int l = r / CV_I_GLU; r -= l * CV_I_GLU; const int kb = r / 16, n0 = (r % 16) * 64;
        cvt_item(in->glu_w + (size_t)l * 512 * 1024, 1024, glu_orig_col_v2(n0 + lane), w.wglu() + ((size_t)l * 1024 + n0) * 512, 512, kb * 64, scr, lane); return; }
    r -= 2 * CV_I_GLU;
    if (r < 8 * CV_I_BR) { const int ln = r / CV_I_BR; r -= ln * CV_I_BR; const int kb = r / 16, n0 = (r % 16) * 64;
        cvt_item(in->w_br + (size_t)ln * 512 * 1024, 1024, n0 + lane, w.wbr() + ((size_t)ln * 1024 + n0) * 512, 512, kb * 64, scr, lane); return; }
    r -= 8 * CV_I_BR;
    { const int l = r / CV_I_OUT; r -= l * CV_I_OUT; const int kb = r / 16, n0 = (r % 16) * 64;
      cvt_item(in->w_out + (size_t)l * 1024 * 1024, 1024, n0 + lane, w.wout() + ((size_t)l * 1024 + n0) * 1024, 1024, kb * 64, scr, lane); }
}
__device__ __forceinline__ void ph_mod(InP in, const W& w, LAS unsigned char* L) {
    const int tid_ = mk_fresh_tid();
    LAS float* sc = (LAS float*)L;
    LAS float* red = (LAS float*)(L + 12288);
    const int G_ = fresh_grid();
    if ((int)blockIdx.x >= 192) return;
    for (int i = tid_; i < 3 * 1024; i += NTHREADS) { const int j = i >> 10, k = i & 1023; const float v = j == 0 ? in->c_ctx[k] : in->c[(size_t)(j - 1) * 1024 + k]; sc[i] = v * fsig(v); }
    __syncthreads();
    for (int it = blockIdx.x; it < 192; it += G_) { const int l = it / 96, n = (it % 96) * 32 + (tid_ & 31), ks = tid_ >> 5; const float* wa = in->w_ada + ((size_t)l * 1024 + ks * 64) * 3072 + n;
        float a0 = 0.f, a1 = 0.f, a2 = 0.f;
#pragma unroll 16
        for (int kk = 0; kk < 64; ++kk) { const float wv = wa[(size_t)kk * 3072]; const int k = ks * 64 + kk; a0 += sc[k] * wv; a1 += sc[1024 + k] * wv; a2 += sc[2048 + k] * wv; }
        red[(ks * 3 + 0) * 32 + (tid_ & 31)] = a0; red[(ks * 3 + 1) * 32 + (tid_ & 31)] = a1; red[(ks * 3 + 2) * 32 + (tid_ & 31)] = a2;
        __syncthreads();
        if (tid_ < 96) { const int j = tid_ >> 5, cidx = tid_ & 31; float t = 0.f;
#pragma unroll
            for (int q = 0; q < 16; ++q) t += red[(q * 3 + j) * 32 + cidx];
            const int nn = (it % 96) * 32 + cidx; w.mod()[((size_t)l * 3 + j) * 3072 + nn] = t + in->b_ada[l * 3072 + nn]; }
        __syncthreads(); }
}
__device__ __forceinline__ void poolfold_item(InP in, const W& w, LAS unsigned char* L, int it, int tid_) {
    LAS float* A = (LAS float*)(L + 16384);
    LAS float* B = (LAS float*)(L + 16384 + 32768);
    const int l = it >> 6, g = (it >> 4) & 3, k0 = (it & 15) * 64, cg = tid_ & 31, kg = tid_ >> 5;
    __syncthreads();
    for (int i = tid_; i < 64 * 32; i += NTHREADS) *(LAS f32x4*)(A + 4 * i) = *(const f32x4*)(in->w_in + ((size_t)l * 1024 + k0 + (i >> 5)) * INC + g2::C_XPOOL + g * 128 + 4 * (i & 31));
    for (int i = tid_; i < 128 * 32; i += NTHREADS) *(LAS f32x4*)(B + 4 * i) = *(const f32x4*)(in->pool_w + ((size_t)l * 4 + g) * 128 * 128 + 4 * i);
    __syncthreads();
    f32x4 acc[4];
#pragma unroll
    for (int kk = 0; kk < 4; ++kk) acc[kk] = (f32x4){0.f, 0.f, 0.f, 0.f};
#pragma unroll 2
    for (int ci = 0; ci < 128; ci += 4) { f32x4 bv[4], av[4];
#pragma unroll
        for (int j = 0; j < 4; ++j) bv[j] = *(const LAS f32x4*)(B + (ci + j) * 128 + 4 * cg);
#pragma unroll
        for (int kk = 0; kk < 4; ++kk) av[kk] = *(const LAS f32x4*)(A + (4 * kg + kk) * 128 + ci);
#pragma unroll
        for (int kk = 0; kk < 4; ++kk) acc[kk] += bv[0] * av[kk].x + bv[1] * av[kk].y + bv[2] * av[kk].z + bv[3] * av[kk].w; }
    const f32x4 sc_ = *(const f32x4*)(in->pool_scale + l * 512 + g * 128 + 4 * cg);
#pragma unroll
    for (int kk = 0; kk < 4; ++kk) acc[kk] = acc[kk] * sc_;
    g2::bf16_t* dst = w.win() + ((size_t)l * INC + 11 * 256 + g * 128 + 4 * cg) * 1024 + k0 + 4 * kg;
    *(unsigned long long*)(dst) = (unsigned long long)pg8::cvt_pk_bf16(acc[0].x, acc[1].x) | ((unsigned long long)pg8::cvt_pk_bf16(acc[2].x, acc[3].x) << 32);
    *(unsigned long long*)(dst + 1024) = (unsigned long long)pg8::cvt_pk_bf16(acc[0].y, acc[1].y) | ((unsigned long long)pg8::cvt_pk_bf16(acc[2].y, acc[3].y) << 32);
    *(unsigned long long*)(dst + 2048) = (unsigned long long)pg8::cvt_pk_bf16(acc[0].z, acc[1].z) | ((unsigned long long)pg8::cvt_pk_bf16(acc[2].z, acc[3].z) << 32);
    *(unsigned long long*)(dst + 3072) = (unsigned long long)pg8::cvt_pk_bf16(acc[0].w, acc[1].w) | ((unsigned long long)pg8::cvt_pk_bf16(acc[2].w, acc[3].w) << 32);
}
__device__ __forceinline__ void ph_poolfold(InP in, const W& w, LAS unsigned char* L) {
    const int tid_ = mk_fresh_tid(); const int G_ = fresh_grid();
    for (int it = G_ - 1 - (int)blockIdx.x; it < 64; it += G_) poolfold_item(in, w, L, it, tid_);
}
constexpr int CW_CVTQ = CW_QUEUE + 64 * 2, CV_IN_BLOCK_ITEMS = CV_I_IN / 8, DEF_ITEMS = 64 + (CV_DEF_BLOCK_ITEMS - CV_IN_BLOCK_ITEMS);
__device__ __forceinline__ void ph_deferred(InP in, const W& w, LAS unsigned char* L, volatile LAS unsigned* MISC) {
    const int tid_ = mk_fresh_tid(); unsigned* ctr = w.ctl() + CW_CVTQ;
    for (;;) {
        __syncthreads();
        if (tid_ == 0) MISC[0] = __hip_atomic_fetch_add(ctr, 1u, __ATOMIC_RELAXED, __HIP_MEMORY_SCOPE_AGENT);
        __syncthreads();
        const int idx = (int)__builtin_amdgcn_readfirstlane(MISC[0]);
        if (idx >= DEF_ITEMS) break;
        int t_ = tid_; asm volatile("" : "+v"(t_));
        if (idx < 64) poolfold_item(in, w, L, 64 + idx, t_); else cvt_deferred_item(in, w, L, idx - 64 + CV_IN_BLOCK_ITEMS, t_);
    }
}
__device__ __forceinline__ void convpool_unit(InP in, const W& w, int l, LAS unsigned char* L, int u, int tid_) {
    const int c = tid_, lane = tid_ & 63, wave = tid_ >> 6;
    LAS float* Y = (LAS float*)L;
    const int m0 = u * 16, s0 = g2::row_seq0(m0), Lseq = g2::row_len(m0), t0 = m0 - s0;
    g2::bf16_t rawp[32], gr[16]; g2::bf16_t* gp2 = w.GATE() + ((size_t)2 * M + m0) * 512 + c;
#pragma unroll
    for (int i = 0; i < 32; ++i) { const int t = t0 - 8 + i; const int tc = t < 0 ? 0 : (t >= Lseq ? Lseq - 1 : t); rawp[i] = w.XP()[(size_t)(s0 + tc) * 512 + c]; }
#pragma unroll
    for (int tt = 0; tt < 16; ++tt) gr[tt] = gp2[(size_t)tt * 512];
    g2::bf16_t rawc[46];
#pragma unroll
    for (int i = 0; i < 46; ++i) { const int t = t0 - 15 + i; const int tc = t < 0 ? 0 : (t >= Lseq ? Lseq - 1 : t); rawc[i] = w.XC()[(size_t)(s0 + tc) * 512 + c]; }
    __builtin_amdgcn_sched_barrier(0);
    { float xp[32];
#pragma unroll
      for (int i = 0; i < 32; ++i) { const int t = t0 - 8 + i; xp[i] = (t >= 0 && t < Lseq) ? g2::bf2f(rawp[i]) : 0.f; }
      const int grp = c >> 7;
#pragma unroll
      for (int tt = 0; tt < 16; ++tt) { float s2 = xp[tt + 7] + xp[tt + 8], s4 = s2 + xp[tt + 6] + xp[tt + 9], s8 = s4 + (xp[tt + 4] + xp[tt + 5]) + (xp[tt + 10] + xp[tt + 11]);
          float s16 = s8 + ((xp[tt] + xp[tt + 1]) + (xp[tt + 2] + xp[tt + 3])) + ((xp[tt + 12] + xp[tt + 13]) + (xp[tt + 14] + xp[tt + 15]));
          const float sum = grp == 0 ? s2 : grp == 1 ? s4 : grp == 2 ? s8 : s16; const int hw = 1 << grp;
          const int t = t0 + tt; const int lo = t - hw < 0 ? 0 : t - hw, hi = t + hw > Lseq ? Lseq : t + hw;
          gp2[(size_t)tt * 512] = g2::f2bf((sum / (float)(hi - lo) - xp[tt + 8]) * g2::bf2f(gr[tt])); } }
    float wj[31];
#pragma unroll
    for (int j = 0; j < 31; ++j) wj[j] = in->conv_dw[((size_t)l * 31 + j) * 512 + c];
    const float bias = in->conv_db[l * 512 + c];
    float lg[8], lb[8]; ldf8(in->conv_ln_g + l * 512 + 8 * lane, lg); ldf8(in->conv_ln_b + l * 512 + 8 * lane, lb);
    u32x4 gt1[2];
#pragma unroll
    for (int q = 0; q < 2; ++q) gt1[q] = *(const u32x4*)(w.GATE() + ((size_t)1 * M + m0 + wave * 2 + q) * 512 + 8 * lane);
    __builtin_amdgcn_sched_barrier(0);
    { float acc[16];
#pragma unroll
      for (int tt = 0; tt < 16; ++tt) acc[tt] = bias;
#pragma unroll
      for (int i = 0; i < 46; ++i) { const int t = t0 - 15 + i; const float x = (t >= 0 && t < Lseq) ? g2::bf2f(rawc[i]) : 0.f;
#pragma unroll
          for (int tt = 0; tt < 16; ++tt) { const int j = i - tt; if (j >= 0 && j < 31) acc[tt] += x * wj[j]; } }
#pragma unroll
      for (int tt = 0; tt < 16; ++tt) Y[tt * 512 + c] = acc[tt]; }
    __syncthreads();
#pragma unroll
    for (int q = 0; q < 2; ++q) { const int tt = wave * 2 + q; float y[8]; const f32x4 a = *(const LAS f32x4*)(Y + tt * 512 + 8 * lane), b = *(const LAS f32x4*)(Y + tt * 512 + 8 * lane + 4);
        y[0] = a.x; y[1] = a.y; y[2] = a.z; y[3] = a.w; y[4] = b.x; y[5] = b.y; y[6] = b.z; y[7] = b.w; float s_ = 0.f;
#pragma unroll
        for (int e = 0; e < 8; ++e) s_ += y[e];
        const float mu = wave_sum(s_) * (1.0f / 512.f); float q2 = 0.f;
#pragma unroll
        for (int e = 0; e < 8; ++e) { y[e] -= mu; q2 += y[e] * y[e]; }
        const float rs = 1.0f / sqrtf(wave_sum(q2) * (1.0f / 512.f) + g2::EPS);
        float gt[8], o[8]; unpack8(gt1[q], gt);
#pragma unroll
        for (int e = 0; e < 8; ++e) o[e] = fsilu(y[e] * rs * lg[e] + lb[e]) * gt[e];
        st16(w.GATE() + ((size_t)1 * M + m0 + tt) * 512 + 8 * lane, pack8(o)); }
    __syncthreads();
}

constexpr size_t WS_BB = 3 * g2::MiB, WS_CC = 3 * g2::MiB + 512 * 1024;
struct FSsmTab { InP in; W w;
    __device__ __forceinline__ void operator()(long i) const { const int p = i % 64, g = (i / 64) % 32; const long ld = i / (64 * 32);
        const float lr = in->lam_re[i], li = in->lam_im[i]; const float dt = expf(in->log_dt[ld * 32 + g]);
        const float e = expf(lr * dt), br_ = e * cosf(li * dt), bi_ = e * sinf(li * dt); w.lamb()[2 * i] = br_; w.lamb()[2 * i + 1] = bi_;
        const float nr = br_ - 1.0f, ni = bi_, den = lr * lr + li * li, fr = (nr * lr + ni * li) / den, fi = (ni * lr - nr * li) / den;
        g2::bf16_t* bb = (g2::bf16_t*)(w.ws + WS_BB) + ((size_t)(ld * 32 + g) * 2 * 64 + p) * 16; g2::bf16_t* cc = (g2::bf16_t*)(w.ws + WS_CC) + (size_t)(ld * 32 + g) * 16 * 128 + 2 * p;
        for (int c = 0; c < 16; ++c) { const float xr = in->b_re[i * 16 + c], xi = in->b_im[i * 16 + c]; bb[c] = g2::f2bf(fr * xr - fi * xi); bb[64 * 16 + c] = g2::f2bf(fr * xi + fi * xr);
            cc[c * 128] = g2::f2bf(in->c_re[((ld * 32 + g) * 16 + c) * 64 + p]); cc[c * 128 + 1] = g2::f2bf(-in->c_im[((ld * 32 + g) * 16 + c) * 64 + p]); } } };

typedef short bf16x8_t __attribute__((ext_vector_type(8)));
typedef float f32x2_t __attribute__((ext_vector_type(2)));
constexpr int SSM_WAVE_LDS = 12800, SSM_HROW = 272, SSM_XCH = 8 * SSM_WAVE_LDS;
__device__ __forceinline__ float fgelu(float x) { const float u = 0.7978845608028654f * (x + 0.044715f * x * x * x); return x * fsig(2.0f * u); }

template <int MODE> __device__ __forceinline__ void ssm_pass(const W& w, int l, int dir, int g, int m_lo, int ntok, float& hr, float& hi, LAS unsigned char* wl, int lane, float dval) {
    LAS f32x2_t* BU = (LAS f32x2_t*)wl; LAS unsigned char* Hb = wl + 8192;
    const int ld = l * 2 + dir, fr = lane & 15, fq = lane >> 4;
    const f32x2_t lam = *(const f32x2_t*)(w.lamb() + ((size_t)(ld * 32 + g) * 64 + lane) * 2);
    bf16x8_t bfr[4][2], cfr[4];
    { const g2::bf16_t* bb = (const g2::bf16_t*)(w.ws + WS_BB) + (size_t)(ld * 32 + g) * 2 * 64 * 16;
#pragma unroll
      for (int q = 0; q < 4; ++q)
#pragma unroll
          for (int ri = 0; ri < 2; ++ri) { const bf16x8_t t_ = *(const bf16x8_t*)(bb + ((size_t)ri * 64 + 16 * q + fr) * 16 + 8 * (fq & 1)); bfr[q][ri] = fq < 2 ? t_ : (bf16x8_t){0, 0, 0, 0, 0, 0, 0, 0}; }
      if (MODE != 0) { const g2::bf16_t* cc = (const g2::bf16_t*)(w.ws + WS_CC) + ((size_t)(ld * 32 + g) * 16 + fr) * 128;
#pragma unroll
          for (int ks = 0; ks < 4; ++ks) cfr[ks] = *(const bf16x8_t*)(cc + 32 * ks + 8 * fq); } }
    const int nch = ntok >> 4; const g2::bf16_t* xs = w.XS() + (size_t)g * 16;
    auto chunk_row = [&](int ci) { return dir == 0 ? m_lo + 16 * ci : m_lo + ntok - 16 - 16 * ci; };
    struct Pre { bf16x8_t a; g2::bf16_t x[4]; float yf[4]; };
    auto fetch = [&](int ci, Pre& P) { if (ci < nch) { const int mn = chunk_row(ci); P.a = *(const bf16x8_t*)(xs + (size_t)(mn + fr) * 512 + 8 * (fq & 1));
            if (MODE != 0) {
#pragma unroll
                for (int r = 0; r < 4; ++r) { const size_t o = (size_t)(mn + 4 * fq + r) * 512 + g * 16 + fr; P.x[r] = w.XS()[o]; if (MODE == 2) P.yf[r] = w.TMP()[o]; } } } };
    auto step = [&](int ci, Pre& P) {
        const int mt = chunk_row(ci); const bf16x8_t a = fq < 2 ? P.a : (bf16x8_t){0, 0, 0, 0, 0, 0, 0, 0}; float xc[4], yfc[4];
#pragma unroll
        for (int r = 0; r < 4; ++r) { xc[r] = g2::bf2f(P.x[r]); yfc[r] = P.yf[r]; }
        fetch(ci + 2, P);
#pragma unroll
        for (int q = 0; q < 4; ++q) { const f32x4 z = {0.f, 0.f, 0.f, 0.f};
            const f32x4 dre = __builtin_amdgcn_mfma_f32_16x16x32_bf16(a, bfr[q][0], z, 0, 0, 0), dim = __builtin_amdgcn_mfma_f32_16x16x32_bf16(a, bfr[q][1], z, 0, 0, 0);
#pragma unroll
            for (int r = 0; r < 4; ++r) BU[(4 * fq + r) * 64 + 16 * q + fr] = (f32x2_t){dre[r], dim[r]}; }
        f32x2_t bq[16];
#pragma unroll
        for (int s_ = 0; s_ < 16; ++s_) bq[s_] = BU[(dir == 0 ? s_ : 15 - s_) * 64 + lane];
        unsigned hw[16];
#pragma unroll
        for (int s_ = 0; s_ < 16; ++s_) { const float nr = lam.x * hr - lam.y * hi + bq[s_].x, ni = lam.x * hi + lam.y * hr + bq[s_].y; hr = nr; hi = ni; if (MODE != 0) hw[s_] = pg8::cvt_pk_bf16(hr, hi); }
        if (MODE != 0) {
#pragma unroll
            for (int s_ = 0; s_ < 16; ++s_) *(LAS unsigned*)(Hb + (dir == 0 ? s_ : 15 - s_) * SSM_HROW + lane * 4) = hw[s_];
            f32x4 y = {0.f, 0.f, 0.f, 0.f};
#pragma unroll
            for (int ks = 0; ks < 4; ++ks) { const bf16x8_t ha = *(const LAS bf16x8_t*)(Hb + fr * SSM_HROW + 64 * ks + 16 * fq); y = __builtin_amdgcn_mfma_f32_16x16x32_bf16(ha, cfr[ks], y, 0, 0, 0); }
#pragma unroll
            for (int r = 0; r < 4; ++r) { const size_t o = (size_t)(mt + 4 * fq + r) * 512 + g * 16 + fr;
                if (MODE == 1) w.TMP()[o] = y[r] + dval * xc[r]; else w.YS()[o] = g2::f2bf(fgelu(y[r] + yfc[r])); } }
    };
    Pre PA, PB;
#pragma unroll
    for (int r = 0; r < 4; ++r) { PA.x[r] = 0; PA.yf[r] = 0.f; PB.x[r] = 0; PB.yf[r] = 0.f; }
    PA.a = (bf16x8_t){0, 0, 0, 0, 0, 0, 0, 0}; PB.a = PA.a;
    fetch(0, PA); fetch(1, PB);
#pragma unroll 1
    for (int ci = 0; ci < nch; ci += 2) { step(ci, PA); step(ci + 1, PB); }
}
__device__ __forceinline__ void cmul(float& ar, float& ai, float br, float bi) { const float t = ar * br - ai * bi; ai = ar * bi + ai * br; ar = t; }
template <int DIR> __device__ __forceinline__ void ssm_pass0_dir(const W& w, int l, int g, const bf16x8_t (&A)[16], float& er, float& ei, LAS f32x2_t* BU, int lane) {
    const int fr = lane & 15, fq = lane >> 4, ld = l * 2 + DIR;
    bf16x8_t bfr[4][2];
    { const g2::bf16_t* bb = (const g2::bf16_t*)(w.ws + WS_BB) + (size_t)(ld * 32 + g) * 2 * 64 * 16;
#pragma unroll
      for (int q = 0; q < 4; ++q)
#pragma unroll
          for (int ri = 0; ri < 2; ++ri) { const bf16x8_t t_ = *(const bf16x8_t*)(bb + ((size_t)ri * 64 + 16 * q + fr) * 16 + 8 * (fq & 1)); bfr[q][ri] = fq < 2 ? t_ : (bf16x8_t){0, 0, 0, 0, 0, 0, 0, 0}; } }
    float l1r[4], l1i[4], l16r[4], l16i[4], wr_[4], wi_[4], sr[4], si[4];
#pragma unroll
    for (int q = 0; q < 4; ++q) { const f32x2_t lam = *(const f32x2_t*)(w.lamb() + ((size_t)(ld * 32 + g) * 64 + 16 * q + fr) * 2); l1r[q] = lam.x; l1i[q] = lam.y;
        float p4r = lam.x, p4i = lam.y; cmul(p4r, p4i, p4r, p4i); cmul(p4r, p4i, p4r, p4i);
        float p8r = p4r, p8i = p4i; cmul(p8r, p8i, p8r, p8i);
        float p16r = p8r, p16i = p8i; cmul(p16r, p16i, p16r, p16i);
        l16r[q] = p16r; l16i[q] = p16i;
        const int k = DIR == 0 ? 3 - fq : fq;
        float p12r = p8r, p12i = p8i; cmul(p12r, p12i, p4r, p4i);
        wr_[q] = k == 0 ? 1.f : k == 1 ? p4r : k == 2 ? p8r : p12r; wi_[q] = k == 0 ? 0.f : k == 1 ? p4i : k == 2 ? p8i : p12i; sr[q] = 0.f; si[q] = 0.f; }
#pragma unroll
    for (int cc = 0; cc < 16; ++cc) { const bf16x8_t a = fq < 2 ? A[DIR == 0 ? cc : 15 - cc] : (bf16x8_t){0, 0, 0, 0, 0, 0, 0, 0};
#pragma unroll
        for (int q = 0; q < 4; ++q) { const f32x4 z = {0.f, 0.f, 0.f, 0.f};
            const f32x4 dre = __builtin_amdgcn_mfma_f32_16x16x32_bf16(a, bfr[q][0], z, 0, 0, 0), dim = __builtin_amdgcn_mfma_f32_16x16x32_bf16(a, bfr[q][1], z, 0, 0, 0);
            float hr, hi;
            if (DIR == 0) { hr = dre[0]; hi = dim[0];
#pragma unroll
                for (int r = 1; r < 4; ++r) { cmul(hr, hi, l1r[q], l1i[q]); hr += dre[r]; hi += dim[r]; } }
            else { hr = dre[3]; hi = dim[3];
#pragma unroll
                for (int r = 2; r >= 0; --r) { cmul(hr, hi, l1r[q], l1i[q]); hr += dre[r]; hi += dim[r]; } }
            cmul(sr[q], si[q], l16r[q], l16i[q]); sr[q] += hr; si[q] += hi; }
        __builtin_amdgcn_sched_barrier(0); }
#pragma unroll
    for (int q = 0; q < 4; ++q) { cmul(sr[q], si[q], wr_[q], wi_[q]); BU[(DIR * 4 + fq) * 64 + 16 * q + fr] = (f32x2_t){sr[q], si[q]}; }
    const f32x2_t e0 = BU[(DIR * 4 + 0) * 64 + lane], e1 = BU[(DIR * 4 + 1) * 64 + lane], e2 = BU[(DIR * 4 + 2) * 64 + lane], e3 = BU[(DIR * 4 + 3) * 64 + lane];
    er = (e0.x + e1.x) + (e2.x + e3.x); ei = (e0.y + e1.y) + (e2.y + e3.y);
}
template <int DIR> __device__ __forceinline__ void ssm_pass0_dir(const W& w, int l, int g, float& er, float& ei, LAS unsigned char* wl, int lane) {
    const int fr = lane & 15, fq = lane >> 4, ld = l * 2 + DIR; LAS f32x2_t* XB = (LAS f32x2_t*)(wl + 8192);
    bf16x8_t bfr[4][2];
    { const g2::bf16_t* bb = (const g2::bf16_t*)(w.ws + WS_BB) + (size_t)(ld * 32 + g) * 2 * 64 * 16;
#pragma unroll
      for (int q = 0; q < 4; ++q)
#pragma unroll
          for (int ri = 0; ri < 2; ++ri) { const bf16x8_t t_ = *(const bf16x8_t*)(bb + ((size_t)ri * 64 + 16 * q + fr) * 16 + 8 * (fq & 1)); bfr[q][ri] = fq < 2 ? t_ : (bf16x8_t){0, 0, 0, 0, 0, 0, 0, 0}; } }
    float l1r[4], l1i[4], l16r[4], l16i[4], wr_[4], wi_[4], sr[4], si[4];
#pragma unroll
    for (int q = 0; q < 4; ++q) { const f32x2_t lam = *(const f32x2_t*)(w.lamb() + ((size_t)(ld * 32 + g) * 64 + 16 * q + fr) * 2); l1r[q] = lam.x; l1i[q] = lam.y;
        float p4r = lam.x, p4i = lam.y; cmul(p4r, p4i, p4r, p4i); cmul(p4r, p4i, p4r, p4i);
        float p8r = p4r, p8i = p4i; cmul(p8r, p8i, p8r, p8i);
        float p16r = p8r, p16i = p8i; cmul(p16r, p16i, p16r, p16i);
        l16r[q] = p16r; l16i[q] = p16i;
        const int k = DIR == 0 ? 3 - fq : fq;
        float p12r = p8r, p12i = p8i; cmul(p12r, p12i, p4r, p4i);
        wr_[q] = k == 0 ? 1.f : k == 1 ? p4r : k == 2 ? p8r : p12r; wi_[q] = k == 0 ? 0.f : k == 1 ? p4i : k == 2 ? p8i : p12i; sr[q] = 0.f; si[q] = 0.f; }
    const LAS bf16x8_t* AS = (const LAS bf16x8_t*)wl + (lane & 31);
    bf16x8_t a_n = AS[(DIR == 0 ? 0 : 15) * 32];
#pragma unroll 1
    for (int cc = 0; cc < 16; ++cc) { const bf16x8_t a = fq < 2 ? a_n : (bf16x8_t){0, 0, 0, 0, 0, 0, 0, 0};
        if (cc + 1 < 16) a_n = AS[(DIR == 0 ? cc + 1 : 14 - cc) * 32];
#pragma unroll
        for (int q = 0; q < 4; ++q) { const f32x4 z = {0.f, 0.f, 0.f, 0.f};
            const f32x4 dre = __builtin_amdgcn_mfma_f32_16x16x32_bf16(a, bfr[q][0], z, 0, 0, 0), dim = __builtin_amdgcn_mfma_f32_16x16x32_bf16(a, bfr[q][1], z, 0, 0, 0);
            float hr, hi;
            if (DIR == 0) { hr = dre[0]; hi = dim[0];
#pragma unroll
                for (int r = 1; r < 4; ++r) { cmul(hr, hi, l1r[q], l1i[q]); hr += dre[r]; hi += dim[r]; } }
            else { hr = dre[3]; hi = dim[3];
#pragma unroll
                for (int r = 2; r >= 0; --r) { cmul(hr, hi, l1r[q], l1i[q]); hr += dre[r]; hi += dim[r]; } }
            cmul(sr[q], si[q], l16r[q], l16i[q]); sr[q] += hr; si[q] += hi; } }
#pragma unroll
    for (int q = 0; q < 4; ++q) { cmul(sr[q], si[q], wr_[q], wi_[q]); XB[(DIR * 4 + fq) * 64 + 16 * q + fr] = (f32x2_t){sr[q], si[q]}; }
    const f32x2_t e0 = XB[(DIR * 4 + 0) * 64 + lane], e1 = XB[(DIR * 4 + 1) * 64 + lane], e2 = XB[(DIR * 4 + 2) * 64 + lane], e3 = XB[(DIR * 4 + 3) * 64 + lane];
    er = (e0.x + e1.x) + (e2.x + e3.x); ei = (e0.y + e1.y) + (e2.y + e3.y);
}
__device__ __forceinline__ void ssm_pass0(const W& w, int l, int g, int m_lo, float (&er)[2], float (&ei)[2], LAS unsigned char* wl, int lane) {
    const int fr = lane & 15, fq = lane >> 4; const g2::bf16_t* xs = w.XS() + (size_t)g * 16;
    { bf16x8_t A[16];
#pragma unroll
      for (int ci = 0; ci < 16; ++ci) A[ci] = *(const bf16x8_t*)(xs + (size_t)(m_lo + 16 * ci + fr) * 512 + 8 * (fq & 1));
      LAS bf16x8_t* AS = (LAS bf16x8_t*)wl + (lane & 31);
#pragma unroll
      for (int ci = 0; ci < 16; ++ci) AS[ci * 32] = A[ci]; }
    ssm_pass0_dir<0>(w, l, g, er[0], ei[0], wl, lane); ssm_pass0_dir<1>(w, l, g, er[1], ei[1], wl, lane);
}
__device__ __forceinline__ void ssm_unit(InP in, const W& w, int l, LAS unsigned char* L, int bu, int tid_) {
    const int lane = tid_ & 63, wave = __builtin_amdgcn_readfirstlane(tid_ >> 6);
    LAS unsigned char* wl = L + wave * SSM_WAVE_LDS; LAS f32x2_t* XCH = (LAS f32x2_t*)(L + SSM_XCH);
    {
        if (bu < 64) {
            const int b = bu >> 5, g = bu & 31, m_lo = MP + b * 2048 + wave * 256; const float dval = in->ssm_d[l * 512 + g * 16 + (lane & 15)];
            float e_r[2], e_i[2];
            ssm_pass0(w, l, g, m_lo, e_r, e_i, wl, lane);
            XCH[(wave * 2 + 0) * 64 + lane] = (f32x2_t){e_r[0], e_i[0]}; XCH[(wave * 2 + 1) * 64 + lane] = (f32x2_t){e_r[1], e_i[1]};
            __syncthreads();
            float cr[2], ci[2];
#pragma unroll
            for (int dir = 0; dir < 2; ++dir) { const f32x2_t lam = *(const f32x2_t*)(w.lamb() + ((size_t)((l * 2 + dir) * 32 + g) * 64 + lane) * 2); float pr = lam.x, pi = lam.y;
#pragma unroll
                for (int sq = 0; sq < 8; ++sq) { const float t = pr * pr - pi * pi; pi = 2.f * pr * pi; pr = t; }
                const float* st = in->state_ssm + ((((size_t)b * 2 + l) * 2 + dir) * 2) * 2048 + g * 64 + lane; float hr = st[0], hi = st[2048];
                if (dir == 0) { for (int j = 0; j < wave; ++j) { const f32x2_t e = XCH[(j * 2 + 0) * 64 + lane]; const float t = pr * hr - pi * hi + e.x; hi = pr * hi + pi * hr + e.y; hr = t; } }
                else { for (int j = 7; j > wave; --j) { const f32x2_t e = XCH[(j * 2 + 1) * 64 + lane]; const float t = pr * hr - pi * hi + e.x; hi = pr * hi + pi * hr + e.y; hr = t; } }
                cr[dir] = hr; ci[dir] = hi; }
            ssm_pass<1>(w, l, 0, g, m_lo, 256, cr[0], ci[0], wl, lane, dval); ssm_pass<2>(w, l, 1, g, m_lo, 256, cr[1], ci[1], wl, lane, dval);
            __syncthreads();
        } else {
            const int pair = (bu - 64) * 8 + wave, b = pair >> 5, g = pair & 31, m_lo = b * 256; const float dval = in->ssm_d[l * 512 + g * 16 + (lane & 15)];
            float hr = 0.f, hi = 0.f;
            ssm_pass<1>(w, l, 0, g, m_lo, 256, hr, hi, wl, lane, dval);
            { float* o = w.out + g2::OUT_ST + ((((size_t)b * 2 + l) * 2 + 0) * 2) * 2048 + g * 64 + lane; o[0] = hr; o[2048] = hi; }
            hr = 0.f; hi = 0.f;
            ssm_pass<2>(w, l, 1, g, m_lo, 256, hr, hi, wl, lane, dval);
            { float* o = w.out + g2::OUT_ST + ((((size_t)b * 2 + l) * 2 + 1) * 2) * 2048 + g * 64 + lane; o[0] = hr; o[2048] = hi; }
        }
    }
}


constexpr size_t WS_CK = g2::WS_BBAR, WS_CV = g2::WS_BBAR + 256 * 1024;
struct FCvtCache { InP in; W w;
    __device__ __forceinline__ void operator()(long i) const { const long n = 2L * 2 * 256 * 128; if (i < n) ((g2::bf16_t*)(w.ws + WS_CK))[i] = g2::f2bf(in->cache_k[i]); else ((g2::bf16_t*)(w.ws + WS_CV))[i - n] = g2::f2bf(in->cache_v[i - n]); } };
typedef float f32x16 __attribute__((ext_vector_type(16)));
typedef short s16x4 __attribute__((ext_vector_type(4)));
constexpr int AT_SLOT = 16384, AT_KOFF = 0, AT_VOFF = 8192;
constexpr float AT_C2 = 0.125f * 1.4426950408889634f, AT_LOG2E = 1.4426950408889634f;
__device__ __forceinline__ int at_crow(int r, int hi) { return (r & 3) + 8 * (r >> 2) + 4 * hi; }
__device__ __forceinline__ float at_rowmax(const f32x16& p0, const f32x16& p1) { float a = fmaxf(p0[0], p1[0]);
#pragma unroll
    for (int r = 1; r < 16; ++r) a = fmaxf(a, fmaxf(p0[r], p1[r]));
    const auto rr = __builtin_amdgcn_permlane32_swap(__float_as_uint(a), __float_as_uint(a), false, false); return fmaxf(__uint_as_float(rr[0]), __uint_as_float(rr[1])); }

__device__ __forceinline__ void attn_unit(InP in, const W& w, int l, LAS unsigned char* L, int u, int tid_) {
    const int lane = tid_ & 63, r32 = lane & 31, hi = lane >> 5, wave = __builtin_amdgcn_readfirstlane(tid_ >> 6);
    {
        int head, kv, mq, qpos, ntile, nctx, klo; const g2::bf16_t *kbase, *vbase, *ckbase, *cvbase;
        if (u < 128) { const int b = u >> 6, rem = u & 63, pb = (rem >> 1) & 15; kv = rem >> 5; head = kv * 4 + (rem & 1) * 2 + (wave >> 2); qpos = pb * 128 + 32 * (wave & 3) + r32; mq = MP + b * 2048 + qpos;
            klo = pb * 128 - 128 < 0 ? 0 : pb * 128 - 128; const int khi = pb * 128 + 256 > 2048 ? 2048 : pb * 128 + 256; nctx = 4; ntile = 4 + (khi - klo) / 64;
            kbase = w.K() + (size_t)(MP + b * 2048 + klo) * 128; vbase = w.V() + (size_t)(MP + b * 2048 + klo) * 128;
            ckbase = (const g2::bf16_t*)(w.ws + WS_CK) + (size_t)(b * 2 + l) * 256 * 128; cvbase = (const g2::bf16_t*)(w.ws + WS_CV) + (size_t)(b * 2 + l) * 256 * 128; }
        else { const int b = (u - 128) >> 3; head = (u - 128) & 7; kv = head >> 2; qpos = 32 * wave + r32; mq = b * 256 + qpos; klo = 0; nctx = 0; ntile = 4;
            kbase = w.K() + (size_t)(b * 256) * 128; vbase = w.V() + (size_t)(b * 256) * 128; ckbase = kbase; cvbase = vbase; }
        bf16x8_t qr[4];
#pragma unroll
        for (int d0 = 0; d0 < 4; ++d0) qr[d0] = *(const bf16x8_t*)(w.Q() + (size_t)mq * 512 + head * 64 + d0 * 16 + hi * 8);
        float mrun = in->attn_sink[l * 8 + head] * AT_LOG2E, lsum = hi == 0 ? 1.0f : 0.0f;
        f32x16 o[2]; o[0] = f32x16{}; o[1] = f32x16{};
        auto ksrc = [&](int i) { const g2::bf16_t* base = i < nctx ? ckbase + (size_t)(64 * i) * 128 : kbase + (size_t)(64 * (i - nctx)) * 128; return base + (size_t)lane * 128 + kv * 64 + 8 * wave; };
        auto vsrc = [&](int i) { const g2::bf16_t* base = i < nctx ? cvbase + (size_t)(64 * i) * 128 : vbase + (size_t)(64 * (i - nctx)) * 128; return base + (size_t)(16 * (wave & 3) + (lane >> 2)) * 128 + kv * 64 + (wave >> 2) * 32 + (lane & 3) * 8; };
        u32x4 kreg = *(const u32x4*)ksrc(0), vreg = *(const u32x4*)vsrc(0);
        __syncthreads();
        *(LAS u32x4*)(L + AT_KOFF + wave * 1024 + lane * 16) = kreg; *(LAS u32x4*)(L + AT_VOFF + wave * 1024 + lane * 16) = vreg;
        __syncthreads();
#pragma unroll 1
        for (int i = 0; i < ntile; ++i) {
            LAS unsigned char* slot = L + (i & 1) * AT_SLOT;
            if (i + 1 < ntile) { kreg = *(const u32x4*)ksrc(i + 1); vreg = *(const u32x4*)vsrc(i + 1); }
            __builtin_amdgcn_sched_barrier(0);
            const int kp0 = klo + 64 * (i - nctx); const int q0 = qpos - r32;
            const bool win = i >= nctx && nctx > 0; const bool skip = win && (kp0 > q0 + 31 + 128 || kp0 + 63 < q0 - 128);
            if (!skip) {
                f32x16 p0 = f32x16{}, p1 = f32x16{};
                { const LAS unsigned char* kb = slot + AT_KOFF + hi * 1024 + r32 * 16;
#pragma unroll
                  for (int d0 = 0; d0 < 4; ++d0) { const bf16x8_t b0 = *(const LAS bf16x8_t*)(kb + d0 * 2048), b1 = *(const LAS bf16x8_t*)(kb + d0 * 2048 + 512);
                      p0 = __builtin_amdgcn_mfma_f32_32x32x16_bf16(b0, qr[d0], p0, 0, 0, 0); p1 = __builtin_amdgcn_mfma_f32_32x32x16_bf16(b1, qr[d0], p1, 0, 0, 0); } }
                if (win && (kp0 + 63 - q0 > 128 || q0 + 31 - kp0 > 128)) {
#pragma unroll
                    for (int r = 0; r < 16; ++r) { const int kk = kp0 + at_crow(r, hi); const int d0_ = qpos - kk, d1_ = qpos - (kk + 32);
                        if (d0_ > 128 || d0_ < -128) p0[r] = -1e30f; if (d1_ > 128 || d1_ < -128) p1[r] = -1e30f; } }
                const float rm = at_rowmax(p0, p1) * AT_C2; const float mnew = fmaxf(mrun, rm); const float alpha = __builtin_amdgcn_exp2f(mrun - mnew); mrun = mnew;
                float psum = 0.f;
#pragma unroll
                for (int r = 0; r < 16; ++r) { p0[r] = __builtin_amdgcn_exp2f(p0[r] * AT_C2 - mnew); p1[r] = __builtin_amdgcn_exp2f(p1[r] * AT_C2 - mnew); psum += p0[r] + p1[r]; }
                lsum = lsum * alpha + psum;
#pragma unroll
                for (int r = 0; r < 16; ++r) { o[0][r] *= alpha; o[1][r] *= alpha; }
                u32x4 pw[4];
#pragma unroll
                for (int s_ = 0; s_ < 4; ++s_) { const f32x16& P = s_ < 2 ? p0 : p1; const int bse = (s_ & 1) * 8;
                    pw[s_] = (u32x4){pg8::cvt_pk_bf16(P[bse], P[bse + 1]), pg8::cvt_pk_bf16(P[bse + 2], P[bse + 3]), pg8::cvt_pk_bf16(P[bse + 4], P[bse + 5]), pg8::cvt_pk_bf16(P[bse + 6], P[bse + 7])}; }
                const unsigned vb = (unsigned)(uintptr_t)(slot + AT_VOFF) + ((lane >> 4) & 1) * 32 + (lane & 3) * 8 + (4 * hi + ((lane & 15) >> 2)) * 64;
#pragma unroll
                for (int d0 = 0; d0 < 2; ++d0) { s16x4 lo[4], hh[4];
#pragma unroll
                    for (int ks = 0; ks < 4; ++ks) {
                        asm volatile("ds_read_b64_tr_b16 %0, %1 offset:%c2" : "=&v"(lo[ks]) : "v"(vb), "i"(d0 * 4096 + ks * 1024) : "memory");
                        asm volatile("ds_read_b64_tr_b16 %0, %1 offset:%c2" : "=&v"(hh[ks]) : "v"(vb), "i"(d0 * 4096 + ks * 1024 + 512) : "memory"); }
                    asm volatile("s_waitcnt lgkmcnt(0)" ::: "memory"); __builtin_amdgcn_sched_barrier(0);
#pragma unroll
                    for (int ks = 0; ks < 4; ++ks) { const bf16x8_t vf = (bf16x8_t){lo[ks][0], lo[ks][1], lo[ks][2], lo[ks][3], hh[ks][0], hh[ks][1], hh[ks][2], hh[ks][3]};
                        o[d0] = __builtin_amdgcn_mfma_f32_32x32x16_bf16(vf, __builtin_bit_cast(bf16x8_t, pw[ks]), o[d0], 0, 0, 0); } }
            }
            if (i + 1 < ntile) { LAS unsigned char* ns = L + ((i + 1) & 1) * AT_SLOT; *(LAS u32x4*)(ns + AT_KOFF + wave * 1024 + lane * 16) = kreg; *(LAS u32x4*)(ns + AT_VOFF + wave * 1024 + lane * 16) = vreg; }
            __syncthreads();
        }
        { const auto rr = __builtin_amdgcn_permlane32_swap(__float_as_uint(lsum), __float_as_uint(lsum), false, false); const float inv = 1.0f / (__uint_as_float(rr[0]) + __uint_as_float(rr[1]));
          g2::bf16_t* gp = w.GATE() + (size_t)mq * 512 + head * 64; unsigned long long gvv[2][4];
#pragma unroll
          for (int d0 = 0; d0 < 2; ++d0)
#pragma unroll
              for (int rq = 0; rq < 4; ++rq) gvv[d0][rq] = *(const unsigned long long*)(gp + 32 * d0 + 8 * rq + 4 * hi);
#pragma unroll
          for (int d0 = 0; d0 < 2; ++d0)
#pragma unroll
              for (int rq = 0; rq < 4; ++rq) { g2::bf16_t* p = gp + 32 * d0 + 8 * rq + 4 * hi; const unsigned long long gv = gvv[d0][rq]; const unsigned g0 = (unsigned)gv, g1 = (unsigned)(gv >> 32);
                  const float a0 = o[d0][4 * rq] * inv * __uint_as_float(g0 << 16), a1 = o[d0][4 * rq + 1] * inv * __uint_as_float(g0 & 0xffff0000u), a2 = o[d0][4 * rq + 2] * inv * __uint_as_float(g1 << 16), a3 = o[d0][4 * rq + 3] * inv * __uint_as_float(g1 & 0xffff0000u);
                  *(unsigned long long*)p = (unsigned long long)pg8::cvt_pk_bf16(a0, a1) | ((unsigned long long)pg8::cvt_pk_bf16(a2, a3) << 32); } }
    }
}


constexpr int MIX_UNITS = 128 + 256 + 512;
__device__ __forceinline__ void ph_mixers(InP in, const W& w, int l, LAS unsigned char* L, volatile LAS unsigned* MISC) {
    const int tid_ = mk_fresh_tid();
    unsigned* ctr = w.ctl() + CW_QUEUE + 64 * l;
    for (;;) {
        __syncthreads();
        if (tid_ == 0) MISC[0] = __hip_atomic_fetch_add(ctr, 1u, __ATOMIC_RELAXED, __HIP_MEMORY_SCOPE_AGENT);
        __syncthreads();
        const int idx = (int)__builtin_amdgcn_readfirstlane(MISC[0]);
        if (idx >= MIX_UNITS + (l == 0 ? CV_IN_BLOCK_ITEMS : 0)) break;
        if (idx >= MIX_UNITS) { int t2_ = tid_; asm volatile("" : "+v"(t2_)); cvt_deferred_item(in, w, L, idx - MIX_UNITS, t2_); continue; }
        int t_ = tid_; asm volatile("" : "+v"(t_));
        if (idx < 128) ssm_unit(in, w, l, L, idx, t_);
        else if (idx < 384) attn_unit(in, w, l, L, idx - 128, t_);
        else convpool_unit(in, w, l, L, idx - 384, t_);
    }
}
struct Args { In in; float* out; unsigned char* ws; };
__device__ __forceinline__ W fresh_w() { const __attribute__((address_space(4))) Args* p = (const __attribute__((address_space(4))) Args*)__builtin_amdgcn_kernarg_segment_ptr(); asm volatile("" : "+s"(p)); W w; w.ws = p->ws; w.out = p->out; return w; }
__device__ __forceinline__ InP fresh_in() { InP p = (InP)__builtin_amdgcn_kernarg_segment_ptr(); asm volatile("" : "+s"(p)); return p; }

template <class F> __device__ __forceinline__ void run_stage(const F& f, long n) {
    const int tid_ = mk_fresh_tid();
    const long stride_ = (long)fresh_grid() * NTHREADS;
    for (long i = (long)blockIdx.x * NTHREADS + tid_; i < n; i += stride_) f(i);
}

__global__ void __launch_bounds__(NTHREADS, 2) mk_fwd(Args a) {
    extern __shared__ __attribute__((aligned(16))) unsigned char lds[];
    LAS unsigned char* L = (LAS unsigned char*)lds;
    volatile LAS unsigned* MISC = (volatile LAS unsigned*)(L + MISC_OFF);
    for (int u = threadIdx.x; u < (LDS_BYTES - LDSCTL_OFF) / 4; u += NTHREADS) ((LAS unsigned*)(L + LDSCTL_OFF))[u] = 0u;
    __syncthreads();
    if ((threadIdx.x & 63) == 0) *(volatile LAS unsigned*)(L + MK_WTAB_OFF + 4 * mk_hw_wave_slot()) = threadIdx.x >> 6;
    __syncthreads();
#define in fresh_in()
#define w fresh_w()
    (void)xcd_barrier_post((unsigned*)w.ctl() + CW_BAR, MISC + 8);
#define BAR() do { XcdBarrier b_; b_.bar = (unsigned*)w.ctl() + CW_BAR; b_.x = xb_xcc_id(); b_.st = MISC + 8; xcd_barrier(b_); } while (0)
    ph_mod(in, w, L); ph_poolfold(in, w, L); __syncthreads(); run_stage(g2::FRope{w}, 2048L * 32); run_stage(FSsmTab{in, w}, 2L * 2 * 32 * 64); run_stage(FCvtCache{in, w}, 2L * 2 * 2 * 256 * 128);
    ph_convert(in, w, L);
    BAR();
#pragma unroll 1
    for (int l = 0; l < 2; ++l) {
        if (l == 0) { ph_rows<false>(in, w, 0); BAR(); }
        { pg8::Gemm g{w.H(), w.win() + (size_t)l * INC * 1024, M, INC, 1024}; pg8::StaticOrder S; S.init(M, INC, (int)gridDim.x, (int)blockIdx.x); Epi1 E{w, l};
          pg8::gemm_phase<Epi1, pg8::StaticOrder, true, true>(L, g, S, E); }
        if (l == 0) ph_deferred(in, w, L, MISC);
        BAR();
        ph_mixers(in, w, l, L, MISC); BAR();
        { pg8::Gemm g{w.YS(), w.wglu() + (size_t)l * 1024 * 512, M, 1024, 512}; SchedN1 S{(int)blockIdx.x}; Epi3 E{w};
          pg8::gemm_phase<Epi3, SchedN1, true, true, 1>(L, g, S, E); }
        BAR();
        { pg8::Gemm g{w.GATE(), w.wbr() + (size_t)l * 4 * 1024 * 512, 4 * M, 4 * 1024, 512}; Sched4a S{(int)blockIdx.x}; Epi4a E{w};
          pg8::gemm_phase<Epi4a, Sched4a, true, true, 1>(L, g, S, E); }
        BAR();
        { pg8::Gemm g{w.MRG(), w.wout() + (size_t)l * 1024 * 1024, M, 1024, 1024}; SchedN1 S{(int)blockIdx.x}; Epi4b E{in, w, l};
          pg8::gemm_phase<Epi4b, SchedN1, true, true, 1>(L, g, S, E); }
        if (l == 0) BAR();
    }
#undef BAR
#undef in
#undef w
}
}

extern "C" void kernel_launch(void* const* d_in, const int* in_sizes, int n_in, void* d_out, int out_size, void* d_ws, size_t ws_size, hipStream_t stream) {
    static int grid = 0;
    if (grid == 0) {
        if (n_in != 30 || (size_t)out_size != g2::OUT_TOTAL || ws_size < g2::WS_END) { fprintf(stderr, "kernel_launch: unexpected problem shape (n_in %d out %d ws %zu)\n", n_in, out_size, ws_size); grid = -1; return; }
        int dev = 0, cus = 0, per_cu = 0;
        if (hipGetDevice(&dev) != hipSuccess || hipDeviceGetAttribute(&cus, hipDeviceAttributeMultiprocessorCount, dev) != hipSuccess) { grid = -1; return; }
        if (hipFuncSetAttribute((const void*)mk::mk_fwd, hipFuncAttributeMaxDynamicSharedMemorySize, mk::LDS_BYTES) != hipSuccess) { fprintf(stderr, "kernel_launch: hipFuncSetAttribute failed\n"); grid = -1; return; }
        if (hipOccupancyMaxActiveBlocksPerMultiprocessor(&per_cu, (const void*)mk::mk_fwd, mk::NTHREADS, mk::LDS_BYTES) != hipSuccess || per_cu < 1) { fprintf(stderr, "kernel_launch: occupancy query says %d blocks/CU\n", per_cu); (void)hipGetLastError(); grid = -1; return; }
        grid = cus;
    }
    if (grid < 0) return;
    if (hipMemsetAsync((char*)d_ws + g2::WS_CTL, 0, mk::CTL_ZERO_BYTES, stream) != hipSuccess) return;
    mk::Args a{}; const float* ptr[30]; for (int i = 0; i < 30; ++i) ptr[i] = (const float*)d_in[i]; memcpy(&a.in, ptr, sizeof(a.in));
    a.out = (float*)d_out; a.ws = (unsigned char*)d_ws;
    hipLaunchKernelGGL(mk::mk_fwd, dim3(grid), dim3(mk::NTHREADS), mk::LDS_BYTES, stream, a);
}
```

```cpp
#include <hip/hip_runtime.h>
#include <cstdio>
#include <cstring>
#include <cstdint>
#ifdef CPU_EMU
#include <cmath>
#include <cstddef>
#include <cstring>
#define HD_FN inline
#else
#define HD_FN __host__ __device__ __forceinline__
#endif

namespace g2 {
typedef unsigned short bf16_t;
#ifndef CFG_BATCH
#define CFG_BATCH 16
#endif
#ifndef CFG_DEC_BATCH
#define CFG_DEC_BATCH 2
#endif
constexpr int D = 1024, DEPTH = 2, NB_P = CFG_BATCH, L_P = 256, NB_S = CFG_DEC_BATCH, L_S = 2048, PAST = 256;
constexpr int MP = NB_P * L_P, MS = NB_S * L_S, M = MP + MS;
constexpr int GRID_W = 64, NH = 8, WINDOW = 128, CONVK = 31, SG = 32, SC = 16, SP = 64, INC = 8960, NT1 = INC / 256;
constexpr int C_XPOOL = 2816;
constexpr float EPS = 1e-6f;

HD_FN bf16_t f2bf(float f) { unsigned u; memcpy(&u, &f, 4); u = (u + 0x7fffu + ((u >> 16) & 1u)) >> 16; return (bf16_t)u; }
HD_FN float bf2f(bf16_t h) { unsigned u = (unsigned)h << 16; float f; memcpy(&f, &u, 4); return f; }
HD_FN float sigmoidf_(float x) { return 1.0f / (1.0f + expf(-x)); }
HD_FN float siluf_(float x) { return x * sigmoidf_(x); }
HD_FN float geluf_(float x) { return 0.5f * x * (1.0f + tanhf(0.7978845608028654f * (x + 0.044715f * x * x * x))); }

HD_FN int row_path(int m) { return m >= MP; }
HD_FN int row_len(int m) { return m >= MP ? L_S : L_P; }
HD_FN int row_seq0(int m) { return m >= MP ? MP + ((m - MP) / L_S) * L_S : (m / L_P) * L_P; }
HD_FN int row_batch(int m) { return m >= MP ? (m - MP) / L_S : m / L_P; }
HD_FN int row_modj(int m) { return m >= MP ? 1 + (m - MP) / L_S : 0; }

struct In {
    const float *x_prompt, *x_sample, *cache_k, *cache_v, *state_ssm, *c, *c_ctx, *norm_g, *w_ada, *b_ada, *w_in, *attn_sink, *conv_dw, *conv_db,
        *conv_ln_g, *conv_ln_b, *pool_w, *pool_scale, *lam_re, *lam_im, *log_dt, *b_re, *b_im, *c_re, *c_im, *ssm_d, *glu_w, *w_br, *w_out, *final_g;
};
#ifdef CPU_EMU
typedef const In* InP;
#else
typedef const __attribute__((address_space(4))) In* InP;
#endif
constexpr size_t OUT_YP = 0, OUT_YS = (size_t)MP * D, OUT_K = (size_t)M * D, OUT_V = OUT_K + (size_t)NB_P * DEPTH * L_P * 128, OUT_ST = OUT_V + (size_t)NB_P * DEPTH * L_P * 128,
                 OUT_TOTAL = OUT_ST + (size_t)NB_P * DEPTH * 2 * 2 * SG * SP;

constexpr size_t MiB = 1u << 20;
constexpr size_t WS_CTL = 0;
constexpr size_t WS_MOD = 1 * MiB;
constexpr size_t WS_ROPE = WS_MOD + 128 * 1024;
constexpr size_t WS_LAMB = WS_ROPE + 512 * 1024;
constexpr size_t WS_BBAR = WS_LAMB + 64 * 1024;
constexpr size_t WS_WIN = 4 * MiB;
constexpr size_t WS_WGLU = WS_WIN + (size_t)2 * INC * 1024 * 2;
constexpr size_t WS_WBR = WS_WGLU + 2 * MiB;
constexpr size_t WS_WOUT = WS_WBR + 8 * MiB;
constexpr size_t WS_H = WS_WOUT + 4 * MiB;
constexpr size_t WS_Q = WS_H + 16 * MiB;
constexpr size_t WS_XC = WS_Q + 8 * MiB;
constexpr size_t WS_MRGP = WS_H;
constexpr size_t WS_XP = WS_XC + 8 * MiB;
constexpr size_t WS_XS = WS_XP + 8 * MiB;
constexpr size_t WS_K = WS_XS + 8 * MiB;
constexpr size_t WS_V = WS_K + 2 * MiB;
constexpr size_t WS_GATE = WS_V + 2 * MiB;
constexpr size_t WS_GM = WS_GATE + 32 * MiB;
constexpr size_t WS_YS = WS_GM + 64 * MiB;
constexpr size_t WS_MRG = WS_YS + 8 * MiB;
constexpr size_t WS_TMP = WS_MRG + 16 * MiB;
constexpr size_t WS_S = WS_TMP + 16 * MiB;
constexpr size_t WS_END = WS_S + 32 * MiB;
static_assert(WS_END <= 293601280ull, "workspace map exceeds the guaranteed d_ws size");

struct W {
    unsigned char* ws; float* out;
    HD_FN unsigned* ctl() const { return (unsigned*)(ws + WS_CTL); }
    HD_FN float* mod() const { return (float*)(ws + WS_MOD); }
    HD_FN float* ropec() const { return (float*)(ws + WS_ROPE); }
    HD_FN float* ropes() const { return (float*)(ws + WS_ROPE) + 2048 * 32; }
    HD_FN float* lamb() const { return (float*)(ws + WS_LAMB); }
    HD_FN float* bbar() const { return (float*)(ws + WS_BBAR); }
    HD_FN bf16_t* win() const { return (bf16_t*)(ws + WS_WIN); }
    HD_FN bf16_t* wglu() const { return (bf16_t*)(ws + WS_WGLU); }
    HD_FN bf16_t* wbr() const { return (bf16_t*)(ws + WS_WBR); }
    HD_FN bf16_t* wout() const { return (bf16_t*)(ws + WS_WOUT); }
    HD_FN bf16_t* H() const { return (bf16_t*)(ws + WS_H); }
    HD_FN bf16_t* Q() const { return (bf16_t*)(ws + WS_Q); }
    HD_FN bf16_t* XC() const { return (bf16_t*)(ws + WS_XC); }
    HD_FN bf16_t* XP() const { return (bf16_t*)(ws + WS_XP); }
    HD_FN bf16_t* XS() const { return (bf16_t*)(ws + WS_XS); }
    HD_FN bf16_t* K() const { return (bf16_t*)(ws + WS_K); }
    HD_FN bf16_t* V() const { return (bf16_t*)(ws + WS_V); }
    HD_FN bf16_t* GATE() const { return (bf16_t*)(ws + WS_GATE); }
    HD_FN bf16_t* GM() const { return (bf16_t*)(ws + WS_GM); }
    HD_FN bf16_t* YS() const { return (bf16_t*)(ws + WS_YS); }
    HD_FN bf16_t* MRG() const { return (bf16_t*)(ws + WS_MRG); }
    HD_FN float* MRGP() const { return (float*)(ws + WS_MRGP); }
    HD_FN float* TMP() const { return (float*)(ws + WS_TMP); }
    HD_FN float* S() const { return (float*)(ws + WS_S); }
};
HD_FN W make_w(unsigned char* ws, float* out) { W w{}; w.ws = ws; w.out = out; return w; }

HD_FN const float* xrow(InP in, const W& w, int l, int m) { return l == 0 ? (m < MP ? in->x_prompt + (size_t)m * D : in->x_sample + (size_t)(m - MP) * D) : w.out + (size_t)m * D; }

HD_FN int in_orig_col(int row) { const int pn = row >> 8, c = row & 255, bj = c >> 7, cc = c & 127;
    if (pn < 2) return (pn * 4 + (cc >> 5)) * 64 + bj * 32 + (cc & 31);
    if (pn == 2) return cc < 64 ? 512 + (cc >> 5) * 64 + bj * 32 + (cc & 31) : 640 + bj * 64 + (cc - 64);
    if (pn < 5) return 768 + (pn - 3) * 256 + c;
    if (pn < 9) return 1280 + bj * 512 + (pn - 5) * 128 + cc;
    if (pn < 11) return 2304 + (pn - 9) * 256 + c;
    if (pn < 13) return 2816 + (pn - 11) * 256 + c;
    if (pn < 15) return 3328 + (pn - 13) * 256 + c;
    if (pn < 17) return 3840 + (pn - 15) * 256 + c;
    if (pn < 19) return 4352 + (pn - 17) * 256 + c;
    return 4864 + (pn - 19) * 256 + c; }
HD_FN int glu_orig_col(int row) { const int pn = row >> 8, c = row & 255, bj = c >> 7, cc = c & 127; return bj * 512 + pn * 128 + cc; }

struct FMod { InP in; W w;
    HD_FN void operator()(long i) const { int n = i % 3072; int j = (i / 3072) % 3; int l = i / (3 * 3072);
        const float* cv = j == 0 ? in->c_ctx : in->c + (size_t)(j - 1) * D; const float* wa = in->w_ada + (size_t)l * D * 3072;
        float acc = 0.f; for (int k = 0; k < D; ++k) acc += siluf_(cv[k]) * wa[(size_t)k * 3072 + n];
        w.mod()[i] = acc + in->b_ada[l * 3072 + n]; } };
struct FRope { W w;
    HD_FN void operator()(long i) const { int j = i % 32, t = i / 32; float row = (float)(t / GRID_W), col = (float)(t % GRID_W);
        float inv = powf(10000.0f, -(float)(j % 16) / 16.0f); float ang = (j < 16 ? row : col) * inv; w.ropec()[i] = cosf(ang); w.ropes()[i] = sinf(ang); } };
struct FSsmParam { InP in; W w;
    HD_FN void operator()(long i) const { int g = (i / SP) % SG; long ld = i / (SP * SG);
        float lr = in->lam_re[i], li = in->lam_im[i]; float dt = expf(in->log_dt[ld * SG + g]);
        float e = expf(lr * dt), br_ = e * cosf(li * dt), bi_ = e * sinf(li * dt); w.lamb()[2 * i] = br_; w.lamb()[2 * i + 1] = bi_;
        float nr = br_ - 1.0f, ni = bi_; float den = lr * lr + li * li; float fr = (nr * lr + ni * li) / den, fi = (ni * lr - nr * li) / den;
        for (int c = 0; c < SC; ++c) { float xr = in->b_re[i * SC + c], xi = in->b_im[i * SC + c];
            w.bbar()[(i * SC + c) * 2] = fr * xr - fi * xi; w.bbar()[(i * SC + c) * 2 + 1] = fr * xi + fi * xr; } } };
struct FCvtIn { InP in; W w;
    HD_FN void operator()(long i) const { int k = i % 1024; int row = (i / 1024) % INC; int l = i / ((long)INC * 1024); const int oc = in_orig_col(row);
        const float* src = in->w_in + ((size_t)l * D + k) * INC; float v;
        if (oc >= C_XPOOL && oc < C_XPOOL + 512) { const int g = (oc - C_XPOOL) >> 7, co = (oc - C_XPOOL) & 127; const float* pw = in->pool_w + ((size_t)l * 4 + g) * 128 * 128 + co; const float* s = src + C_XPOOL + g * 128;
            float acc = 0.f; for (int ci = 0; ci < 128; ++ci) acc += s[ci] * pw[(size_t)ci * 128]; v = acc * in->pool_scale[l * 512 + g * 128 + co]; }
        else v = src[oc];
        w.win()[i] = f2bf(v); } };
struct FCvtGlu { InP in; W w;
    HD_FN void operator()(long i) const { int k = i % 512; int row = (i / 512) % 1024; int l = i / (512 * 1024); w.wglu()[i] = f2bf(in->glu_w[((size_t)l * 512 + k) * 1024 + glu_orig_col(row)]); } };
struct FCvtBr { InP in; W w;
    HD_FN void operator()(long i) const { int k = i % 512; int d = (i / 512) % 1024; int ln = i / (512 * 1024); w.wbr()[i] = f2bf(in->w_br[((size_t)ln * 512 + k) * 1024 + d]); } };
struct FCvtOut { InP in; W w;
    HD_FN void operator()(long i) const { int k = i % 1024; int d = (i / 1024) % 1024; int l = i / (1024 * 1024); w.wout()[i] = f2bf(in->w_out[((size_t)l * 1024 + k) * 1024 + d]); } };

struct FH { InP in; W w; int l, pad;
    HD_FN void operator()(long m) const { const float* x = xrow(in, w, l, (int)m); float ss = 0.f; for (int k = 0; k < D; ++k) ss += x[k] * x[k];
        float r = 1.0f / sqrtf(ss / D + EPS); const float* mo = w.mod() + ((size_t)l * 3 + row_modj((int)m)) * 3072; const float* g = in->norm_g + l * D;
        for (int k = 0; k < D; ++k) w.H()[(size_t)m * D + k] = f2bf((x[k] * r) * g[k] * (1.0f + mo[1024 + k]) + mo[k]); } };

HD_FN void epi1(const W& w, int l, int m, int pn, int cc, float a0, float a1) {
    if (pn <= 2) { const bool smp = m >= MP; const int t = m - row_seq0(m);
        if (pn < 2 || cc < 64) { const int j = cc & 31; float o1 = a0, o2 = a1;
            if (smp) { const float cs = w.ropec()[t * 32 + j], sn = w.ropes()[t * 32 + j]; o1 = a0 * cs - a1 * sn; o2 = a0 * sn + a1 * cs; }
            if (pn < 2) { const int h = pn * 4 + (cc >> 5); w.Q()[(size_t)m * 512 + h * 64 + j] = f2bf(o1); w.Q()[(size_t)m * 512 + h * 64 + 32 + j] = f2bf(o2); }
            else { const int kv = cc >> 5; w.K()[(size_t)m * 128 + kv * 64 + j] = f2bf(o1); w.K()[(size_t)m * 128 + kv * 64 + 32 + j] = f2bf(o2);
                if (!smp) { float* o = w.out + OUT_K + (((size_t)row_batch(m) * DEPTH + l) * L_P + t) * 128 + kv * 64 + j; o[0] = a0; o[32] = a1; } } }
        else { const int c2 = cc - 64; w.V()[(size_t)m * 128 + c2] = f2bf(a0); w.V()[(size_t)m * 128 + 64 + c2] = f2bf(a1);
            if (!smp) { float* o = w.out + OUT_V + (((size_t)row_batch(m) * DEPTH + l) * L_P + t) * 128 + c2; o[0] = a0; o[64] = a1; } }
        return; }
    if (pn >= 5 && pn < 9) { w.XC()[(size_t)m * 512 + (pn - 5) * 128 + cc] = f2bf(a0 * sigmoidf_(a1)); return; }
    if (pn >= 19) { bf16_t* o = w.GM() + (size_t)m * 4096 + (pn - 19) * 256 + cc; o[0] = f2bf(sigmoidf_(a0)); o[128] = f2bf(sigmoidf_(a1)); return; }
    if (pn == 11 || pn == 12) { bf16_t* o = w.XP() + (size_t)m * 512 + (pn - 11) * 256 + cc; o[0] = f2bf(a0); o[128] = f2bf(a1); return; }
    if (pn == 15 || pn == 16) { bf16_t* o = w.XS() + (size_t)m * 512 + (pn - 15) * 256 + cc; o[0] = f2bf(a0); o[128] = f2bf(a1); return; }
    { const int br = pn < 5 ? 0 : pn < 11 ? 1 : pn < 15 ? 2 : 3; const int t0 = br == 0 ? 3 : br == 1 ? 9 : br == 2 ? 13 : 17;
      bf16_t* o = w.GATE() + ((size_t)br * M + m) * 512 + (pn - t0) * 256 + cc; o[0] = f2bf(siluf_(a0)); o[128] = f2bf(siluf_(a1)); } }
struct FG1 { InP in; W w; int l, pad;
    HD_FN void operator()(long i) const { int cc = i % 128; int pn = (i / 128) % NT1; int m = i / (128 * NT1); const bf16_t* a = w.H() + (size_t)m * D;
        const bf16_t* b0 = w.win() + ((size_t)l * INC + pn * 256 + cc) * D; const bf16_t* b1 = b0 + (size_t)128 * D; float a0 = 0.f, a1 = 0.f;
        for (int k = 0; k < D; ++k) { const float av = bf2f(a[k]); a0 += av * bf2f(b0[k]); a1 += av * bf2f(b1[k]); }
        epi1(w, l, m, pn, cc, a0, a1); } };

struct FAttn { InP in; W w; int l, pad;
    HD_FN void operator()(long i) const { int dp = i % 4, hh = (i / 4) % 8; int m = i / 32; const bool smp = m >= MP; const int L = row_len(m), s0 = row_seq0(m), t = m - s0, kv = hh / 4, bb = row_batch(m);
        const bf16_t* q = w.Q() + (size_t)m * 512 + hh * 64; const float sink = in->attn_sink[l * NH + hh];
        const float* ck = in->cache_k + (((size_t)bb * DEPTH + l) * PAST) * 128 + kv * 64; const float* cvp = in->cache_v + (((size_t)bb * DEPTH + l) * PAST) * 128 + kv * 64;
        int lo, hi; if (!smp) { lo = 0; hi = L - 1; } else { lo = t - WINDOW < 0 ? 0 : t - WINDOW; hi = t + WINDOW > L - 1 ? L - 1 : t + WINDOW; }
        const int nctx = smp ? PAST : 0; float mx = sink;
        for (int pass = 0; pass < 2; ++pass) { float den = 0.f, acc[16];
#pragma unroll
            for (int d = 0; d < 16; ++d) acc[d] = 0.f;
            for (int kk = 0; kk < nctx + (hi - lo + 1); ++kk) { float sc = 0.f;
                if (kk < nctx) { const float* kp = ck + (size_t)kk * 128; for (int d = 0; d < 64; ++d) sc += bf2f(q[d]) * kp[d]; }
                else { const bf16_t* kp = w.K() + (size_t)(s0 + lo + kk - nctx) * 128 + kv * 64; for (int d = 0; d < 64; ++d) sc += bf2f(q[d]) * bf2f(kp[d]); }
                sc *= 0.125f;
                if (pass == 0) { mx = sc > mx ? sc : mx; }
                else { const float p = expf(sc - mx); den += p;
                    if (kk < nctx) { const float* vp = cvp + (size_t)kk * 128 + dp * 16;
#pragma unroll
                        for (int d = 0; d < 16; ++d) acc[d] += p * vp[d]; }
                    else { const bf16_t* vp = w.V() + (size_t)(s0 + lo + kk - nctx) * 128 + kv * 64 + dp * 16;
#pragma unroll
                        for (int d = 0; d < 16; ++d) acc[d] += p * bf2f(vp[d]); } } }
            if (pass == 1) { den += expf(sink - mx); bf16_t* o = w.GATE() + (size_t)m * 512 + hh * 64 + dp * 16;
#pragma unroll
                for (int d = 0; d < 16; ++d) o[d] = f2bf(acc[d] / den * bf2f(o[d])); } } } };
struct FConv { InP in; W w; int l, pad;
    HD_FN void operator()(long i) const { int ch = i % 512; int m = i / 512; const int L = row_len(m), s0 = row_seq0(m), t = m - s0; float acc = in->conv_db[l * 512 + ch];
        for (int j = 0; j < CONVK; ++j) { int tt = t + j - CONVK / 2; if (tt < 0 || tt >= L) continue; acc += bf2f(w.XC()[(size_t)(s0 + tt) * 512 + ch]) * in->conv_dw[((size_t)l * CONVK + j) * 512 + ch]; }
        w.TMP()[i] = acc; } };
struct FConvLn { InP in; W w; int l, pad;
    HD_FN void operator()(long m) const { const float* y = w.TMP() + (size_t)m * 512; float mu = 0.f; for (int k = 0; k < 512; ++k) mu += y[k]; mu /= 512.f;
        float var = 0.f; for (int k = 0; k < 512; ++k) { float d = y[k] - mu; var += d * d; } float r = 1.0f / sqrtf(var / 512.f + EPS); bf16_t* o = w.GATE() + ((size_t)1 * M + m) * 512;
        for (int k = 0; k < 512; ++k) o[k] = f2bf(siluf_((y[k] - mu) * r * in->conv_ln_g[l * 512 + k] + in->conv_ln_b[l * 512 + k]) * bf2f(o[k])); } };
struct FPool { W w;
    HD_FN void operator()(long i) const { int ch = i % 512; int m = i / 512; const int L = row_len(m), s0 = row_seq0(m), t = m - s0; const int wd = 2 << (ch / 128);
        int lo = t - wd / 2 < 0 ? 0 : t - wd / 2, hi = t + wd / 2 > L ? L : t + wd / 2; float sum = 0.f;
        for (int tt = lo; tt < hi; ++tt) sum += bf2f(w.XP()[(size_t)(s0 + tt) * 512 + ch]);
        bf16_t* o = w.GATE() + ((size_t)2 * M + m) * 512 + ch; *o = f2bf((sum / (float)(hi - lo) - bf2f(w.XP()[(size_t)m * 512 + ch])) * bf2f(*o)); } };
struct FSsmBu { W w; int l, dir, m0, pad;
    HD_FN void operator()(long i) const { int p = i % SP, g = (i / SP) % SG; int tl = i / (SP * SG); const bf16_t* x = w.XS() + (size_t)(m0 + tl) * 512 + g * SC;
        const float* bb = w.bbar() + ((((size_t)l * 2 + dir) * SG + g) * SP + p) * SC * 2; float ar = 0.f, ai = 0.f;
        for (int k = 0; k < SC; ++k) { const float xv = bf2f(x[k]); ar += xv * bb[2 * k]; ai += xv * bb[2 * k + 1]; } w.S()[2 * i] = ar; w.S()[2 * i + 1] = ai; } };
struct FSsmScan { InP in; W w; int l, dir, m0, pad;
    HD_FN void operator()(long i) const { int p = i % SP, g = (i / SP) % SG; int s = i / (SP * SG); const int L = row_len(m0); const int bb = row_batch(m0) + s;
        const float* lb = w.lamb() + ((((size_t)l * 2 + dir) * SG + g) * SP + p) * 2; float lr = lb[0], li = lb[1]; float hr = 0.f, hi = 0.f;
        if (m0 >= MP) { const float* st = in->state_ssm + ((((size_t)bb * DEPTH + l) * 2 + dir) * 2) * SG * SP + g * SP + p; hr = st[0]; hi = st[SG * SP]; }
        for (int k = 0; k < L; ++k) { int t = dir == 0 ? k : L - 1 - k; float* S = w.S() + (((size_t)(s * L + t) * SG + g) * SP + p) * 2;
            float nr = lr * hr - li * hi + S[0], ni = lr * hi + li * hr + S[1]; hr = nr; hi = ni; S[0] = hr; S[1] = hi; }
        if (m0 < MP) { float* o = w.out + OUT_ST + ((((size_t)bb * DEPTH + l) * 2 + dir) * 2) * SG * SP + g * SP + p; o[0] = hr; o[SG * SP] = hi; } } };
struct FSsmY { InP in; W w; int l, dir, m0, pad;
    HD_FN void operator()(long i) const { int gc = i % 512; int tl = i / 512; int g = gc / SC, ch = gc % SC; const int m = m0 + tl; const float* S = w.S() + ((size_t)tl * SG + g) * SP * 2;
        const float* cr = in->c_re + ((((size_t)l * 2 + dir) * SG + g) * SC + ch) * SP; const float* cim = in->c_im + ((((size_t)l * 2 + dir) * SG + g) * SC + ch) * SP;
        float acc = 0.f; for (int p = 0; p < SP; ++p) acc += S[2 * p] * cr[p] - S[2 * p + 1] * cim[p];
        float* y = w.TMP() + (size_t)m * 512 + gc;
        if (dir == 0) *y = acc + in->ssm_d[l * 512 + gc] * bf2f(w.XS()[(size_t)m * 512 + gc]); else w.YS()[(size_t)m * 512 + gc] = f2bf(geluf_(*y + acc)); } };
HD_FN void epi3(const W& w, int m, int pn, int cc, float a0, float a1) { bf16_t* o = w.GATE() + ((size_t)3 * M + m) * 512 + pn * 128 + cc; *o = f2bf(a0 * sigmoidf_(a1) * bf2f(*o)); }
struct FG3 { W w; int l, pad;
    HD_FN void operator()(long i) const { int cc = i % 128; int pn = (i / 128) % 4; int m = i / 512; const bf16_t* a = w.YS() + (size_t)m * 512;
        const bf16_t* b0 = w.wglu() + ((size_t)l * 1024 + pn * 256 + cc) * 512; const bf16_t* b1 = b0 + (size_t)128 * 512; float a0 = 0.f, a1 = 0.f;
        for (int k = 0; k < 512; ++k) { const float av = bf2f(a[k]); a0 += av * bf2f(b0[k]); a1 += av * bf2f(b1[k]); }
        epi3(w, m, pn, cc, a0, a1); } };
struct FG4a { W w; int l, pad;
    HD_FN void operator()(long i) const { int d = i % 1024; int m = i / 1024; float mg = 0.f;
        for (int n = 0; n < 4; ++n) { const bf16_t* a = w.GATE() + ((size_t)n * M + m) * 512; const bf16_t* b = w.wbr() + (((size_t)l * 4 + n) * 1024 + d) * 512; float acc = 0.f;
            for (int k = 0; k < 512; ++k) acc += bf2f(a[k]) * bf2f(b[k]); mg += bf2f(w.GM()[(size_t)m * 4096 + n * 1024 + d]) * acc; }
        w.MRG()[i] = f2bf(mg); } };
struct FG4b { InP in; W w; int l, pad;
    HD_FN void operator()(long i) const { int d = i % 1024; int m = i / 1024; const bf16_t* a = w.MRG() + (size_t)m * 1024; const bf16_t* b = w.wout() + ((size_t)l * 1024 + d) * 1024; float acc = 0.f;
        for (int k = 0; k < 1024; ++k) acc += bf2f(a[k]) * bf2f(b[k]);
        const float gate = w.mod()[((size_t)l * 3 + row_modj(m)) * 3072 + 2048 + d]; w.out[i] = xrow(in, w, l, m)[d] + gate * acc; } };
struct FFinal { InP in; W w;
    HD_FN void operator()(long m) const { float* xr = w.out + (size_t)m * D; float ss = 0.f; for (int k = 0; k < D; ++k) ss += xr[k] * xr[k]; float r = 1.0f / sqrtf(ss / D + EPS);
        for (int k = 0; k < D; ++k) xr[k] = xr[k] * r * in->final_g[k]; } };

template <class Runner> inline void forward(InP in, const W& w, Runner& R) {
    R(FMod{in, w}, 2L * 3 * 3072); R(FRope{w}, 2048L * 32); R(FSsmParam{in, w}, 2L * 2 * SG * SP);
    R(FCvtIn{in, w}, 2L * INC * 1024); R(FCvtGlu{in, w}, 2L * 1024 * 512); R(FCvtBr{in, w}, 2L * 4 * 1024 * 512); R(FCvtOut{in, w}, 2L * 1024 * 1024);
    for (int l = 0; l < DEPTH; ++l) {
        R(FH{in, w, l, 0}, (long)M);
        R(FG1{in, w, l, 0}, (long)M * NT1 * 128);
        R(FAttn{in, w, l, 0}, (long)M * 32);
        R(FConv{in, w, l, 0}, (long)M * 512); R(FConvLn{in, w, l, 0}, (long)M);
        R(FPool{w}, (long)M * 512);
        for (int m0 = 0; m0 < M;) { const int L = row_len(m0); int nrows = 2048; if (m0 < MP && m0 + nrows > MP) nrows = MP - m0; const int nseq = nrows / L;
            for (int dir = 0; dir < 2; ++dir) { R(FSsmBu{w, l, dir, m0, 0}, (long)nrows * SG * SP); R(FSsmScan{in, w, l, dir, m0, 0}, (long)nseq * SG * SP); R(FSsmY{in, w, l, dir, m0, 0}, (long)nrows * 512); }
            m0 += nrows; }
        R(FG3{w, l, 0}, (long)M * 512);
        R(FG4a{w, l, 0}, (long)M * 1024);
        R(FG4b{in, w, l, 0}, (long)M * 1024);
    }
    R(FFinal{in, w}, (long)M);
}
}
#define MK_WTAB_OFF (131072 + 512)
__device__ __forceinline__ unsigned mk_hw_wave_slot() { return (unsigned)__builtin_amdgcn_s_getreg(((6 - 1) << 11) | 4) & 63u; }
__device__ __forceinline__ int mk_fresh_tid() { extern __shared__ __attribute__((aligned(16))) unsigned char mk_lds_[];
    const unsigned wv = *(const volatile __attribute__((address_space(3))) unsigned*)((__attribute__((address_space(3))) unsigned char*)mk_lds_ + MK_WTAB_OFF + 4 * mk_hw_wave_slot());
    unsigned ln; asm volatile("v_mbcnt_lo_u32_b32 %0, -1, 0\n\tv_mbcnt_hi_u32_b32 %0, -1, %0" : "=v"(ln));
    int t = (int)((unsigned)__builtin_amdgcn_readfirstlane((int)wv) * 64u + ln); return t; }
namespace pg8 {
#define PG8_LAS __attribute__((address_space(3)))
typedef unsigned short bf16_t;
typedef short bf16x8 __attribute__((ext_vector_type(8)));
typedef float f32x4 __attribute__((ext_vector_type(4)));
typedef unsigned u32x4 __attribute__((ext_vector_type(4)));
constexpr int BM = 256, BK = 64, HALF = 128, HTB = HALF * BK * 2  , STAGE_BYTES = 8 * HTB, NXCD = 8, WGM = 8;

__host__ __device__ __forceinline__ int lds_byte(int r, int c) { const int st = (r >> 4) * 2 + (c >> 5), rr = r & 15, cc = c & 31, ob = rr * 64 + cc * 2; return st * 1024 + (ob ^ (((ob >> 9) & 1) << 5)); }
__host__ __device__ __forceinline__ void stage_rc(int b, int& R, int& C) { const int st = b / 1024, sb = b % 1024, swz = sb ^ (((sb >> 9) & 1) << 5); R = (st >> 1) * 16 + swz / 64; C = (st & 1) * 32 + (swz % 64) / 2; }
__host__ __device__ __forceinline__ int perm32(int rho) { const int n = rho >> 4, i = rho & 15; return 8 * (i >> 2) + 4 * n + (i & 3); }

struct Unit { int pm, pn; };
struct Gemm { const bf16_t* A; const bf16_t* Bt; int M, N, K; };

struct StaticOrder {
    int nM, nN, nwg, G, c;
    __host__ __device__ void init(int M, int N, int G_, int c_) { nM = M / BM; nN = N / BM; nwg = nM * nN; G = G_; c = c_; }
    __host__ __device__ bool next(int i, Unit& u) const {
        const long L = (long)i * G + c; if (L >= nwg) return false;
        int wgid = (int)L; { const int q = nwg / NXCD, r = nwg % NXCD, xcd = wgid % NXCD, off = wgid / NXCD; wgid = (xcd < r ? xcd * (q + 1) : r * (q + 1) + (xcd - r) * q) + off; }
        const int nig = WGM * nN, gid = wgid / nig, fm = gid * WGM, gsz = (nM - fm) < WGM ? (nM - fm) : WGM;
        u.pm = fm + ((wgid % nig) % gsz); u.pn = (wgid % nig) / gsz; return true;
    }
    __device__ __forceinline__ void a_ready(const Unit&) const {}
    __device__ __forceinline__ void done(const Unit&) const {}
};

__device__ __forceinline__ unsigned cvt_pk_bf16(float lo, float hi) { unsigned r; asm volatile("v_cvt_pk_bf16_f32 %0, %1, %2" : "=v"(r) : "v"(lo), "v"(hi)); return r; }
typedef float f32x2 __attribute__((ext_vector_type(2)));
template <class Epi, class Sched, bool ALIGN_EPI = false, bool SP2 = false, int NB = 2>
__device__ __forceinline__ void gemm_phase(PG8_LAS unsigned char* lds, const Gemm g, const Sched& S, const Epi& E) {
    const int tid_ = mk_fresh_tid();
    const int tid = tid_, wid = __builtin_amdgcn_readfirstlane(tid >> 6), lane = tid & 63, wr = wid >> 2, wc = wid & 3, fr = lane & 15, fq = lane >> 4;
    const int K = g.K, nt = K / BK;
    unsigned voffA[2], voffB[2];
#pragma unroll
    for (int i = 0; i < 2; ++i) { int R, C; stage_rc(tid * 16 + i * 8192, R, C); const int Rb = Epi::PERM ? ((R & ~31) + perm32(R & 31)) : R;
        voffA[i] = (unsigned)(R * K + C) * 2u; voffB[i] = (unsigned)(Rb * K + C) * 2u; }
    const size_t kstep = (size_t)(BK * 2);
    const size_t hstep = (size_t)HALF * K * 2;
    const size_t tstep = 2 * hstep;
    const size_t tstepB = NB == 2 ? tstep : hstep;
    static_assert(NB == 2 || (NB == 1 && SP2), "NB == 1 is implemented for the SP2 loop only");
    const unsigned ldsw = (unsigned)wid * 1024u;
    const int aoff = lds_byte(wr * 64 + fr, fq * 8), boff = lds_byte(wc * 32 + fr, fq * 8);
#define PG8_SA(b, h) (((b) * 2 + (h)) * HTB)
#define PG8_SB(b, h) ((4 + (b) * 2 + (h)) * HTB)
#define PG8_STAGE(bufoff, gbase, voff) do { _Pragma("unroll") for (int _i = 0; _i < 2; ++_i) \
        __builtin_amdgcn_global_load_lds((const unsigned*)((const char*)(gbase) + (voff)[_i]), (PG8_LAS unsigned*)(lds + (bufoff) + ldsw + _i * 8192), 16, 0, 0); } while (0)
#define PG8_LDA(dst, b, h) do { _Pragma("unroll") for (int m = 0; m < 4; ++m) _Pragma("unroll") for (int k = 0; k < 2; ++k) dst[m][k] = *(const PG8_LAS bf16x8*)(lds + PG8_SA(b, h) + aoff + m * 2048 + k * 1024); } while (0)
#define PG8_LDB(dst, b, h) do { _Pragma("unroll") for (int n = 0; n < 2; ++n) _Pragma("unroll") for (int k = 0; k < 2; ++k) dst[n][k] = *(const PG8_LAS bf16x8*)(lds + PG8_SB(b, h) + boff + n * 2048 + k * 1024); } while (0)
#define PG8_MMA(ai, bj, At, Bt) do { __builtin_amdgcn_s_setprio(1); _Pragma("unroll") for (int m = 0; m < 4; ++m) _Pragma("unroll") for (int n = 0; n < 2; ++n) _Pragma("unroll") for (int k = 0; k < 2; ++k) \
        acc[ai][bj][m][n] = __builtin_amdgcn_mfma_f32_16x16x32_bf16(Bt[n][k], At[m][k], acc[ai][bj][m][n], 0, 0, 0); __builtin_amdgcn_s_setprio(0); } while (0)
#define PG8_WAIT_V(n) asm volatile("s_waitcnt vmcnt(" #n ")" ::: "memory")
#define PG8_WAIT_L(n) asm volatile("s_waitcnt lgkmcnt(" #n ")" ::: "memory")
#define PG8_WAIT_VL do { if constexpr (NB == 2) PG8_WAIT_V(8); else PG8_WAIT_V(6); PG8_WAIT_L(0); } while (0)
#define PG8_BAR __builtin_amdgcn_s_barrier()
#define PG8_SCHED __builtin_amdgcn_sched_barrier(0)
    Unit cur, nxt; int ui = 0;
    if (!S.next(0, cur)) return;
    f32x4 acc[2][NB][4][2];
#pragma unroll
    for (int a = 0; a < 2; ++a)
#pragma unroll
        for (int b = 0; b < NB; ++b)
#pragma unroll
            for (int m = 0; m < 4; ++m)
#pragma unroll
                for (int n = 0; n < 2; ++n) acc[a][b][m][n] = (f32x4){0.f, 0.f, 0.f, 0.f};
    bf16x8 At[4][2], B0[2][2], B1[2][2];
    const char* cA = (const char*)g.A + (size_t)cur.pm * tstep; const char* cB = (const char*)g.Bt + (size_t)cur.pn * tstepB;
    S.a_ready(cur);
    if constexpr (SP2) {
        PG8_STAGE(PG8_SB(0, 0), cB, voffB); if constexpr (NB == 2) PG8_STAGE(PG8_SB(0, 1), cB + hstep, voffB); PG8_STAGE(PG8_SA(0, 0), cA, voffA); PG8_STAGE(PG8_SA(0, 1), cA + hstep, voffA);
        if (wr == 1) PG8_BAR;
        PG8_WAIT_V(2); PG8_BAR;
        PG8_STAGE(PG8_SB(1, 0), cB + kstep, voffB); PG8_STAGE(PG8_SA(1, 0), cA + kstep, voffA); if constexpr (NB == 2) PG8_STAGE(PG8_SB(1, 1), cB + hstep + kstep, voffB);
        if constexpr (NB == 2) PG8_WAIT_V(6); else PG8_WAIT_V(4);
        PG8_BAR;
    } else {
        PG8_STAGE(PG8_SB(0, 0), cB, voffB); PG8_STAGE(PG8_SA(0, 0), cA, voffA); PG8_STAGE(PG8_SB(0, 1), cB + hstep, voffB); PG8_STAGE(PG8_SA(0, 1), cA + hstep, voffA);
        if (wr == 1) PG8_BAR;
        PG8_WAIT_V(4); PG8_BAR;
        PG8_STAGE(PG8_SB(1, 0), cB + kstep, voffB); PG8_STAGE(PG8_SA(1, 0), cA + kstep, voffA); PG8_STAGE(PG8_SB(1, 1), cB + hstep + kstep, voffB);
        PG8_WAIT_V(6); PG8_BAR;
    }
    for (;;) {
        const bool has_next = S.next(ui + 1, nxt);
        const char* nA = has_next ? (const char*)g.A + (size_t)nxt.pm * tstep : cA; const char* nB = has_next ? (const char*)g.Bt + (size_t)nxt.pn * tstepB : cB;
        for (int t = 0; t < nt; t += 2) {
            const bool last = (t == nt - 2);
            const char* a1 = cA + (size_t)(t + 1) * kstep;
            const char* a2 = last ? nA : cA + (size_t)(t + 2) * kstep; const char* b2 = last ? nB : cB + (size_t)(t + 2) * kstep;
            const char* a3 = a2 + kstep; const char* b3 = b2 + kstep;
            if (last && has_next) S.a_ready(nxt);
            if constexpr (SP2) {
            PG8_LDB(B0, 0, 0); if constexpr (NB == 2) PG8_LDB(B1, 0, 1); PG8_SCHED; PG8_LDA(At, 0, 0); PG8_STAGE(PG8_SA(1, 1), a1 + hstep, voffA);
            PG8_WAIT_VL; PG8_BAR; PG8_MMA(0, 0, At, B0); if constexpr (NB == 2) PG8_MMA(0, 1, At, B1); PG8_BAR; PG8_SCHED;
            PG8_LDA(At, 0, 1); PG8_STAGE(PG8_SB(0, 0), b2, voffB); if constexpr (NB == 2) PG8_STAGE(PG8_SB(0, 1), b2 + hstep, voffB); PG8_STAGE(PG8_SA(0, 0), a2, voffA);
            PG8_WAIT_VL; PG8_BAR; PG8_MMA(1, 0, At, B0); if constexpr (NB == 2) PG8_MMA(1, 1, At, B1); PG8_BAR; PG8_SCHED;
            PG8_LDB(B0, 1, 0); if constexpr (NB == 2) PG8_LDB(B1, 1, 1); PG8_SCHED; PG8_LDA(At, 1, 0); PG8_STAGE(PG8_SA(0, 1), a2 + hstep, voffA);
            PG8_WAIT_VL; PG8_BAR; PG8_MMA(0, 0, At, B0); if constexpr (NB == 2) PG8_MMA(0, 1, At, B1); PG8_BAR; PG8_SCHED;
            PG8_LDA(At, 1, 1); PG8_STAGE(PG8_SB(1, 0), b3, voffB); if constexpr (NB == 2) PG8_STAGE(PG8_SB(1, 1), b3 + hstep, voffB); PG8_STAGE(PG8_SA(1, 0), a3, voffA);
            PG8_WAIT_VL; PG8_BAR; PG8_MMA(1, 0, At, B0); if constexpr (NB == 2) PG8_MMA(1, 1, At, B1); PG8_BAR; PG8_SCHED;
            } else {
            PG8_LDB(B0, 0, 0); PG8_SCHED; PG8_LDA(At, 0, 0); PG8_STAGE(PG8_SA(1, 1), a1 + hstep, voffA);
            PG8_WAIT_L(8); PG8_BAR; PG8_WAIT_L(0); PG8_MMA(0, 0, At, B0); PG8_BAR; PG8_SCHED;
            PG8_LDB(B1, 0, 1); PG8_STAGE(PG8_SB(0, 0), b2, voffB);
            PG8_BAR; PG8_WAIT_L(0); PG8_MMA(0, 1, At, B1); PG8_BAR;
            PG8_LDA(At, 0, 1); PG8_STAGE(PG8_SA(0, 0), a2, voffA);
            PG8_BAR; PG8_WAIT_L(0); PG8_MMA(1, 0, At, B0); PG8_BAR; PG8_SCHED;
            PG8_STAGE(PG8_SB(0, 1), b2 + hstep, voffB);
            PG8_WAIT_V(6); PG8_BAR; PG8_MMA(1, 1, At, B1); PG8_BAR;
            PG8_LDB(B0, 1, 0); PG8_SCHED; PG8_LDA(At, 1, 0); PG8_STAGE(PG8_SA(0, 1), a2 + hstep, voffA);
            PG8_WAIT_L(8); PG8_BAR; PG8_WAIT_L(0); PG8_MMA(0, 0, At, B0); PG8_BAR; PG8_SCHED;
            PG8_LDB(B1, 1, 1); PG8_STAGE(PG8_SB(1, 0), b3, voffB);
            PG8_BAR; PG8_WAIT_L(0); PG8_MMA(0, 1, At, B1); PG8_BAR;
            PG8_LDA(At, 1, 1); PG8_STAGE(PG8_SA(1, 0), a3, voffA);
            PG8_BAR; PG8_WAIT_L(0); PG8_MMA(1, 0, At, B0); PG8_BAR; PG8_SCHED;
            PG8_STAGE(PG8_SB(1, 1), b3 + hstep, voffB);
            PG8_WAIT_V(6); PG8_BAR; PG8_MMA(1, 1, At, B1); PG8_BAR;
            }
        }
        if constexpr (ALIGN_EPI) { if (wr == 0) PG8_BAR; }
        if constexpr (!Epi::AFTER_DRAIN) { E(acc, cur, wr, wc, fr, fq); S.done(cur); }
        if (!has_next) break;
#pragma unroll
        for (int a = 0; a < 2; ++a)
#pragma unroll
            for (int b = 0; b < NB; ++b)
#pragma unroll
                for (int m = 0; m < 4; ++m)
#pragma unroll
                    for (int n = 0; n < 2; ++n) acc[a][b][m][n] = (f32x4){0.f, 0.f, 0.f, 0.f};
        cur = nxt; cA = nA; cB = nB; ++ui;
        if constexpr (ALIGN_EPI) { if (wr == 1) PG8_BAR; }
    }
    PG8_WAIT_V(0);
    if constexpr (!ALIGN_EPI) { if (wr == 0) PG8_BAR; }
    PG8_BAR;
    if constexpr (Epi::AFTER_DRAIN) { E.fused(acc, cur, wr, wc, fr, fq, lds, wid, lane); S.done(cur); }
#undef PG8_SA
#undef PG8_SB
#undef PG8_STAGE
#undef PG8_LDA
#undef PG8_LDB
#undef PG8_MMA
#undef PG8_WAIT_V
#undef PG8_WAIT_L
#undef PG8_WAIT_VL
#undef PG8_BAR
#undef PG8_SCHED
}
}
namespace pg8 {
template <class Epi, class Sched>
__device__ __forceinline__ void gemm_phase_n1(PG8_LAS unsigned char* lds, const Gemm g, const Sched& S, const Epi& E) {
    const int tid_ = mk_fresh_tid();
    const int tid = tid_, wid = __builtin_amdgcn_readfirstlane(tid >> 6), lane = tid & 63, wr = wid >> 2, wc = wid & 3, fr = lane & 15, fq = lane >> 4;
    const int K = g.K, nt = K / BK;
    unsigned voffA[2], voffB[2];
#pragma unroll
    for (int i = 0; i < 2; ++i) { int R, C; stage_rc(tid * 16 + i * 8192, R, C); const int Rb = Epi::PERM ? ((R & ~31) + perm32(R & 31)) : R;
        voffA[i] = (unsigned)(R * K + C) * 2u; voffB[i] = (unsigned)(Rb * K + C) * 2u; }
    const size_t kstep = (size_t)(BK * 2), hstep = (size_t)HALF * K * 2, tstep = 2 * hstep;
    const unsigned ldsw = (unsigned)wid * 1024u;
    const int aoff = lds_byte(wr * 64 + fr, fq * 8), boff = lds_byte(wc * 32 + fr, fq * 8);
#define N1_SA(b, h) (((b) * 2 + (h)) * HTB)
#define N1_SB(b) ((4 + (b) * 2) * HTB)
#define N1_STAGE(bufoff, gbase, voff) do { _Pragma("unroll") for (int _i = 0; _i < 2; ++_i) \
        __builtin_amdgcn_global_load_lds((const unsigned*)((const char*)(gbase) + (voff)[_i]), (PG8_LAS unsigned*)(lds + (bufoff) + ldsw + _i * 8192), 16, 0, 0); } while (0)
#define N1_STAGE3(b, pa, pb) do { N1_STAGE(N1_SB(b), pb, voffB); N1_STAGE(N1_SA(b, 0), pa, voffA); N1_STAGE(N1_SA(b, 1), (pa) + hstep, voffA); } while (0)
#define N1_LDA(dst, b, h) do { _Pragma("unroll") for (int m = 0; m < 4; ++m) _Pragma("unroll") for (int k = 0; k < 2; ++k) dst[m][k] = *(const PG8_LAS bf16x8*)(lds + N1_SA(b, h) + aoff + m * 2048 + k * 1024); } while (0)
#define N1_LDB(dst, b) do { _Pragma("unroll") for (int n = 0; n < 2; ++n) _Pragma("unroll") for (int k = 0; k < 2; ++k) dst[n][k] = *(const PG8_LAS bf16x8*)(lds + N1_SB(b) + boff + n * 2048 + k * 1024); } while (0)
#define N1_MMA(ai, At) do { _Pragma("unroll") for (int m = 0; m < 4; ++m) _Pragma("unroll") for (int n = 0; n < 2; ++n) _Pragma("unroll") for (int k = 0; k < 2; ++k) \
        acc[ai][0][m][n] = __builtin_amdgcn_mfma_f32_16x16x32_bf16(B0[n][k], At[m][k], acc[ai][0][m][n], 0, 0, 0); } while (0)
#define N1_WAIT_V(n) asm volatile("s_waitcnt vmcnt(" #n ")" ::: "memory")
#define N1_WAIT_L0 asm volatile("s_waitcnt lgkmcnt(0)" ::: "memory")
#define N1_BAR __builtin_amdgcn_s_barrier()
#define N1_TILE(b, sa, sb) do { N1_LDB(B0, b); N1_LDA(At0, b, 0); N1_LDA(At1, b, 1); N1_WAIT_L0; N1_BAR; \
        if (sa) { N1_STAGE3(b, sa, sb); } __builtin_amdgcn_sched_barrier(0); N1_MMA(0, At0); N1_MMA(1, At1); __builtin_amdgcn_sched_barrier(0); \
        if (sa) N1_WAIT_V(6); else N1_WAIT_V(0); N1_BAR; } while (0)
    Unit cur, nxt; int ui = 0;
    if (!S.next(0, cur)) return;
    f32x4 acc[2][1][4][2];
#pragma unroll
    for (int a = 0; a < 2; ++a)
#pragma unroll
        for (int m = 0; m < 4; ++m)
#pragma unroll
            for (int n = 0; n < 2; ++n) acc[a][0][m][n] = (f32x4){0.f, 0.f, 0.f, 0.f};
    bf16x8 At0[4][2], At1[4][2], B0[2][2];
    const char* cA = (const char*)g.A + (size_t)cur.pm * tstep; const char* cB = (const char*)g.Bt + (size_t)cur.pn * hstep;
    S.a_ready(cur);
    N1_STAGE3(0, cA, cB); N1_STAGE3(1, cA + kstep, cB + kstep);
    N1_WAIT_V(6); N1_BAR;
    for (;;) {
        const bool has_next = S.next(ui + 1, nxt);
        const char* nA = has_next ? (const char*)g.A + (size_t)nxt.pm * tstep : (const char*)nullptr; const char* nB = has_next ? (const char*)g.Bt + (size_t)nxt.pn * hstep : (const char*)nullptr;
        for (int t = 0; t < nt; t += 2) {
            const bool last = (t == nt - 2);
            const char* a2 = last ? nA : cA + (size_t)(t + 2) * kstep; const char* b2 = last ? nB : cB + (size_t)(t + 2) * kstep;
            const char* a3 = a2 ? a2 + kstep : a2; const char* b3 = b2 ? b2 + kstep : b2;
            if (last && has_next) S.a_ready(nxt);
            N1_TILE(0, a2, b2);
            N1_TILE(1, a3, b3);
        }
        { const int t2_ = mk_fresh_tid() & 63; E(acc, cur, wr, wc, t2_ & 15, t2_ >> 4); }
        S.done(cur);
        if (!has_next) break;
#pragma unroll
        for (int a = 0; a < 2; ++a)
#pragma unroll
            for (int m = 0; m < 4; ++m)
#pragma unroll
                for (int n = 0; n < 2; ++n) acc[a][0][m][n] = (f32x4){0.f, 0.f, 0.f, 0.f};
        cur = nxt; cA = nA; cB = nB; ++ui;
    }
    N1_WAIT_V(0); N1_BAR;
#undef N1_SA
#undef N1_SB
#undef N1_STAGE
#undef N1_STAGE3
#undef N1_LDA
#undef N1_LDB
#undef N1_MMA
#undef N1_WAIT_V
#undef N1_WAIT_L0
#undef N1_BAR
#undef N1_TILE
}
}
#define GAS __attribute__((address_space(1)))
#define LAS __attribute__((address_space(3)))
typedef unsigned short bf16;
typedef unsigned v4u __attribute__((ext_vector_type(4)));
typedef float f32x4 __attribute__((ext_vector_type(4)));
typedef short bf16x8 __attribute__((ext_vector_type(8)));
typedef GAS unsigned gu32;
typedef GAS unsigned long long gu64;
#define RLX_AGENT __ATOMIC_RELAXED, __HIP_MEMORY_SCOPE_AGENT
#define LDS_WAIT() asm volatile("s_waitcnt lgkmcnt(0)" ::: "memory")
#define VM_WAIT() asm volatile("s_waitcnt vmcnt(0)" ::: "memory")
__device__ __forceinline__ unsigned long long rt() { return __builtin_amdgcn_s_memrealtime(); }
__device__ __forceinline__ unsigned f2bf(float f) { unsigned u = __builtin_bit_cast(unsigned, f); return (u + 0x7fffu + ((u >> 16) & 1u)) >> 16; }
__device__ __forceinline__ unsigned pk2(float lo, float hi) { return f2bf(lo) | (f2bf(hi) << 16); }
#define XB_TMO      128
#define XB_XCNT(j)  (256  + 64 * (j))
#define XB_XSUB(j)  (1280 + 64 * (j))
#define XB_XGEN(j)  (2304 + 64 * (j))
#define XB_TOP      3328
#define XB_TOPGEN   3392
#define XCD_BAR_WORDS 3456
#define XB_SPIN_CAP (1u << 18)

__device__ __forceinline__ unsigned xb_ld(unsigned* p)              { return __hip_atomic_load(p, __ATOMIC_RELAXED, __HIP_MEMORY_SCOPE_AGENT); }
__device__ __forceinline__ unsigned xb_add(unsigned* p, unsigned v) { return __hip_atomic_fetch_add(p, v, __ATOMIC_RELAXED, __HIP_MEMORY_SCOPE_AGENT); }
__device__ __forceinline__ unsigned xb_xcc_id() { return (unsigned)__builtin_amdgcn_s_getreg((3 << 11) | 20) & 0xFu; }
#define XB_SPIN(cond, bar) do { unsigned _sp = 0; while (cond) { __builtin_amdgcn_s_sleep(1); \
    if ((++_sp & 255u) == 0u) { if (xb_ld(&(bar)[XB_TMO])) break; if (_sp > XB_SPIN_CAP) { atomicAdd(&(bar)[XB_TMO], 1u); break; } } } } while (0)

struct XcdBarrier {
    unsigned* bar; unsigned x;
    volatile LAS unsigned* st;
};

__device__ __forceinline__ XcdBarrier xcd_barrier_post(unsigned* bar, volatile LAS unsigned* st) {
    XcdBarrier b; b.bar = bar; b.x = xb_xcc_id(); b.st = st;
    if (threadIdx.x == 0) (void)xb_add(&bar[XB_XCNT(b.x)], 1u);
    return b;
}
__device__ __forceinline__ void xcd_barrier_complete(unsigned* bar, unsigned x, unsigned& nloc, unsigned& nx) {
    const unsigned G = gridDim.x * gridDim.y * gridDim.z;
    unsigned sum, cnt, mine, sp = 0u;
    for (;;) {
        sum = 0u; cnt = 0u; mine = 0u;
#pragma unroll
        for (unsigned j = 0; j < 16; ++j) { const unsigned c = xb_ld(&bar[XB_XCNT(j)]); sum += c; cnt += (c > 0u) ? 1u : 0u; mine = (j == x) ? c : mine; }
        if (sum == G) break;
        __builtin_amdgcn_s_sleep(1);
        if ((++sp & 255u) == 0u) { if (xb_ld(&bar[XB_TMO])) break; if (sp > XB_SPIN_CAP) { atomicAdd(&bar[XB_TMO], 1u); break; } }
    }
    nloc = mine > 0u ? mine : 1u; nx = cnt > 0u ? cnt : 1u;
}

__device__ __forceinline__ void xcd_barrier(const XcdBarrier& b) {
    asm volatile("s_waitcnt vmcnt(0)" ::: "memory");
    __syncthreads();
    if (mk_fresh_tid() == 0) {
        unsigned* bar = b.bar; asm volatile("" : "+s"(bar));
        __builtin_amdgcn_s_waitcnt(0);
        unsigned nloc = b.st[0], nx = b.st[1];
        if (nloc == 0u) { xcd_barrier_complete(bar, b.x, nloc, nx); b.st[0] = nloc; b.st[1] = nx; }
        const unsigned old = xb_add(&bar[XB_XSUB(b.x)], 1u);
        const unsigned gen = old / nloc;
        if (old + 1u == (gen + 1u) * nloc) {
            __builtin_amdgcn_fence(__ATOMIC_RELEASE, "agent");
            asm volatile("s_waitcnt vmcnt(0)" ::: "memory");
            const unsigned og = xb_add(&bar[XB_TOP], 1u);
            const unsigned tg = og / nx;
            if (og + 1u == (tg + 1u) * nx) xb_add(&bar[XB_TOPGEN], 1u);
            else XB_SPIN(xb_ld(&bar[XB_TOPGEN]) == tg, bar);
            __builtin_amdgcn_fence(__ATOMIC_ACQUIRE, "agent");
            xb_add(&bar[XB_XGEN(b.x)], 1u);
            asm volatile("s_waitcnt vmcnt(0)" ::: "memory");
        } else {
            XB_SPIN(xb_ld(&bar[XB_XGEN(b.x)]) == gen, bar);
            __builtin_amdgcn_fence(__ATOMIC_ACQUIRE, "agent");
            asm volatile("s_waitcnt vmcnt(0)" ::: "memory");
        }
    }
    __syncthreads();
}
namespace mk {
using pg8::f32x4; using pg8::Unit;
using g2::In; using g2::InP; using g2::W; using g2::M; using g2::MP; using g2::INC;
typedef unsigned u32x4 __attribute__((ext_vector_type(4)));
constexpr int NWAVES = 8, NTHREADS = 512;
constexpr int RING_BYTES = 131072, LDSCTL_OFF = RING_BYTES, MISC_OFF = LDSCTL_OFF + 320, LDS_BYTES = 147456;
constexpr int CW_BAR = 4096, CW_QUEUE = 2048, CW_MODDONE = 3072; constexpr size_t CTL_ZERO_BYTES = 65536;

typedef float f32x2c_t __attribute__((ext_vector_type(2))); typedef __bf16 bf16x2c_t __attribute__((ext_vector_type(2)));
__device__ __forceinline__ unsigned cvtpk_c(float lo, float hi) { const f32x2c_t v = {lo, hi}; return __builtin_bit_cast(unsigned, __builtin_convertvector(v, bf16x2c_t)); }
__device__ __forceinline__ float fsig(float x) { return __builtin_amdgcn_rcpf(1.0f + __builtin_amdgcn_exp2f(-1.4426950408889634f * x)); }
__device__ __forceinline__ float fsilu(float x) { return x * fsig(x); }
__device__ __forceinline__ u32x4 pack8(const float* v) { u32x4 r; r.x = cvtpk_c(v[0], v[1]); r.y = cvtpk_c(v[2], v[3]); r.z = cvtpk_c(v[4], v[5]); r.w = cvtpk_c(v[6], v[7]); return r; }
__device__ __forceinline__ void unpack8(u32x4 r, float* v) { v[0] = __uint_as_float(r.x << 16); v[1] = __uint_as_float(r.x & 0xffff0000u); v[2] = __uint_as_float(r.y << 16); v[3] = __uint_as_float(r.y & 0xffff0000u);
    v[4] = __uint_as_float(r.z << 16); v[5] = __uint_as_float(r.z & 0xffff0000u); v[6] = __uint_as_float(r.w << 16); v[7] = __uint_as_float(r.w & 0xffff0000u); }
__device__ __forceinline__ void st16(g2::bf16_t* p, u32x4 v) { *(u32x4*)p = v; }
__device__ __forceinline__ void stf8(float* p, const float* v) { *(f32x4*)p = (f32x4){v[0], v[1], v[2], v[3]}; *(f32x4*)(p + 4) = (f32x4){v[4], v[5], v[6], v[7]}; }
__device__ __forceinline__ void ldf8(const float* p, float* v) { const f32x4 a = *(const f32x4*)p, b = *(const f32x4*)(p + 4); v[0] = a.x; v[1] = a.y; v[2] = a.z; v[3] = a.w; v[4] = b.x; v[5] = b.y; v[6] = b.z; v[7] = b.w; }

#define MK_ROWS_BEGIN _Pragma("unroll") for (int ai = 0; ai < 2; ++ai) _Pragma("unroll") for (int m = 0; m < 4; ++m) { \
        float v0[8], v1[8]; _Pragma("unroll") for (int n = 0; n < 2; ++n) _Pragma("unroll") for (int i = 0; i < 4; ++i) { v0[4 * n + i] = acc[ai][0][m][n][i]; v1[4 * n + i] = acc[ai][1][m][n][i]; }
#define MK_ROWS_END }

struct Epi1 {
    static constexpr bool PERM = true, AFTER_DRAIN = false;
    W w; int l;
    __device__ __forceinline__ void operator()(const f32x4 (&acc)[2][2][4][2], const Unit& u, int wr, int wc, int fr, int fq) const {
        int pn_ = __builtin_amdgcn_readfirstlane(u.pn), pm_ = __builtin_amdgcn_readfirstlane(u.pm); asm volatile("" : "+s"(pn_), "+s"(pm_), "+v"(fr), "+v"(fq));
        const int pn = pn_, cc0 = wc * 32 + fq * 8, rowb = pm_ * 256 + wr * 64 + fr;
#define MK_ROW (rowb + ai * 128 + m * 16)
        if (pn <= 2) {
            if (pn < 2 || wc < 2) {
                MK_ROWS_BEGIN
                    const int row = MK_ROW; const bool smp = row >= MP; const int t = smp ? ((row - MP) & 2047) : (row & 255);
                    float o1[8], o2[8];
                    if (smp) { float cs[8], sn[8]; ldf8(w.ropec() + t * 32 + fq * 8, cs); ldf8(w.ropes() + t * 32 + fq * 8, sn);
#pragma unroll
                        for (int e = 0; e < 8; ++e) { o1[e] = v0[e] * cs[e] - v1[e] * sn[e]; o2[e] = v0[e] * sn[e] + v1[e] * cs[e]; } }
                    else {
#pragma unroll
                        for (int e = 0; e < 8; ++e) { o1[e] = v0[e]; o2[e] = v1[e]; } }
                    if (pn < 2) { g2::bf16_t* q = w.Q() + (size_t)row * 512 + (pn * 4 + wc) * 64 + fq * 8; st16(q, pack8(o1)); st16(q + 32, pack8(o2)); }
                    else { g2::bf16_t* k = w.K() + (size_t)row * 128 + wc * 64 + fq * 8; st16(k, pack8(o1)); st16(k + 32, pack8(o2));
                        if (!smp) { float* o = w.out + g2::OUT_K + (((size_t)(row >> 8) * 2 + l) * 256 + t) * 128 + wc * 64 + fq * 8; stf8(o, v0); stf8(o + 32, v1); } }
                MK_ROWS_END
            } else {
                const int c2 = (wc - 2) * 32 + fq * 8;
                MK_ROWS_BEGIN
                    const int row = MK_ROW; g2::bf16_t* vp = w.V() + (size_t)row * 128 + c2; st16(vp, pack8(v0)); st16(vp + 64, pack8(v1));
                    if (row < MP) { float* o = w.out + g2::OUT_V + (((size_t)(row >> 8) * 2 + l) * 256 + (row & 255)) * 128 + c2; stf8(o, v0); stf8(o + 64, v1); }
                MK_ROWS_END
            }
        } else if (pn >= 19) {
            g2::bf16_t* base = w.GM() + (size_t)(pn - 19) * 256 + cc0;
            MK_ROWS_BEGIN
                float o0[8], o1[8];
#pragma unroll
                for (int e = 0; e < 8; ++e) { o0[e] = fsig(v0[e]); o1[e] = fsig(v1[e]); }
                g2::bf16_t* p = base + (size_t)MK_ROW * 4096; st16(p, pack8(o0)); st16(p + 128, pack8(o1));
            MK_ROWS_END
        } else if (pn >= 5 && pn < 9) {
            g2::bf16_t* base = w.XC() + (pn - 5) * 128 + cc0;
            MK_ROWS_BEGIN
                float o[8];
#pragma unroll
                for (int e = 0; e < 8; ++e) o[e] = v0[e] * fsig(v1[e]);
                st16(base + (size_t)MK_ROW * 512, pack8(o));
            MK_ROWS_END
        } else if (pn == 11 || pn == 12 || pn == 15 || pn == 16) {
            g2::bf16_t* base = (pn < 13 ? w.XP() + (pn - 11) * 256 : w.XS() + (pn - 15) * 256) + cc0;
            MK_ROWS_BEGIN
                g2::bf16_t* p = base + (size_t)MK_ROW * 512; st16(p, pack8(v0)); st16(p + 128, pack8(v1));
            MK_ROWS_END
        } else {
            const int br = pn < 5 ? 0 : pn < 11 ? 1 : pn < 15 ? 2 : 3; const int t0 = br == 0 ? 3 : br == 1 ? 9 : br == 2 ? 13 : 17;
            g2::bf16_t* base = w.GATE() + (size_t)br * M * 512 + (pn - t0) * 256 + cc0;
            MK_ROWS_BEGIN
                float o0[8], o1[8];
#pragma unroll
                for (int e = 0; e < 8; ++e) { o0[e] = fsilu(v0[e]); o1[e] = fsilu(v1[e]); }
                g2::bf16_t* p = base + (size_t)MK_ROW * 512; st16(p, pack8(o0)); st16(p + 128, pack8(o1));
            MK_ROWS_END
        }
#undef MK_ROW
    }
};
#define MK1_ROW(ai, m) (rowb + (ai) * 128 + (m) * 16)
__device__ __forceinline__ int glu_orig_col_v2(int row) { const int t = row >> 7, r = row & 127, gi = r >> 3, e = r & 7; return (e < 4 ? 0 : 512) + 64 * t + 4 * gi + (e & 3); }
struct SchedN1 { int c;
    __device__ __forceinline__ bool next(int i, Unit& u) const { if (i > 0 || c >= 256) return false; const int x = c & 7, slot = c >> 3; u.pm = x * 4 + (slot >> 3); u.pn = slot & 7; return true; }
    __device__ __forceinline__ void a_ready(const Unit&) const {}
    __device__ __forceinline__ void done(const Unit&) const {}
};
struct Epi3 {
    static constexpr bool PERM = true, AFTER_DRAIN = false;
    W w;
    __device__ __forceinline__ void operator()(const f32x4 (&acc)[2][1][4][2], const Unit& u, int wr, int wc, int fr, int fq) const {
        int pn_ = __builtin_amdgcn_readfirstlane(u.pn), pm_ = __builtin_amdgcn_readfirstlane(u.pm); asm volatile("" : "+s"(pn_), "+s"(pm_), "+v"(fr), "+v"(fq));
        const int rowb = pm_ * 256 + wr * 64 + fr; g2::bf16_t* base = w.GATE() + (size_t)3 * M * 512 + 64 * pn_ + 16 * wc + 4 * fq;
        unsigned long long gv[2][4];
#pragma unroll
        for (int ai = 0; ai < 2; ++ai)
#pragma unroll
            for (int m = 0; m < 4; ++m) gv[ai][m] = *(const unsigned long long*)(base + (size_t)MK1_ROW(ai, m) * 512);
#pragma unroll
        for (int ai = 0; ai < 2; ++ai)
#pragma unroll
            for (int m = 0; m < 4; ++m) { const f32x4 v = acc[ai][0][m][0], gt = acc[ai][0][m][1]; const unsigned g0 = (unsigned)gv[ai][m], g1 = (unsigned)(gv[ai][m] >> 32);
                const float o0 = v.x * fsig(gt.x) * __uint_as_float(g0 << 16), o1 = v.y * fsig(gt.y) * __uint_as_float(g0 & 0xffff0000u), o2 = v.z * fsig(gt.z) * __uint_as_float(g1 << 16), o3 = v.w * fsig(gt.w) * __uint_as_float(g1 & 0xffff0000u);
                *(unsigned long long*)(base + (size_t)MK1_ROW(ai, m) * 512) = (unsigned long long)pg8::cvt_pk_bf16(o0, o1) | ((unsigned long long)pg8::cvt_pk_bf16(o2, o3) << 32); }
    }
};
struct Epi4a {
    static constexpr bool PERM = true, AFTER_DRAIN = false;
    W w; mutable f32x4 mg[2][4][2];
    __device__ __forceinline__ void operator()(const f32x4 (&acc)[2][1][4][2], const Unit& u, int wr, int wc, int fr, int fq) const {
        int pn_ = __builtin_amdgcn_readfirstlane(u.pn), pm_ = __builtin_amdgcn_readfirstlane(u.pm); asm volatile("" : "+s"(pn_), "+s"(pm_), "+v"(fr), "+v"(fq));
        const int n_ = pn_ >> 3, pn8 = pn_ & 7, rowb = (pm_ & 31) * 256 + wr * 64 + fr, col = pn8 * 128 + wc * 32 + fq * 8;
        u32x4 gv[2][4];
#pragma unroll
        for (int ai = 0; ai < 2; ++ai)
#pragma unroll
            for (int m = 0; m < 4; ++m) gv[ai][m] = *(const u32x4*)(w.GM() + (size_t)MK1_ROW(ai, m) * 4096 + n_ * 1024 + col);
#pragma unroll
        for (int ai = 0; ai < 2; ++ai)
#pragma unroll
            for (int m = 0; m < 4; ++m) { float g[8]; unpack8(gv[ai][m], g);
                const f32x4 p0 = acc[ai][0][m][0] * (f32x4){g[0], g[1], g[2], g[3]}, p1 = acc[ai][0][m][1] * (f32x4){g[4], g[5], g[6], g[7]};
                if (n_ == 0) { mg[ai][m][0] = p0; mg[ai][m][1] = p1; } else { mg[ai][m][0] += p0; mg[ai][m][1] += p1; }
                if (n_ == 3) { const f32x4 a = mg[ai][m][0], b = mg[ai][m][1]; const float o[8] = {a.x, a.y, a.z, a.w, b.x, b.y, b.z, b.w}; st16(w.MRG() + (size_t)MK1_ROW(ai, m) * 1024 + col, pack8(o)); } }
    }
};
struct Sched4a { int c;
    __device__ __forceinline__ bool next(int i, Unit& u) const { if (c >= 256 || i >= 4) return false; const int x = c & 7, slot = c >> 3; u.pm = x * 4 + (slot >> 3) + 32 * i; u.pn = (slot & 7) + 8 * i; return true; }
    __device__ __forceinline__ void a_ready(const Unit&) const {}
    __device__ __forceinline__ void done(const Unit&) const {}
};
constexpr int CW_PANEL = 10240, RMS_P_OFF = 133120, RMS_S_OFF = RMS_P_OFF + 4096;
constexpr size_t WS_RMSX = g2::WS_S + 4 * g2::MiB;
struct Epi4b {
    static constexpr bool PERM = true, AFTER_DRAIN = false;
    InP in; W w; int l;
    __device__ __forceinline__ void operator()(const f32x4 (&acc)[2][1][4][2], const Unit& u, int wr, int wc, int fr, int fq) const {
        int pn_ = __builtin_amdgcn_readfirstlane(u.pn), pm_ = __builtin_amdgcn_readfirstlane(u.pm); asm volatile("" : "+s"(pn_), "+s"(pm_), "+v"(fr), "+v"(fq));
        extern __shared__ __attribute__((aligned(16))) unsigned char lds_e_[]; LAS float* P = (LAS float*)((LAS unsigned char*)lds_e_ + RMS_P_OFF); LAS float* S = (LAS float*)((LAS unsigned char*)lds_e_ + RMS_S_OFF);
        const int rowb = pm_ * 256 + wr * 64 + fr, col = pn_ * 128 + wc * 32 + fq * 8, tid_ = mk_fresh_tid();
        const float* gt = w.mod() + ((size_t)l * 3 + g2::row_modj(pm_ * 256)) * 3072 + 2048 + col; const f32x4 g0 = *(const f32x4*)gt, g1 = *(const f32x4*)(gt + 4);
        f32x4 xn[2][4][2];
#pragma unroll
        for (int ai = 0; ai < 2; ++ai)
#pragma unroll
            for (int m = 0; m < 4; ++m) { const float* xr = g2::xrow(in, w, l, MK1_ROW(ai, m)) + col; xn[ai][m][0] = *(const f32x4*)xr; xn[ai][m][1] = *(const f32x4*)(xr + 4); }
#pragma unroll
        for (int ai = 0; ai < 2; ++ai)
#pragma unroll
            for (int m = 0; m < 4; ++m) { xn[ai][m][0] += g0 * acc[ai][0][m][0]; xn[ai][m][1] += g1 * acc[ai][0][m][1];
                const f32x4 a = xn[ai][m][0], b = xn[ai][m][1]; float s = (a.x * a.x + a.y * a.y) + (a.z * a.z + a.w * a.w) + (b.x * b.x + b.y * b.y) + (b.z * b.z + b.w * b.w);
                s += __int_as_float(__builtin_amdgcn_ds_swizzle(__float_as_int(s), 0x401f));
                { const auto rr = __builtin_amdgcn_permlane32_swap(__float_as_uint(s), __float_as_uint(s), false, false); s = __uint_as_float(rr[0]) + __uint_as_float(rr[1]); }
                if (fq == 0) P[(ai * 128 + wr * 64 + m * 16 + fr) * 4 + wc] = s; }
        if (l == 0) {
#pragma unroll
            for (int ai = 0; ai < 2; ++ai)
#pragma unroll
                for (int m = 0; m < 4; ++m) { float* o = w.out + (size_t)MK1_ROW(ai, m) * 1024 + col; *(f32x4*)o = xn[ai][m][0]; *(f32x4*)(o + 4) = xn[ai][m][1]; } }
        __syncthreads();
        float* slots = (float*)(w.ws + WS_RMSX) + ((size_t)l * M + pm_ * 256) * 8; unsigned* cnt = w.ctl() + CW_PANEL + 16 * (l * 32 + pm_);
        if (tid_ < 256) { const f32x4 p4 = *(const LAS f32x4*)(P + tid_ * 4); __hip_atomic_store(slots + (size_t)tid_ * 8 + pn_, (p4.x + p4.y) + (p4.z + p4.w), __ATOMIC_RELAXED, __HIP_MEMORY_SCOPE_AGENT); }
        asm volatile("s_waitcnt vmcnt(0)" ::: "memory");
        __syncthreads();
        if (tid_ == 0) { __hip_atomic_fetch_add(cnt, 1u, __ATOMIC_RELAXED, __HIP_MEMORY_SCOPE_AGENT);
            unsigned sp = 0; while (__hip_atomic_load(cnt, __ATOMIC_RELAXED, __HIP_MEMORY_SCOPE_AGENT) < 8u && ++sp < (1u << 22)) __builtin_amdgcn_s_sleep(1);
            __builtin_amdgcn_fence(__ATOMIC_ACQUIRE, "agent"); asm volatile("s_waitcnt vmcnt(0)" ::: "memory"); }
        __syncthreads();
        if (tid_ < 256) { const f32x4 a = *(const f32x4*)(slots + (size_t)tid_ * 8), b = *(const f32x4*)(slots + (size_t)tid_ * 8 + 4); S[tid_] = 1.0f / sqrtf(((a.x + a.y) + (a.z + a.w) + (b.x + b.y) + (b.z + b.w)) * (1.0f / 1024.f) + g2::EPS); }
        __syncthreads();
        if (l == 0) { const float* mo = w.mod() + ((size_t)1 * 3 + g2::row_modj(pm_ * 256)) * 3072; float ng[8], sc[8], sh[8]; ldf8(in->norm_g + 1024 + col, ng); ldf8(mo + 1024 + col, sc); ldf8(mo + col, sh);
#pragma unroll
            for (int ai = 0; ai < 2; ++ai)
#pragma unroll
                for (int m = 0; m < 4; ++m) { const float rr = S[ai * 128 + wr * 64 + m * 16 + fr]; const f32x4 a = xn[ai][m][0], b = xn[ai][m][1]; const float xv[8] = {a.x, a.y, a.z, a.w, b.x, b.y, b.z, b.w}; float o[8];
#pragma unroll
                    for (int e = 0; e < 8; ++e) o[e] = (xv[e] * rr) * ng[e] * (1.0f + sc[e]) + sh[e];
                    st16(w.H() + (size_t)MK1_ROW(ai, m) * 1024 + col, pack8(o)); } }
        else { float fg[8]; ldf8(in->final_g + col, fg); const f32x4 f0 = {fg[0], fg[1], fg[2], fg[3]}, f1 = {fg[4], fg[5], fg[6], fg[7]};
#pragma unroll
            for (int ai = 0; ai < 2; ++ai)
#pragma unroll
                for (int m = 0; m < 4; ++m) { const float rr = S[ai * 128 + wr * 64 + m * 16 + fr]; float* o = w.out + (size_t)MK1_ROW(ai, m) * 1024 + col; *(f32x4*)o = xn[ai][m][0] * rr * f0; *(f32x4*)(o + 4) = xn[ai][m][1] * rr * f1; } }
    }
};

__device__ __forceinline__ int fresh_grid() { int g = (int)gridDim.x; asm volatile("" : "+s"(g)); return g; }
__device__ __forceinline__ float wave_sum(float v) {
    v += __int_as_float(__builtin_amdgcn_ds_swizzle(__float_as_int(v), 0x041f)); v += __int_as_float(__builtin_amdgcn_ds_swizzle(__float_as_int(v), 0x081f));
    v += __int_as_float(__builtin_amdgcn_ds_swizzle(__float_as_int(v), 0x101f)); v += __int_as_float(__builtin_amdgcn_ds_swizzle(__float_as_int(v), 0x201f));
    v += __int_as_float(__builtin_amdgcn_ds_swizzle(__float_as_int(v), 0x401f));
    const auto rr = __builtin_amdgcn_permlane32_swap(__float_as_uint(v), __float_as_uint(v), false, false);
    return __uint_as_float(rr[0]) + __uint_as_float(rr[1]);
}
template <bool FINAL> __device__ __forceinline__ void ph_rows(InP in, const W& w, int l) {
    const int tid_ = mk_fresh_tid(); const int lane = tid_ & 63, wave = tid_ >> 6;
    const int gw = blockIdx.x * NWAVES + wave, NGW = fresh_grid() * NWAVES;
    for (int m0 = 4 * gw; m0 < M; m0 += 4 * NGW) {
        f32x4 v[4][4], pg[4], ps[4], ph[4];
#pragma unroll
        for (int q = 0; q < 4; ++q) { const float* xr = FINAL ? w.out + (size_t)(m0 + q) * 1024 : g2::xrow(in, w, l, m0 + q);
#pragma unroll
            for (int j = 0; j < 4; ++j) v[q][j] = *(const f32x4*)(xr + 256 * j + 4 * lane); }
        if (FINAL) {
#pragma unroll
            for (int j = 0; j < 4; ++j) pg[j] = *(const f32x4*)(in->final_g + 256 * j + 4 * lane); }
        else { const float* mo = w.mod() + ((size_t)l * 3 + g2::row_modj(m0)) * 3072; const float* g = in->norm_g + l * 1024;
#pragma unroll
            for (int j = 0; j < 4; ++j) { const int k = 256 * j + 4 * lane; pg[j] = *(const f32x4*)(g + k); ps[j] = *(const f32x4*)(mo + 1024 + k); ph[j] = *(const f32x4*)(mo + k); } }
        __builtin_amdgcn_sched_barrier(0);
#pragma unroll
        for (int q = 0; q < 4; ++q) { float s = 0.f;
#pragma unroll
            for (int j = 0; j < 4; ++j) s += (v[q][j].x * v[q][j].x + v[q][j].y * v[q][j].y) + (v[q][j].z * v[q][j].z + v[q][j].w * v[q][j].w);
            const float r = 1.0f / sqrtf(wave_sum(s) * (1.0f / 1024.f) + g2::EPS);
            if (FINAL) {
#pragma unroll
                for (int j = 0; j < 4; ++j) *(f32x4*)(w.out + (size_t)(m0 + q) * 1024 + 256 * j + 4 * lane) = v[q][j] * r * pg[j]; }
            else {
#pragma unroll
                for (int j = 0; j < 4; ++j) { const int k = 256 * j + 4 * lane; const f32x4 o = (v[q][j] * r) * pg[j] * (ps[j] + 1.0f) + ph[j];
                    *(unsigned long long*)(w.H() + (size_t)(m0 + q) * 1024 + k) = (unsigned long long)pg8::cvt_pk_bf16(o.x, o.y) | ((unsigned long long)pg8::cvt_pk_bf16(o.z, o.w) << 32); } } }
    }
}
__device__ __forceinline__ void cvt_item(const float* Wsrc, int ldw, int oc, g2::bf16_t* WT, int K, int k0, LAS float* scr, int lane) {
    float v[64];
#pragma unroll
    for (int kk = 0; kk < 64; ++kk) v[kk] = Wsrc[(size_t)(k0 + kk) * ldw + oc];
#pragma unroll
    for (int kk = 0; kk < 64; ++kk) scr[kk * 64 + (lane ^ (8 * (kk >> 3)))] = v[kk];
    asm volatile("s_waitcnt lgkmcnt(0)" ::: "memory");
    const int c = lane & 7;
#pragma unroll
    for (int j = 0; j < 8; ++j) { const int n = (lane >> 3) + 8 * j; const LAS float* s_ = scr + (8 * c) * 64 + (n ^ (8 * c));
        u32x4 o; o.x = pg8::cvt_pk_bf16(s_[0 * 64], s_[1 * 64]); o.y = pg8::cvt_pk_bf16(s_[2 * 64], s_[3 * 64]); o.z = pg8::cvt_pk_bf16(s_[4 * 64], s_[5 * 64]); o.w = pg8::cvt_pk_bf16(s_[6 * 64], s_[7 * 64]);
        *(u32x4*)(WT + (size_t)n * K + k0 + 8 * c) = o; }
    asm volatile("s_waitcnt lgkmcnt(0)" ::: "memory");
}
constexpr int CV_I_IN = 16 * (INC / 64), CV_I_GLU = 8 * 16, CV_I_BR = 8 * 16, CV_I_OUT = 16 * 16;
__device__ __forceinline__ void cvt_in_item(InP in, const W& w, int l, int r, LAS float* scr, int lane) {
    const int kb = r / (INC / 64), n0 = (r % (INC / 64)) * 64; const int oca = g2::in_orig_col(n0), ocb = g2::in_orig_col(n0 + 32);
    if (oca >= g2::C_XPOOL && oca < g2::C_XPOOL + 512) return;
    cvt_item(in->w_in + (size_t)l * 1024 * INC, INC, (lane < 32 ? oca : ocb) + (lane & 31), w.win() + ((size_t)l * INC + n0) * 1024, 1024, kb * 64, scr, lane);
}
__device__ __forceinline__ void ph_convert(InP in, const W& w, LAS unsigned char* L) {
    const int tid_ = mk_fresh_tid(); const int lane = tid_ & 63, wave = tid_ >> 6;
    LAS float* scr = (LAS float*)(L + wave * 16384);
    const int gw = blockIdx.x * NWAVES + wave, NGW = fresh_grid() * NWAVES;
    for (int it = gw; it < CV_I_IN; it += NGW) cvt_in_item(in, w, 0, it, scr, lane);
}
constexpr int CV_DEF_WAVE_ITEMS = CV_I_IN + 2 * CV_I_GLU + 8 * CV_I_BR + 2 * CV_I_OUT, CV_DEF_BLOCK_ITEMS = CV_DEF_WAVE_ITEMS / 8;
static_assert(CV_DEF_WAVE_ITEMS % 8 == 0, "deferred conversion items come in groups of 8 (one per wave)");
__device__ __forceinline__ void cvt_deferred_item(InP in, const W& w, LAS unsigned char* L, int bi, int tid_) {
    const int lane = tid_ & 63, wave = tid_ >> 6; LAS float* scr = (LAS float*)(L + wave * 16384);
    int r = bi * 8 + wave;
    if (r < CV_I_IN) { cvt_in_item(in, w, 1, r, scr, lane); return; }
    r -= CV_I_IN;
    if (r < 2 * CV_I_GLU) { const int l = r / CV_I_GLU; r -= l * CV_I_GLU; const int kb = r / 16, n0 = (r % 16) * 64;
        cvt_item(in->glu_w + (size_t)l * 512 * 1024, 1024, glu_orig_col_v2(n0 + lane), w.wglu() + ((size_t)l * 1024 + n0) * 512, 512, kb * 64, scr, lane); return; }
    r -= 2 * CV_I_GLU;
    if (r < 8 * CV_I_BR) { const int ln = r / CV_I_BR; r -= ln * CV_I_BR; const int kb = r / 16, n0 = (r % 16) * 64;
        cvt_item(in->w_br + (size_t)ln * 512 * 1024, 1024, n0 + lane, w.wbr() + ((size_t)ln * 1024 + n0) * 512, 512, kb * 64, scr, lane); return; }
    r -= 8 * CV_I_BR;
    { const int l = r / CV_I_OUT; r -= l * CV_I_OUT; const int kb = r / 16, n0 = (r % 16) * 64;
      cvt_item(in->w_out + (size_t)l * 1024 * 1024, 1024, n0 + lane, w.wout() + ((size_t)l * 1024 + n0) * 1024, 1024, kb * 64, scr, lane); }
}
__device__ __forceinline__ void ph_mod(InP in, const W& w, LAS unsigned char* L) {
    const int tid_ = mk_fresh_tid();
    LAS float* sc = (LAS float*)L;
    LAS float* red = (LAS float*)(L + 12288);
    const int G_ = fresh_grid();
    if ((int)blockIdx.x >= 192) return;
    for (int i = tid_; i < 3 * 1024; i += NTHREADS) { const int j = i >> 10, k = i & 1023; const float v = j == 0 ? in->c_ctx[k] : in->c[(size_t)(j - 1) * 1024 + k]; sc[i] = v * fsig(v); }
    __syncthreads();
    for (int it = blockIdx.x; it < 192; it += G_) { const int l = it / 96, n = (it % 96) * 32 + (tid_ & 31), ks = tid_ >> 5; const float* wa = in->w_ada + ((size_t)l * 1024 + ks * 64) * 3072 + n;
        float a0 = 0.f, a1 = 0.f, a2 = 0.f;
#pragma unroll 16
        for (int kk = 0; kk < 64; ++kk) { const float wv = wa[(size_t)kk * 3072]; const int k = ks * 64 + kk; a0 += sc[k] * wv; a1 += sc[1024 + k] * wv; a2 += sc[2048 + k] * wv; }
        red[(ks * 3 + 0) * 32 + (tid_ & 31)] = a0; red[(ks * 3 + 1) * 32 + (tid_ & 31)] = a1; red[(ks * 3 + 2) * 32 + (tid_ & 31)] = a2;
        __syncthreads();
        if (tid_ < 96) { const int j = tid_ >> 5, cidx = tid_ & 31; float t = 0.f;
#pragma unroll
            for (int q = 0; q < 16; ++q) t += red[(q * 3 + j) * 32 + cidx];
            const int nn = (it % 96) * 32 + cidx; __hip_atomic_store(w.mod() + ((size_t)l * 3 + j) * 3072 + nn, t + in->b_ada[l * 3072 + nn], __ATOMIC_RELAXED, __HIP_MEMORY_SCOPE_AGENT); }
        asm volatile("s_waitcnt vmcnt(0)" ::: "memory");
        __syncthreads();
        if (tid_ == 0) __hip_atomic_fetch_add(w.ctl() + CW_MODDONE, 1u, __ATOMIC_RELAXED, __HIP_MEMORY_SCOPE_AGENT); }
}
__device__ __forceinline__ void poolfold_item(InP in, const W& w, LAS unsigned char* L, int it, int tid_) {
    LAS float* A = (LAS float*)(L + 16384);
    LAS float* B = (LAS float*)(L + 16384 + 32768);
    const int l = it >> 6, g = (it >> 4) & 3, k0 = (it & 15) * 64, cg = tid_ & 31, kg = tid_ >> 5;
    __syncthreads();
    for (int i = tid_; i < 64 * 32; i += NTHREADS) *(LAS f32x4*)(A + 4 * i) = *(const f32x4*)(in->w_in + ((size_t)l * 1024 + k0 + (i >> 5)) * INC + g2::C_XPOOL + g * 128 + 4 * (i & 31));
    for (int i = tid_; i < 128 * 32; i += NTHREADS) *(LAS f32x4*)(B + 4 * i) = *(const f32x4*)(in->pool_w + ((size_t)l * 4 + g) * 128 * 128 + 4 * i);
    __syncthreads();
    f32x4 acc[4];
#pragma unroll
    for (int kk = 0; kk < 4; ++kk) acc[kk] = (f32x4){0.f, 0.f, 0.f, 0.f};
#pragma unroll 2
    for (int ci = 0; ci < 128; ci += 4) { f32x4 bv[4], av[4];
#pragma unroll
        for (int j = 0; j < 4; ++j) bv[j] = *(const LAS f32x4*)(B + (ci + j) * 128 + 4 * cg);
#pragma unroll
        for (int kk = 0; kk < 4; ++kk) av[kk] = *(const LAS f32x4*)(A + (4 * kg + kk) * 128 + ci);
#pragma unroll
        for (int kk = 0; kk < 4; ++kk) acc[kk] += bv[0] * av[kk].x + bv[1] * av[kk].y + bv[2] * av[kk].z + bv[3] * av[kk].w; }
    const f32x4 sc_ = *(const f32x4*)(in->pool_scale + l * 512 + g * 128 + 4 * cg);
#pragma unroll
    for (int kk = 0; kk < 4; ++kk) acc[kk] = acc[kk] * sc_;
    g2::bf16_t* dst = w.win() + ((size_t)l * INC + 11 * 256 + g * 128 + 4 * cg) * 1024 + k0 + 4 * kg;
    *(unsigned long long*)(dst) = (unsigned long long)pg8::cvt_pk_bf16(acc[0].x, acc[1].x) | ((unsigned long long)pg8::cvt_pk_bf16(acc[2].x, acc[3].x) << 32);
    *(unsigned long long*)(dst + 1024) = (unsigned long long)pg8::cvt_pk_bf16(acc[0].y, acc[1].y) | ((unsigned long long)pg8::cvt_pk_bf16(acc[2].y, acc[3].y) << 32);
    *(unsigned long long*)(dst + 2048) = (unsigned long long)pg8::cvt_pk_bf16(acc[0].z, acc[1].z) | ((unsigned long long)pg8::cvt_pk_bf16(acc[2].z, acc[3].z) << 32);
    *(unsigned long long*)(dst + 3072) = (unsigned long long)pg8::cvt_pk_bf16(acc[0].w, acc[1].w) | ((unsigned long long)pg8::cvt_pk_bf16(acc[2].w, acc[3].w) << 32);
}
__device__ __forceinline__ void ph_poolfold(InP in, const W& w, LAS unsigned char* L) {
    const int tid_ = mk_fresh_tid(); const int G_ = fresh_grid();
    for (int it = G_ - 1 - (int)blockIdx.x; it < 64; it += G_) poolfold_item(in, w, L, it, tid_);
}
constexpr int CW_CVTQ = CW_QUEUE + 64 * 2, CV_IN_BLOCK_ITEMS = CV_I_IN / 8, DEF_ITEMS = 64 + (CV_DEF_BLOCK_ITEMS - CV_IN_BLOCK_ITEMS);
__device__ __forceinline__ void ph_deferred(InP in, const W& w, LAS unsigned char* L, volatile LAS unsigned* MISC) {
    const int tid_ = mk_fresh_tid(); unsigned* ctr = w.ctl() + CW_CVTQ;
    for (;;) {
        __syncthreads();
        if (tid_ == 0) MISC[0] = __hip_atomic_fetch_add(ctr, 1u, __ATOMIC_RELAXED, __HIP_MEMORY_SCOPE_AGENT);
        __syncthreads();
        const int idx = (int)__builtin_amdgcn_readfirstlane(MISC[0]);
        if (idx >= DEF_ITEMS) break;
        int t_ = tid_; asm volatile("" : "+v"(t_));
        if (idx < 64) poolfold_item(in, w, L, 64 + idx, t_); else cvt_deferred_item(in, w, L, idx - 64 + CV_IN_BLOCK_ITEMS, t_);
    }
}
__device__ __forceinline__ void convpool_unit(InP in, const W& w, int l, LAS unsigned char* L, int u, int tid_) {
    const int c = tid_, lane = tid_ & 63, wave = tid_ >> 6;
    LAS float* Y = (LAS float*)L;
    const int m0 = u * 16, s0 = g2::row_seq0(m0), Lseq = g2::row_len(m0), t0 = m0 - s0;
    g2::bf16_t rawp[32], gr[16]; g2::bf16_t* gp2 = w.GATE() + ((size_t)2 * M + m0) * 512 + c;
#pragma unroll
    for (int i = 0; i < 32; ++i) { const int t = t0 - 8 + i; const int tc = t < 0 ? 0 : (t >= Lseq ? Lseq - 1 : t); rawp[i] = w.XP()[(size_t)(s0 + tc) * 512 + c]; }
#pragma unroll
    for (int tt = 0; tt < 16; ++tt) gr[tt] = gp2[(size_t)tt * 512];
    g2::bf16_t rawc[46];
#pragma unroll
    for (int i = 0; i < 46; ++i) { const int t = t0 - 15 + i; const int tc = t < 0 ? 0 : (t >= Lseq ? Lseq - 1 : t); rawc[i] = w.XC()[(size_t)(s0 + tc) * 512 + c]; }
    __builtin_amdgcn_sched_barrier(0);
    { float xp[32];
#pragma unroll
      for (int i = 0; i < 32; ++i) { const int t = t0 - 8 + i; xp[i] = (t >= 0 && t < Lseq) ? g2::bf2f(rawp[i]) : 0.f; }
      const int grp = c >> 7;
#pragma unroll
      for (int tt = 0; tt < 16; ++tt) { float s2 = xp[tt + 7] + xp[tt + 8], s4 = s2 + xp[tt + 6] + xp[tt + 9], s8 = s4 + (xp[tt + 4] + xp[tt + 5]) + (xp[tt + 10] + xp[tt + 11]);
          float s16 = s8 + ((xp[tt] + xp[tt + 1]) + (xp[tt + 2] + xp[tt + 3])) + ((xp[tt + 12] + xp[tt + 13]) + (xp[tt + 14] + xp[tt + 15]));
          const float sum = grp == 0 ? s2 : grp == 1 ? s4 : grp == 2 ? s8 : s16; const int hw = 1 << grp;
          const int t = t0 + tt; const int lo = t - hw < 0 ? 0 : t - hw, hi = t + hw > Lseq ? Lseq : t + hw;
          gp2[(size_t)tt * 512] = g2::f2bf((sum / (float)(hi - lo) - xp[tt + 8]) * g2::bf2f(gr[tt])); } }
    float wj[31];
#pragma unroll
    for (int j = 0; j < 31; ++j) wj[j] = in->conv_dw[((size_t)l * 31 + j) * 512 + c];
    const float bias = in->conv_db[l * 512 + c];
    float lg[8], lb[8]; ldf8(in->conv_ln_g + l * 512 + 8 * lane, lg); ldf8(in->conv_ln_b + l * 512 + 8 * lane, lb);
    u32x4 gt1[2];
#pragma unroll
    for (int q = 0; q < 2; ++q) gt1[q] = *(const u32x4*)(w.GATE() + ((size_t)1 * M + m0 + wave * 2 + q) * 512 + 8 * lane);
    __builtin_amdgcn_sched_barrier(0);
    { float acc[16];
#pragma unroll
      for (int tt = 0; tt < 16; ++tt) acc[tt] = bias;
#pragma unroll
      for (int i = 0; i < 46; ++i) { const int t = t0 - 15 + i; const float x = (t >= 0 && t < Lseq) ? g2::bf2f(rawc[i]) : 0.f;
#pragma unroll
          for (int tt = 0; tt < 16; ++tt) { const int j = i - tt; if (j >= 0 && j < 31) acc[tt] += x * wj[j]; } }
#pragma unroll
      for (int tt = 0; tt < 16; ++tt) Y[tt * 512 + c] = acc[tt]; }
    __syncthreads();
#pragma unroll
    for (int q = 0; q < 2; ++q) { const int tt = wave * 2 + q; float y[8]; const f32x4 a = *(const LAS f32x4*)(Y + tt * 512 + 8 * lane), b = *(const LAS f32x4*)(Y + tt * 512 + 8 * lane + 4);
        y[0] = a.x; y[1] = a.y; y[2] = a.z; y[3] = a.w; y[4] = b.x; y[5] = b.y; y[6] = b.z; y[7] = b.w; float s_ = 0.f;
#pragma unroll
        for (int e = 0; e < 8; ++e) s_ += y[e];
        const float mu = wave_sum(s_) * (1.0f / 512.f); float q2 = 0.f;
#pragma unroll
        for (int e = 0; e < 8; ++e) { y[e] -= mu; q2 += y[e] * y[e]; }
        const float rs = 1.0f / sqrtf(wave_sum(q2) * (1.0f / 512.f) + g2::EPS);
        float gt[8], o[8]; unpack8(gt1[q], gt);
#pragma unroll
        for (int e = 0; e < 8; ++e) o[e] = fsilu(y[e] * rs * lg[e] + lb[e]) * gt[e];
        st16(w.GATE() + ((size_t)1 * M + m0 + tt) * 512 + 8 * lane, pack8(o)); }
    __syncthreads();
}

constexpr size_t WS_BB = 3 * g2::MiB, WS_CC = 3 * g2::MiB + 512 * 1024;
struct FSsmTab { InP in; W w;
    __device__ __forceinline__ void operator()(long i) const { const int p = i % 64, g = (i / 64) % 32; const long ld = i / (64 * 32);
        const float lr = in->lam_re[i], li = in->lam_im[i]; const float dt = expf(in->log_dt[ld * 32 + g]);
        const float e = expf(lr * dt), br_ = e * cosf(li * dt), bi_ = e * sinf(li * dt); w.lamb()[2 * i] = br_; w.lamb()[2 * i + 1] = bi_;
        const float nr = br_ - 1.0f, ni = bi_, den = lr * lr + li * li, fr = (nr * lr + ni * li) / den, fi = (ni * lr - nr * li) / den;
        g2::bf16_t* bb = (g2::bf16_t*)(w.ws + WS_BB) + ((size_t)(ld * 32 + g) * 2 * 64 + p) * 16; g2::bf16_t* cc = (g2::bf16_t*)(w.ws + WS_CC) + (size_t)(ld * 32 + g) * 16 * 128 + 2 * p;
        for (int c = 0; c < 16; ++c) { const float xr = in->b_re[i * 16 + c], xi = in->b_im[i * 16 + c]; bb[c] = g2::f2bf(fr * xr - fi * xi); bb[64 * 16 + c] = g2::f2bf(fr * xi + fi * xr);
            cc[c * 128] = g2::f2bf(in->c_re[((ld * 32 + g) * 16 + c) * 64 + p]); cc[c * 128 + 1] = g2::f2bf(-in->c_im[((ld * 32 + g) * 16 + c) * 64 + p]); } } };

typedef short bf16x8_t __attribute__((ext_vector_type(8)));
typedef float f32x2_t __attribute__((ext_vector_type(2)));
constexpr int SSM_WAVE_LDS = 12800, SSM_HROW = 272, SSM_XCH = 8 * SSM_WAVE_LDS;
__device__ __forceinline__ float fgelu(float x) { const float u = 0.7978845608028654f * (x + 0.044715f * x * x * x); return x * fsig(2.0f * u); }

template <int MODE> __device__ __forceinline__ void ssm_pass(const W& w, int l, int dir, int g, int m_lo, int ntok, float& hr, float& hi, LAS unsigned char* wl, int lane, float dval) {
    LAS unsigned* BUH = (LAS unsigned*)wl; LAS unsigned char* Hb = wl + 8192;
    const int ld = l * 2 + dir, fr = lane & 15, fq = lane >> 4;
    const f32x2_t lam = *(const f32x2_t*)(w.lamb() + ((size_t)(ld * 32 + g) * 64 + lane) * 2);
    bf16x8_t bfr[4][2], cfr[4];
    { const g2::bf16_t* bb = (const g2::bf16_t*)(w.ws + WS_BB) + (size_t)(ld * 32 + g) * 2 * 64 * 16;
#pragma unroll
      for (int q = 0; q < 4; ++q)
#pragma unroll
          for (int ri = 0; ri < 2; ++ri) { const bf16x8_t t_ = *(const bf16x8_t*)(bb + ((size_t)ri * 64 + 16 * q + fr) * 16 + 8 * (fq & 1)); bfr[q][ri] = fq < 2 ? t_ : (bf16x8_t){0, 0, 0, 0, 0, 0, 0, 0}; }
      if (MODE != 0) { const g2::bf16_t* cc = (const g2::bf16_t*)(w.ws + WS_CC) + ((size_t)(ld * 32 + g) * 16 + fr) * 128;
#pragma unroll
          for (int ks = 0; ks < 4; ++ks) cfr[ks] = *(const bf16x8_t*)(cc + 32 * ks + 8 * fq); } }
    const int nch = ntok >> 4; const g2::bf16_t* xs = w.XS() + (size_t)g * 16;
    auto chunk_row = [&](int ci) { return dir == 0 ? m_lo + 16 * ci : m_lo + ntok - 16 - 16 * ci; };
    struct Pre { bf16x8_t a; g2::bf16_t x[4]; float yf[4]; };
    auto fetch = [&](int ci, Pre& P) { if (ci < nch) { const int mn = chunk_row(ci); P.a = *(const bf16x8_t*)(xs + (size_t)(mn + fr) * 512 + 8 * (fq & 1));
            if (MODE != 0) {
#pragma unroll
                for (int r = 0; r < 4; ++r) { const size_t o = (size_t)(mn + 4 * fq + r) * 512 + g * 16 + fr; P.x[r] = w.XS()[o]; if (MODE == 2) P.yf[r] = w.TMP()[o]; } } } };
    auto step = [&](int ci, Pre& P) {
        const int mt = chunk_row(ci); const bf16x8_t a = fq < 2 ? P.a : (bf16x8_t){0, 0, 0, 0, 0, 0, 0, 0}; float xc[4], yfc[4];
#pragma unroll
        for (int r = 0; r < 4; ++r) { xc[r] = g2::bf2f(P.x[r]); yfc[r] = P.yf[r]; }
        fetch(ci + 2, P);
#pragma unroll
        for (int q = 0; q < 4; ++q) { const f32x4 z = {0.f, 0.f, 0.f, 0.f};
            const f32x4 dre = __builtin_amdgcn_mfma_f32_16x16x32_bf16(a, bfr[q][0], z, 0, 0, 0), dim = __builtin_amdgcn_mfma_f32_16x16x32_bf16(a, bfr[q][1], z, 0, 0, 0);
#pragma unroll
            for (int r = 0; r < 4; ++r) BUH[(4 * fq + r) * 64 + 16 * q + fr] = cvtpk_c(dre[r], dim[r]); }
        unsigned bq[16];
#pragma unroll
        for (int s_ = 0; s_ < 16; ++s_) bq[s_] = BUH[(dir == 0 ? s_ : 15 - s_) * 64 + lane];
        unsigned hw[16];
#pragma unroll
        for (int s_ = 0; s_ < 16; ++s_) { const float nr = lam.x * hr - lam.y * hi + __uint_as_float(bq[s_] << 16), ni = lam.x * hi + lam.y * hr + __uint_as_float(bq[s_] & 0xffff0000u); hr = nr; hi = ni; if (MODE != 0) hw[s_] = pg8::cvt_pk_bf16(hr, hi); }
        if (MODE != 0) {
#pragma unroll
            for (int s_ = 0; s_ < 16; ++s_) *(LAS unsigned*)(Hb + (dir == 0 ? s_ : 15 - s_) * SSM_HROW + lane * 4) = hw[s_];
            f32x4 y = {0.f, 0.f, 0.f, 0.f};
#pragma unroll
            for (int ks = 0; ks < 4; ++ks) { const bf16x8_t ha = *(const LAS bf16x8_t*)(Hb + fr * SSM_HROW + 64 * ks + 16 * fq); y = __builtin_amdgcn_mfma_f32_16x16x32_bf16(ha, cfr[ks], y, 0, 0, 0); }
#pragma unroll
            for (int r = 0; r < 4; ++r) { const size_t o = (size_t)(mt + 4 * fq + r) * 512 + g * 16 + fr;
                if (MODE == 1) w.TMP()[o] = y[r] + dval * xc[r]; else w.YS()[o] = g2::f2bf(fgelu(y[r] + yfc[r])); } }
    };
    Pre PA, PB;
#pragma unroll
    for (int r = 0; r < 4; ++r) { PA.x[r] = 0; PA.yf[r] = 0.f; PB.x[r] = 0; PB.yf[r] = 0.f; }
    PA.a = (bf16x8_t){0, 0, 0, 0, 0, 0, 0, 0}; PB.a = PA.a;
    fetch(0, PA); fetch(1, PB);
#pragma unroll 1
    for (int ci = 0; ci < nch; ci += 2) { step(ci, PA); step(ci + 1, PB); }
}
__device__ __forceinline__ void cmul(float& ar, float& ai, float br, float bi) { const float t = ar * br - ai * bi; ai = ar * bi + ai * br; ar = t; }
template <int DIR> __device__ __forceinline__ void ssm_pass0_dir(const W& w, int l, int g, const bf16x8_t (&A)[16], float& er, float& ei, LAS f32x2_t* BU, int lane) {
    const int fr = lane & 15, fq = lane >> 4, ld = l * 2 + DIR;
    bf16x8_t bfr[4][2];
    { const g2::bf16_t* bb = (const g2::bf16_t*)(w.ws + WS_BB) + (size_t)(ld * 32 + g) * 2 * 64 * 16;
#pragma unroll
      for (int q = 0; q < 4; ++q)
#pragma unroll
          for (int ri = 0; ri < 2; ++ri) { const bf16x8_t t_ = *(const bf16x8_t*)(bb + ((size_t)ri * 64 + 16 * q + fr) * 16 + 8 * (fq & 1)); bfr[q][ri] = fq < 2 ? t_ : (bf16x8_t){0, 0, 0, 0, 0, 0, 0, 0}; } }
    float l1r[4], l1i[4], l16r[4], l16i[4], wr_[4], wi_[4], sr[4], si[4];
#pragma unroll
    for (int q = 0; q < 4; ++q) { const f32x2_t lam = *(const f32x2_t*)(w.lamb() + ((size_t)(ld * 32 + g) * 64 + 16 * q + fr) * 2); l1r[q] = lam.x; l1i[q] = lam.y;
        float p4r = lam.x, p4i = lam.y; cmul(p4r, p4i, p4r, p4i); cmul(p4r, p4i, p4r, p4i);
        float p8r = p4r, p8i = p4i; cmul(p8r, p8i, p8r, p8i);
        float p16r = p8r, p16i = p8i; cmul(p16r, p16i, p16r, p16i);
        l16r[q] = p16r; l16i[q] = p16i;
        const int k = DIR == 0 ? 3 - fq : fq;
        float p12r = p8r, p12i = p8i; cmul(p12r, p12i, p4r, p4i);
        wr_[q] = k == 0 ? 1.f : k == 1 ? p4r : k == 2 ? p8r : p12r; wi_[q] = k == 0 ? 0.f : k == 1 ? p4i : k == 2 ? p8i : p12i; sr[q] = 0.f; si[q] = 0.f; }
#pragma unroll
    for (int cc = 0; cc < 16; ++cc) { const bf16x8_t a = fq < 2 ? A[DIR == 0 ? cc : 15 - cc] : (bf16x8_t){0, 0, 0, 0, 0, 0, 0, 0};
#pragma unroll
        for (int q = 0; q < 4; ++q) { const f32x4 z = {0.f, 0.f, 0.f, 0.f};
            const f32x4 dre = __builtin_amdgcn_mfma_f32_16x16x32_bf16(a, bfr[q][0], z, 0, 0, 0), dim = __builtin_amdgcn_mfma_f32_16x16x32_bf16(a, bfr[q][1], z, 0, 0, 0);
            float hr, hi;
            if (DIR == 0) { hr = dre[0]; hi = dim[0];
#pragma unroll
                for (int r = 1; r < 4; ++r) { cmul(hr, hi, l1r[q], l1i[q]); hr += dre[r]; hi += dim[r]; } }
            else { hr = dre[3]; hi = dim[3];
#pragma unroll
                for (int r = 2; r >= 0; --r) { cmul(hr, hi, l1r[q], l1i[q]); hr += dre[r]; hi += dim[r]; } }
            cmul(sr[q], si[q], l16r[q], l16i[q]); sr[q] += hr; si[q] += hi; }
        __builtin_amdgcn_sched_barrier(0); }
#pragma unroll
    for (int q = 0; q < 4; ++q) { cmul(sr[q], si[q], wr_[q], wi_[q]); BU[(DIR * 4 + fq) * 64 + 16 * q + fr] = (f32x2_t){sr[q], si[q]}; }
    const f32x2_t e0 = BU[(DIR * 4 + 0) * 64 + lane], e1 = BU[(DIR * 4 + 1) * 64 + lane], e2 = BU[(DIR * 4 + 2) * 64 + lane], e3 = BU[(DIR * 4 + 3) * 64 + lane];
    er = (e0.x + e1.x) + (e2.x + e3.x); ei = (e0.y + e1.y) + (e2.y + e3.y);
}
template <int DIR> __device__ __forceinline__ void ssm_pass0_dir(const W& w, int l, int g, float& er, float& ei, LAS unsigned char* wl, int lane) {
    const int fr = lane & 15, fq = lane >> 4, ld = l * 2 + DIR; LAS f32x2_t* XB = (LAS f32x2_t*)(wl + 8192);
    bf16x8_t bfr[4][2];
    { const g2::bf16_t* bb = (const g2::bf16_t*)(w.ws + WS_BB) + (size_t)(ld * 32 + g) * 2 * 64 * 16;
#pragma unroll
      for (int q = 0; q < 4; ++q)
#pragma unroll
          for (int ri = 0; ri < 2; ++ri) { const bf16x8_t t_ = *(const bf16x8_t*)(bb + ((size_t)ri * 64 + 16 * q + fr) * 16 + 8 * (fq & 1)); bfr[q][ri] = fq < 2 ? t_ : (bf16x8_t){0, 0, 0, 0, 0, 0, 0, 0}; } }
    float l1r[4], l1i[4], l16r[4], l16i[4], wr_[4], wi_[4], sr[4], si[4];
#pragma unroll
    for (int q = 0; q < 4; ++q) { const f32x2_t lam = *(const f32x2_t*)(w.lamb() + ((size_t)(ld * 32 + g) * 64 + 16 * q + fr) * 2); l1r[q] = lam.x; l1i[q] = lam.y;
        float p4r = lam.x, p4i = lam.y; cmul(p4r, p4i, p4r, p4i); cmul(p4r, p4i, p4r, p4i);
        float p8r = p4r, p8i = p4i; cmul(p8r, p8i, p8r, p8i);
        float p16r = p8r, p16i = p8i; cmul(p16r, p16i, p16r, p16i);
        l16r[q] = p16r; l16i[q] = p16i;
        const int k = DIR == 0 ? 3 - fq : fq;
        float p12r = p8r, p12i = p8i; cmul(p12r, p12i, p4r, p4i);
        wr_[q] = k == 0 ? 1.f : k == 1 ? p4r : k == 2 ? p8r : p12r; wi_[q] = k == 0 ? 0.f : k == 1 ? p4i : k == 2 ? p8i : p12i; sr[q] = 0.f; si[q] = 0.f; }
    const LAS bf16x8_t* AS = (const LAS bf16x8_t*)wl + (lane & 31);
    bf16x8_t a_n = AS[(DIR == 0 ? 0 : 15) * 32];
#pragma unroll 1
    for (int cc = 0; cc < 16; ++cc) { const bf16x8_t a = fq < 2 ? a_n : (bf16x8_t){0, 0, 0, 0, 0, 0, 0, 0};
        if (cc + 1 < 16) a_n = AS[(DIR == 0 ? cc + 1 : 14 - cc) * 32];
#pragma unroll
        for (int q = 0; q < 4; ++q) { const f32x4 z = {0.f, 0.f, 0.f, 0.f};
            const f32x4 dre = __builtin_amdgcn_mfma_f32_16x16x32_bf16(a, bfr[q][0], z, 0, 0, 0), dim = __builtin_amdgcn_mfma_f32_16x16x32_bf16(a, bfr[q][1], z, 0, 0, 0);
            float hr, hi;
            if (DIR == 0) { hr = dre[0]; hi = dim[0];
#pragma unroll
                for (int r = 1; r < 4; ++r) { cmul(hr, hi, l1r[q], l1i[q]); hr += dre[r]; hi += dim[r]; } }
            else { hr = dre[3]; hi = dim[3];
#pragma unroll
                for (int r = 2; r >= 0; --r) { cmul(hr, hi, l1r[q], l1i[q]); hr += dre[r]; hi += dim[r]; } }
            cmul(sr[q], si[q], l16r[q], l16i[q]); sr[q] += hr; si[q] += hi; } }
#pragma unroll
    for (int q = 0; q < 4; ++q) { cmul(sr[q], si[q], wr_[q], wi_[q]); XB[(DIR * 4 + fq) * 64 + 16 * q + fr] = (f32x2_t){sr[q], si[q]}; }
    const f32x2_t e0 = XB[(DIR * 4 + 0) * 64 + lane], e1 = XB[(DIR * 4 + 1) * 64 + lane], e2 = XB[(DIR * 4 + 2) * 64 + lane], e3 = XB[(DIR * 4 + 3) * 64 + lane];
    er = (e0.x + e1.x) + (e2.x + e3.x); ei = (e0.y + e1.y) + (e2.y + e3.y);
}
__device__ __forceinline__ void ssm_pass0(const W& w, int l, int g, int m_lo, float (&er)[2], float (&ei)[2], LAS unsigned char* wl, int lane) {
    const int fr = lane & 15, fq = lane >> 4; const g2::bf16_t* xs = w.XS() + (size_t)g * 16;
    { bf16x8_t A[16];
#pragma unroll
      for (int ci = 0; ci < 16; ++ci) A[ci] = *(const bf16x8_t*)(xs + (size_t)(m_lo + 16 * ci + fr) * 512 + 8 * (fq & 1));
      LAS bf16x8_t* AS = (LAS bf16x8_t*)wl + (lane & 31);
#pragma unroll
      for (int ci = 0; ci < 16; ++ci) AS[ci * 32] = A[ci]; }
    ssm_pass0_dir<0>(w, l, g, er[0], ei[0], wl, lane); ssm_pass0_dir<1>(w, l, g, er[1], ei[1], wl, lane);
}
__device__ __forceinline__ void ssm_unit(InP in, const W& w, int l, LAS unsigned char* L, int bu, int tid_) {
    const int lane = tid_ & 63, wave = __builtin_amdgcn_readfirstlane(tid_ >> 6);
    LAS unsigned char* wl = L + wave * SSM_WAVE_LDS; LAS f32x2_t* XCH = (LAS f32x2_t*)(L + SSM_XCH);
    {
        if (bu < 64) {
            const int b = bu >> 5, g = bu & 31, m_lo = MP + b * 2048 + wave * 256; const float dval = in->ssm_d[l * 512 + g * 16 + (lane & 15)];
            float e_r[2], e_i[2];
            ssm_pass0(w, l, g, m_lo, e_r, e_i, wl, lane);
            XCH[(wave * 2 + 0) * 64 + lane] = (f32x2_t){e_r[0], e_i[0]}; XCH[(wave * 2 + 1) * 64 + lane] = (f32x2_t){e_r[1], e_i[1]};
            __syncthreads();
            float cr[2], ci[2];
#pragma unroll
            for (int dir = 0; dir < 2; ++dir) { const f32x2_t lam = *(const f32x2_t*)(w.lamb() + ((size_t)((l * 2 + dir) * 32 + g) * 64 + lane) * 2); float pr = lam.x, pi = lam.y;
#pragma unroll
                for (int sq = 0; sq < 8; ++sq) { const float t = pr * pr - pi * pi; pi = 2.f * pr * pi; pr = t; }
                const float* st = in->state_ssm + ((((size_t)b * 2 + l) * 2 + dir) * 2) * 2048 + g * 64 + lane; float hr = st[0], hi = st[2048];
                if (dir == 0) { for (int j = 0; j < wave; ++j) { const f32x2_t e = XCH[(j * 2 + 0) * 64 + lane]; const float t = pr * hr - pi * hi + e.x; hi = pr * hi + pi * hr + e.y; hr = t; } }
                else { for (int j = 7; j > wave; --j) { const f32x2_t e = XCH[(j * 2 + 1) * 64 + lane]; const float t = pr * hr - pi * hi + e.x; hi = pr * hi + pi * hr + e.y; hr = t; } }
                cr[dir] = hr; ci[dir] = hi; }
            ssm_pass<1>(w, l, 0, g, m_lo, 256, cr[0], ci[0], wl, lane, dval); ssm_pass<2>(w, l, 1, g, m_lo, 256, cr[1], ci[1], wl, lane, dval);
            __syncthreads();
        } else {
            const int pair = (bu - 64) * 8 + wave, b = pair >> 5, g = pair & 31, m_lo = b * 256; const float dval = in->ssm_d[l * 512 + g * 16 + (lane & 15)];
            float hr = 0.f, hi = 0.f;
            ssm_pass<1>(w, l, 0, g, m_lo, 256, hr, hi, wl, lane, dval);
            { float* o = w.out + g2::OUT_ST + ((((size_t)b * 2 + l) * 2 + 0) * 2) * 2048 + g * 64 + lane; o[0] = hr; o[2048] = hi; }
            hr = 0.f; hi = 0.f;
            ssm_pass<2>(w, l, 1, g, m_lo, 256, hr, hi, wl, lane, dval);
            { float* o = w.out + g2::OUT_ST + ((((size_t)b * 2 + l) * 2 + 1) * 2) * 2048 + g * 64 + lane; o[0] = hr; o[2048] = hi; }
        }
    }
}


constexpr size_t WS_CK = g2::WS_BBAR, WS_CV = g2::WS_BBAR + 256 * 1024;
struct FCvtCache { InP in; W w;
    __device__ __forceinline__ void operator()(long i) const { const long n = 2L * 2 * 256 * 128; if (i < n) ((g2::bf16_t*)(w.ws + WS_CK))[i] = g2::f2bf(in->cache_k[i]); else ((g2::bf16_t*)(w.ws + WS_CV))[i - n] = g2::f2bf(in->cache_v[i - n]); } };
typedef float f32x16 __attribute__((ext_vector_type(16)));
typedef short s16x4 __attribute__((ext_vector_type(4)));
constexpr int AT_SLOT = 16384, AT_KOFF = 0, AT_VOFF = 8192;
constexpr float AT_C2 = 0.125f * 1.4426950408889634f, AT_LOG2E = 1.4426950408889634f;
__device__ __forceinline__ int at_crow(int r, int hi) { return (r & 3) + 8 * (r >> 2) + 4 * hi; }
__device__ __forceinline__ float at_rowmax(const f32x16& p0, const f32x16& p1) { float a = fmaxf(p0[0], p1[0]);
#pragma unroll
    for (int r = 1; r < 16; ++r) a = fmaxf(a, fmaxf(p0[r], p1[r]));
    const auto rr = __builtin_amdgcn_permlane32_swap(__float_as_uint(a), __float_as_uint(a), false, false); return fmaxf(__uint_as_float(rr[0]), __uint_as_float(rr[1])); }

__device__ __forceinline__ void attn_unit(InP in, const W& w, int l, LAS unsigned char* L, int u, int tid_) {
    const int lane = tid_ & 63, r32 = lane & 31, hi = lane >> 5, wave = __builtin_amdgcn_readfirstlane(tid_ >> 6);
    {
        int head, kv, mq, qpos, ntile, nctx, klo; const g2::bf16_t *kbase, *vbase, *ckbase, *cvbase;
        if (u < 128) { const int b = u >> 6, rem = u & 63, pb = (rem >> 1) & 15; kv = rem >> 5; head = kv * 4 + (rem & 1) * 2 + (wave >> 2); qpos = pb * 128 + 32 * (wave & 3) + r32; mq = MP + b * 2048 + qpos;
            klo = pb * 128 - 128 < 0 ? 0 : pb * 128 - 128; const int khi = pb * 128 + 256 > 2048 ? 2048 : pb * 128 + 256; nctx = 4; ntile = 4 + (khi - klo) / 64;
            kbase = w.K() + (size_t)(MP + b * 2048 + klo) * 128; vbase = w.V() + (size_t)(MP + b * 2048 + klo) * 128;
            ckbase = (const g2::bf16_t*)(w.ws + WS_CK) + (size_t)(b * 2 + l) * 256 * 128; cvbase = (const g2::bf16_t*)(w.ws + WS_CV) + (size_t)(b * 2 + l) * 256 * 128; }
        else { const int b = (u - 128) >> 3; head = (u - 128) & 7; kv = head >> 2; qpos = 32 * wave + r32; mq = b * 256 + qpos; klo = 0; nctx = 0; ntile = 4;
            kbase = w.K() + (size_t)(b * 256) * 128; vbase = w.V() + (size_t)(b * 256) * 128; ckbase = kbase; cvbase = vbase; }
        bf16x8_t qr[4];
#pragma unroll
        for (int d0 = 0; d0 < 4; ++d0) qr[d0] = *(const bf16x8_t*)(w.Q() + (size_t)mq * 512 + head * 64 + d0 * 16 + hi * 8);
        float mrun = in->attn_sink[l * 8 + head] * AT_LOG2E, lsum = hi == 0 ? 1.0f : 0.0f;
        f32x16 o[2]; o[0] = f32x16{}; o[1] = f32x16{};
        auto ksrc = [&](int i) { const g2::bf16_t* base = i < nctx ? ckbase + (size_t)(64 * i) * 128 : kbase + (size_t)(64 * (i - nctx)) * 128; return base + (size_t)lane * 128 + kv * 64 + 8 * wave; };
        auto vsrc = [&](int i) { const g2::bf16_t* base = i < nctx ? cvbase + (size_t)(64 * i) * 128 : vbase + (size_t)(64 * (i - nctx)) * 128; return base + (size_t)(16 * (wave & 3) + (lane >> 2)) * 128 + kv * 64 + (wave >> 2) * 32 + (lane & 3) * 8; };
        u32x4 kreg = *(const u32x4*)ksrc(0), vreg = *(const u32x4*)vsrc(0);
        __syncthreads();
        *(LAS u32x4*)(L + AT_KOFF + wave * 1024 + lane * 16) = kreg; *(LAS u32x4*)(L + AT_VOFF + wave * 1024 + lane * 16) = vreg;
        __syncthreads();
#pragma unroll 1
        for (int i = 0; i < ntile; ++i) {
            LAS unsigned char* slot = L + (i & 1) * AT_SLOT;
            if (i + 1 < ntile) { kreg = *(const u32x4*)ksrc(i + 1); vreg = *(const u32x4*)vsrc(i + 1); }
            __builtin_amdgcn_sched_barrier(0);
            const int kp0 = klo + 64 * (i - nctx); const int q0 = qpos - r32;
            const bool win = i >= nctx && nctx > 0; const bool skip = win && (kp0 > q0 + 31 + 128 || kp0 + 63 < q0 - 128);
            if (!skip) {
                f32x16 p0 = f32x16{}, p1 = f32x16{};
                { const LAS unsigned char* kb = slot + AT_KOFF + hi * 1024 + r32 * 16;
#pragma unroll
                  for (int d0 = 0; d0 < 4; ++d0) { const bf16x8_t b0 = *(const LAS bf16x8_t*)(kb + d0 * 2048), b1 = *(const LAS bf16x8_t*)(kb + d0 * 2048 + 512);
                      p0 = __builtin_amdgcn_mfma_f32_32x32x16_bf16(b0, qr[d0], p0, 0, 0, 0); p1 = __builtin_amdgcn_mfma_f32_32x32x16_bf16(b1, qr[d0], p1, 0, 0, 0); } }
                if (win && (kp0 + 63 - q0 > 128 || q0 + 31 - kp0 > 128)) {
#pragma unroll
                    for (int r = 0; r < 16; ++r) { const int kk = kp0 + at_crow(r, hi); const int d0_ = qpos - kk, d1_ = qpos - (kk + 32);
                        if (d0_ > 128 || d0_ < -128) p0[r] = -1e30f; if (d1_ > 128 || d1_ < -128) p1[r] = -1e30f; } }
                const float rm = at_rowmax(p0, p1) * AT_C2; const float mnew = fmaxf(mrun, rm); const float alpha = __builtin_amdgcn_exp2f(mrun - mnew); mrun = mnew;
                float psum = 0.f;
#pragma unroll
                for (int r = 0; r < 16; ++r) { p0[r] = __builtin_amdgcn_exp2f(p0[r] * AT_C2 - mnew); p1[r] = __builtin_amdgcn_exp2f(p1[r] * AT_C2 - mnew); psum += p0[r] + p1[r]; }
                lsum = lsum * alpha + psum;
#pragma unroll
                for (int r = 0; r < 16; ++r) { o[0][r] *= alpha; o[1][r] *= alpha; }
                u32x4 pw[4];
#pragma unroll
                for (int s_ = 0; s_ < 4; ++s_) { const f32x16& P = s_ < 2 ? p0 : p1; const int bse = (s_ & 1) * 8;
                    pw[s_] = (u32x4){pg8::cvt_pk_bf16(P[bse], P[bse + 1]), pg8::cvt_pk_bf16(P[bse + 2], P[bse + 3]), pg8::cvt_pk_bf16(P[bse + 4], P[bse + 5]), pg8::cvt_pk_bf16(P[bse + 6], P[bse + 7])}; }
                const unsigned vb = (unsigned)(uintptr_t)(slot + AT_VOFF) + ((lane >> 4) & 1) * 32 + (lane & 3) * 8 + (4 * hi + ((lane & 15) >> 2)) * 64;
#pragma unroll
                for (int d0 = 0; d0 < 2; ++d0) { s16x4 lo[4], hh[4];
#pragma unroll
                    for (int ks = 0; ks < 4; ++ks) {
                        asm volatile("ds_read_b64_tr_b16 %0, %1 offset:%c2" : "=&v"(lo[ks]) : "v"(vb), "i"(d0 * 4096 + ks * 1024) : "memory");
                        asm volatile("ds_read_b64_tr_b16 %0, %1 offset:%c2" : "=&v"(hh[ks]) : "v"(vb), "i"(d0 * 4096 + ks * 1024 + 512) : "memory"); }
                    asm volatile("s_waitcnt lgkmcnt(0)" ::: "memory"); __builtin_amdgcn_sched_barrier(0);
#pragma unroll
                    for (int ks = 0; ks < 4; ++ks) { const bf16x8_t vf = (bf16x8_t){lo[ks][0], lo[ks][1], lo[ks][2], lo[ks][3], hh[ks][0], hh[ks][1], hh[ks][2], hh[ks][3]};
                        o[d0] = __builtin_amdgcn_mfma_f32_32x32x16_bf16(vf, __builtin_bit_cast(bf16x8_t, pw[ks]), o[d0], 0, 0, 0); } }
            }
            if (i + 1 < ntile) { LAS unsigned char* ns = L + ((i + 1) & 1) * AT_SLOT; *(LAS u32x4*)(ns + AT_KOFF + wave * 1024 + lane * 16) = kreg; *(LAS u32x4*)(ns + AT_VOFF + wave * 1024 + lane * 16) = vreg; }
            __syncthreads();
        }
        { const auto rr = __builtin_amdgcn_permlane32_swap(__float_as_uint(lsum), __float_as_uint(lsum), false, false); const float inv = 1.0f / (__uint_as_float(rr[0]) + __uint_as_float(rr[1]));
          g2::bf16_t* gp = w.GATE() + (size_t)mq * 512 + head * 64; unsigned long long gvv[2][4];
#pragma unroll
          for (int d0 = 0; d0 < 2; ++d0)
#pragma unroll
              for (int rq = 0; rq < 4; ++rq) gvv[d0][rq] = *(const unsigned long long*)(gp + 32 * d0 + 8 * rq + 4 * hi);
#pragma unroll
          for (int d0 = 0; d0 < 2; ++d0)
#pragma unroll
              for (int rq = 0; rq < 4; ++rq) { g2::bf16_t* p = gp + 32 * d0 + 8 * rq + 4 * hi; const unsigned long long gv = gvv[d0][rq]; const unsigned g0 = (unsigned)gv, g1 = (unsigned)(gv >> 32);
                  const float a0 = o[d0][4 * rq] * inv * __uint_as_float(g0 << 16), a1 = o[d0][4 * rq + 1] * inv * __uint_as_float(g0 & 0xffff0000u), a2 = o[d0][4 * rq + 2] * inv * __uint_as_float(g1 << 16), a3 = o[d0][4 * rq + 3] * inv * __uint_as_float(g1 & 0xffff0000u);
                  *(unsigned long long*)p = (unsigned long long)pg8::cvt_pk_bf16(a0, a1) | ((unsigned long long)pg8::cvt_pk_bf16(a2, a3) << 32); } }
    }
}


constexpr int MIX_UNITS = 128 + 256 + 512;
__device__ __forceinline__ void ph_mixers(InP in, const W& w, int l, LAS unsigned char* L, volatile LAS unsigned* MISC) {
    const int tid_ = mk_fresh_tid();
    unsigned* ctr = w.ctl() + CW_QUEUE + 64 * l;
    for (;;) {
        __syncthreads();
        if (tid_ == 0) MISC[0] = __hip_atomic_fetch_add(ctr, 1u, __ATOMIC_RELAXED, __HIP_MEMORY_SCOPE_AGENT);
        __syncthreads();
        const int idx = (int)__builtin_amdgcn_readfirstlane(MISC[0]);
        if (idx >= MIX_UNITS + (l == 0 ? CV_IN_BLOCK_ITEMS : 0)) break;
        if (idx >= MIX_UNITS) { int t2_ = tid_; asm volatile("" : "+v"(t2_)); cvt_deferred_item(in, w, L, idx - MIX_UNITS, t2_); continue; }
        int t_ = tid_; asm volatile("" : "+v"(t_));
        if (idx < 128) ssm_unit(in, w, l, L, idx, t_);
        else if (idx < 384) attn_unit(in, w, l, L, idx - 128, t_);
        else convpool_unit(in, w, l, L, idx - 384, t_);
    }
}
struct Args { In in; float* out; unsigned char* ws; };
__device__ __forceinline__ W fresh_w() { const __attribute__((address_space(4))) Args* p = (const __attribute__((address_space(4))) Args*)__builtin_amdgcn_kernarg_segment_ptr(); asm volatile("" : "+s"(p)); W w; w.ws = p->ws; w.out = p->out; return w; }
__device__ __forceinline__ InP fresh_in() { InP p = (InP)__builtin_amdgcn_kernarg_segment_ptr(); asm volatile("" : "+s"(p)); return p; }

template <class F> __device__ __forceinline__ void run_stage(const F& f, long n) {
    const int tid_ = mk_fresh_tid();
    const long stride_ = (long)fresh_grid() * NTHREADS;
    for (long i = (long)blockIdx.x * NTHREADS + tid_; i < n; i += stride_) f(i);
}

__global__ void __launch_bounds__(NTHREADS, 2) mk_fwd(Args a) {
    extern __shared__ __attribute__((aligned(16))) unsigned char lds[];
    LAS unsigned char* L = (LAS unsigned char*)lds;
    volatile LAS unsigned* MISC = (volatile LAS unsigned*)(L + MISC_OFF);
    for (int u = threadIdx.x; u < (LDS_BYTES - LDSCTL_OFF) / 4; u += NTHREADS) ((LAS unsigned*)(L + LDSCTL_OFF))[u] = 0u;
    __syncthreads();
    if ((threadIdx.x & 63) == 0) *(volatile LAS unsigned*)(L + MK_WTAB_OFF + 4 * mk_hw_wave_slot()) = threadIdx.x >> 6;
    __syncthreads();
#define in fresh_in()
#define w fresh_w()
    (void)xcd_barrier_post((unsigned*)w.ctl() + CW_BAR, MISC + 8);
#define BAR() do { XcdBarrier b_; b_.bar = (unsigned*)w.ctl() + CW_BAR; b_.x = xb_xcc_id(); b_.st = MISC + 8; xcd_barrier(b_); } while (0)
    ph_mod(in, w, L); ph_poolfold(in, w, L); __syncthreads(); run_stage(g2::FRope{w}, 2048L * 32); run_stage(FSsmTab{in, w}, 2L * 2 * 32 * 64); run_stage(FCvtCache{in, w}, 2L * 2 * 2 * 256 * 128);
    ph_convert(in, w, L);
    if (mk_fresh_tid() == 0) { unsigned sp = 0; while (__hip_atomic_load(w.ctl() + CW_MODDONE, __ATOMIC_RELAXED, __HIP_MEMORY_SCOPE_AGENT) < 192u && ++sp < (1u << 22)) __builtin_amdgcn_s_sleep(2);
        __builtin_amdgcn_fence(__ATOMIC_ACQUIRE, "agent"); asm volatile("s_waitcnt vmcnt(0)" ::: "memory"); }
    __syncthreads();
    ph_rows<false>(in, w, 0);
    BAR();
#pragma unroll 1
    for (int l = 0; l < 2; ++l) {
        { pg8::Gemm g{w.H(), w.win() + (size_t)l * INC * 1024, M, INC, 1024}; pg8::StaticOrder S; S.init(M, INC, (int)gridDim.x, (int)blockIdx.x); Epi1 E{w, l};
          pg8::gemm_phase<Epi1, pg8::StaticOrder, true, true>(L, g, S, E); }
        if (l == 0) ph_deferred(in, w, L, MISC);
        BAR();
        ph_mixers(in, w, l, L, MISC); BAR();
        { pg8::Gemm g{w.YS(), w.wglu() + (size_t)l * 1024 * 512, M, 1024, 512}; SchedN1 S{(int)blockIdx.x}; Epi3 E{w};
          pg8::gemm_phase<Epi3, SchedN1, true, true, 1>(L, g, S, E); }
        BAR();
        { pg8::Gemm g{w.GATE(), w.wbr() + (size_t)l * 4 * 1024 * 512, 4 * M, 4 * 1024, 512}; Sched4a S{(int)blockIdx.x}; Epi4a E{w};
          pg8::gemm_phase<Epi4a, Sched4a, true, true, 1>(L, g, S, E); }
        BAR();
        { pg8::Gemm g{w.MRG(), w.wout() + (size_t)l * 1024 * 1024, M, 1024, 1024}; SchedN1 S{(int)blockIdx.x}; Epi4b E{in, w, l};
          pg8::gemm_phase<Epi4b, SchedN1, true, true, 1>(L, g, S, E); }
        if (l == 0) BAR();
    }
#undef BAR
#undef in
#undef w
}
}

extern "C" void kernel_launch(void* const* d_in, const int* in_sizes, int n_in, void* d_out, int out_size, void* d_ws, size_t ws_size, hipStream_t stream) {
    static int grid = 0;
    if (grid == 0) {
        if (n_in != 30 || (size_t)out_size != g2::OUT_TOTAL || ws_size < g2::WS_END) { fprintf(stderr, "kernel_launch: unexpected problem shape (n_in %d out %d ws %zu)\n", n_in, out_size, ws_size); grid = -1; return; }
        int dev = 0, cus = 0, per_cu = 0;
        if (hipGetDevice(&dev) != hipSuccess || hipDeviceGetAttribute(&cus, hipDeviceAttributeMultiprocessorCount, dev) != hipSuccess) { grid = -1; return; }
        if (hipFuncSetAttribute((const void*)mk::mk_fwd, hipFuncAttributeMaxDynamicSharedMemorySize, mk::LDS_BYTES) != hipSuccess) { fprintf(stderr, "kernel_launch: hipFuncSetAttribute failed\n"); grid = -1; return; }
        if (hipOccupancyMaxActiveBlocksPerMultiprocessor(&per_cu, (const void*)mk::mk_fwd, mk::NTHREADS, mk::LDS_BYTES) != hipSuccess || per_cu < 1) { fprintf(stderr, "kernel_launch: occupancy query says %d blocks/CU\n", per_cu); (void)hipGetLastError(); grid = -1; return; }
        grid = cus;
    }
    if (grid < 0) return;
    if (hipMemsetAsync((char*)d_ws + g2::WS_CTL, 0, mk::CTL_ZERO_BYTES, stream) != hipSuccess) return;
    mk::Args a{}; const float* ptr[30]; for (int i = 0; i < 30; ++i) ptr[i] = (const float*)d_in[i]; memcpy(&a.in, ptr, sizeof(a.in));
    a.out = (float*)d_out; a.ws = (unsigned char*)d_ws;
    hipLaunchKernelGGL(mk::mk_fwd, dim3(grid), dim3(mk::NTHREADS), mk::LDS_BYTES, stream, a);
}
```
